# Optimizing an MI355X kernel written in HIP

```python
import math
import jax
import jax.numpy as jnp
from jax import lax
import numpy as np

D_MODEL = 1024
BATCH = 16
SEQ = 2048
DEPTH = 2

HEAD_DIM = 64
DIL_CONFIGS = ((128, 1), (512, 4), (2048, 16))
N_DIL_GROUPS = 3
DIL_HEADS = 4
DIL_WIDTH = DIL_HEADS * HEAD_DIM
MOBA_HEADS = 8
MOBA_WIDTH = MOBA_HEADS * HEAD_DIM
MOBA_BLOCK = 256
MOBA_TOPK = 3
MOBA_QCHUNK = 16
RMS_EPS = 1e-6
NEG_INF = -1e30
SPLIT_SIZES = (N_DIL_GROUPS * 3 * DIL_WIDTH, DIL_WIDTH, 3 * MOBA_WIDTH, MOBA_WIDTH, D_MODEL, D_MODEL)
IN_COLS = N_DIL_GROUPS * 3 * DIL_WIDTH + DIL_WIDTH + 4 * MOBA_WIDTH + 2 * D_MODEL

kernel_name = 'hybrid_dilated_moba_gated'


def alibi_slopes(n):
    return jnp.asarray(2.0 ** (-8.0 * np.arange(1, n + 1) / n), dtype=jnp.float32)


def rmsnorm(x, g):
    xf = x.astype(jnp.float32)
    y = xf * lax.rsqrt(jnp.mean(xf * xf, axis=-1, keepdims=True) + RMS_EPS)
    return (y * g.astype(jnp.float32)).astype(x.dtype)


def dilated_band_attention(q, k, v, window, dilation, slopes):
    B, S, H, Dh = q.shape
    d = dilation
    blk = window // dilation
    L = S // d
    nb = -(-L // blk)
    lp = nb * blk

    def to_res(t):
        t = t.astype(jnp.float32).reshape(B, L, d, H, Dh).transpose(0, 3, 2, 1, 4)
        t = jnp.pad(t, ((0, 0), (0, 0), (0, 0), (0, lp - L), (0, 0)))
        return t.reshape(B, H, d, nb, blk, Dh)

    def with_prev(t):
        prev = jnp.pad(t[:, :, :, :-1], ((0, 0), (0, 0), (0, 0), (1, 0), (0, 0), (0, 0)))
        return jnp.concatenate([prev, t], axis=4)

    qb = to_res(q)
    kk = with_prev(to_res(k))
    vv = with_prev(to_res(v))
    s = jnp.einsum('bhrnqd,bhrnkd->bhrnqk', qb, kk) * (Dh ** -0.5)
    qi = jnp.arange(blk)[:, None]
    kj = jnp.arange(2 * blk)[None, :]
    rel = blk + qi - kj
    blk_id = jnp.arange(nb)[:, None, None]
    valid = (rel >= 0) & (rel <= blk) & ((blk_id > 0) | (kj >= blk))
    bias = -slopes[:, None, None] * (rel * d).astype(jnp.float32)
    s = jnp.where(valid[None, None, None], s + bias[None, :, None, None], NEG_INF)
    m = jnp.max(s, axis=-1, keepdims=True)
    p = jnp.exp(s - m)
    den = jnp.sum(p, axis=-1)
    o = jnp.einsum('bhrnqk,bhrnkd->bhrnqd', p, vv) / den[..., None]
    lse = m[..., 0] + jnp.log(den)
    o = o.reshape(B, H, d, lp, Dh)[:, :, :, :L].transpose(0, 3, 2, 1, 4).reshape(B, S, H, Dh)
    lse = lse.reshape(B, H, d, lp)[:, :, :, :L].transpose(0, 3, 2, 1).reshape(B, S, H)
    return o, lse


def moba_attention(q, k, v, slopes):
    B, S, H, Dh = q.shape
    blk = MOBA_BLOCK
    nb = -(-S // blk)
    sp = nb * blk
    qc = MOBA_QCHUNK
    nch = sp // qc
    topk = min(MOBA_TOPK, nb)
    scale = Dh ** -0.5

    def prep(t):
        t = jnp.pad(t.astype(jnp.float32), ((0, 0), (0, sp - S), (0, 0), (0, 0)))
        return t.transpose(0, 2, 1, 3)

    qp, kp, vp = prep(q), prep(k), prep(v)
    kb = kp.reshape(B, H, nb, blk, Dh)
    vb = vp.reshape(B, H, nb, blk, Dh)
    kmean = jnp.mean(kb, axis=3)
    gate = jnp.einsum('bhtd,bhnd->bhtn', qp, kmean)
    qblk = jnp.arange(sp) // blk
    past = jnp.arange(nb)[None, :] < qblk[:, None]
    gate = jnp.where(past, gate, NEG_INF)
    _, sel = lax.top_k(gate, topk)
    sel_ok = sel < qblk[None, None, :, None]

    def chunks(t):
        return jnp.moveaxis(t.reshape(B, H, nch, qc, *t.shape[3:]), 2, 0)

    bidx = jnp.arange(B)[:, None, None, None]
    hidx = jnp.arange(H)[None, :, None, None]
    m = slopes[None, :, None, None]
    koff = jnp.arange(blk)

    def one_chunk(args):
        q_c, sel_c, ok_c, ci = args
        t_pos = ci * qc + jnp.arange(qc)
        c = (ci * qc) // blk
        k_sel = kb[bidx, hidx, sel_c]
        v_sel = vb[bidx, hidx, sel_c]
        s_pos = sel_c[..., None] * blk + koff
        d_sel = (t_pos[:, None, None] - s_pos).astype(jnp.float32)
        s_sel = jnp.einsum('bhqd,bhqnkd->bhqnk', q_c, k_sel) * scale - m[..., None] * d_sel
        s_sel = jnp.where(ok_c[..., None], s_sel, NEG_INF)
        k_own = lax.dynamic_index_in_dim(kb, c, axis=2, keepdims=False)
        v_own = lax.dynamic_index_in_dim(vb, c, axis=2, keepdims=False)
        d_own = t_pos[:, None] - (c * blk + koff)[None, :]
        s_own = jnp.einsum('bhqd,bhkd->bhqk', q_c, k_own) * scale - m * d_own.astype(jnp.float32)
        s_own = jnp.where(d_own >= 0, s_own, NEG_INF)
        s_all = jnp.concatenate([s_sel.reshape(B, H, qc, topk * blk), s_own], axis=-1)
        p = jax.nn.softmax(s_all, axis=-1)
        p_sel = p[..., :topk * blk].reshape(B, H, qc, topk, blk)
        p_own = p[..., topk * blk:]
        return (jnp.einsum('bhqnk,bhqnkd->bhqd', p_sel, v_sel)
                + jnp.einsum('bhqk,bhkd->bhqd', p_own, v_own))

    out = lax.map(one_chunk, (chunks(qp), chunks(sel), chunks(sel_ok), jnp.arange(nch)))
    out = jnp.moveaxis(out, 0, 2).reshape(B, H, sp, Dh)[:, :, :S]
    return out.transpose(0, 2, 1, 3)


def hybrid_layer(x, norm_g, w_in, b_merge, w_pa, w_pb, w_out):
    B, S, _ = x.shape
    h = rmsnorm(x, norm_g)
    proj = jnp.einsum('bsd,dc->bsc', h, w_in)
    offs = [int(o) for o in np.cumsum(SPLIT_SIZES)[:-1]]
    a_qkv, z_a, b_qkv, z_b, r_a, r_b = jnp.split(proj, offs, axis=-1)

    a_qkv = a_qkv.reshape(B, S, N_DIL_GROUPS, 3, DIL_HEADS, HEAD_DIM)
    slopes_a = alibi_slopes(N_DIL_GROUPS * DIL_HEADS).reshape(N_DIL_GROUPS, DIL_HEADS)
    outs, lses = [], []
    for g, (window, dilation) in enumerate(DIL_CONFIGS):
        o, lse = dilated_band_attention(a_qkv[:, :, g, 0], a_qkv[:, :, g, 1], a_qkv[:, :, g, 2],
                                        window, dilation, slopes_a[g])
        outs.append(o)
        lses.append(lse)
    wts = jax.nn.softmax(jnp.stack(lses, axis=0), axis=0)
    attn_a = jnp.sum(wts[..., None] * jnp.stack(outs, axis=0), axis=0).reshape(B, S, DIL_WIDTH)
    y_a = jnp.einsum('bsc,cd->bsd', attn_a.astype(x.dtype) * jax.nn.silu(z_a), w_pa)

    b_qkv = b_qkv.reshape(B, S, 3, MOBA_HEADS, HEAD_DIM)
    attn_b = moba_attention(b_qkv[:, :, 0], b_qkv[:, :, 1], b_qkv[:, :, 2],
                            alibi_slopes(MOBA_HEADS)).reshape(B, S, MOBA_WIDTH)
    y_b = jnp.einsum('bsc,cd->bsd', attn_b.astype(x.dtype) * jax.nn.silu(z_b), w_pb)

    merged = (jax.nn.sigmoid(r_a + b_merge[:D_MODEL]) * y_a
              + jax.nn.sigmoid(r_b + b_merge[D_MODEL:]) * y_b)
    return x + jnp.einsum('bsd,de->bse', merged, w_out)


def setup_inputs(seed: int = 0) -> dict:
    key = jax.random.key(seed)
    ks = jax.random.split(key, 8)
    x = jax.random.normal(ks[0], (BATCH, SEQ, D_MODEL), jnp.float32)
    norm_g = 1.0 + 0.05 * jax.random.normal(ks[1], (DEPTH, D_MODEL), jnp.float32)
    w_in = jax.random.normal(ks[2], (DEPTH, D_MODEL, IN_COLS), jnp.float32) * D_MODEL ** -0.5
    b_merge = 0.1 * jax.random.normal(ks[3], (DEPTH, 2 * D_MODEL), jnp.float32)
    w_pa = jax.random.normal(ks[4], (DEPTH, DIL_WIDTH, D_MODEL), jnp.float32) * DIL_WIDTH ** -0.5
    w_pb = jax.random.normal(ks[5], (DEPTH, MOBA_WIDTH, D_MODEL), jnp.float32) * MOBA_WIDTH ** -0.5
    w_out = jax.random.normal(ks[6], (DEPTH, D_MODEL, D_MODEL), jnp.float32) * D_MODEL ** -0.5
    final_g = 1.0 + 0.05 * jax.random.normal(ks[7], (D_MODEL,), jnp.float32)
    return {'x': x, 'norm_g': norm_g, 'w_in': w_in, 'b_merge': b_merge,
            'w_pa': w_pa, 'w_pb': w_pb, 'w_out': w_out, 'final_g': final_g}


def reference(x, norm_g, w_in, b_merge, w_pa, w_pb, w_out, final_g):
    for layer in range(DEPTH):
        x = hybrid_layer(x, norm_g[layer], w_in[layer], b_merge[layer],
                         w_pa[layer], w_pb[layer], w_out[layer])
    return rmsnorm(x, final_g)
```

```cpp
#include <hip/hip_runtime.h>
#include <cstdio>
#include <cstdint>
namespace pg8 {
#define PG8_LAS __attribute__((address_space(3)))
typedef unsigned short bf16_t;
typedef short bf16x8 __attribute__((ext_vector_type(8)));
typedef float f32x4 __attribute__((ext_vector_type(4)));
typedef unsigned u32x4 __attribute__((ext_vector_type(4)));
constexpr int BM = 256, BK = 64, HALF = 128, HTB = HALF * BK * 2  , STAGE_BYTES = 8 * HTB, NXCD = 8, WGM = 8;
constexpr int EPI_OFF = STAGE_BYTES, EPI_PITCH = 144, EPI_WAVE = 16 * EPI_PITCH;

__host__ __device__ __forceinline__ int lds_byte(int r, int c) { const int st = (r >> 4) * 2 + (c >> 5), rr = r & 15, cc = c & 31, ob = rr * 64 + cc * 2; return st * 1024 + (ob ^ (((ob >> 9) & 1) << 5)); }
__host__ __device__ __forceinline__ void stage_rc(int b, int& R, int& C) { const int st = b / 1024, sb = b % 1024, swz = sb ^ (((sb >> 9) & 1) << 5); R = (st >> 1) * 16 + swz / 64; C = (st & 1) * 32 + (swz % 64) / 2; }
__host__ __device__ __forceinline__ int perm32(int rho) { const int n = rho >> 4, i = rho & 15; return 8 * (i >> 2) + 4 * n + (i & 3); }

struct Unit { int pm, pn; };
struct Gemm { const bf16_t* A; const bf16_t* Bt; int M, N, K, lda; };

struct StaticOrder {
    int nM, nN, nwg, G, c;
    __host__ __device__ void init(int M, int N, int G_, int c_) { nM = M / BM; nN = N / BM; nwg = nM * nN; G = G_; c = c_; }
    __host__ __device__ bool next(int i, Unit& u) const {
        const long L = (long)i * G + c; if (L >= nwg) return false;
        int wgid = (int)L; { const int q = nwg / NXCD, r = nwg % NXCD, xcd = wgid % NXCD, off = wgid / NXCD; wgid = (xcd < r ? xcd * (q + 1) : r * (q + 1) + (xcd - r) * q) + off; }
        const int nig = WGM * nN, gid = wgid / nig, fm = gid * WGM, gsz = (nM - fm) < WGM ? (nM - fm) : WGM;
        u.pm = fm + ((wgid % nig) % gsz); u.pn = (wgid % nig) / gsz; return true;
    }
    __device__ __forceinline__ void a_ready(const Unit&) const {}
    __device__ __forceinline__ void done(const Unit&) const {}
};


template <class Epi, class Sched, bool ALIGN_EPI = false, bool SP2 = false>
__device__ __forceinline__ void gemm_phase(PG8_LAS unsigned char* lds, const Gemm g, const Sched& S, const Epi& E) {
    int tid_ = threadIdx.x; asm volatile("" : "+v"(tid_));
    const int tid = tid_, wid = __builtin_amdgcn_readfirstlane(tid >> 6), lane = tid & 63, wr = wid >> 2, wc = wid & 3, fr = lane & 15, fq = lane >> 4;
    const int K = g.K, nt = K / BK;
    unsigned voffA[2], voffB[2];
#pragma unroll
    for (int i = 0; i < 2; ++i) { int R, C; stage_rc(tid * 16 + i * 8192, R, C); const int Rb = 64 * (R >> 5) + (Epi::PERM ? perm32(R & 31) : (R & 31));
        voffA[i] = (unsigned)(R * g.lda + C) * 2u; voffB[i] = (unsigned)(Rb * K + C) * 2u; }
    const size_t kstep = (size_t)(BK * 2);
    const size_t hstepB = (size_t)32 * K * 2, hstepA = (size_t)HALF * g.lda * 2;
    const size_t tstepB = (size_t)BM * K * 2, tstepA = 2 * hstepA;
    const unsigned ldsw = (unsigned)wid * 1024u;
    const int aoff = lds_byte(wr * 64 + fr, fq * 8), boff = lds_byte(wc * 32 + fr, fq * 8);
#define PG8_SA(b, h) (((b) * 2 + (h)) * HTB)
#define PG8_SB(b, h) ((4 + (b) * 2 + (h)) * HTB)
#define PG8_STAGE(bufoff, gbase, voff) do { _Pragma("unroll") for (int _i = 0; _i < 2; ++_i) \
        __builtin_amdgcn_global_load_lds((const unsigned*)((const char*)(gbase) + (voff)[_i]), (PG8_LAS unsigned*)(lds + (bufoff) + ldsw + _i * 8192), 16, 0, 0); } while (0)
#define PG8_LDA(dst, b, h) do { _Pragma("unroll") for (int m = 0; m < 4; ++m) _Pragma("unroll") for (int k = 0; k < 2; ++k) dst[m][k] = *(const PG8_LAS bf16x8*)(lds + PG8_SA(b, h) + aoff + m * 2048 + k * 1024); } while (0)
#define PG8_LDB(dst, b, h) do { _Pragma("unroll") for (int n = 0; n < 2; ++n) _Pragma("unroll") for (int k = 0; k < 2; ++k) dst[n][k] = *(const PG8_LAS bf16x8*)(lds + PG8_SB(b, h) + boff + n * 2048 + k * 1024); } while (0)
#define PG8_MMA(ai, bj, At, Bt) do { __builtin_amdgcn_s_setprio(1); _Pragma("unroll") for (int m = 0; m < 4; ++m) _Pragma("unroll") for (int n = 0; n < 2; ++n) _Pragma("unroll") for (int k = 0; k < 2; ++k) \
        acc[ai][bj][m][n] = __builtin_amdgcn_mfma_f32_16x16x32_bf16(Bt[n][k], At[m][k], acc[ai][bj][m][n], 0, 0, 0); __builtin_amdgcn_s_setprio(0); } while (0)
#define PG8_WAIT_V(n) asm volatile("s_waitcnt vmcnt(" #n ")" ::: "memory")
#define PG8_WAIT_L(n) asm volatile("s_waitcnt lgkmcnt(" #n ")" ::: "memory")
#define PG8_BAR __builtin_amdgcn_s_barrier()
#define PG8_SCHED __builtin_amdgcn_sched_barrier(0)
    Unit cur, nxt; int ui = 0;
    if (!S.next(0, cur)) return;
    f32x4 acc[2][2][4][2];
#pragma unroll
    for (int a = 0; a < 2; ++a)
#pragma unroll
        for (int b = 0; b < 2; ++b)
#pragma unroll
            for (int m = 0; m < 4; ++m)
#pragma unroll
                for (int n = 0; n < 2; ++n) acc[a][b][m][n] = (f32x4){0.f, 0.f, 0.f, 0.f};
    bf16x8 At[4][2], B0[2][2], B1[2][2];
    const char* cA = (const char*)g.A + (size_t)cur.pm * tstepA; const char* cB = (const char*)g.Bt + (size_t)cur.pn * tstepB;
    S.a_ready(cur);
    if constexpr (SP2) {
        PG8_STAGE(PG8_SB(0, 0), cB, voffB); PG8_STAGE(PG8_SB(0, 1), cB + hstepB, voffB); PG8_STAGE(PG8_SA(0, 0), cA, voffA); PG8_STAGE(PG8_SA(0, 1), cA + hstepA, voffA);
        if (wr == 1) PG8_BAR;
        PG8_WAIT_V(2); PG8_BAR;
        PG8_STAGE(PG8_SB(1, 0), cB + kstep, voffB); PG8_STAGE(PG8_SA(1, 0), cA + kstep, voffA); PG8_STAGE(PG8_SB(1, 1), cB + hstepB + kstep, voffB);
        PG8_WAIT_V(6); PG8_BAR;
    } else {
        PG8_STAGE(PG8_SB(0, 0), cB, voffB); PG8_STAGE(PG8_SA(0, 0), cA, voffA); PG8_STAGE(PG8_SB(0, 1), cB + hstepB, voffB); PG8_STAGE(PG8_SA(0, 1), cA + hstepA, voffA);
        if (wr == 1) PG8_BAR;
        PG8_WAIT_V(4); PG8_BAR;
        PG8_STAGE(PG8_SB(1, 0), cB + kstep, voffB); PG8_STAGE(PG8_SA(1, 0), cA + kstep, voffA); PG8_STAGE(PG8_SB(1, 1), cB + hstepB + kstep, voffB);
        PG8_WAIT_V(6); PG8_BAR;
    }
    for (;;) {
        const bool has_next = S.next(ui + 1, nxt);
        const char* nA = has_next ? (const char*)g.A + (size_t)nxt.pm * tstepA : cA; const char* nB = has_next ? (const char*)g.Bt + (size_t)nxt.pn * tstepB : cB;
        for (int t = 0; t < nt; t += 2) {
            const bool last = (t == nt - 2);
            const char* a1 = cA + (size_t)(t + 1) * kstep;
            const char* a2 = last ? nA : cA + (size_t)(t + 2) * kstep; const char* b2 = last ? nB : cB + (size_t)(t + 2) * kstep;
            const char* a3 = a2 + kstep; const char* b3 = b2 + kstep;
            if (last && has_next) S.a_ready(nxt);
            if constexpr (SP2) {
            PG8_LDB(B0, 0, 0); PG8_LDB(B1, 0, 1); PG8_SCHED; PG8_LDA(At, 0, 0); PG8_STAGE(PG8_SA(1, 1), a1 + hstepA, voffA);
            PG8_WAIT_V(8); PG8_WAIT_L(0); PG8_BAR; PG8_MMA(0, 0, At, B0); PG8_MMA(0, 1, At, B1); PG8_BAR; PG8_SCHED;
            PG8_LDA(At, 0, 1); PG8_STAGE(PG8_SB(0, 0), b2, voffB); PG8_STAGE(PG8_SB(0, 1), b2 + hstepB, voffB); PG8_STAGE(PG8_SA(0, 0), a2, voffA);
            PG8_WAIT_V(8); PG8_WAIT_L(0); PG8_BAR; PG8_MMA(1, 0, At, B0); PG8_MMA(1, 1, At, B1); PG8_BAR; PG8_SCHED;
            PG8_LDB(B0, 1, 0); PG8_LDB(B1, 1, 1); PG8_SCHED; PG8_LDA(At, 1, 0); PG8_STAGE(PG8_SA(0, 1), a2 + hstepA, voffA);
            PG8_WAIT_V(8); PG8_WAIT_L(0); PG8_BAR; PG8_MMA(0, 0, At, B0); PG8_MMA(0, 1, At, B1); PG8_BAR; PG8_SCHED;
            PG8_LDA(At, 1, 1); PG8_STAGE(PG8_SB(1, 0), b3, voffB); PG8_STAGE(PG8_SB(1, 1), b3 + hstepB, voffB); PG8_STAGE(PG8_SA(1, 0), a3, voffA);
            PG8_WAIT_V(8); PG8_WAIT_L(0); PG8_BAR; PG8_MMA(1, 0, At, B0); PG8_MMA(1, 1, At, B1); PG8_BAR; PG8_SCHED;
            if constexpr (Epi::HAS_MID) { if (t == Epi::MID_T) { E.mid(acc, cur, wr, wc, fr, fq, wid); PG8_SCHED; } }
            } else {
            PG8_LDB(B0, 0, 0); PG8_SCHED; PG8_LDA(At, 0, 0); PG8_STAGE(PG8_SA(1, 1), a1 + hstepA, voffA);
            PG8_WAIT_L(8); PG8_BAR; PG8_WAIT_L(0); PG8_MMA(0, 0, At, B0); PG8_BAR; PG8_SCHED;
            PG8_LDB(B1, 0, 1); PG8_STAGE(PG8_SB(0, 0), b2, voffB);
            PG8_BAR; PG8_WAIT_L(0); PG8_MMA(0, 1, At, B1); PG8_BAR;
            PG8_LDA(At, 0, 1); PG8_STAGE(PG8_SA(0, 0), a2, voffA);
            PG8_BAR; PG8_WAIT_L(0); PG8_MMA(1, 0, At, B0); PG8_BAR; PG8_SCHED;
            PG8_STAGE(PG8_SB(0, 1), b2 + hstepB, voffB);
            PG8_WAIT_V(6); PG8_BAR; PG8_MMA(1, 1, At, B1); PG8_BAR;
            PG8_LDB(B0, 1, 0); PG8_SCHED; PG8_LDA(At, 1, 0); PG8_STAGE(PG8_SA(0, 1), a2 + hstepA, voffA);
            PG8_WAIT_L(8); PG8_BAR; PG8_WAIT_L(0); PG8_MMA(0, 0, At, B0); PG8_BAR; PG8_SCHED;
            PG8_LDB(B1, 1, 1); PG8_STAGE(PG8_SB(1, 0), b3, voffB);
            PG8_BAR; PG8_WAIT_L(0); PG8_MMA(0, 1, At, B1); PG8_BAR;
            PG8_LDA(At, 1, 1); PG8_STAGE(PG8_SA(1, 0), a3, voffA);
            PG8_BAR; PG8_WAIT_L(0); PG8_MMA(1, 0, At, B0); PG8_BAR; PG8_SCHED;
            PG8_STAGE(PG8_SB(1, 1), b3 + hstepB, voffB);
            PG8_WAIT_V(6); PG8_BAR; PG8_MMA(1, 1, At, B1); PG8_BAR;
            }
        }
        if constexpr (ALIGN_EPI) { if (wr == 0) PG8_BAR; }
        if constexpr (!Epi::AFTER_DRAIN) { E(acc, cur, wr, wc, fr, fq, lds + EPI_OFF + wid * EPI_WAVE, lane, wid); S.done(cur); }
        if (!has_next) break;
#pragma unroll
        for (int a = 0; a < 2; ++a)
#pragma unroll
            for (int b = 0; b < 2; ++b)
#pragma unroll
                for (int m = 0; m < 4; ++m)
#pragma unroll
                    for (int n = 0; n < 2; ++n) acc[a][b][m][n] = (f32x4){0.f, 0.f, 0.f, 0.f};
        cur = nxt; cA = nA; cB = nB; ++ui;
        if constexpr (ALIGN_EPI) { if (wr == 1) PG8_BAR; }
    }
    PG8_WAIT_V(0);
    if constexpr (!ALIGN_EPI) { if (wr == 0) PG8_BAR; }
    PG8_BAR;
    if constexpr (Epi::AFTER_DRAIN) { E.fused(acc, cur, wr, wc, fr, fq, lds, wid, lane); S.done(cur); }
#undef PG8_SA
#undef PG8_SB
#undef PG8_STAGE
#undef PG8_LDA
#undef PG8_LDB
#undef PG8_MMA
#undef PG8_WAIT_V
#undef PG8_WAIT_L
#undef PG8_BAR
#undef PG8_SCHED
}
}


namespace pg8 {
__device__ __forceinline__ unsigned cvt_pk_bf16(float lo, float hi) { unsigned r; asm volatile("v_cvt_pk_bf16_f32 %0, %1, %2" : "=v"(r) : "v"(lo), "v"(hi)); return r; }
__device__ __forceinline__ float bflo(unsigned u) { return __uint_as_float(u << 16); }
__device__ __forceinline__ float bfhi(unsigned u) { return __uint_as_float(u & 0xffff0000u); }
__device__ __forceinline__ float sigmoidf_(float v) { return __builtin_amdgcn_rcpf(1.0f + __expf(-v)); }
typedef unsigned u32x2 __attribute__((ext_vector_type(2)));
__device__ __forceinline__ void piece_xpose(PG8_LAS unsigned char* stg, u32x4 in0, u32x4 in1, u32x4& out0, u32x4& out1, int fr, int fq, int lane) {
    *(PG8_LAS u32x4*)(stg + fr * EPI_PITCH + fq * 16) = in0; *(PG8_LAS u32x4*)(stg + fr * EPI_PITCH + 64 + fq * 16) = in1;
    out0 = *(const PG8_LAS u32x4*)(stg + (lane >> 3) * EPI_PITCH + (lane & 7) * 16); out1 = *(const PG8_LAS u32x4*)(stg + ((lane >> 3) + 8) * EPI_PITCH + (lane & 7) * 16);
}

struct EpiProj {
    static constexpr bool PERM = true, AFTER_DRAIN = false, HAS_MID = false; static constexpr int MID_T = 0;
    bf16_t* O; int ldc; const float* bmerge; float* kmean; unsigned char* gates; const float* rowss;
    __device__ __forceinline__ void operator()(const f32x4 (&acc)[2][2][4][2], const Unit& u, int wr, int wc, int fr, int fq, PG8_LAS unsigned char* stg, int lane, int wid) const {
        asm volatile("" : "+v"(fr), "+v"(fq), "+v"(lane));
        const int col0 = u.pn * BM + wc * 64 + 8 * fq;
        const int kind = (u.pn == 9 || u.pn == 16 || u.pn == 17) ? 1 : (u.pn >= 18 ? 2 : 0);
        PG8_LAS float* const tab = (PG8_LAS float*)(stg - wid * EPI_WAVE + 8 * EPI_WAVE + 256);
        if (__builtin_amdgcn_readfirstlane(((const PG8_LAS int*)tab)[256]) != u.pm) {
            asm volatile("s_waitcnt lgkmcnt(0)" ::: "memory"); __builtin_amdgcn_s_barrier(); asm volatile("" ::: "memory");
            const int t_ = wid * 64 + lane;
            if (t_ < 256) { const f32x4* pp = (const f32x4*)(rowss + (size_t)(u.pm * BM + t_) * 16); const f32x4 s4 = (pp[0] + pp[1]) + (pp[2] + pp[3]);
                tab[t_] = __builtin_amdgcn_rsqf(((s4[0] + s4[1]) + (s4[2] + s4[3])) * (1.0f / 1024.0f) + 1e-6f); }
            if (t_ == 0) ((PG8_LAS int*)tab)[256] = u.pm;
            asm volatile("s_waitcnt vmcnt(0) lgkmcnt(0)" ::: "memory"); __builtin_amdgcn_s_barrier(); asm volatile("" ::: "memory");
        }
        float rs[2][4];
#pragma unroll
        for (int ai = 0; ai < 2; ++ai)
#pragma unroll
            for (int m = 0; m < 4; ++m) rs[ai][m] = tab[ai * HALF + wr * 64 + m * 16 + fr];
        const float qs = (u.pn == 0 || u.pn == 3 || u.pn == 6 || u.pn == 10 || u.pn == 11) ? 0.18033688011112042f : 1.0f;
        if (kind == 2) {
            f32x4 bv[2][2];
#pragma unroll
            for (int bj = 0; bj < 2; ++bj)
#pragma unroll
                for (int n = 0; n < 2; ++n) bv[bj][n] = *(const f32x4*)(bmerge + (col0 - 4608) + bj * 32 + 4 * n);
            unsigned char* gp = gates + ((size_t)((u.pm * 8 + (u.pn - 18)) * 8 + wid) * 8) * 1024 + fr * 64 + fq * 16;
#pragma unroll
            for (int ai = 0; ai < 2; ++ai)
#pragma unroll
                for (int m = 0; m < 4; ++m) { u32x4 q;
#pragma unroll
                    for (int bj = 0; bj < 2; ++bj)
#pragma unroll
                        for (int n = 0; n < 2; ++n) { const f32x4 v = acc[ai][bj][m][n] * rs[ai][m] + bv[bj][n]; unsigned w = 0u;
#pragma unroll
                            for (int e = 0; e < 4; ++e) w |= (unsigned)__builtin_fmaxf(sigmoidf_(v[e]) * 255.0f + 0.5f, 1.0f) << (8 * e);
                            q[2 * bj + n] = w; }
                    __builtin_nontemporal_store(q, (u32x4*)(gp + (ai * 4 + m) * 1024)); }
            return;
        }
        const size_t rbase = (size_t)(u.pm * BM + wr * 64 + (lane >> 3)); bf16_t* const op = O + u.pn * BM + wc * 64 + 8 * (lane & 7);
#pragma unroll
        for (int ai = 0; ai < 2; ++ai)
#pragma unroll
            for (int m = 0; m < 4; ++m) { u32x4 w[2];
#pragma unroll
                for (int bj = 0; bj < 2; ++bj) { f32x4 v0 = acc[ai][bj][m][0] * rs[ai][m], v1 = acc[ai][bj][m][1] * rs[ai][m];
                    if (kind == 1) {
#pragma unroll
                        for (int e = 0; e < 4; ++e) { v0[e] = v0[e] * sigmoidf_(v0[e]); v1[e] = v1[e] * sigmoidf_(v1[e]); } }
                    v0 = v0 * qs; v1 = v1 * qs;
                    w[bj].x = cvt_pk_bf16(v0[0], v0[1]); w[bj].y = cvt_pk_bf16(v0[2], v0[3]); w[bj].z = cvt_pk_bf16(v1[0], v1[1]); w[bj].w = cvt_pk_bf16(v1[2], v1[3]); }
                u32x4 o0, o1; piece_xpose(stg, w[0], w[1], o0, o1, fr, fq, lane);
                bf16_t* rp = op + (rbase + ai * HALF + m * 16) * ldc;
                __builtin_nontemporal_store(o0, (u32x4*)rp); __builtin_nontemporal_store(o1, (u32x4*)(rp + (size_t)8 * ldc));
                asm volatile("" ::: "memory"); }
        if (u.pn == 12 || u.pn == 13) {
#pragma unroll
            for (int bj = 0; bj < 2; ++bj)
#pragma unroll
                for (int n = 0; n < 2; ++n) { f32x4 cs = (f32x4){0.f, 0.f, 0.f, 0.f};
#pragma unroll
                    for (int ai = 0; ai < 2; ++ai)
#pragma unroll
                        for (int m = 0; m < 4; ++m) { float r2 = rs[ai][m]; asm volatile("" : "+v"(r2)); cs += acc[ai][bj][m][n] * r2; }
#pragma unroll
                    for (int e = 0; e < 4; ++e) { float v = cs[e]; v += __shfl_xor(v, 1); v += __shfl_xor(v, 2); v += __shfl_xor(v, 4); v += __shfl_xor(v, 8); cs[e] = v; }
                    if (fr == 0) { float* kp = kmean + (size_t)u.pm * 512 + (u.pn - 12) * 256 + wc * 64 + bj * 32 + 8 * fq + 4 * n;
#pragma unroll
                        for (int e = 0; e < 4; ++e) atomicAdd(kp + e, cs[e] * (1.0f / 256.0f)); } }
        }
    }
};
struct EpiMerge {
    static constexpr bool PERM = true, AFTER_DRAIN = false, HAS_MID = true; static constexpr int MID_T = 2;
    bf16_t* O; const unsigned char* gates; int ldc;
    __device__ __forceinline__ static float ub(unsigned w, int i) { return (float)((w >> (8 * i)) & 0xffu); }
    __device__ __forceinline__ void mid(f32x4 (&acc)[2][2][4][2], const Unit& u, int wr, int wc, int fr, int fq, int wid) const {
        asm volatile("" : "+v"(fr), "+v"(fq));
        const unsigned char* ga = gates + ((size_t)((u.pm * 8 + u.pn) * 8 + wid) * 8) * 1024 + fr * 64 + fq * 16; const unsigned char* gb = ga + (size_t)4 * 8 * 8 * 1024;
        u32x4 av[2][4], bv[2][4];
#pragma unroll
        for (int ai = 0; ai < 2; ++ai)
#pragma unroll
            for (int m = 0; m < 4; ++m) { av[ai][m] = __builtin_nontemporal_load((const u32x4*)(ga + (ai * 4 + m) * 1024)); bv[ai][m] = *(const u32x4*)(gb + (ai * 4 + m) * 1024); }
#pragma unroll
        for (int ai = 0; ai < 2; ++ai)
#pragma unroll
            for (int m = 0; m < 4; ++m)
#pragma unroll
                for (int bj = 0; bj < 2; ++bj)
#pragma unroll
                    for (int n = 0; n < 2; ++n)
#pragma unroll
                        for (int e = 0; e < 4; ++e) acc[ai][bj][m][n][e] *= ub(av[ai][m][2 * bj + n], e) * __builtin_amdgcn_rcpf(ub(bv[ai][m][2 * bj + n], e));
    }
    __device__ __forceinline__ void operator()(const f32x4 (&acc)[2][2][4][2], const Unit& u, int wr, int wc, int fr, int fq, PG8_LAS unsigned char* stg, int lane, int wid) const {
        asm volatile("" : "+v"(fr), "+v"(fq), "+v"(lane));
        const unsigned char* gb = gates + ((size_t)((u.pm * 8 + 4 + u.pn) * 8 + wid) * 8) * 1024 + fr * 64 + fq * 16;
        const size_t rbase = (size_t)(u.pm * BM + wr * 64 + (lane >> 3)); bf16_t* const op = O + u.pn * BM + wc * 64 + 8 * (lane & 7);
        u32x4 gvv[2][4];
#pragma unroll
        for (int ai = 0; ai < 2; ++ai)
#pragma unroll
            for (int m = 0; m < 4; ++m) gvv[ai][m] = __builtin_nontemporal_load((const u32x4*)(gb + (ai * 4 + m) * 1024));
#pragma unroll
        for (int ai = 0; ai < 2; ++ai)
#pragma unroll
            for (int m = 0; m < 4; ++m) { const u32x4 gv = gvv[ai][m]; u32x4 w[2];
#pragma unroll
                for (int bj = 0; bj < 2; ++bj) { f32x4 v0 = acc[ai][bj][m][0], v1 = acc[ai][bj][m][1];
#pragma unroll
                    for (int e = 0; e < 4; ++e) { v0[e] *= ub(gv[2 * bj], e) * (1.0f / 255.0f); v1[e] *= ub(gv[2 * bj + 1], e) * (1.0f / 255.0f); }
                    w[bj].x = cvt_pk_bf16(v0[0], v0[1]); w[bj].y = cvt_pk_bf16(v0[2], v0[3]); w[bj].z = cvt_pk_bf16(v1[0], v1[1]); w[bj].w = cvt_pk_bf16(v1[2], v1[3]); }
                u32x4 o0, o1; piece_xpose(stg, w[0], w[1], o0, o1, fr, fq, lane);
                bf16_t* rp = op + (rbase + ai * HALF + m * 16) * ldc;
                __builtin_nontemporal_store(o0, (u32x4*)rp); __builtin_nontemporal_store(o1, (u32x4*)(rp + (size_t)8 * ldc));
                if (m & 1) asm volatile("" ::: "memory"); }
    }
};
template <int MODE> struct EpiResid {
    static constexpr bool PERM = false, AFTER_DRAIN = false, HAS_MID = false; static constexpr int MID_T = 0;
    const float* R; bf16_t* XB; float* rowss; int ldc;
    __device__ __forceinline__ void operator()(const f32x4 (&acc)[2][2][4][2], const Unit& u, int wr, int wc, int fr, int fq, PG8_LAS unsigned char* stg, int lane, int wid) const {
        asm volatile("" : "+v"(fr), "+v"(fq), "+v"(lane));
        const size_t rbase = (size_t)(u.pm * BM + wr * 64 + (lane >> 3)); const int cb = u.pn * BM + wc * 64 + 4 * (lane & 7);
#pragma unroll
        for (int ai = 0; ai < 2; ++ai) {
            f32x4 rr[4][2][2];
#pragma unroll
            for (int m = 0; m < 4; ++m)
#pragma unroll
                for (int bj = 0; bj < 2; ++bj) { const size_t ro = (rbase + ai * HALF + m * 16) * ldc + cb + bj * 32;
                    if (MODE == 0) { rr[m][bj][0] = __builtin_nontemporal_load((const f32x4*)(R + ro)); rr[m][bj][1] = __builtin_nontemporal_load((const f32x4*)(R + ro + (size_t)8 * ldc)); }
                    else { const u32x2 b0 = __builtin_nontemporal_load((const u32x2*)(XB + ro)), b1 = __builtin_nontemporal_load((const u32x2*)(XB + ro + (size_t)8 * ldc));
                        rr[m][bj][0] = __builtin_bit_cast(f32x4, (u32x4){b0.x, b0.y, b1.x, b1.y}); } }
#pragma unroll
            for (int m = 0; m < 4; ++m) { float ss0 = 0.f, ss1 = 0.f;
#pragma unroll
                for (int bj = 0; bj < 2; ++bj) { const size_t ro = (rbase + ai * HALF + m * 16) * ldc + cb + bj * 32;
                    f32x4 r0, r1;
                    if (MODE == 0) { r0 = rr[m][bj][0]; r1 = rr[m][bj][1]; }
                    else { const u32x4 pk = __builtin_bit_cast(u32x4, rr[m][bj][0]);
                        r0 = (f32x4){bflo(pk.x), bfhi(pk.x), bflo(pk.y), bfhi(pk.y)}; r1 = (f32x4){bflo(pk.z), bfhi(pk.z), bflo(pk.w), bfhi(pk.w)}; }
                    u32x4 o0, o1; piece_xpose(stg, __builtin_bit_cast(u32x4, acc[ai][bj][m][0]), __builtin_bit_cast(u32x4, acc[ai][bj][m][1]), o0, o1, fr, fq, lane);
                    const f32x4 x0 = r0 + __builtin_bit_cast(f32x4, o0), x1 = r1 + __builtin_bit_cast(f32x4, o1);
                    *(u32x2*)(XB + ro) = (u32x2){cvt_pk_bf16(x0[0], x0[1]), cvt_pk_bf16(x0[2], x0[3])}; *(u32x2*)(XB + ro + (size_t)8 * ldc) = (u32x2){cvt_pk_bf16(x1[0], x1[1]), cvt_pk_bf16(x1[2], x1[3])};
                    ss0 += (x0[0] * x0[0] + x0[1] * x0[1]) + (x0[2] * x0[2] + x0[3] * x0[3]); ss1 += (x1[0] * x1[0] + x1[1] * x1[1]) + (x1[2] * x1[2] + x1[3] * x1[3]); }
                ss0 += __shfl_xor(ss0, 1); ss0 += __shfl_xor(ss0, 2); ss0 += __shfl_xor(ss0, 4); ss1 += __shfl_xor(ss1, 1); ss1 += __shfl_xor(ss1, 2); ss1 += __shfl_xor(ss1, 4);
                if ((lane & 7) == 0) { rowss[(rbase + ai * HALF + m * 16) * 16 + u.pn * 4 + wc] = ss0; rowss[(rbase + ai * HALF + m * 16 + 8) * 16 + u.pn * 4 + wc] = ss1; } }
            asm volatile("" ::: "memory");
        }
    }
};
}
#include <hip/hip_bf16.h>
#include <cmath>
namespace moba {
using bf16=__hip_bfloat16;
using bf16x8=__attribute__((ext_vector_type(8)))short;
using s16x4=__attribute__((ext_vector_type(4)))short;
using f32x16=__attribute__((ext_vector_type(16)))float;
using u32x4=__attribute__((ext_vector_type(4)))unsigned;
constexpr int SEQ=2048,D=64,PITCH=4608;
constexpr int NW=8,QBLK=32,QB=QBLK*NW,KVBLK=64;
__device__ __forceinline__ int crow(int r,int hi){return (r&3)+8*(r>>2)+4*hi;}
#define SBAR() __builtin_amdgcn_sched_barrier(0)
__device__ __forceinline__ void cmask(f32x16&p0,f32x16&p1,int jb,int qrel,int hi){
  const float NEG=-INFINITY; int kb=64*jb+4*hi;
  #pragma unroll
  for(int r=0;r<16;++r){int kv=kb+(r&3)+8*(r>>2); if(kv>qrel)p0[r]=NEG; if(kv+32>qrel)p1[r]=NEG;}
}

constexpr int NSLOT=3, SLOTB=8192;
constexpr int NVSLOT=4;
constexpr int LDS_K=0, LDS_V=NSLOT*SLOTB, LDS_WS=LDS_V+NVSLOT*SLOTB, LDS_OST=LDS_WS+NW*64*4, LDS_KM=LDS_OST+NW*4096, LDS_BYTES=LDS_KM+8*64*4;
__device__ __forceinline__ void glds16(const void*gsrc,unsigned lds_dst){unsigned keep;
  asm volatile("s_mov_b32 %0, m0\n\ts_mov_b32 m0, %2\n\ts_nop 0\n\tglobal_load_lds_dwordx4 %1, off\n\ts_mov_b32 m0, %0":"=&s"(keep):"v"(gsrc),"s"(lds_dst):"memory");}
__device__ __forceinline__ float max3f(float a,float b,float c){float r;asm("v_max3_f32 %0, %1, %2, %3":"=v"(r):"v"(a),"v"(b),"v"(c));return r;}
__device__ __forceinline__ float max2f(float a,float b){float r;asm("v_max_f32_e32 %0, %1, %2":"=v"(r):"v"(a),"v"(b));return r;}
typedef float f32x2_t __attribute__((ext_vector_type(2))); typedef __bf16 bf16x2_t __attribute__((ext_vector_type(2)));
__device__ __forceinline__ unsigned cvtpk_s(float lo,float hi){f32x2_t v={lo,hi};bf16x2_t b=__builtin_convertvector(v,bf16x2_t);return __builtin_bit_cast(unsigned,b);}
__device__ __forceinline__ float bl(unsigned u){return __uint_as_float(u<<16);}
__device__ __forceinline__ float bh(unsigned u){return __uint_as_float(u&0xffff0000u);}
#define WAIT_BAR(N) asm volatile("s_waitcnt vmcnt(" #N ") lgkmcnt(0)\n\ts_barrier":::"memory")

__device__ __forceinline__ void qkt(f32x16&p0,f32x16&p1,const char*Kslot,const bf16x8*qr,const f32x16&negm,int r32,int hi){
  const char*kb=Kslot+r32*128; const int s3=(r32&7)^hi;
  #pragma unroll
  for(int d0=0;d0<4;++d0){
    const bf16x8 b0=*reinterpret_cast<const bf16x8*>(kb+(((2*d0)^s3)<<4));
    const bf16x8 b1=*reinterpret_cast<const bf16x8*>(kb+(((2*d0)^s3)<<4)+4096);
    if(d0==0){p0=__builtin_amdgcn_mfma_f32_32x32x16_bf16(b0,qr[0],negm,0,0,0);p1=__builtin_amdgcn_mfma_f32_32x32x16_bf16(b1,qr[0],negm,0,0,0);}
    else{p0=__builtin_amdgcn_mfma_f32_32x32x16_bf16(b0,qr[d0],p0,0,0,0);p1=__builtin_amdgcn_mfma_f32_32x32x16_bf16(b1,qr[d0],p1,0,0,0);}}
}
typedef __attribute__((address_space(3))) const char* lds_cptr;
typedef short v4i16_t __attribute__((ext_vector_type(4)));
__device__ __forceinline__ void kload2(bf16x8*kf,lds_cptr kp,int s3,int j){ const int o=((2*j)^s3)<<4; kf[2*j]=*(const __attribute__((address_space(3))) bf16x8*)(kp+o); kf[2*j+1]=*(const __attribute__((address_space(3))) bf16x8*)(kp+o+4096); }
__device__ __forceinline__ void kload8(bf16x8*kf,lds_cptr kp,int s3){ kload2(kf,kp,s3,0); kload2(kf,kp,s3,1); kload2(kf,kp,s3,2); kload2(kf,kp,s3,3); }
__device__ __forceinline__ s16x4 vtr(lds_cptr p){ return __builtin_bit_cast(s16x4,__builtin_amdgcn_ds_read_tr16_b64_v4i16((__attribute__((address_space(3))) v4i16_t*)p)); }
__device__ __forceinline__ float rowmax(const f32x16&p0,const f32x16&p1){
  float a=max3f(p0[0],p0[1],p1[0]),b=max3f(p0[2],p0[3],p1[1]);a=max3f(a,p1[2],p1[3]);
  #pragma unroll
  for(int r=4;r<16;r+=4){a=max3f(a,p0[r],p0[r+1]);b=max3f(b,p0[r+2],p0[r+3]);a=max3f(a,p1[r],p1[r+1]);b=max3f(b,p1[r+2],p1[r+3]);}
  const float m=max2f(a,b);
  auto rr=__builtin_amdgcn_permlane32_swap(__float_as_uint(m),__float_as_uint(m),false,false);
  return max2f(__uint_as_float(rr[0]),__uint_as_float(rr[1]));
}
__device__ __forceinline__ float xhalf_sum(float v){ auto rr=__builtin_amdgcn_permlane32_swap(__float_as_uint(v),__float_as_uint(v),false,false); return __uint_as_float(rr[0])+__uint_as_float(rr[1]); }
__device__ __forceinline__ void pv(f32x16*o,lds_cptr vp,int vsw,bf16x8 pa0,bf16x8 pa1,bf16x8 pa2,bf16x8 pa3){
  #pragma unroll
  for(int d0=0;d0<2;++d0){s16x4 lo[4],hi[4]; const lds_cptr vd=vp+((d0*64)^vsw);
    #pragma unroll
    for(int ks=0;ks<4;++ks){ lo[ks]=vtr(vd+ks*2048); hi[ks]=vtr(vd+ks*2048+1024); }
    #define PK(k) (bf16x8){lo[k][0],lo[k][1],lo[k][2],lo[k][3],hi[k][0],hi[k][1],hi[k][2],hi[k][3]}
    o[d0]=__builtin_amdgcn_mfma_f32_32x32x16_bf16(pa0,PK(0),o[d0],0,0,0);
    o[d0]=__builtin_amdgcn_mfma_f32_32x32x16_bf16(pa1,PK(1),o[d0],0,0,0);
    o[d0]=__builtin_amdgcn_mfma_f32_32x32x16_bf16(pa2,PK(2),o[d0],0,0,0);
    o[d0]=__builtin_amdgcn_mfma_f32_32x32x16_bf16(pa3,PK(3),o[d0],0,0,0);
    #undef PK
  }
}

template<int THRL> __device__ __forceinline__ void moba_unit(int b,int h,int c,const bf16*Pq,const bf16*__restrict__ Pk,const bf16*__restrict__ Pv,const bf16*Pz,bf16*Po,const float*__restrict__ kmean,char*shm){
  int tid_=threadIdx.x; asm volatile("":"+v"(tid_));
  const int tid=tid_,lane=tid&63,r32=lane&31,hi=lane>>5; const int wid=__builtin_amdgcn_readfirstlane(tid>>6);
  const long rowbase=(long)b*SEQ; const int q0=c*QB;
  const bf16*Qw=Pq+(rowbase+q0+wid*QBLK)*PITCH+h*D;
  const bf16*Kh=Pk+rowbase*PITCH+h*D,*Vh=Pv+rowbase*PITCH+h*D;
  const unsigned lds0=(unsigned)(uintptr_t)shm;
  float*wsf=(float*)(shm+LDS_WS)+wid*64;
  float*kml=(float*)(shm+LDS_KM);
  const int NT=(q0+QB)/KVBLK;
  const bf16*ksrc=Kh+(long)(8*wid+(lane>>3))*PITCH+(((lane&7)^(lane>>3))*8);
  const bf16*vsrc=Vh+(long)(8*wid+(lane>>3))*PITCH+(((lane&7)^(((lane>>4)&1)<<2))*8);
  const unsigned kdst=lds0+LDS_K+wid*1024, vdst=lds0+LDS_V+wid*1024;
  #define DMA_K(t,slot) glds16(ksrc+(long)(NT-1-(t))*KVBLK*PITCH,(unsigned)__builtin_amdgcn_readfirstlane(kdst+(slot)))
  #define DMA_V(t,slot) glds16(vsrc+(long)(NT-1-(t))*KVBLK*PITCH,(unsigned)__builtin_amdgcn_readfirstlane(vdst+(slot)))
  const char*Kbase=shm+LDS_K; bf16x8 kf[8];
  const lds_cptr shm3=(lds_cptr)shm; const lds_cptr kp0=shm3+LDS_K+r32*128; const int s3=(r32&7)^hi;
  const int vq_=(lane&15)>>2; const lds_cptr vp0=shm3+LDS_V+(4*hi+vq_)*128+((lane>>4)&1)*32+(lane&3)*8; const int vsw=((vq_>>1)&1)*64;
  #define VS(t) ((((t))&3)*SLOTB)
  DMA_K(0,0);DMA_V(0,VS(0));DMA_K(1,SLOTB);
  bf16x8 qr[4];
  #pragma unroll
  for(int d0=0;d0<4;++d0)qr[d0]=*reinterpret_cast<const bf16x8*>(&Qw[(long)r32*PITCH+d0*16+hi*8]);
  const int qrel=wid*QBLK+r32;
  u32x4 kdg[4];
  { const bf16*Kd=Kh+(long)(q0+qrel)*PITCH;
    #pragma unroll
    for(int d0=0;d0<4;++d0)kdg[d0]=*reinterpret_cast<const u32x4*>(&Kd[d0*16+hi*8]); }
  const float sl2=__uint_as_float(__builtin_amdgcn_readfirstlane(__float_as_uint(__builtin_amdgcn_exp2f(-(float)(h+1))*1.4426950408889634f)));
  unsigned sel=0u;
  if(c>0){
    if(tid<c*64) kml[tid]=kmean[((long)(b*8)+(tid>>6))*512+h*64+(tid&63)];
    asm volatile("s_waitcnt vmcnt(0) lgkmcnt(0)\n\ts_barrier":::"memory");
    if(c<=3) sel=(1u<<c)-1u;
    else{
      float g[8];
      #pragma unroll
      for(int j=0;j<8;++j){ g[j]=-INFINITY;
        if(j<c){ float a=0.f;
          #pragma unroll
          for(int d0=0;d0<4;++d0){ const u32x4 qv=__builtin_bit_cast(u32x4,qr[d0]); const float*km=kml+j*64+d0*16+hi*8;
            const float4 k0=*(const float4*)km, k1=*(const float4*)(km+4);
            a+=bl(qv.x)*k0.x+bh(qv.x)*k0.y+bl(qv.y)*k0.z+bh(qv.y)*k0.w+bl(qv.z)*k1.x+bh(qv.z)*k1.y+bl(qv.w)*k1.z+bh(qv.w)*k1.w; }
          g[j]=xhalf_sum(a); } }
      #pragma unroll
      for(int j=0;j<8;++j){ int rank=0;
        #pragma unroll
        for(int j2=0;j2<8;++j2){ if(j2!=j) rank+=((g[j2]>g[j])||(g[j2]==g[j]&&j2<j))?1:0; }
        if(j<c&&rank<3) sel|=(1u<<j); }
    }
  }
  float mhat;
  { float a=0.f;
    #pragma unroll
    for(int d0=0;d0<4;++d0){ const u32x4 kv=kdg[d0]; const u32x4 qv=__builtin_bit_cast(u32x4,qr[d0]);
      a+=bl(qv.x)*bl(kv.x)+bh(qv.x)*bh(kv.x)+bl(qv.y)*bl(kv.y)+bh(qv.y)*bh(kv.y)+bl(qv.z)*bl(kv.z)+bh(qv.z)*bh(kv.z)+bl(qv.w)*bl(kv.w)+bh(qv.w)*bh(kv.w); }
    mhat=xhalf_sum(a)+sl2*(float)qrel; }
  float l_reg=0.f;f32x16 o[2];o[0]=f32x16{};o[1]=f32x16{};
  f32x16 negm;
  #pragma unroll
  for(int r=0;r<16;++r)negm[r]=sl2*(float)((r&3)+8*(r>>2))-mhat;
  asm volatile("":"+v"(negm));
  #define MBIAS(P0,P1,t) do{ const int T_=NT-1-(t); const int jb_=T_-(NT-4); float a0_=sl2*(float)(64*jb_+4*hi); \
      if(jb_<0){ if(!((sel>>(T_>>2))&1u)) a0_=-INFINITY; } const float a1_=a0_+32.f*sl2; \
      _Pragma("unroll") for(int r=0;r<16;++r){P0[r]+=a0_;P1[r]+=a1_;} \
      if(jb_>=0)cmask(P0,P1,jb_,qrel,hi); }while(0)
  bool resc=false;
  #define RESC() do{ if(resc){ asm volatile("s_waitcnt lgkmcnt(0)":::"memory"); \
      _Pragma("unroll") for(int d_=0;d_<2;++d_) _Pragma("unroll") for(int r=0;r<16;++r)o[d_][r]*=wsf[crow(r,hi)]; } }while(0)
  f32x16 pA0,pA1,pB0,pB1;
  int sl_prev=0,sl_cur=0,sl_next=SLOTB;
  #define ROT() do{sl_prev=sl_cur;sl_cur=sl_next;sl_next=(sl_next==(NSLOT-1)*SLOTB)?0:sl_next+SLOTB;}while(0)
  DMA_K(2,2*SLOTB);DMA_V(1,VS(1));
  WAIT_BAR(2);
  qkt(pA0,pA1,Kbase,qr,negm,r32,hi);asm volatile("s_nop 15\n\ts_nop 7":"+v"(pA0),"+v"(pA1));MBIAS(pA0,pA1,0);
  { const float rm=rowmax(pA0,pA1);
    if(__any(rm>(float)THRL)){ const float dl=__builtin_fmaxf(rm,0.f);
      _Pragma("unroll") for(int r=0;r<16;++r){pA0[r]-=dl;pA1[r]-=dl;negm[r]-=dl;}
      asm volatile("":"+v"(negm)); } }
  _Pragma("unroll") for(int r=0;r<16;++r){pA0[r]=__builtin_amdgcn_exp2f(pA0[r]);pA1[r]=__builtin_amdgcn_exp2f(pA1[r]);}
  WAIT_BAR(2);
  DMA_K(3,0);DMA_V(2,VS(2));
  ROT();
  kload8(kf,kp0+sl_cur,s3);
  WAIT_BAR(3);
  s16x4 vlo[8],vhi[8]; u32x4 pw0,pw1,pw2,pw3;
  #define PKW(P,B) cvtpk_s(P[B],P[B+1])
  #define PAF(k) __builtin_bit_cast(bf16x8,pw##k)
  #define VFR(i) (bf16x8){vlo[i][0],vlo[i][1],vlo[i][2],vlo[i][3],vhi[i][0],vhi[i][1],vhi[i][2],vhi[i][3]}
  #define PIN(x) asm volatile("":"+v"(x))
  #define MX3(a,b,c) __builtin_fmaxf(__builtin_fmaxf((a),(b)),(c))
  #define GAPA(MF,A0,A1,A2,A3,W0,W1,PW) do{ MF; sacc+=A0; sacc+=A1; sacc+=A2; sacc+=A3; PIN(sacc); W0; W1; PIN(PW); SBAR(); }while(0)
  #define EX(v) __builtin_amdgcn_exp2f(v)
  #define GAPB(MF,X,B) do{ MF; X[B]=EX(X[B]); X[B+1]=EX(X[B+1]); X[B+2]=EX(X[B+2]); X[B+3]=EX(X[B+3]); PIN(X); SBAR(); }while(0)
  #define VRD(i) do{ vlo[i]=vtr(vp_+(((((i)>>2)*64)^vsw)+((i)&3)*2048)); vhi[i]=vtr(vp_+(((((i)>>2)*64)^vsw)+((i)&3)*2048+1024)); }while(0)
  #define KRD(G,j) do{ if(G){ kload2(kf,kp0+sl_next,s3,j); SBAR(); } }while(0)
  #define STEP(C0,C1,P0,P1,t,GK,GV,GL) do{ SBAR(); \
    const lds_cptr vp_=vp0+VS((t)-1); \
    VRD(0); SBAR(); float sacc=(P0[0]+P0[1]); \
    GAPA(C0=__builtin_amdgcn_mfma_f32_32x32x16_bf16(kf[0],qr[0],negm,0,0,0), P0[2],P0[3],P0[4],P0[5],     pw0[0]=PKW(P0,0), pw0[1]=PKW(P0,2), pw0); \
    VRD(4); SBAR(); GAPA(C1=__builtin_amdgcn_mfma_f32_32x32x16_bf16(kf[1],qr[0],negm,0,0,0), P0[6],P0[7],P0[8],P0[9],     pw0[2]=PKW(P0,4), pw0[3]=PKW(P0,6), pw0); \
    VRD(1); SBAR(); GAPA(C0=__builtin_amdgcn_mfma_f32_32x32x16_bf16(kf[2],qr[1],C0,0,0,0),   P0[10],P0[11],P0[12],P0[13], pw1[0]=PKW(P0,8), pw1[1]=PKW(P0,10), pw1); \
    VRD(5); SBAR(); GAPA(C1=__builtin_amdgcn_mfma_f32_32x32x16_bf16(kf[3],qr[1],C1,0,0,0),   P0[14],P0[15],P1[0],P1[1],   pw1[2]=PKW(P0,12),pw1[3]=PKW(P0,14), pw1); \
    VRD(2); SBAR(); GAPA(C0=__builtin_amdgcn_mfma_f32_32x32x16_bf16(kf[4],qr[2],C0,0,0,0),   P1[2],P1[3],P1[4],P1[5],     pw2[0]=PKW(P1,0), pw2[1]=PKW(P1,2), pw2); \
    VRD(6); SBAR(); GAPA(C1=__builtin_amdgcn_mfma_f32_32x32x16_bf16(kf[5],qr[2],C1,0,0,0),   P1[6],P1[7],P1[8],P1[9],     pw2[2]=PKW(P1,4), pw2[3]=PKW(P1,6), pw2); \
    VRD(3); SBAR(); GAPA(C0=__builtin_amdgcn_mfma_f32_32x32x16_bf16(kf[6],qr[3],C0,0,0,0),   P1[10],P1[11],P1[12],P1[13], pw3[0]=PKW(P1,8), pw3[1]=PKW(P1,10), pw3); \
    VRD(7); SBAR(); GAPA(C1=__builtin_amdgcn_mfma_f32_32x32x16_bf16(kf[7],qr[3],C1,0,0,0),   P1[14],P1[15],0.f,0.f,       pw3[2]=PKW(P1,12),pw3[3]=PKW(P1,14), pw3); \
    l_reg+=sacc; \
    if(GK){DMA_K((t)+3,sl_cur);} if(GV){DMA_V((t)+2,VS((t)+2));} \
    MBIAS(C0,C1,t); \
    { float a=MX3(C0[0],C0[1],C1[0]),b=MX3(C0[2],C0[3],C1[1]); a=MX3(a,C1[2],C1[3]); \
      _Pragma("unroll") for(int r=4;r<16;r+=4){a=MX3(a,C0[r],C0[r+1]);b=MX3(b,C0[r+2],C0[r+3]);a=MX3(a,C1[r],C1[r+1]);b=MX3(b,C1[r+2],C1[r+3]);} \
      float rm=__builtin_fmaxf(a,b); { auto rr=__builtin_amdgcn_permlane32_swap(__float_as_uint(rm),__float_as_uint(rm),false,false); rm=__builtin_fmaxf(__uint_as_float(rr[0]),__uint_as_float(rr[1])); } \
      resc=false; \
      if(__builtin_expect(__any(rm>(float)THRL),0)){ const float dl=__builtin_fmaxf(rm,0.f); \
        _Pragma("unroll") for(int r=0;r<16;++r){C0[r]-=dl;C1[r]-=dl;} \
        _Pragma("unroll") for(int r=0;r<16;++r)negm[r]-=dl; asm volatile("":"+v"(negm)); \
        const float f=__builtin_amdgcn_exp2f(-dl); l_reg*=f; if(hi==0)wsf[r32]=f; resc=true; } } \
    SBAR(); \
    GAPB(o[0]=__builtin_amdgcn_mfma_f32_32x32x16_bf16(PAF(0),VFR(0),o[0],0,0,0), C0,0); \
    GAPB(o[1]=__builtin_amdgcn_mfma_f32_32x32x16_bf16(PAF(0),VFR(4),o[1],0,0,0), C0,4); \
    KRD(GL,0); GAPB(o[0]=__builtin_amdgcn_mfma_f32_32x32x16_bf16(PAF(1),VFR(1),o[0],0,0,0), C0,8); \
    KRD(GL,1); GAPB(o[1]=__builtin_amdgcn_mfma_f32_32x32x16_bf16(PAF(1),VFR(5),o[1],0,0,0), C0,12); \
    KRD(GL,2); GAPB(o[0]=__builtin_amdgcn_mfma_f32_32x32x16_bf16(PAF(2),VFR(2),o[0],0,0,0), C1,0); \
    KRD(GL,3); GAPB(o[1]=__builtin_amdgcn_mfma_f32_32x32x16_bf16(PAF(2),VFR(6),o[1],0,0,0), C1,4); \
    GAPB(o[0]=__builtin_amdgcn_mfma_f32_32x32x16_bf16(PAF(3),VFR(3),o[0],0,0,0), C1,8); \
    GAPB(o[1]=__builtin_amdgcn_mfma_f32_32x32x16_bf16(PAF(3),VFR(7),o[1],0,0,0), C1,12); \
    }while(0)
  int t=1;
  for(;t+5<NT;t+=2){
    STEP(pB0,pB1,pA0,pA1,t,true,true,true);     WAIT_BAR(3); RESC(); ROT();
    STEP(pA0,pA1,pB0,pB1,t+1,true,true,true);   WAIT_BAR(3); RESC(); ROT();
  }
  #define ENDW(tt) do{ if((tt)+3<NT){WAIT_BAR(3);} else if((tt)+2<NT){WAIT_BAR(2);} else {WAIT_BAR(0);} }while(0)
  for(;t+1<NT;t+=2){
    STEP(pB0,pB1,pA0,pA1,t,(t+3<NT),(t+2<NT),(t+1<NT));       ENDW(t);   RESC(); ROT();
    STEP(pA0,pA1,pB0,pB1,t+1,(t+4<NT),(t+3<NT),(t+2<NT));     ENDW(t+1); RESC(); ROT();
  }
  STEP(pB0,pB1,pA0,pA1,NT-1,false,false,false); RESC();
  { float sacc=pB0[0]+pB0[1]; _Pragma("unroll") for(int r=2;r<16;++r)sacc+=pB0[r]; _Pragma("unroll") for(int r=0;r<16;++r)sacc+=pB1[r]; l_reg+=sacc;
    pw0=(u32x4){PKW(pB0,0),PKW(pB0,2),PKW(pB0,4),PKW(pB0,6)};pw1=(u32x4){PKW(pB0,8),PKW(pB0,10),PKW(pB0,12),PKW(pB0,14)};pw2=(u32x4){PKW(pB1,0),PKW(pB1,2),PKW(pB1,4),PKW(pB1,6)};pw3=(u32x4){PKW(pB1,8),PKW(pB1,10),PKW(pB1,12),PKW(pB1,14)};
    SBAR(); pv(o,vp0+VS(NT-1),vsw,PAF(0),PAF(1),PAF(2),PAF(3)); }
  #undef PKW
  #undef PAF
  #undef VFR
  #undef PIN
  #undef MX3
  #undef GAPA
  #undef GAPB
  #undef EX
  #undef VRD
  #undef KRD
  #undef STEP
  #undef ENDW
  l_reg=xhalf_sum(l_reg);
  if(hi==0)wsf[32+r32]=l_reg;asm volatile("s_waitcnt lgkmcnt(0)":::"memory");
  float rli[16];
  #pragma unroll
  for(int r=0;r<16;++r)rli[r]=__builtin_amdgcn_rcpf(wsf[32+crow(r,hi)]);
  const bf16*Zw=Pz+(rowbase+q0+wid*QBLK)*PITCH+h*D; bf16*Ow=Po+(rowbase+q0+wid*QBLK)*PITCH+h*D;
  { bf16*stg=(bf16*)(shm+LDS_OST)+wid*2048;
    #pragma unroll
    for(int r=0;r<16;++r){const int orow=crow(r,hi);
      #pragma unroll
      for(int d0=0;d0<2;++d0)((unsigned short*)stg)[orow*64+d0*32+r32]=(unsigned short)cvtpk_s(o[d0][r]*rli[r],0.f);}
    asm volatile("s_waitcnt lgkmcnt(0)":::"memory");
    #pragma unroll
    for(int i=0;i<4;++i){const int row=i*8+(lane>>3),ch=lane&7; const u32x4 v=*(const u32x4*)(stg+row*64+ch*8);
      const u32x4 z=__builtin_nontemporal_load((const u32x4*)(Zw+(long)row*PITCH+ch*8)); u32x4*zp=(u32x4*)(Ow+(long)row*PITCH+ch*8); u32x4 w;
      w.x=cvtpk_s(bl(v.x)*bl(z.x),bh(v.x)*bh(z.x)); w.y=cvtpk_s(bl(v.y)*bl(z.y),bh(v.y)*bh(z.y)); w.z=cvtpk_s(bl(v.z)*bl(z.z),bh(v.z)*bh(z.z)); w.w=cvtpk_s(bl(v.w)*bl(z.w),bh(v.w)*bh(z.w));
      *zp=w; } }
  asm volatile("s_waitcnt lgkmcnt(0)\n\ts_barrier":::"memory");
  #undef DMA_K
  #undef DMA_V
  #undef VS
  #undef MBIAS
  #undef RESC
  #undef ROT
}
constexpr int ATTN_LDS_BYTES=LDS_BYTES;
#undef SBAR
#undef WAIT_BAR
}
namespace attna {
using moba::bf16; using moba::bf16x8; using moba::s16x4; using moba::f32x16; using moba::u32x4; using moba::lds_cptr;
using moba::crow; using moba::cvtpk_s; using moba::bl; using moba::bh; using moba::vtr; using moba::xhalf_sum;
constexpr int SEQ=2048,PITCH=4608;
constexpr int WK=0,WV=4608,WO=12800,WSC=16896,WBYTES=17152,LSE_OFF=8*WBYTES,LDS_BYTES=LSE_OFF+3*512*4;
#define AMFMA(a,b,c) __builtin_amdgcn_mfma_f32_32x32x16_bf16(a,b,c,0,0,0)

__device__ __forceinline__ void sub_item(bf16*P,int b,int hs,int g,int res,int l0,int chunk,char*wl,float*lse_l,int lane){
  asm volatile("":"+v"(lane));
  const int r32=lane&31,hi=lane>>5;
  const int dsh=2*g;
  const long rowb=(long)b*SEQ+res;
  const int qcol=g*768+hs*64;
  const float sl2=__builtin_amdgcn_exp2f(-(2.0f/3.0f)*(float)(4*g+hs+1))*(float)(1<<dsh)*1.4426950408889634f;
  #define AROW(l) ((rowb+((long)(l)<<dsh))*PITCH)
  #define KL(i,x) ((l0-128+32*(i)+(x))<0?0:(l0-128+32*(i)+(x)))
  const int i0=(l0>=128)?0:(4-(l0>>5));
  const int lrow=lane>>3, lch=lane&7;
  u32x4 qg[4],kg[5][4],vg[5][4];
  #pragma unroll
  for(int j=0;j<4;++j)qg[j]=*reinterpret_cast<const u32x4*>(P+AROW(l0+lrow+8*j)+qcol+lch*8);
  #pragma unroll
  for(int i=4;i>=0;--i)
    #pragma unroll
    for(int j=0;j<4;++j)kg[i][j]=*reinterpret_cast<const u32x4*>(P+AROW(KL(i,lrow+8*j))+qcol+256+lch*8);
  #pragma unroll
  for(int i=4;i>=0;--i)
    #pragma unroll
    for(int j=0;j<4;++j)vg[i][j]=*reinterpret_cast<const u32x4*>(P+AROW(KL(i,lrow+8*j))+qcol+512+lch*8);
  __builtin_amdgcn_sched_barrier(0);
  char*kb=wl+WK; const int kwoff=lrow*144+lch*16, kroff=r32*144+hi*16;
  bf16x8 qf[4];
  #pragma unroll
  for(int j=0;j<4;++j)*reinterpret_cast<u32x4*>(kb+kwoff+j*8*144)=qg[j];
  #pragma unroll
  for(int d0=0;d0<4;++d0)qf[d0]=*reinterpret_cast<const bf16x8*>(kb+kroff+d0*32);
  f32x16 S[5];
  #pragma unroll
  for(int i=4;i>=0;--i){
    #pragma unroll
    for(int j=0;j<4;++j)*reinterpret_cast<u32x4*>(kb+kwoff+j*8*144)=kg[i][j];
    bf16x8 kf[4];
    #pragma unroll
    for(int d0=0;d0<4;++d0)kf[d0]=*reinterpret_cast<const bf16x8*>(kb+kroff+d0*32);
    f32x16 acc=f32x16{};
    #pragma unroll
    for(int d0=0;d0<4;++d0)acc=AMFMA(kf[d0],qf[d0],acc);
    const float sbi=((i<i0)?-INFINITY:0.f)-sl2*(float)(32*(4-i)+r32-4*hi);
    #pragma unroll
    for(int r=0;r<16;++r){ const int kc=(r&3)+8*(r>>2); float v=__builtin_fmaf(sl2,(float)kc,acc[r]+sbi);
      if(i==4&&kc+4*hi>r32)v=-INFINITY; if(i==0&&kc+4*hi<r32)v=-INFINITY; acc[r]=v; }
    S[i]=acc;
  }
  float mx=-INFINITY;
  #pragma unroll
  for(int i=0;i<5;++i)
    #pragma unroll
    for(int r=0;r<16;++r)mx=fmaxf(mx,S[i][r]);
  { auto rr=__builtin_amdgcn_permlane32_swap(__float_as_uint(mx),__float_as_uint(mx),false,false); mx=fmaxf(__uint_as_float(rr[0]),__uint_as_float(rr[1])); }
  float ls=0.f;
  #pragma unroll
  for(int i=0;i<5;++i)
    #pragma unroll
    for(int r=0;r<16;++r){ const float p=__builtin_amdgcn_exp2f(S[i][r]-mx); S[i][r]=p; ls+=p; }
  ls=xhalf_sum(ls);
  f32x16 o[2]; o[0]=f32x16{}; o[1]=f32x16{};
  const lds_cptr wl3=(lds_cptr)wl;
  const int vtoff=((lane>>4)&1)*32+(lane&3)*8+(4*hi+((lane&15)>>2))*64;
  const int vwoff=(lch>>2)*2048+lrow*64+(lch&3)*16;
  #define PVSTEP(i) do{ char*vb_=wl+WV+((i)&1)*4096; \
      _Pragma("unroll") for(int j=0;j<4;++j)*reinterpret_cast<u32x4*>(vb_+vwoff+j*8*64)=vg[i][j]; \
      const u32x4 pw0=(u32x4){cvtpk_s(S[i][0],S[i][1]),cvtpk_s(S[i][2],S[i][3]),cvtpk_s(S[i][4],S[i][5]),cvtpk_s(S[i][6],S[i][7])}; \
      const u32x4 pw1=(u32x4){cvtpk_s(S[i][8],S[i][9]),cvtpk_s(S[i][10],S[i][11]),cvtpk_s(S[i][12],S[i][13]),cvtpk_s(S[i][14],S[i][15])}; \
      const lds_cptr vp=wl3+WV+((i)&1)*4096+vtoff; \
      _Pragma("unroll") for(int d0=0;d0<2;++d0){ \
        const s16x4 a0=vtr(vp+d0*2048),a1=vtr(vp+d0*2048+512),b0=vtr(vp+d0*2048+1024),b1=vtr(vp+d0*2048+1536); \
        const bf16x8 f0=(bf16x8){a0[0],a0[1],a0[2],a0[3],a1[0],a1[1],a1[2],a1[3]}, f1=(bf16x8){b0[0],b0[1],b0[2],b0[3],b1[0],b1[1],b1[2],b1[3]}; \
        o[d0]=AMFMA(__builtin_bit_cast(bf16x8,pw0),f0,o[d0]); \
        o[d0]=AMFMA(__builtin_bit_cast(bf16x8,pw1),f1,o[d0]); } }while(0)
  PVSTEP(4); PVSTEP(3); PVSTEP(2); PVSTEP(1); PVSTEP(0);
  float*ws=(float*)(wl+WSC);
  const int tokc=((l0+r32)<<dsh)+res-chunk*512;
  if(hi==0){ ws[r32]=__builtin_amdgcn_rcpf(ls); lse_l[g*512+tokc]=mx+__builtin_amdgcn_logf(ls); }
  bf16*stg=(bf16*)(wl+WO);
  #pragma unroll
  for(int r=0;r<16;++r){ const int orow=crow(r,hi); const float il=ws[orow];
    #pragma unroll
    for(int d0=0;d0<2;++d0)((unsigned short*)stg)[orow*64+d0*32+r32]=(unsigned short)cvtpk_s(o[d0][r]*il,0.f); }
  #pragma unroll
  for(int i=0;i<4;++i){ const int row=i*8+(lane>>3),ch=lane&7; const u32x4 v=*reinterpret_cast<const u32x4*>(stg+row*64+ch*8);
    *reinterpret_cast<u32x4*>(P+AROW(l0+row)+qcol+ch*8)=v; }
  #undef AROW
  #undef KL
  #undef PVSTEP
}

__device__ __forceinline__ void wg_item(bf16*P,int b,int hs,int chunk,char*shm){
  int tid_=threadIdx.x; asm volatile("":"+v"(tid_));
  const int tid=tid_,lane=tid&63; const int wid=__builtin_amdgcn_readfirstlane(tid>>6);
  char*wl=shm+wid*WBYTES; float*lse_l=(float*)(shm+LSE_OFF);
  #pragma unroll 1
  for(int i6=0;i6<6;++i6){
    const int si=wid+8*i6, g=si>>4, k=si&15;
    int res,l0;
    if(g==0){res=0;l0=32*(chunk*16+k);} else if(g==1){res=k>>2;l0=128*chunk+32*(k&3);} else {res=k;l0=32*chunk;}
    sub_item(P,b,hs,g,res,l0,chunk,wl,lse_l,lane);
  }
  __syncthreads();
  #pragma unroll
  for(int idx=tid;idx<512*8;idx+=512){
    const int tok=idx>>3,ch=idx&7; const long row=((long)b*SEQ+chunk*512+tok)*PITCH;
    const float e0=lse_l[tok],e1=lse_l[512+tok],e2=lse_l[1024+tok]; const float em=fmaxf(e0,fmaxf(e1,e2));
    float w0=__builtin_amdgcn_exp2f(e0-em),w1=__builtin_amdgcn_exp2f(e1-em),w2=__builtin_amdgcn_exp2f(e2-em); const float iw=__builtin_amdgcn_rcpf(w0+w1+w2); w0*=iw;w1*=iw;w2*=iw;
    const u32x4 a=*reinterpret_cast<const u32x4*>(P+row+hs*64+ch*8), bq=*reinterpret_cast<const u32x4*>(P+row+768+hs*64+ch*8), cq=*reinterpret_cast<const u32x4*>(P+row+1536+hs*64+ch*8);
    u32x4*zp=reinterpret_cast<u32x4*>(P+row+2304+hs*64+ch*8); const u32x4 z=__builtin_nontemporal_load(zp); u32x4 w;
    #define CMB(f) cvtpk_s((w0*bl(a.f)+w1*bl(bq.f)+w2*bl(cq.f))*bl(z.f),(w0*bh(a.f)+w1*bh(bq.f)+w2*bh(cq.f))*bh(z.f))
    w.x=CMB(x); w.y=CMB(y); w.z=CMB(z); w.w=CMB(w);
    #undef CMB
    *zp=w;
  }
  __syncthreads();
}
#undef AMFMA
}

constexpr int NWAVES = 8;
constexpr int BATCH = 16, SEQ = 2048, DM = 1024, M = BATCH * SEQ, DEPTH = 2;
constexpr int INC = 6656;
constexpr int LDP = 4608;
constexpr int C_AQKV = 0, C_ZA = 2304, C_BQKV = 2560, C_ZB = 4096, C_RA = 4608, C_RB = 5632;
constexpr int C_MERGED = 0;
constexpr float RMS_EPS = 1e-6f;
constexpr size_t MiB = 1u << 20;
constexpr size_t WS_CTL = 0;
constexpr size_t WS_BAR = 0, WS_BAR_BYTES = 64 * 1024;
constexpr size_t WS_KMEAN = 256 * 1024;
constexpr size_t WS_WIN = 1 * MiB;
constexpr size_t WS_WCAT = 14 * MiB;
constexpr size_t WS_WOUT = 17 * MiB;
constexpr size_t WS_XB = 21 * MiB;
constexpr size_t WS_PROJ = 85 * MiB;
constexpr size_t WS_GATES = 373 * MiB;
constexpr size_t WS_WIN1 = 437 * MiB;
constexpr size_t WS_ROWSS = 450 * MiB;
constexpr size_t WS_END = 454 * MiB;
static_assert(WS_PROJ + (size_t)M * LDP * 2 == WS_GATES && WS_GATES + (size_t)M * 2048 == WS_WIN1, "ws map");
constexpr int LDS_MISC = pg8::EPI_OFF + 8 * pg8::EPI_WAVE;
constexpr int LDS_RSTAB = LDS_MISC + 256;
constexpr int LDS_BYTES = LDS_RSTAB + 1024 + 64;

#define LAS __attribute__((address_space(3)))
typedef unsigned short bf16;
typedef unsigned v4u __attribute__((ext_vector_type(4)));
typedef float f32x4 __attribute__((ext_vector_type(4)));
#define RLX_AGENT __ATOMIC_RELAXED, __HIP_MEMORY_SCOPE_AGENT
#define XB_TMO      128
#define XB_XCNT(j)  (256  + 64 * (j))
#define XB_XSUB(j)  (1280 + 64 * (j))
#define XB_XGEN(j)  (2304 + 64 * (j))
#define XB_TOP      3328
#define XB_TOPGEN   3392
#define XCD_BAR_WORDS 3456
#define XB_SPIN_CAP (1u << 18)

__device__ __forceinline__ unsigned xb_ld(unsigned* p)              { return __hip_atomic_load(p, __ATOMIC_RELAXED, __HIP_MEMORY_SCOPE_AGENT); }
__device__ __forceinline__ unsigned xb_add(unsigned* p, unsigned v) { return __hip_atomic_fetch_add(p, v, __ATOMIC_RELAXED, __HIP_MEMORY_SCOPE_AGENT); }
__device__ __forceinline__ unsigned xb_xcc_id() { return (unsigned)__builtin_amdgcn_s_getreg((3 << 11) | 20) & 0xFu; }
#define XB_SPIN(cond, bar) do { unsigned _sp = 0; while (cond) { __builtin_amdgcn_s_sleep(1); \
    if ((++_sp & 255u) == 0u) { if (xb_ld(&(bar)[XB_TMO])) break; if (_sp > XB_SPIN_CAP) { atomicAdd(&(bar)[XB_TMO], 1u); break; } } } } while (0)

struct XcdBarrier {
    unsigned* bar; unsigned x;
    volatile LAS unsigned* st;
};

__device__ __forceinline__ XcdBarrier xcd_barrier_post(unsigned* bar, volatile LAS unsigned* st) {
    XcdBarrier b; b.bar = bar; b.x = xb_xcc_id(); b.st = st;
    if (threadIdx.x == 0) (void)xb_add(&bar[XB_XCNT(b.x)], 1u);
    return b;
}
__device__ __forceinline__ void xcd_barrier_complete(unsigned* bar, unsigned x, unsigned& nloc, unsigned& nx) {
    const unsigned G = gridDim.x * gridDim.y * gridDim.z;
    unsigned sum, cnt, mine, sp = 0u;
    for (;;) {
        sum = 0u; cnt = 0u; mine = 0u;
#pragma unroll
        for (unsigned j = 0; j < 16; ++j) { const unsigned c = xb_ld(&bar[XB_XCNT(j)]); sum += c; cnt += (c > 0u) ? 1u : 0u; mine = (j == x) ? c : mine; }
        if (sum == G) break;
        __builtin_amdgcn_s_sleep(1);
        if ((++sp & 255u) == 0u) { if (xb_ld(&bar[XB_TMO])) break; if (sp > XB_SPIN_CAP) { atomicAdd(&bar[XB_TMO], 1u); break; } }
    }
    nloc = mine > 0u ? mine : 1u; nx = cnt > 0u ? cnt : 1u;
}

__device__ __forceinline__ void xcd_barrier(const XcdBarrier& b) {
    asm volatile("s_waitcnt vmcnt(0)" ::: "memory");
    __syncthreads();
    if (threadIdx.x == 0) {
        unsigned* bar = b.bar;
        __builtin_amdgcn_s_waitcnt(0);
        unsigned nloc = b.st[0], nx = b.st[1];
        if (nloc == 0u) { xcd_barrier_complete(bar, b.x, nloc, nx); b.st[0] = nloc; b.st[1] = nx; }
        const unsigned old = xb_add(&bar[XB_XSUB(b.x)], 1u);
        const unsigned gen = old / nloc;
        if (old + 1u == (gen + 1u) * nloc) {
            __builtin_amdgcn_fence(__ATOMIC_RELEASE, "agent");
            asm volatile("s_waitcnt vmcnt(0)" ::: "memory");
            const unsigned og = xb_add(&bar[XB_TOP], 1u);
            const unsigned tg = og / nx;
            if (og + 1u == (tg + 1u) * nx) xb_add(&bar[XB_TOPGEN], 1u);
            else XB_SPIN(xb_ld(&bar[XB_TOPGEN]) == tg, bar);
            __builtin_amdgcn_fence(__ATOMIC_ACQUIRE, "agent");
            xb_add(&bar[XB_XGEN(b.x)], 1u);
            asm volatile("s_waitcnt vmcnt(0)" ::: "memory");
        } else {
            XB_SPIN(xb_ld(&bar[XB_XGEN(b.x)]) == gen, bar);
            __builtin_amdgcn_fence(__ATOMIC_ACQUIRE, "agent");
            asm volatile("s_waitcnt vmcnt(0)" ::: "memory");
        }
    }
    __syncthreads();
}

__device__ __forceinline__ unsigned f2bf(float f) { unsigned u = __builtin_bit_cast(unsigned, f); return (u + 0x7fffu + ((u >> 16) & 1u)) >> 16; }
__device__ __forceinline__ unsigned pk2(float lo, float hi) { return f2bf(lo) | (f2bf(hi) << 16); }
__device__ __forceinline__ float bf2f(bf16 v) { return __uint_as_float(((unsigned)v) << 16); }
__device__ __forceinline__ float blo(unsigned u) { return __uint_as_float(u << 16); }
__device__ __forceinline__ float bhi(unsigned u) { return __uint_as_float(u & 0xffff0000u); }
__device__ __forceinline__ float wave_sum(float v) {
#pragma unroll
    for (int o = 1; o < 64; o <<= 1) v += __shfl_xor(v, o);
    return v;
}
__device__ __forceinline__ float wave_max(float v) {
#pragma unroll
    for (int o = 1; o < 64; o <<= 1) v = fmaxf(v, __shfl_xor(v, o));
    return v;
}
__device__ __forceinline__ void transpose_item(const float* W, int K, int N, bf16* WT, int ldw, LAS float* scr, int item, int lane, const float* gain = nullptr) {
    const int nblk = N / 32, kb = item / nblk, nb = item % nblk, k0 = 64 * kb, n0 = 32 * nb;
    f32x4 v[8]; float gk[8];
#pragma unroll
    for (int i = 0; i < 8; ++i) { const int kk = 8 * i + (lane >> 3); v[i] = __builtin_nontemporal_load((const f32x4*)(W + (size_t)(k0 + kk) * N + n0 + 4 * (lane & 7))); gk[i] = gain ? gain[k0 + kk] : 1.0f; }
#pragma unroll
    for (int i = 0; i < 8; ++i) { const int kk = 8 * i + (lane >> 3); LAS float* d = scr + kk * 33 + 4 * (lane & 7); d[0] = v[i].x * gk[i]; d[1] = v[i].y * gk[i]; d[2] = v[i].z * gk[i]; d[3] = v[i].w * gk[i]; }
    asm volatile("s_waitcnt lgkmcnt(0)" ::: "memory");
    const int c = lane & 7;
#pragma unroll
    for (int j = 0; j < 4; ++j) { const int n = (lane >> 3) + 8 * j; const LAS float* s = scr + (8 * c) * 33 + n;
        v4u o; o.x = pk2(s[0 * 33], s[1 * 33]); o.y = pk2(s[2 * 33], s[3 * 33]); o.z = pk2(s[4 * 33], s[5 * 33]); o.w = pk2(s[6 * 33], s[7 * 33]);
        *(v4u*)(WT + (size_t)(n0 + n) * ldw + k0 + 8 * c) = o; }
    asm volatile("s_waitcnt lgkmcnt(0)" ::: "memory");
}
template <bool OUT_BF16> __device__ __forceinline__ void rms_row(const float* xrow, const float* g, void* orow, int lane) {
    const f32x4* xr = (const f32x4*)xrow + lane; const f32x4* gr = (const f32x4*)g + lane;
    f32x4 v[4]; float s = 0.f;
#pragma unroll
    for (int j = 0; j < 4; ++j) { v[j] = xr[64 * j]; s += (v[j].x * v[j].x + v[j].y * v[j].y) + (v[j].z * v[j].z + v[j].w * v[j].w); }
    const float rstd = 1.0f / sqrtf(wave_sum(s) * (1.f / DM) + RMS_EPS);
#pragma unroll
    for (int j = 0; j < 4; ++j) { const f32x4 gg = gr[64 * j]; v[j] = v[j] * rstd * gg; }
    if (OUT_BF16) { unsigned long long* o8 = (unsigned long long*)orow + lane;
#pragma unroll
        for (int j = 0; j < 4; ++j) o8[64 * j] = (unsigned long long)pk2(v[j].x, v[j].y) | ((unsigned long long)pk2(v[j].z, v[j].w) << 32);
    } else { f32x4* o = (f32x4*)orow + lane;
#pragma unroll
        for (int j = 0; j < 4; ++j) o[64 * j] = v[j]; }
}
__device__ __forceinline__ void raw_row(const float* xrow, bf16* orow, float* ss, int lane) {
    const f32x4* xr = (const f32x4*)xrow + lane; f32x4 v[4]; float s = 0.f;
#pragma unroll
    for (int j = 0; j < 4; ++j) { v[j] = __builtin_nontemporal_load(xr + 64 * j); s += (v[j].x * v[j].x + v[j].y * v[j].y) + (v[j].z * v[j].z + v[j].w * v[j].w); }
    s = wave_sum(s); if (lane < 16) ss[lane] = (lane == 0) ? s : 0.f;
    unsigned long long* o8 = (unsigned long long*)orow + lane;
#pragma unroll
    for (int j = 0; j < 4; ++j) o8[64 * j] = (unsigned long long)pk2(v[j].x, v[j].y) | ((unsigned long long)pk2(v[j].z, v[j].w) << 32);
}
__device__ __forceinline__ float dot64(const v4u (&q)[8], const bf16* krow) {
    const v4u* kp = (const v4u*)krow; float a0 = 0.f, a1 = 0.f;
#pragma unroll
    for (int i = 0; i < 8; ++i) { const v4u k = kp[i];
        a0 += blo(q[i].x) * blo(k.x) + blo(q[i].y) * blo(k.y) + blo(q[i].z) * blo(k.z) + blo(q[i].w) * blo(k.w);
        a1 += bhi(q[i].x) * bhi(k.x) + bhi(q[i].y) * bhi(k.y) + bhi(q[i].z) * bhi(k.z) + bhi(q[i].w) * bhi(k.w); }
    return a0 + a1;
}

struct Args { const float* x; const float* norm_g; const float* w_in; const float* b_merge; const float* w_pa; const float* w_pb; const float* w_out; const float* final_g;
              float* out; unsigned char* ws; };

#define PHASE_VARS() \
    int tid_ = threadIdx.x; asm volatile("" : "+v"(tid_)); \
    const int lane = tid_ & 63, wave = __builtin_amdgcn_readfirstlane(tid_ >> 6); \
    const int G = gridDim.x, gw = blockIdx.x * NWAVES + wave, NGW = G * NWAVES; \
    unsigned long long wsb_ = (unsigned long long)a.ws; asm volatile("" : "+s"(wsb_)); \
    unsigned char* const ws = (unsigned char*)(__attribute__((address_space(1))) unsigned char*)wsb_;     \
    bf16* const Win = (bf16*)(ws + (layer == 0 ? WS_WIN : WS_WIN1)); float* const rowss = (float*)(ws + WS_ROWSS); bf16* const Wcat = (bf16*)(ws + WS_WCAT); bf16* const Wout = (bf16*)(ws + WS_WOUT); \
    bf16* const XB = (bf16*)(ws + WS_XB); bf16* const P = (bf16*)(ws + WS_PROJ); float* const kmean = (float*)(ws + WS_KMEAN); unsigned char* const gatesb = ws + WS_GATES; \
    (void)lane; (void)wave; (void)G; (void)gw; (void)NGW; (void)Win; (void)Wcat; (void)Wout; (void)rowss; (void)XB; (void)P; (void)kmean; (void)gatesb;

#define GRID_BAR() do { unsigned long long wb_ = (unsigned long long)a.ws; asm volatile("" : "+s"(wb_)); XcdBarrier bb_; bb_.bar = (unsigned*)(__attribute__((address_space(1))) unsigned*)wb_; \
    bb_.x = xb_xcc_id(); bb_.st = (volatile LAS unsigned*)(L + LDS_MISC); xcd_barrier(bb_); } while (0)
template <int layer> __device__ __forceinline__ void layer_fwd(const Args& a, unsigned char* lds, LAS unsigned char* L) {
    if (layer == 0) {
        PHASE_VARS();
        LAS float* scr = (LAS float*)(L + wave * 16384);
        constexpr int I_IN = (DM / 64) * (INC / 32), I_PA = (256 / 64) * (DM / 32), I_PB = (512 / 64) * (DM / 32), I_OUT = (DM / 64) * (DM / 32);
        const int nitems = 2 * (I_IN + I_PA + I_PB + I_OUT);
        for (int it = gw; it < nitems; it += NGW) {
            const int l2 = it / (I_IN + I_PA + I_PB + I_OUT); int r = it - l2 * (I_IN + I_PA + I_PB + I_OUT);
            if (r < I_IN) { transpose_item(a.w_in + (size_t)l2 * DM * INC, DM, INC, (bf16*)(ws + (l2 == 0 ? WS_WIN : WS_WIN1)), DM, scr, r, lane, a.norm_g + l2 * DM); continue; } r -= I_IN;
            if (r < I_PA) { transpose_item(a.w_pa + (size_t)l2 * 256 * DM, 256, DM, Wcat + (size_t)l2 * DM * 768, 768, scr, r, lane); continue; } r -= I_PA;
            if (r < I_PB) { transpose_item(a.w_pb + (size_t)l2 * 512 * DM, 512, DM, Wcat + (size_t)l2 * DM * 768 + 256, 768, scr, r, lane); continue; } r -= I_PB;
            transpose_item(a.w_out + (size_t)l2 * DM * DM, DM, DM, Wout + (size_t)l2 * DM * DM, DM, scr, r, lane);
        }
        for (int i = gw * 64 + lane; i < 2 * 128 * 512; i += NGW * 64) kmean[i] = 0.f;
        for (int m = gw; m < M; m += NGW) raw_row(a.x + (size_t)m * DM, XB + (size_t)m * DM, rowss + (size_t)m * 16, lane);
    }
    if (layer == 0) GRID_BAR();
    {
        PHASE_VARS();
        if (threadIdx.x == 0) ((LAS int*)(L + LDS_RSTAB))[256] = -1;
        __syncthreads();
        pg8::Gemm g{XB, Win, M, INC, DM, DM}; pg8::StaticOrder S; S.init(M, INC, G, (int)blockIdx.x);
        pg8::EpiProj E{P, LDP, a.b_merge + layer * 2 * DM, kmean + layer * 128 * 512, gatesb, rowss + (size_t)layer * M * 16};
        pg8::gemm_phase<pg8::EpiProj, pg8::StaticOrder, true, true>(L, g, S, E);
    }
    GRID_BAR();
    {
        PHASE_VARS();
        const int vcu = (G % 8 == 0) ? ((int)blockIdx.x % 8) * (G / 8) + (int)blockIdx.x / 8 : (int)blockIdx.x;
#pragma unroll 1
        for (int pass = 0; pass < 2; ++pass) {
            if ((pass ^ (vcu >> 2)) & 1) {
                for (int it = (int)blockIdx.x; it < BATCH * 4 * 4; it += G) attna::wg_item((attna::bf16*)P, it >> 4, (it >> 2) & 3, it & 3, (char*)lds);
            } else {
                for (int p = vcu; p < BATCH * 8 * 4; p += G) {
                    const int bh = p >> 2, s = p & 3;
#pragma unroll 1
                    for (int u = 0; u < 2; ++u)
                        moba::moba_unit<8>(bh >> 3, bh & 7, u ? 7 - s : s, (const moba::bf16*)(P + C_BQKV), (const moba::bf16*)(P + C_BQKV + 512), (const moba::bf16*)(P + C_BQKV + 1024), (const moba::bf16*)(P + C_ZB), (moba::bf16*)(P + C_BQKV), kmean + layer * 128 * 512, (char*)lds);
                }
            }
        }
    }
    GRID_BAR();
    {
        PHASE_VARS();
        pg8::StaticOrder S; S.init(M, DM, G, (int)blockIdx.x);
        pg8::Gemm g{P + C_ZA, Wcat + (size_t)layer * DM * 768, M, DM, 768, LDP}; pg8::EpiMerge E{P + C_MERGED, gatesb, LDP};
        pg8::gemm_phase<pg8::EpiMerge, pg8::StaticOrder, true, true>(L, g, S, E);
    }
    GRID_BAR();
    {
        PHASE_VARS();
        pg8::Gemm g{P + C_MERGED, Wout + (size_t)layer * DM * DM, M, DM, DM, LDP}; pg8::StaticOrder S; S.init(M, DM, G, (int)blockIdx.x);
        pg8::EpiResid<layer> E{a.x, XB, rowss + (layer == 0 ? (size_t)M * 16 : 0), DM};
        pg8::gemm_phase<pg8::EpiResid<layer>, pg8::StaticOrder, true, true>(L, g, S, E);
    }
    GRID_BAR();
}

__global__ void __launch_bounds__(NWAVES * 64, 2) hybrid_fwd(Args a) {
    extern __shared__ __attribute__((aligned(16))) unsigned char lds[];
    LAS unsigned char* L = (LAS unsigned char*)lds;
    if (threadIdx.x < 16) ((LAS unsigned*)(L + LDS_MISC))[threadIdx.x] = 0u;
    __syncthreads();
    (void)xcd_barrier_post((unsigned*)a.ws, (volatile LAS unsigned*)(L + LDS_MISC));
    layer_fwd<0>(a, lds, L);
    layer_fwd<1>(a, lds, L);
    {
        constexpr int layer = 1; (void)layer;
        PHASE_VARS();
        typedef unsigned u32x2_t __attribute__((ext_vector_type(2)));
        f32x4 gg[4];
#pragma unroll
        for (int j = 0; j < 4; ++j) gg[j] = *((const f32x4*)a.final_g + lane + 64 * j);
        for (int m = gw; m < M; m += NGW) {
            const f32x4* pp = (const f32x4*)(rowss + (size_t)m * 16); const f32x4 s4 = (pp[0] + pp[1]) + (pp[2] + pp[3]);
            const float rstd = __builtin_amdgcn_rsqf(((s4[0] + s4[1]) + (s4[2] + s4[3])) * (1.0f / 1024.0f) + RMS_EPS);
            const u32x2_t* xb = (const u32x2_t*)(XB + (size_t)m * DM) + lane; f32x4* o = (f32x4*)(a.out + (size_t)m * DM) + lane;
            u32x2_t bv[4];
#pragma unroll
            for (int j = 0; j < 4; ++j) bv[j] = __builtin_nontemporal_load(xb + 64 * j);
#pragma unroll
            for (int j = 0; j < 4; ++j) __builtin_nontemporal_store((f32x4){blo(bv[j].x), bhi(bv[j].x), blo(bv[j].y), bhi(bv[j].y)} * rstd * gg[j], o + 64 * j);
        }
    }
}

extern "C" void kernel_launch(void* const* d_in, const int* in_sizes, int n_in, void* d_out, int out_size, void* d_ws, size_t ws_size, hipStream_t stream) {
    static int grid = 0;
    if (grid == 0) {
        if (n_in != 8 || in_sizes[0] != M * DM || out_size != M * DM || ws_size < WS_END) { fprintf(stderr, "kernel_launch: unexpected shapes / workspace (n_in %d, ws %zu)\n", n_in, ws_size); grid = -1; return; }
        int dev = 0, cus = 0, per_cu = 0;
        hipGetDevice(&dev); hipDeviceGetAttribute(&cus, hipDeviceAttributeMultiprocessorCount, dev);
        if (hipFuncSetAttribute((const void*)hybrid_fwd, hipFuncAttributeMaxDynamicSharedMemorySize, LDS_BYTES) != hipSuccess) { fprintf(stderr, "kernel_launch: hipFuncSetAttribute failed\n"); grid = -1; return; }
        if (hipOccupancyMaxActiveBlocksPerMultiprocessor(&per_cu, (const void*)hybrid_fwd, NWAVES * 64, LDS_BYTES) != hipSuccess || per_cu < 1) { fprintf(stderr, "kernel_launch: the occupancy query admits %d workgroups per CU; nothing launched\n", per_cu); grid = -1; return; }
        (void)hipGetLastError();
        grid = cus;
    }
    if (grid < 0) return;
    if (hipMemsetAsync((char*)d_ws + WS_BAR, 0, WS_BAR_BYTES, stream) != hipSuccess) { fprintf(stderr, "kernel_launch: hipMemsetAsync failed\n"); return; }
    Args a{};
    a.x = (const float*)d_in[0]; a.norm_g = (const float*)d_in[1]; a.w_in = (const float*)d_in[2]; a.b_merge = (const float*)d_in[3];
    a.w_pa = (const float*)d_in[4]; a.w_pb = (const float*)d_in[5]; a.w_out = (const float*)d_in[6]; a.final_g = (const float*)d_in[7];
    a.out = (float*)d_out; a.ws = (unsigned char*)d_ws;
    hipLaunchKernelGGL(hybrid_fwd, dim3(grid), dim3(NWAVES * 64), LDS_BYTES, stream, a);
    const hipError_t e = hipPeekAtLastError();
    if (e != hipSuccess) fprintf(stderr, "kernel_launch: launch failed: %s (grid %d)\n", hipGetErrorString(e), grid);
}
```

```cpp
#include <hip/hip_runtime.h>
#include <cstdio>
#include <cstdint>
namespace pg8 {
#define PG8_LAS __attribute__((address_space(3)))
typedef unsigned short bf16_t;
typedef short bf16x8 __attribute__((ext_vector_type(8)));
typedef float f32x4 __attribute__((ext_vector_type(4)));
typedef unsigned u32x4 __attribute__((ext_vector_type(4)));
constexpr int BM = 256, BK = 64, HALF = 128, HTB = HALF * BK * 2  , STAGE_BYTES = 8 * HTB, NXCD = 8, WGM = 8;
constexpr int EPI_OFF = STAGE_BYTES, EPI_PITCH = 144, EPI_WAVE = 16 * EPI_PITCH;

__host__ __device__ __forceinline__ int lds_byte(int r, int c) { const int st = (r >> 4) * 2 + (c >> 5), rr = r & 15, cc = c & 31, ob = rr * 64 + cc * 2; return st * 1024 + (ob ^ (((ob >> 9) & 1) << 5)); }
__host__ __device__ __forceinline__ void stage_rc(int b, int& R, int& C) { const int st = b / 1024, sb = b % 1024, swz = sb ^ (((sb >> 9) & 1) << 5); R = (st >> 1) * 16 + swz / 64; C = (st & 1) * 32 + (swz % 64) / 2; }
__host__ __device__ __forceinline__ int perm32(int rho) { const int n = rho >> 4, i = rho & 15; return 8 * (i >> 2) + 4 * n + (i & 3); }

struct Unit { int pm, pn; };
struct Gemm { const bf16_t* A; const bf16_t* Bt; int M, N, K, lda; };

struct StaticOrder {
    int nM, nN, nwg, G, c;
    __host__ __device__ void init(int M, int N, int G_, int c_) { nM = M / BM; nN = N / BM; nwg = nM * nN; G = G_; c = c_; }
    __host__ __device__ bool next(int i, Unit& u) const {
        const long L = (long)i * G + c; if (L >= nwg) return false;
        int wgid = (int)L; { const int q = nwg / NXCD, r = nwg % NXCD, xcd = wgid % NXCD, off = wgid / NXCD; wgid = (xcd < r ? xcd * (q + 1) : r * (q + 1) + (xcd - r) * q) + off; }
        const int nig = WGM * nN, gid = wgid / nig, fm = gid * WGM, gsz = (nM - fm) < WGM ? (nM - fm) : WGM;
        u.pm = fm + ((wgid % nig) % gsz); u.pn = (wgid % nig) / gsz; return true;
    }
    __device__ __forceinline__ void a_ready(const Unit&) const {}
    __device__ __forceinline__ void done(const Unit&) const {}
};


template <class Epi, class Sched, bool ALIGN_EPI = false, bool SP2 = false>
__device__ __forceinline__ void gemm_phase(PG8_LAS unsigned char* lds, const Gemm g, const Sched& S, const Epi& E) {
    int tid_ = threadIdx.x; asm volatile("" : "+v"(tid_));
    const int tid = tid_, wid = __builtin_amdgcn_readfirstlane(tid >> 6), lane = tid & 63, wr = wid >> 2, wc = wid & 3, fr = lane & 15, fq = lane >> 4;
    const int K = g.K, nt = K / BK;
    unsigned voffA[2], voffB[2];
#pragma unroll
    for (int i = 0; i < 2; ++i) { int R, C; stage_rc(tid * 16 + i * 8192, R, C); const int Rb = 64 * (R >> 5) + (Epi::PERM ? perm32(R & 31) : (R & 31));
        voffA[i] = (unsigned)(R * g.lda + C) * 2u; voffB[i] = (unsigned)(Rb * K + C) * 2u; }
    const size_t kstep = (size_t)(BK * 2);
    const size_t hstepB = (size_t)32 * K * 2, hstepA = (size_t)HALF * g.lda * 2;
    const size_t tstepB = (size_t)BM * K * 2, tstepA = 2 * hstepA;
    const unsigned ldsw = (unsigned)wid * 1024u;
    const int aoff = lds_byte(wr * 64 + fr, fq * 8), boff = lds_byte(wc * 32 + fr, fq * 8);
#define PG8_SA(b, h) (((b) * 2 + (h)) * HTB)
#define PG8_SB(b, h) ((4 + (b) * 2 + (h)) * HTB)
#define PG8_STAGE(bufoff, gbase, voff) do { _Pragma("unroll") for (int _i = 0; _i < 2; ++_i) \
        __builtin_amdgcn_global_load_lds((const unsigned*)((const char*)(gbase) + (voff)[_i]), (PG8_LAS unsigned*)(lds + (bufoff) + ldsw + _i * 8192), 16, 0, 0); } while (0)
#define PG8_LDA(dst, b, h) do { _Pragma("unroll") for (int m = 0; m < 4; ++m) _Pragma("unroll") for (int k = 0; k < 2; ++k) dst[m][k] = *(const PG8_LAS bf16x8*)(lds + PG8_SA(b, h) + aoff + m * 2048 + k * 1024); } while (0)
#define PG8_LDB(dst, b, h) do { _Pragma("unroll") for (int n = 0; n < 2; ++n) _Pragma("unroll") for (int k = 0; k < 2; ++k) dst[n][k] = *(const PG8_LAS bf16x8*)(lds + PG8_SB(b, h) + boff + n * 2048 + k * 1024); } while (0)
#define PG8_MMA(ai, bj, At, Bt) do { __builtin_amdgcn_s_setprio(1); _Pragma("unroll") for (int m = 0; m < 4; ++m) _Pragma("unroll") for (int n = 0; n < 2; ++n) _Pragma("unroll") for (int k = 0; k < 2; ++k) \
        acc[ai][bj][m][n] = __builtin_amdgcn_mfma_f32_16x16x32_bf16(Bt[n][k], At[m][k], acc[ai][bj][m][n], 0, 0, 0); __builtin_amdgcn_s_setprio(0); } while (0)
#define PG8_WAIT_V(n) asm volatile("s_waitcnt vmcnt(" #n ")" ::: "memory")
#define PG8_WAIT_L(n) asm volatile("s_waitcnt lgkmcnt(" #n ")" ::: "memory")
#define PG8_BAR __builtin_amdgcn_s_barrier()
#define PG8_SCHED __builtin_amdgcn_sched_barrier(0)
    Unit cur, nxt; int ui = 0;
    if (!S.next(0, cur)) return;
    f32x4 acc[2][2][4][2];
#pragma unroll
    for (int a = 0; a < 2; ++a)
#pragma unroll
        for (int b = 0; b < 2; ++b)
#pragma unroll
            for (int m = 0; m < 4; ++m)
#pragma unroll
                for (int n = 0; n < 2; ++n) acc[a][b][m][n] = (f32x4){0.f, 0.f, 0.f, 0.f};
    bf16x8 At[4][2], B0[2][2], B1[2][2];
    const char* cA = (const char*)g.A + (size_t)cur.pm * tstepA; const char* cB = (const char*)g.Bt + (size_t)cur.pn * tstepB;
    S.a_ready(cur);
    if constexpr (SP2) {
        PG8_STAGE(PG8_SB(0, 0), cB, voffB); PG8_STAGE(PG8_SB(0, 1), cB + hstepB, voffB); PG8_STAGE(PG8_SA(0, 0), cA, voffA); PG8_STAGE(PG8_SA(0, 1), cA + hstepA, voffA);
        if (wr == 1) PG8_BAR;
        PG8_WAIT_V(2); PG8_BAR;
        PG8_STAGE(PG8_SB(1, 0), cB + kstep, voffB); PG8_STAGE(PG8_SA(1, 0), cA + kstep, voffA); PG8_STAGE(PG8_SB(1, 1), cB + hstepB + kstep, voffB);
        PG8_WAIT_V(6); PG8_BAR;
    } else {
        PG8_STAGE(PG8_SB(0, 0), cB, voffB); PG8_STAGE(PG8_SA(0, 0), cA, voffA); PG8_STAGE(PG8_SB(0, 1), cB + hstepB, voffB); PG8_STAGE(PG8_SA(0, 1), cA + hstepA, voffA);
        if (wr == 1) PG8_BAR;
        PG8_WAIT_V(4); PG8_BAR;
        PG8_STAGE(PG8_SB(1, 0), cB + kstep, voffB); PG8_STAGE(PG8_SA(1, 0), cA + kstep, voffA); PG8_STAGE(PG8_SB(1, 1), cB + hstepB + kstep, voffB);
        PG8_WAIT_V(6); PG8_BAR;
    }
    for (;;) {
        const bool has_next = S.next(ui + 1, nxt);
        const char* nA = has_next ? (const char*)g.A + (size_t)nxt.pm * tstepA : cA; const char* nB = has_next ? (const char*)g.Bt + (size_t)nxt.pn * tstepB : cB;
        for (int t = 0; t < nt; t += 2) {
            const bool last = (t == nt - 2);
            const char* a1 = cA + (size_t)(t + 1) * kstep;
            const char* a2 = last ? nA : cA + (size_t)(t + 2) * kstep; const char* b2 = last ? nB : cB + (size_t)(t + 2) * kstep;
            const char* a3 = a2 + kstep; const char* b3 = b2 + kstep;
            if (last && has_next) S.a_ready(nxt);
            if constexpr (SP2) {
            PG8_LDB(B0, 0, 0); PG8_LDB(B1, 0, 1); PG8_SCHED; PG8_LDA(At, 0, 0); PG8_STAGE(PG8_SA(1, 1), a1 + hstepA, voffA);
            PG8_WAIT_V(8); PG8_WAIT_L(0); PG8_BAR; PG8_MMA(0, 0, At, B0); PG8_MMA(0, 1, At, B1); PG8_BAR; PG8_SCHED;
            PG8_LDA(At, 0, 1); PG8_STAGE(PG8_SB(0, 0), b2, voffB); PG8_STAGE(PG8_SB(0, 1), b2 + hstepB, voffB); PG8_STAGE(PG8_SA(0, 0), a2, voffA);
            PG8_WAIT_V(8); PG8_WAIT_L(0); PG8_BAR; PG8_MMA(1, 0, At, B0); PG8_MMA(1, 1, At, B1); PG8_BAR; PG8_SCHED;
            PG8_LDB(B0, 1, 0); PG8_LDB(B1, 1, 1); PG8_SCHED; PG8_LDA(At, 1, 0); PG8_STAGE(PG8_SA(0, 1), a2 + hstepA, voffA);
            PG8_WAIT_V(8); PG8_WAIT_L(0); PG8_BAR; PG8_MMA(0, 0, At, B0); PG8_MMA(0, 1, At, B1); PG8_BAR; PG8_SCHED;
            PG8_LDA(At, 1, 1); PG8_STAGE(PG8_SB(1, 0), b3, voffB); PG8_STAGE(PG8_SB(1, 1), b3 + hstepB, voffB); PG8_STAGE(PG8_SA(1, 0), a3, voffA);
            PG8_WAIT_V(8); PG8_WAIT_L(0); PG8_BAR; PG8_MMA(1, 0, At, B0); PG8_MMA(1, 1, At, B1); PG8_BAR; PG8_SCHED;
            if constexpr (Epi::HAS_MID) { if (t == Epi::MID_T) { E.mid(acc, cur, wr, wc, fr, fq, wid); PG8_SCHED; } }
            } else {
            PG8_LDB(B0, 0, 0); PG8_SCHED; PG8_LDA(At, 0, 0); PG8_STAGE(PG8_SA(1, 1), a1 + hstepA, voffA);
            PG8_WAIT_L(8); PG8_BAR; PG8_WAIT_L(0); PG8_MMA(0, 0, At, B0); PG8_BAR; PG8_SCHED;
            PG8_LDB(B1, 0, 1); PG8_STAGE(PG8_SB(0, 0), b2, voffB);
            PG8_BAR; PG8_WAIT_L(0); PG8_MMA(0, 1, At, B1); PG8_BAR;
            PG8_LDA(At, 0, 1); PG8_STAGE(PG8_SA(0, 0), a2, voffA);
            PG8_BAR; PG8_WAIT_L(0); PG8_MMA(1, 0, At, B0); PG8_BAR; PG8_SCHED;
            PG8_STAGE(PG8_SB(0, 1), b2 + hstepB, voffB);
            PG8_WAIT_V(6); PG8_BAR; PG8_MMA(1, 1, At, B1); PG8_BAR;
            PG8_LDB(B0, 1, 0); PG8_SCHED; PG8_LDA(At, 1, 0); PG8_STAGE(PG8_SA(0, 1), a2 + hstepA, voffA);
            PG8_WAIT_L(8); PG8_BAR; PG8_WAIT_L(0); PG8_MMA(0, 0, At, B0); PG8_BAR; PG8_SCHED;
            PG8_LDB(B1, 1, 1); PG8_STAGE(PG8_SB(1, 0), b3, voffB);
            PG8_BAR; PG8_WAIT_L(0); PG8_MMA(0, 1, At, B1); PG8_BAR;
            PG8_LDA(At, 1, 1); PG8_STAGE(PG8_SA(1, 0), a3, voffA);
            PG8_BAR; PG8_WAIT_L(0); PG8_MMA(1, 0, At, B0); PG8_BAR; PG8_SCHED;
            PG8_STAGE(PG8_SB(1, 1), b3 + hstepB, voffB);
            PG8_WAIT_V(6); PG8_BAR; PG8_MMA(1, 1, At, B1); PG8_BAR;
            }
        }
        if constexpr (ALIGN_EPI) { if (wr == 0) PG8_BAR; }
        if constexpr (!Epi::AFTER_DRAIN) { E(acc, cur, wr, wc, fr, fq, lds + EPI_OFF + wid * EPI_WAVE, lane, wid); S.done(cur); }
        if (!has_next) break;
#pragma unroll
        for (int a = 0; a < 2; ++a)
#pragma unroll
            for (int b = 0; b < 2; ++b)
#pragma unroll
                for (int m = 0; m < 4; ++m)
#pragma unroll
                    for (int n = 0; n < 2; ++n) acc[a][b][m][n] = (f32x4){0.f, 0.f, 0.f, 0.f};
        cur = nxt; cA = nA; cB = nB; ++ui;
        if constexpr (ALIGN_EPI) { if (wr == 1) PG8_BAR; }
    }
    PG8_WAIT_V(0);
    if constexpr (!ALIGN_EPI) { if (wr == 0) PG8_BAR; }
    PG8_BAR;
    if constexpr (Epi::AFTER_DRAIN) { E.fused(acc, cur, wr, wc, fr, fq, lds, wid, lane); S.done(cur); }
#undef PG8_SA
#undef PG8_SB
#undef PG8_STAGE
#undef PG8_LDA
#undef PG8_LDB
#undef PG8_MMA
#undef PG8_WAIT_V
#undef PG8_WAIT_L
#undef PG8_BAR
#undef PG8_SCHED
}
}


namespace pg8 {
__device__ __forceinline__ unsigned cvt_pk_bf16(float lo, float hi) { unsigned r; asm volatile("v_cvt_pk_bf16_f32 %0, %1, %2" : "=v"(r) : "v"(lo), "v"(hi)); return r; }
__device__ __forceinline__ float bflo(unsigned u) { return __uint_as_float(u << 16); }
__device__ __forceinline__ float bfhi(unsigned u) { return __uint_as_float(u & 0xffff0000u); }
__device__ __forceinline__ float sigmoidf_(float v) { return __builtin_amdgcn_rcpf(1.0f + __expf(-v)); }
typedef unsigned u32x2 __attribute__((ext_vector_type(2)));
__device__ __forceinline__ void piece_xpose(PG8_LAS unsigned char* stg, u32x4 in0, u32x4 in1, u32x4& out0, u32x4& out1, int fr, int fq, int lane) {
    *(PG8_LAS u32x4*)(stg + fr * EPI_PITCH + fq * 16) = in0; *(PG8_LAS u32x4*)(stg + fr * EPI_PITCH + 64 + fq * 16) = in1;
    out0 = *(const PG8_LAS u32x4*)(stg + (lane >> 3) * EPI_PITCH + (lane & 7) * 16); out1 = *(const PG8_LAS u32x4*)(stg + ((lane >> 3) + 8) * EPI_PITCH + (lane & 7) * 16);
}

struct EpiProj {
    static constexpr bool PERM = true, AFTER_DRAIN = false, HAS_MID = false; static constexpr int MID_T = 0;
    bf16_t* O; int ldc; const float* bmerge; float* kmean; unsigned char* gates; const float* rowss;
    __device__ __forceinline__ void operator()(const f32x4 (&acc)[2][2][4][2], const Unit& u, int wr, int wc, int fr, int fq, PG8_LAS unsigned char* stg, int lane, int wid) const {
        asm volatile("" : "+v"(fr), "+v"(fq), "+v"(lane));
        const int col0 = u.pn * BM + wc * 64 + 8 * fq;
        const int kind = (u.pn == 9 || u.pn == 16 || u.pn == 17) ? 1 : (u.pn >= 18 ? 2 : 0);
        PG8_LAS float* const tab = (PG8_LAS float*)(stg - wid * EPI_WAVE + 8 * EPI_WAVE + 256);
        if (__builtin_amdgcn_readfirstlane(((const PG8_LAS int*)tab)[256]) != u.pm) {
            asm volatile("s_waitcnt lgkmcnt(0)" ::: "memory"); __builtin_amdgcn_s_barrier(); asm volatile("" ::: "memory");
            const int t_ = wid * 64 + lane;
            if (t_ < 256) { const f32x4* pp = (const f32x4*)(rowss + (size_t)(u.pm * BM + t_) * 16); const f32x4 s4 = (pp[0] + pp[1]) + (pp[2] + pp[3]);
                tab[t_] = __builtin_amdgcn_rsqf(((s4[0] + s4[1]) + (s4[2] + s4[3])) * (1.0f / 1024.0f) + 1e-6f); }
            if (t_ == 0) ((PG8_LAS int*)tab)[256] = u.pm;
            asm volatile("s_waitcnt vmcnt(0) lgkmcnt(0)" ::: "memory"); __builtin_amdgcn_s_barrier(); asm volatile("" ::: "memory");
        }
        float rs[2][4];
#pragma unroll
        for (int ai = 0; ai < 2; ++ai)
#pragma unroll
            for (int m = 0; m < 4; ++m) rs[ai][m] = tab[ai * HALF + wr * 64 + m * 16 + fr];
        const float qs = (u.pn == 0 || u.pn == 3 || u.pn == 6 || u.pn == 10 || u.pn == 11) ? 0.18033688011112042f : 1.0f;
        if (kind == 2) {
            f32x4 bv[2][2];
#pragma unroll
            for (int bj = 0; bj < 2; ++bj)
#pragma unroll
                for (int n = 0; n < 2; ++n) bv[bj][n] = *(const f32x4*)(bmerge + (col0 - 4608) + bj * 32 + 4 * n) * (-1.4426950408889634f);
            unsigned char* gp = gates + ((size_t)((u.pm * 8 + (u.pn - 18)) * 8 + wid) * 8) * 1024 + fr * 64 + fq * 16;
#pragma unroll
            for (int ai = 0; ai < 2; ++ai)
#pragma unroll
                for (int m = 0; m < 4; ++m) { u32x4 q;
#pragma unroll
                    for (int bj = 0; bj < 2; ++bj)
#pragma unroll
                        for (int n = 0; n < 2; ++n) { const f32x4 v = acc[ai][bj][m][n] * (rs[ai][m] * -1.4426950408889634f) + bv[bj][n]; unsigned w = 0u;
#pragma unroll
                            for (int e = 0; e < 4; ++e) w = __builtin_amdgcn_cvt_pk_u8_f32(__builtin_fmaxf(255.0f * __builtin_amdgcn_rcpf(1.0f + __builtin_amdgcn_exp2f(v[e])), 1.0f), e, w);
                            q[2 * bj + n] = w; }
                    __builtin_nontemporal_store(q, (u32x4*)(gp + (ai * 4 + m) * 1024)); }
            return;
        }
        const size_t rbase = (size_t)(u.pm * BM + wr * 64 + (lane >> 3)); bf16_t* const op = O + u.pn * BM + wc * 64 + 8 * (lane & 7);
#pragma unroll
        for (int ai = 0; ai < 2; ++ai)
#pragma unroll
            for (int m = 0; m < 4; ++m) { u32x4 w[2];
#pragma unroll
                for (int bj = 0; bj < 2; ++bj) { f32x4 v0 = acc[ai][bj][m][0] * rs[ai][m], v1 = acc[ai][bj][m][1] * rs[ai][m];
                    if (kind == 1) {
#pragma unroll
                        for (int e = 0; e < 4; ++e) { v0[e] = v0[e] * sigmoidf_(v0[e]); v1[e] = v1[e] * sigmoidf_(v1[e]); } }
                    v0 = v0 * qs; v1 = v1 * qs;
                    w[bj].x = cvt_pk_bf16(v0[0], v0[1]); w[bj].y = cvt_pk_bf16(v0[2], v0[3]); w[bj].z = cvt_pk_bf16(v1[0], v1[1]); w[bj].w = cvt_pk_bf16(v1[2], v1[3]); }
                u32x4 o0, o1; piece_xpose(stg, w[0], w[1], o0, o1, fr, fq, lane);
                bf16_t* rp = op + (rbase + ai * HALF + m * 16) * ldc;
                __builtin_nontemporal_store(o0, (u32x4*)rp); __builtin_nontemporal_store(o1, (u32x4*)(rp + (size_t)8 * ldc));
                asm volatile("" ::: "memory"); }
        if (u.pn == 12 || u.pn == 13) {
#pragma unroll
            for (int bj = 0; bj < 2; ++bj)
#pragma unroll
                for (int n = 0; n < 2; ++n) { f32x4 cs = (f32x4){0.f, 0.f, 0.f, 0.f};
#pragma unroll
                    for (int ai = 0; ai < 2; ++ai)
#pragma unroll
                        for (int m = 0; m < 4; ++m) { float r2 = rs[ai][m]; asm volatile("" : "+v"(r2)); cs += acc[ai][bj][m][n] * r2; }
#pragma unroll
                    for (int e = 0; e < 4; ++e) { float v = cs[e]; v += __shfl_xor(v, 1); v += __shfl_xor(v, 2); v += __shfl_xor(v, 4); v += __shfl_xor(v, 8); cs[e] = v; }
                    if (fr == 0) { float* kp = kmean + (size_t)u.pm * 512 + (u.pn - 12) * 256 + wc * 64 + bj * 32 + 8 * fq + 4 * n;
#pragma unroll
                        for (int e = 0; e < 4; ++e) atomicAdd(kp + e, cs[e] * (1.0f / 256.0f)); } }
        }
    }
};
struct EpiMerge {
    static constexpr bool PERM = true, AFTER_DRAIN = false, HAS_MID = true; static constexpr int MID_T = 2;
    bf16_t* O; const unsigned char* gates; int ldc;
    __device__ __forceinline__ static float ub(unsigned w, int i) { return (float)((w >> (8 * i)) & 0xffu); }
    __device__ __forceinline__ void mid(f32x4 (&acc)[2][2][4][2], const Unit& u, int wr, int wc, int fr, int fq, int wid) const {
        asm volatile("" : "+v"(fr), "+v"(fq));
        const unsigned char* ga = gates + ((size_t)((u.pm * 8 + u.pn) * 8 + wid) * 8) * 1024 + fr * 64 + fq * 16; const unsigned char* gb = ga + (size_t)4 * 8 * 8 * 1024;
        u32x4 av[2][4], bv[2][4];
#pragma unroll
        for (int ai = 0; ai < 2; ++ai)
#pragma unroll
            for (int m = 0; m < 4; ++m) { av[ai][m] = __builtin_nontemporal_load((const u32x4*)(ga + (ai * 4 + m) * 1024)); bv[ai][m] = *(const u32x4*)(gb + (ai * 4 + m) * 1024); }
#pragma unroll
        for (int ai = 0; ai < 2; ++ai)
#pragma unroll
            for (int m = 0; m < 4; ++m)
#pragma unroll
                for (int bj = 0; bj < 2; ++bj)
#pragma unroll
                    for (int n = 0; n < 2; ++n)
#pragma unroll
                        for (int e = 0; e < 4; ++e) acc[ai][bj][m][n][e] *= ub(av[ai][m][2 * bj + n], e) * __builtin_amdgcn_rcpf(ub(bv[ai][m][2 * bj + n], e));
    }
    __device__ __forceinline__ void operator()(const f32x4 (&acc)[2][2][4][2], const Unit& u, int wr, int wc, int fr, int fq, PG8_LAS unsigned char* stg, int lane, int wid) const {
        asm volatile("" : "+v"(fr), "+v"(fq), "+v"(lane));
        const unsigned char* gb = gates + ((size_t)((u.pm * 8 + 4 + u.pn) * 8 + wid) * 8) * 1024 + fr * 64 + fq * 16;
        const size_t rbase = (size_t)(u.pm * BM + wr * 64 + (lane >> 3)); bf16_t* const op = O + u.pn * BM + wc * 64 + 8 * (lane & 7);
        u32x4 gvv[2][4];
#pragma unroll
        for (int ai = 0; ai < 2; ++ai)
#pragma unroll
            for (int m = 0; m < 4; ++m) gvv[ai][m] = __builtin_nontemporal_load((const u32x4*)(gb + (ai * 4 + m) * 1024));
#pragma unroll
        for (int ai = 0; ai < 2; ++ai)
#pragma unroll
            for (int m = 0; m < 4; ++m) { const u32x4 gv = gvv[ai][m]; u32x4 w[2];
#pragma unroll
                for (int bj = 0; bj < 2; ++bj) { f32x4 v0 = acc[ai][bj][m][0], v1 = acc[ai][bj][m][1];
#pragma unroll
                    for (int e = 0; e < 4; ++e) { v0[e] *= ub(gv[2 * bj], e) * (1.0f / 255.0f); v1[e] *= ub(gv[2 * bj + 1], e) * (1.0f / 255.0f); }
                    w[bj].x = cvt_pk_bf16(v0[0], v0[1]); w[bj].y = cvt_pk_bf16(v0[2], v0[3]); w[bj].z = cvt_pk_bf16(v1[0], v1[1]); w[bj].w = cvt_pk_bf16(v1[2], v1[3]); }
                u32x4 o0, o1; piece_xpose(stg, w[0], w[1], o0, o1, fr, fq, lane);
                bf16_t* rp = op + (rbase + ai * HALF + m * 16) * ldc;
                __builtin_nontemporal_store(o0, (u32x4*)rp); __builtin_nontemporal_store(o1, (u32x4*)(rp + (size_t)8 * ldc));
                if (m & 1) asm volatile("" ::: "memory"); }
    }
};
template <int MODE> struct EpiResid {
    static constexpr bool PERM = false, AFTER_DRAIN = false, HAS_MID = false; static constexpr int MID_T = 0;
    const float* R; bf16_t* XB; float* rowss; int ldc;
    __device__ __forceinline__ void operator()(const f32x4 (&acc)[2][2][4][2], const Unit& u, int wr, int wc, int fr, int fq, PG8_LAS unsigned char* stg, int lane, int wid) const {
        asm volatile("" : "+v"(fr), "+v"(fq), "+v"(lane));
        const size_t rbase = (size_t)(u.pm * BM + wr * 64 + (lane >> 3)); const int cb = u.pn * BM + wc * 64 + 4 * (lane & 7);
#pragma unroll
        for (int ai = 0; ai < 2; ++ai) {
            f32x4 rr[4][2][2];
#pragma unroll
            for (int m = 0; m < 4; ++m)
#pragma unroll
                for (int bj = 0; bj < 2; ++bj) { const size_t ro = (rbase + ai * HALF + m * 16) * ldc + cb + bj * 32;
                    if (MODE == 0) { rr[m][bj][0] = __builtin_nontemporal_load((const f32x4*)(R + ro)); rr[m][bj][1] = __builtin_nontemporal_load((const f32x4*)(R + ro + (size_t)8 * ldc)); }
                    else { const u32x2 b0 = __builtin_nontemporal_load((const u32x2*)(XB + ro)), b1 = __builtin_nontemporal_load((const u32x2*)(XB + ro + (size_t)8 * ldc));
                        rr[m][bj][0] = __builtin_bit_cast(f32x4, (u32x4){b0.x, b0.y, b1.x, b1.y}); } }
#pragma unroll
            for (int m = 0; m < 4; ++m) { float ss0 = 0.f, ss1 = 0.f;
#pragma unroll
                for (int bj = 0; bj < 2; ++bj) { const size_t ro = (rbase + ai * HALF + m * 16) * ldc + cb + bj * 32;
                    f32x4 r0, r1;
                    if (MODE == 0) { r0 = rr[m][bj][0]; r1 = rr[m][bj][1]; }
                    else { const u32x4 pk = __builtin_bit_cast(u32x4, rr[m][bj][0]);
                        r0 = (f32x4){bflo(pk.x), bfhi(pk.x), bflo(pk.y), bfhi(pk.y)}; r1 = (f32x4){bflo(pk.z), bfhi(pk.z), bflo(pk.w), bfhi(pk.w)}; }
                    u32x4 o0, o1; piece_xpose(stg, __builtin_bit_cast(u32x4, acc[ai][bj][m][0]), __builtin_bit_cast(u32x4, acc[ai][bj][m][1]), o0, o1, fr, fq, lane);
                    const f32x4 x0 = r0 + __builtin_bit_cast(f32x4, o0), x1 = r1 + __builtin_bit_cast(f32x4, o1);
                    *(u32x2*)(XB + ro) = (u32x2){cvt_pk_bf16(x0[0], x0[1]), cvt_pk_bf16(x0[2], x0[3])}; *(u32x2*)(XB + ro + (size_t)8 * ldc) = (u32x2){cvt_pk_bf16(x1[0], x1[1]), cvt_pk_bf16(x1[2], x1[3])};
                    ss0 += (x0[0] * x0[0] + x0[1] * x0[1]) + (x0[2] * x0[2] + x0[3] * x0[3]); ss1 += (x1[0] * x1[0] + x1[1] * x1[1]) + (x1[2] * x1[2] + x1[3] * x1[3]); }
                ss0 += __shfl_xor(ss0, 1); ss0 += __shfl_xor(ss0, 2); ss0 += __shfl_xor(ss0, 4); ss1 += __shfl_xor(ss1, 1); ss1 += __shfl_xor(ss1, 2); ss1 += __shfl_xor(ss1, 4);
                if ((lane & 7) == 0) { rowss[(rbase + ai * HALF + m * 16) * 16 + u.pn * 4 + wc] = ss0; rowss[(rbase + ai * HALF + m * 16 + 8) * 16 + u.pn * 4 + wc] = ss1; } }
            asm volatile("" ::: "memory");
        }
    }
};
}
#include <hip/hip_bf16.h>
#include <cmath>
namespace moba {
using bf16=__hip_bfloat16;
using bf16x8=__attribute__((ext_vector_type(8)))short;
using s16x4=__attribute__((ext_vector_type(4)))short;
using f32x16=__attribute__((ext_vector_type(16)))float;
using u32x4=__attribute__((ext_vector_type(4)))unsigned;
constexpr int SEQ=2048,D=64,PITCH=4608;
constexpr int NW=8,QBLK=32,QB=QBLK*NW,KVBLK=64;
__device__ __forceinline__ int crow(int r,int hi){return (r&3)+8*(r>>2)+4*hi;}
#define SBAR() __builtin_amdgcn_sched_barrier(0)
__device__ __forceinline__ void cmask(f32x16&p0,f32x16&p1,int jb,int qrel,int hi){
  const float NEG=-INFINITY; int kb=64*jb+4*hi;
  #pragma unroll
  for(int r=0;r<16;++r){int kv=kb+(r&3)+8*(r>>2); if(kv>qrel)p0[r]=NEG; if(kv+32>qrel)p1[r]=NEG;}
}

constexpr int NSLOT=3, SLOTB=8192;
constexpr int NVSLOT=4;
constexpr int LDS_K=0, LDS_V=NSLOT*SLOTB, LDS_WS=LDS_V+NVSLOT*SLOTB, LDS_OST=LDS_WS+NW*64*4, LDS_KM=LDS_OST+NW*4096, LDS_BYTES=LDS_KM+8*64*4;
__device__ __forceinline__ void glds16(const void*gsrc,unsigned lds_dst){unsigned keep;
  asm volatile("s_mov_b32 %0, m0\n\ts_mov_b32 m0, %2\n\ts_nop 0\n\tglobal_load_lds_dwordx4 %1, off\n\ts_mov_b32 m0, %0":"=&s"(keep):"v"(gsrc),"s"(lds_dst):"memory");}
__device__ __forceinline__ float max3f(float a,float b,float c){float r;asm("v_max3_f32 %0, %1, %2, %3":"=v"(r):"v"(a),"v"(b),"v"(c));return r;}
__device__ __forceinline__ float max2f(float a,float b){float r;asm("v_max_f32_e32 %0, %1, %2":"=v"(r):"v"(a),"v"(b));return r;}
typedef float f32x2_t __attribute__((ext_vector_type(2))); typedef __bf16 bf16x2_t __attribute__((ext_vector_type(2)));
__device__ __forceinline__ unsigned cvtpk_s(float lo,float hi){f32x2_t v={lo,hi};bf16x2_t b=__builtin_convertvector(v,bf16x2_t);return __builtin_bit_cast(unsigned,b);}
__device__ __forceinline__ float bl(unsigned u){return __uint_as_float(u<<16);}
__device__ __forceinline__ float bh(unsigned u){return __uint_as_float(u&0xffff0000u);}
#define WAIT_BAR(N) asm volatile("s_waitcnt vmcnt(" #N ") lgkmcnt(0)\n\ts_barrier":::"memory")

__device__ __forceinline__ void qkt(f32x16&p0,f32x16&p1,const char*Kslot,const bf16x8*qr,const f32x16&negm,int r32,int hi){
  const char*kb=Kslot+hi*1024+r32*16;
  #pragma unroll
  for(int d0=0;d0<4;++d0){
    const bf16x8 b0=*reinterpret_cast<const bf16x8*>(kb+d0*2048);
    const bf16x8 b1=*reinterpret_cast<const bf16x8*>(kb+d0*2048+512);
    if(d0==0){p0=__builtin_amdgcn_mfma_f32_32x32x16_bf16(b0,qr[0],negm,0,0,0);p1=__builtin_amdgcn_mfma_f32_32x32x16_bf16(b1,qr[0],negm,0,0,0);}
    else{p0=__builtin_amdgcn_mfma_f32_32x32x16_bf16(b0,qr[d0],p0,0,0,0);p1=__builtin_amdgcn_mfma_f32_32x32x16_bf16(b1,qr[d0],p1,0,0,0);}}
}
typedef __attribute__((address_space(3))) const char* lds_cptr;
typedef short v4i16_t __attribute__((ext_vector_type(4)));
__device__ __forceinline__ void kload8(bf16x8*kf,lds_cptr kp){
  kf[0]=*(const __attribute__((address_space(3))) bf16x8*)(kp);      kf[1]=*(const __attribute__((address_space(3))) bf16x8*)(kp+512);
  kf[2]=*(const __attribute__((address_space(3))) bf16x8*)(kp+2048); kf[3]=*(const __attribute__((address_space(3))) bf16x8*)(kp+2560);
  kf[4]=*(const __attribute__((address_space(3))) bf16x8*)(kp+4096); kf[5]=*(const __attribute__((address_space(3))) bf16x8*)(kp+4608);
  kf[6]=*(const __attribute__((address_space(3))) bf16x8*)(kp+6144); kf[7]=*(const __attribute__((address_space(3))) bf16x8*)(kp+6656);
}
__device__ __forceinline__ void kload2(bf16x8*kf,lds_cptr kp,int j){ kf[2*j]=*(const __attribute__((address_space(3))) bf16x8*)(kp+j*2048); kf[2*j+1]=*(const __attribute__((address_space(3))) bf16x8*)(kp+j*2048+512); }
__device__ __forceinline__ s16x4 vtr(lds_cptr p){ return __builtin_bit_cast(s16x4,__builtin_amdgcn_ds_read_tr16_b64_v4i16((__attribute__((address_space(3))) v4i16_t*)p)); }
__device__ __forceinline__ float rowmax(const f32x16&p0,const f32x16&p1){
  float a=max3f(p0[0],p0[1],p1[0]),b=max3f(p0[2],p0[3],p1[1]);a=max3f(a,p1[2],p1[3]);
  #pragma unroll
  for(int r=4;r<16;r+=4){a=max3f(a,p0[r],p0[r+1]);b=max3f(b,p0[r+2],p0[r+3]);a=max3f(a,p1[r],p1[r+1]);b=max3f(b,p1[r+2],p1[r+3]);}
  const float m=max2f(a,b);
  auto rr=__builtin_amdgcn_permlane32_swap(__float_as_uint(m),__float_as_uint(m),false,false);
  return max2f(__uint_as_float(rr[0]),__uint_as_float(rr[1]));
}
__device__ __forceinline__ float xhalf_sum(float v){ auto rr=__builtin_amdgcn_permlane32_swap(__float_as_uint(v),__float_as_uint(v),false,false); return __uint_as_float(rr[0])+__uint_as_float(rr[1]); }
__device__ __forceinline__ void pv(f32x16*o,int vb,bf16x8 pa0,bf16x8 pa1,bf16x8 pa2,bf16x8 pa3){
  #pragma unroll
  for(int d0=0;d0<2;++d0){s16x4 lo[4],hi[4];
    #pragma unroll
    for(int ks=0;ks<4;++ks){
      asm volatile("ds_read_b64_tr_b16 %0,%1 offset:%c2":"=&v"(lo[ks]):"v"(vb),"i"(d0*4096+ks*1024):"memory");
      asm volatile("ds_read_b64_tr_b16 %0,%1 offset:%c2":"=&v"(hi[ks]):"v"(vb),"i"(d0*4096+ks*1024+512):"memory");}
    asm volatile("s_waitcnt lgkmcnt(0)":::"memory");SBAR();
    #define PK(k) (bf16x8){lo[k][0],lo[k][1],lo[k][2],lo[k][3],hi[k][0],hi[k][1],hi[k][2],hi[k][3]}
    o[d0]=__builtin_amdgcn_mfma_f32_32x32x16_bf16(pa0,PK(0),o[d0],0,0,0);
    o[d0]=__builtin_amdgcn_mfma_f32_32x32x16_bf16(pa1,PK(1),o[d0],0,0,0);
    o[d0]=__builtin_amdgcn_mfma_f32_32x32x16_bf16(pa2,PK(2),o[d0],0,0,0);
    o[d0]=__builtin_amdgcn_mfma_f32_32x32x16_bf16(pa3,PK(3),o[d0],0,0,0);
    #undef PK
  }
}

template<int THRL> __device__ __forceinline__ void moba_unit(int b,int h,int c,const bf16*Pq,const bf16*__restrict__ Pk,const bf16*__restrict__ Pv,const bf16*Pz,bf16*Po,const float*__restrict__ kmean,char*shm){
  int tid_=threadIdx.x; asm volatile("":"+v"(tid_));
  const int tid=tid_,lane=tid&63,r32=lane&31,hi=lane>>5; const int wid=__builtin_amdgcn_readfirstlane(tid>>6);
  const long rowbase=(long)b*SEQ; const int q0=c*QB;
  const bf16*Qw=Pq+(rowbase+q0+wid*QBLK)*PITCH+h*D;
  const bf16*Kh=Pk+rowbase*PITCH+h*D,*Vh=Pv+rowbase*PITCH+h*D;
  const unsigned lds0=(unsigned)(uintptr_t)shm;
  float*wsf=(float*)(shm+LDS_WS)+wid*64;
  float*kml=(float*)(shm+LDS_KM);
  const int NT=(q0+QB)/KVBLK;
  const bf16*ksrc=Kh+(long)lane*PITCH+wid*8;
  const bf16*vsrc=Vh+(long)(16*(wid&3)+(lane>>2))*PITCH+(wid>>2)*32+(lane&3)*8;
  const unsigned kdst=lds0+LDS_K+wid*1024, vdst=lds0+LDS_V+wid*1024;
  #define DMA_K(t,slot) glds16(ksrc+(long)(NT-1-(t))*KVBLK*PITCH,(unsigned)__builtin_amdgcn_readfirstlane(kdst+(slot)))
  #define DMA_V(t,slot) glds16(vsrc+(long)(NT-1-(t))*KVBLK*PITCH,(unsigned)__builtin_amdgcn_readfirstlane(vdst+(slot)))
  const int vb0=(int)(lds0+LDS_V)+((lane>>4)&1)*32+(lane&3)*8+(4*hi+((lane&15)>>2))*64;
  const char*Kbase=shm+LDS_K; bf16x8 kf[8];
  const lds_cptr shm3=(lds_cptr)shm; const lds_cptr kp0=shm3+LDS_K+hi*1024+r32*16; const lds_cptr vp0=shm3+LDS_V+((lane>>4)&1)*32+(lane&3)*8+(4*hi+((lane&15)>>2))*64;
  #define VS(t) ((((t))&3)*SLOTB)
  DMA_K(0,0);DMA_V(0,VS(0));DMA_K(1,SLOTB);
  bf16x8 qr[4];
  #pragma unroll
  for(int d0=0;d0<4;++d0)qr[d0]=*reinterpret_cast<const bf16x8*>(&Qw[(long)r32*PITCH+d0*16+hi*8]);
  const int qrel=wid*QBLK+r32;
  u32x4 kdg[4];
  { const bf16*Kd=Kh+(long)(q0+qrel)*PITCH;
    #pragma unroll
    for(int d0=0;d0<4;++d0)kdg[d0]=*reinterpret_cast<const u32x4*>(&Kd[d0*16+hi*8]); }
  const float sl2=__uint_as_float(__builtin_amdgcn_readfirstlane(__float_as_uint(__builtin_amdgcn_exp2f(-(float)(h+1))*1.4426950408889634f)));
  unsigned sel=0u;
  if(c>0){
    if(tid<c*64) kml[tid]=kmean[((long)(b*8)+(tid>>6))*512+h*64+(tid&63)];
    asm volatile("s_waitcnt vmcnt(0) lgkmcnt(0)\n\ts_barrier":::"memory");
    if(c<=3) sel=(1u<<c)-1u;
    else{
      float g[8];
      #pragma unroll
      for(int j=0;j<8;++j){ g[j]=-INFINITY;
        if(j<c){ float a=0.f;
          #pragma unroll
          for(int d0=0;d0<4;++d0){ const u32x4 qv=__builtin_bit_cast(u32x4,qr[d0]); const float*km=kml+j*64+d0*16+hi*8;
            const float4 k0=*(const float4*)km, k1=*(const float4*)(km+4);
            a+=bl(qv.x)*k0.x+bh(qv.x)*k0.y+bl(qv.y)*k0.z+bh(qv.y)*k0.w+bl(qv.z)*k1.x+bh(qv.z)*k1.y+bl(qv.w)*k1.z+bh(qv.w)*k1.w; }
          g[j]=xhalf_sum(a); } }
      #pragma unroll
      for(int j=0;j<8;++j){ int rank=0;
        #pragma unroll
        for(int j2=0;j2<8;++j2){ if(j2!=j) rank+=((g[j2]>g[j])||(g[j2]==g[j]&&j2<j))?1:0; }
        if(j<c&&rank<3) sel|=(1u<<j); }
    }
  }
  float mhat;
  { float a=0.f;
    #pragma unroll
    for(int d0=0;d0<4;++d0){ const u32x4 kv=kdg[d0]; const u32x4 qv=__builtin_bit_cast(u32x4,qr[d0]);
      a+=bl(qv.x)*bl(kv.x)+bh(qv.x)*bh(kv.x)+bl(qv.y)*bl(kv.y)+bh(qv.y)*bh(kv.y)+bl(qv.z)*bl(kv.z)+bh(qv.z)*bh(kv.z)+bl(qv.w)*bl(kv.w)+bh(qv.w)*bh(kv.w); }
    mhat=xhalf_sum(a)+sl2*(float)qrel; }
  float l_reg=0.f;f32x16 o[2];o[0]=f32x16{};o[1]=f32x16{};
  f32x16 negm;
  #pragma unroll
  for(int r=0;r<16;++r)negm[r]=sl2*(float)((r&3)+8*(r>>2))-mhat;
  asm volatile("":"+v"(negm));
  #define MBIAS(P0,P1,t) do{ const int T_=NT-1-(t); const int jb_=T_-(NT-4); float a0_=sl2*(float)(64*jb_+4*hi); \
      if(jb_<0){ if(!((sel>>(T_>>2))&1u)) a0_=-INFINITY; } const float a1_=a0_+32.f*sl2; \
      _Pragma("unroll") for(int r=0;r<16;++r){P0[r]+=a0_;P1[r]+=a1_;} \
      if(jb_>=0)cmask(P0,P1,jb_,qrel,hi); }while(0)
  bool resc=false;
  #define RESC() do{ if(resc){ asm volatile("s_waitcnt lgkmcnt(0)":::"memory"); \
      _Pragma("unroll") for(int d_=0;d_<2;++d_) _Pragma("unroll") for(int r=0;r<16;++r)o[d_][r]*=wsf[crow(r,hi)]; } }while(0)
  f32x16 pA0,pA1,pB0,pB1;
  int sl_prev=0,sl_cur=0,sl_next=SLOTB;
  #define ROT() do{sl_prev=sl_cur;sl_cur=sl_next;sl_next=(sl_next==(NSLOT-1)*SLOTB)?0:sl_next+SLOTB;}while(0)
  DMA_K(2,2*SLOTB);DMA_V(1,VS(1));
  WAIT_BAR(2);
  qkt(pA0,pA1,Kbase,qr,negm,r32,hi);asm volatile("s_nop 15\n\ts_nop 7":"+v"(pA0),"+v"(pA1));MBIAS(pA0,pA1,0);
  { const float rm=rowmax(pA0,pA1);
    if(__any(rm>(float)THRL)){ const float dl=__builtin_fmaxf(rm,0.f);
      _Pragma("unroll") for(int r=0;r<16;++r){pA0[r]-=dl;pA1[r]-=dl;negm[r]-=dl;}
      asm volatile("":"+v"(negm)); } }
  _Pragma("unroll") for(int r=0;r<16;++r){pA0[r]=__builtin_amdgcn_exp2f(pA0[r]);pA1[r]=__builtin_amdgcn_exp2f(pA1[r]);}
  WAIT_BAR(2);
  DMA_K(3,0);DMA_V(2,VS(2));
  ROT();
  kload8(kf,kp0+sl_cur);
  WAIT_BAR(3);
  s16x4 vlo[8],vhi[8]; u32x4 pw0,pw1,pw2,pw3;
  #define PKW(P,B) cvtpk_s(P[B],P[B+1])
  #define PAF(k) __builtin_bit_cast(bf16x8,pw##k)
  #define VFR(i) (bf16x8){vlo[i][0],vlo[i][1],vlo[i][2],vlo[i][3],vhi[i][0],vhi[i][1],vhi[i][2],vhi[i][3]}
  #define PIN(x) asm volatile("":"+v"(x))
  #define MX3(a,b,c) __builtin_fmaxf(__builtin_fmaxf((a),(b)),(c))
  #define GAPA(MF,A0,A1,A2,A3,W0,W1,PW) do{ MF; sacc+=A0; sacc+=A1; sacc+=A2; sacc+=A3; PIN(sacc); W0; W1; PIN(PW); SBAR(); }while(0)
  #define EX(v) __builtin_amdgcn_exp2f(v)
  #define GAPB(MF,X,B) do{ MF; X[B]=EX(X[B]); X[B+1]=EX(X[B+1]); X[B+2]=EX(X[B+2]); X[B+3]=EX(X[B+3]); PIN(X); SBAR(); }while(0)
  #define VRD(i) do{ vlo[i]=vtr(vp_+(((i)>>2)*4096+((i)&3)*1024)); vhi[i]=vtr(vp_+(((i)>>2)*4096+((i)&3)*1024+512)); }while(0)
  #define KRD(G,j) do{ if(G){ kload2(kf,kp0+sl_next,j); SBAR(); } }while(0)
  #define STEP(C0,C1,P0,P1,t,GK,GV,GL) do{ SBAR(); \
    const lds_cptr vp_=vp0+VS((t)-1); \
    VRD(0); SBAR(); float sacc=(P0[0]+P0[1]); \
    GAPA(C0=__builtin_amdgcn_mfma_f32_32x32x16_bf16(kf[0],qr[0],negm,0,0,0), P0[2],P0[3],P0[4],P0[5],     pw0[0]=PKW(P0,0), pw0[1]=PKW(P0,2), pw0); \
    VRD(4); SBAR(); GAPA(C1=__builtin_amdgcn_mfma_f32_32x32x16_bf16(kf[1],qr[0],negm,0,0,0), P0[6],P0[7],P0[8],P0[9],     pw0[2]=PKW(P0,4), pw0[3]=PKW(P0,6), pw0); \
    VRD(1); SBAR(); GAPA(C0=__builtin_amdgcn_mfma_f32_32x32x16_bf16(kf[2],qr[1],C0,0,0,0),   P0[10],P0[11],P0[12],P0[13], pw1[0]=PKW(P0,8), pw1[1]=PKW(P0,10), pw1); \
    VRD(5); SBAR(); GAPA(C1=__builtin_amdgcn_mfma_f32_32x32x16_bf16(kf[3],qr[1],C1,0,0,0),   P0[14],P0[15],P1[0],P1[1],   pw1[2]=PKW(P0,12),pw1[3]=PKW(P0,14), pw1); \
    VRD(2); SBAR(); GAPA(C0=__builtin_amdgcn_mfma_f32_32x32x16_bf16(kf[4],qr[2],C0,0,0,0),   P1[2],P1[3],P1[4],P1[5],     pw2[0]=PKW(P1,0), pw2[1]=PKW(P1,2), pw2); \
    VRD(6); SBAR(); GAPA(C1=__builtin_amdgcn_mfma_f32_32x32x16_bf16(kf[5],qr[2],C1,0,0,0),   P1[6],P1[7],P1[8],P1[9],     pw2[2]=PKW(P1,4), pw2[3]=PKW(P1,6), pw2); \
    VRD(3); SBAR(); GAPA(C0=__builtin_amdgcn_mfma_f32_32x32x16_bf16(kf[6],qr[3],C0,0,0,0),   P1[10],P1[11],P1[12],P1[13], pw3[0]=PKW(P1,8), pw3[1]=PKW(P1,10), pw3); \
    VRD(7); SBAR(); GAPA(C1=__builtin_amdgcn_mfma_f32_32x32x16_bf16(kf[7],qr[3],C1,0,0,0),   P1[14],P1[15],0.f,0.f,       pw3[2]=PKW(P1,12),pw3[3]=PKW(P1,14), pw3); \
    l_reg+=sacc; \
    if(GK){DMA_K((t)+3,sl_cur);} if(GV){DMA_V((t)+2,VS((t)+2));} \
    MBIAS(C0,C1,t); \
    { float a=MX3(C0[0],C0[1],C1[0]),b=MX3(C0[2],C0[3],C1[1]); a=MX3(a,C1[2],C1[3]); \
      _Pragma("unroll") for(int r=4;r<16;r+=4){a=MX3(a,C0[r],C0[r+1]);b=MX3(b,C0[r+2],C0[r+3]);a=MX3(a,C1[r],C1[r+1]);b=MX3(b,C1[r+2],C1[r+3]);} \
      float rm=__builtin_fmaxf(a,b); { auto rr=__builtin_amdgcn_permlane32_swap(__float_as_uint(rm),__float_as_uint(rm),false,false); rm=__builtin_fmaxf(__uint_as_float(rr[0]),__uint_as_float(rr[1])); } \
      resc=false; \
      if(__builtin_expect(__any(rm>(float)THRL),0)){ const float dl=__builtin_fmaxf(rm,0.f); \
        _Pragma("unroll") for(int r=0;r<16;++r){C0[r]-=dl;C1[r]-=dl;} \
        _Pragma("unroll") for(int r=0;r<16;++r)negm[r]-=dl; asm volatile("":"+v"(negm)); \
        const float f=__builtin_amdgcn_exp2f(-dl); l_reg*=f; if(hi==0)wsf[r32]=f; resc=true; } } \
    SBAR(); \
    GAPB(o[0]=__builtin_amdgcn_mfma_f32_32x32x16_bf16(PAF(0),VFR(0),o[0],0,0,0), C0,0); \
    GAPB(o[1]=__builtin_amdgcn_mfma_f32_32x32x16_bf16(PAF(0),VFR(4),o[1],0,0,0), C0,4); \
    KRD(GL,0); GAPB(o[0]=__builtin_amdgcn_mfma_f32_32x32x16_bf16(PAF(1),VFR(1),o[0],0,0,0), C0,8); \
    KRD(GL,1); GAPB(o[1]=__builtin_amdgcn_mfma_f32_32x32x16_bf16(PAF(1),VFR(5),o[1],0,0,0), C0,12); \
    KRD(GL,2); GAPB(o[0]=__builtin_amdgcn_mfma_f32_32x32x16_bf16(PAF(2),VFR(2),o[0],0,0,0), C1,0); \
    KRD(GL,3); GAPB(o[1]=__builtin_amdgcn_mfma_f32_32x32x16_bf16(PAF(2),VFR(6),o[1],0,0,0), C1,4); \
    GAPB(o[0]=__builtin_amdgcn_mfma_f32_32x32x16_bf16(PAF(3),VFR(3),o[0],0,0,0), C1,8); \
    GAPB(o[1]=__builtin_amdgcn_mfma_f32_32x32x16_bf16(PAF(3),VFR(7),o[1],0,0,0), C1,12); \
    }while(0)
  int t=1;
  for(;t+5<NT;t+=2){
    STEP(pB0,pB1,pA0,pA1,t,true,true,true);     WAIT_BAR(3); RESC(); ROT();
    STEP(pA0,pA1,pB0,pB1,t+1,true,true,true);   WAIT_BAR(3); RESC(); ROT();
  }
  #define ENDW(tt) do{ if((tt)+3<NT){WAIT_BAR(3);} else if((tt)+2<NT){WAIT_BAR(2);} else {WAIT_BAR(0);} }while(0)
  for(;t+1<NT;t+=2){
    STEP(pB0,pB1,pA0,pA1,t,(t+3<NT),(t+2<NT),(t+1<NT));       ENDW(t);   RESC(); ROT();
    STEP(pA0,pA1,pB0,pB1,t+1,(t+4<NT),(t+3<NT),(t+2<NT));     ENDW(t+1); RESC(); ROT();
  }
  STEP(pB0,pB1,pA0,pA1,NT-1,false,false,false); RESC();
  { float sacc=pB0[0]+pB0[1]; _Pragma("unroll") for(int r=2;r<16;++r)sacc+=pB0[r]; _Pragma("unroll") for(int r=0;r<16;++r)sacc+=pB1[r]; l_reg+=sacc;
    pw0=(u32x4){PKW(pB0,0),PKW(pB0,2),PKW(pB0,4),PKW(pB0,6)};pw1=(u32x4){PKW(pB0,8),PKW(pB0,10),PKW(pB0,12),PKW(pB0,14)};pw2=(u32x4){PKW(pB1,0),PKW(pB1,2),PKW(pB1,4),PKW(pB1,6)};pw3=(u32x4){PKW(pB1,8),PKW(pB1,10),PKW(pB1,12),PKW(pB1,14)};
    SBAR(); pv(o,vb0+VS(NT-1),PAF(0),PAF(1),PAF(2),PAF(3)); }
  #undef PKW
  #undef PAF
  #undef VFR
  #undef PIN
  #undef MX3
  #undef GAPA
  #undef GAPB
  #undef EX
  #undef VRD
  #undef KRD
  #undef STEP
  #undef ENDW
  l_reg=xhalf_sum(l_reg);
  if(hi==0)wsf[32+r32]=l_reg;asm volatile("s_waitcnt lgkmcnt(0)":::"memory");
  float rli[16];
  #pragma unroll
  for(int r=0;r<16;++r)rli[r]=__builtin_amdgcn_rcpf(wsf[32+crow(r,hi)]);
  const bf16*Zw=Pz+(rowbase+q0+wid*QBLK)*PITCH+h*D; bf16*Ow=Po+(rowbase+q0+wid*QBLK)*PITCH+h*D;
  { bf16*stg=(bf16*)(shm+LDS_OST)+wid*2048;
    #pragma unroll
    for(int r=0;r<16;++r){const int orow=crow(r,hi);
      #pragma unroll
      for(int d0=0;d0<2;++d0)((unsigned short*)stg)[orow*64+d0*32+r32]=(unsigned short)cvtpk_s(o[d0][r]*rli[r],0.f);}
    asm volatile("s_waitcnt lgkmcnt(0)":::"memory");
    #pragma unroll
    for(int i=0;i<4;++i){const int row=i*8+(lane>>3),ch=lane&7; const u32x4 v=*(const u32x4*)(stg+row*64+ch*8);
      const u32x4 z=__builtin_nontemporal_load((const u32x4*)(Zw+(long)row*PITCH+ch*8)); u32x4*zp=(u32x4*)(Ow+(long)row*PITCH+ch*8); u32x4 w;
      w.x=cvtpk_s(bl(v.x)*bl(z.x),bh(v.x)*bh(z.x)); w.y=cvtpk_s(bl(v.y)*bl(z.y),bh(v.y)*bh(z.y)); w.z=cvtpk_s(bl(v.z)*bl(z.z),bh(v.z)*bh(z.z)); w.w=cvtpk_s(bl(v.w)*bl(z.w),bh(v.w)*bh(z.w));
      *zp=w; } }
  asm volatile("s_waitcnt lgkmcnt(0)\n\ts_barrier":::"memory");
  #undef DMA_K
  #undef DMA_V
  #undef VS
  #undef MBIAS
  #undef RESC
  #undef ROT
}
constexpr int ATTN_LDS_BYTES=LDS_BYTES;
#undef SBAR
#undef WAIT_BAR
}
namespace attna {
using moba::bf16; using moba::bf16x8; using moba::s16x4; using moba::f32x16; using moba::u32x4; using moba::lds_cptr;
using moba::crow; using moba::cvtpk_s; using moba::bl; using moba::bh; using moba::vtr; using moba::xhalf_sum;
constexpr int SEQ=2048,PITCH=4608;
constexpr int WK=0,WV=4608,WO=12800,WSC=16896,WBYTES=17152,LSE_OFF=8*WBYTES,LDS_BYTES=LSE_OFF+3*512*4;
#define AMFMA(a,b,c) __builtin_amdgcn_mfma_f32_32x32x16_bf16(a,b,c,0,0,0)

__device__ __forceinline__ void sub_item(bf16*P,int b,int hs,int g,int res,int l0,int chunk,char*wl,float*lse_l,int lane){
  asm volatile("":"+v"(lane));
  const int r32=lane&31,hi=lane>>5;
  const int dsh=2*g;
  const long rowb=(long)b*SEQ+res;
  const int qcol=g*768+hs*64;
  const float sl2=__builtin_amdgcn_exp2f(-(2.0f/3.0f)*(float)(4*g+hs+1))*(float)(1<<dsh)*1.4426950408889634f;
  #define AROW(l) ((rowb+((long)(l)<<dsh))*PITCH)
  #define KL(i,x) ((l0-128+32*(i)+(x))<0?0:(l0-128+32*(i)+(x)))
  const int i0=(l0>=128)?0:(4-(l0>>5));
  const int lrow=lane>>3, lch=lane&7;
  u32x4 qg[4],kg[5][4],vg[5][4];
  #pragma unroll
  for(int j=0;j<4;++j)qg[j]=*reinterpret_cast<const u32x4*>(P+AROW(l0+lrow+8*j)+qcol+lch*8);
  #pragma unroll
  for(int i=4;i>=0;--i)
    #pragma unroll
    for(int j=0;j<4;++j)kg[i][j]=*reinterpret_cast<const u32x4*>(P+AROW(KL(i,lrow+8*j))+qcol+256+lch*8);
  #pragma unroll
  for(int i=4;i>=0;--i)
    #pragma unroll
    for(int j=0;j<4;++j)vg[i][j]=*reinterpret_cast<const u32x4*>(P+AROW(KL(i,lrow+8*j))+qcol+512+lch*8);
  __builtin_amdgcn_sched_barrier(0);
  char*kb=wl+WK; const int kwoff=lrow*144+lch*16, kroff=r32*144+hi*16;
  bf16x8 qf[4];
  #pragma unroll
  for(int j=0;j<4;++j)*reinterpret_cast<u32x4*>(kb+kwoff+j*8*144)=qg[j];
  #pragma unroll
  for(int d0=0;d0<4;++d0)qf[d0]=*reinterpret_cast<const bf16x8*>(kb+kroff+d0*32);
  f32x16 S[5];
  #pragma unroll
  for(int i=4;i>=0;--i){
    #pragma unroll
    for(int j=0;j<4;++j)*reinterpret_cast<u32x4*>(kb+kwoff+j*8*144)=kg[i][j];
    bf16x8 kf[4];
    #pragma unroll
    for(int d0=0;d0<4;++d0)kf[d0]=*reinterpret_cast<const bf16x8*>(kb+kroff+d0*32);
    f32x16 acc=f32x16{};
    #pragma unroll
    for(int d0=0;d0<4;++d0)acc=AMFMA(kf[d0],qf[d0],acc);
    const float sbi=((i<i0)?-INFINITY:0.f)-sl2*(float)(32*(4-i)+r32-4*hi);
    #pragma unroll
    for(int r=0;r<16;++r){ const int kc=(r&3)+8*(r>>2); float v=__builtin_fmaf(sl2,(float)kc,acc[r]+sbi);
      if(i==4&&kc+4*hi>r32)v=-INFINITY; if(i==0&&kc+4*hi<r32)v=-INFINITY; acc[r]=v; }
    S[i]=acc;
  }
  float mx=-INFINITY;
  #pragma unroll
  for(int i=0;i<5;++i)
    #pragma unroll
    for(int r=0;r<16;++r)mx=fmaxf(mx,S[i][r]);
  { auto rr=__builtin_amdgcn_permlane32_swap(__float_as_uint(mx),__float_as_uint(mx),false,false); mx=fmaxf(__uint_as_float(rr[0]),__uint_as_float(rr[1])); }
  float ls=0.f;
  #pragma unroll
  for(int i=0;i<5;++i)
    #pragma unroll
    for(int r=0;r<16;++r){ const float p=__builtin_amdgcn_exp2f(S[i][r]-mx); S[i][r]=p; ls+=p; }
  ls=xhalf_sum(ls);
  f32x16 o[2]; o[0]=f32x16{}; o[1]=f32x16{};
  const lds_cptr wl3=(lds_cptr)wl;
  const int vtoff=((lane>>4)&1)*32+(lane&3)*8+(4*hi+((lane&15)>>2))*64;
  const int vwoff=(lch>>2)*2048+lrow*64+(lch&3)*16;
  #define PVSTEP(i) do{ char*vb_=wl+WV+((i)&1)*4096; \
      _Pragma("unroll") for(int j=0;j<4;++j)*reinterpret_cast<u32x4*>(vb_+vwoff+j*8*64)=vg[i][j]; \
      const u32x4 pw0=(u32x4){cvtpk_s(S[i][0],S[i][1]),cvtpk_s(S[i][2],S[i][3]),cvtpk_s(S[i][4],S[i][5]),cvtpk_s(S[i][6],S[i][7])}; \
      const u32x4 pw1=(u32x4){cvtpk_s(S[i][8],S[i][9]),cvtpk_s(S[i][10],S[i][11]),cvtpk_s(S[i][12],S[i][13]),cvtpk_s(S[i][14],S[i][15])}; \
      const lds_cptr vp=wl3+WV+((i)&1)*4096+vtoff; \
      _Pragma("unroll") for(int d0=0;d0<2;++d0){ \
        const s16x4 a0=vtr(vp+d0*2048),a1=vtr(vp+d0*2048+512),b0=vtr(vp+d0*2048+1024),b1=vtr(vp+d0*2048+1536); \
        const bf16x8 f0=(bf16x8){a0[0],a0[1],a0[2],a0[3],a1[0],a1[1],a1[2],a1[3]}, f1=(bf16x8){b0[0],b0[1],b0[2],b0[3],b1[0],b1[1],b1[2],b1[3]}; \
        o[d0]=AMFMA(__builtin_bit_cast(bf16x8,pw0),f0,o[d0]); \
        o[d0]=AMFMA(__builtin_bit_cast(bf16x8,pw1),f1,o[d0]); } }while(0)
  PVSTEP(4); PVSTEP(3); PVSTEP(2); PVSTEP(1); PVSTEP(0);
  float*ws=(float*)(wl+WSC);
  const int tokc=((l0+r32)<<dsh)+res-chunk*512;
  if(hi==0){ ws[r32]=__builtin_amdgcn_rcpf(ls); lse_l[g*512+tokc]=mx+__builtin_amdgcn_logf(ls); }
  bf16*stg=(bf16*)(wl+WO);
  #pragma unroll
  for(int r=0;r<16;++r){ const int orow=crow(r,hi); const float il=ws[orow];
    #pragma unroll
    for(int d0=0;d0<2;++d0)((unsigned short*)stg)[orow*64+d0*32+r32]=(unsigned short)cvtpk_s(o[d0][r]*il,0.f); }
  #pragma unroll
  for(int i=0;i<4;++i){ const int row=i*8+(lane>>3),ch=lane&7; const u32x4 v=*reinterpret_cast<const u32x4*>(stg+row*64+ch*8);
    *reinterpret_cast<u32x4*>(P+AROW(l0+row)+qcol+ch*8)=v; }
  #undef AROW
  #undef KL
  #undef PVSTEP
}

__device__ __forceinline__ void wg_item(bf16*P,int b,int hs,int chunk,char*shm){
  int tid_=threadIdx.x; asm volatile("":"+v"(tid_));
  const int tid=tid_,lane=tid&63; const int wid=__builtin_amdgcn_readfirstlane(tid>>6);
  char*wl=shm+wid*WBYTES; float*lse_l=(float*)(shm+LSE_OFF);
  #pragma unroll 1
  for(int i6=0;i6<6;++i6){
    const int si=wid+8*i6, g=si>>4, k=si&15;
    int res,l0;
    if(g==0){res=0;l0=32*(chunk*16+k);} else if(g==1){res=k>>2;l0=128*chunk+32*(k&3);} else {res=k;l0=32*chunk;}
    sub_item(P,b,hs,g,res,l0,chunk,wl,lse_l,lane);
  }
  __syncthreads();
  #pragma unroll
  for(int idx=tid;idx<512*8;idx+=512){
    const int tok=idx>>3,ch=idx&7; const long row=((long)b*SEQ+chunk*512+tok)*PITCH;
    const float e0=lse_l[tok],e1=lse_l[512+tok],e2=lse_l[1024+tok]; const float em=fmaxf(e0,fmaxf(e1,e2));
    float w0=__builtin_amdgcn_exp2f(e0-em),w1=__builtin_amdgcn_exp2f(e1-em),w2=__builtin_amdgcn_exp2f(e2-em); const float iw=__builtin_amdgcn_rcpf(w0+w1+w2); w0*=iw;w1*=iw;w2*=iw;
    const u32x4 a=*reinterpret_cast<const u32x4*>(P+row+hs*64+ch*8), bq=*reinterpret_cast<const u32x4*>(P+row+768+hs*64+ch*8), cq=*reinterpret_cast<const u32x4*>(P+row+1536+hs*64+ch*8);
    u32x4*zp=reinterpret_cast<u32x4*>(P+row+2304+hs*64+ch*8); const u32x4 z=__builtin_nontemporal_load(zp); u32x4 w;
    #define CMB(f) cvtpk_s((w0*bl(a.f)+w1*bl(bq.f)+w2*bl(cq.f))*bl(z.f),(w0*bh(a.f)+w1*bh(bq.f)+w2*bh(cq.f))*bh(z.f))
    w.x=CMB(x); w.y=CMB(y); w.z=CMB(z); w.w=CMB(w);
    #undef CMB
    *zp=w;
  }
  __syncthreads();
}
#undef AMFMA
}

constexpr int NWAVES = 8;
constexpr int BATCH = 16, SEQ = 2048, DM = 1024, M = BATCH * SEQ, DEPTH = 2;
constexpr int INC = 6656;
constexpr int LDP = 4608;
constexpr int C_AQKV = 0, C_ZA = 2304, C_BQKV = 2560, C_ZB = 4096, C_RA = 4608, C_RB = 5632;
constexpr int C_MERGED = 0;
constexpr float RMS_EPS = 1e-6f;
constexpr size_t MiB = 1u << 20;
constexpr size_t WS_CTL = 0;
constexpr size_t WS_BAR = 0, WS_BAR_BYTES = 64 * 1024;
constexpr size_t WS_KMEAN = 256 * 1024;
constexpr size_t WS_WIN = 1 * MiB;
constexpr size_t WS_WCAT = 14 * MiB;
constexpr size_t WS_WOUT = 17 * MiB;
constexpr size_t WS_XB = 21 * MiB;
constexpr size_t WS_PROJ = 85 * MiB;
constexpr size_t WS_GATES = 373 * MiB;
constexpr size_t WS_WIN1 = 437 * MiB;
constexpr size_t WS_ROWSS = 450 * MiB;
constexpr size_t WS_END = 454 * MiB;
static_assert(WS_PROJ + (size_t)M * LDP * 2 == WS_GATES && WS_GATES + (size_t)M * 2048 == WS_WIN1, "ws map");
constexpr int LDS_MISC = pg8::EPI_OFF + 8 * pg8::EPI_WAVE;
constexpr int LDS_RSTAB = LDS_MISC + 256;
constexpr int LDS_BYTES = LDS_RSTAB + 1024 + 64;

#define LAS __attribute__((address_space(3)))
typedef unsigned short bf16;
typedef unsigned v4u __attribute__((ext_vector_type(4)));
typedef float f32x4 __attribute__((ext_vector_type(4)));
#define RLX_AGENT __ATOMIC_RELAXED, __HIP_MEMORY_SCOPE_AGENT
#define XB_TMO      128
#define XB_XCNT(j)  (256  + 64 * (j))
#define XB_XSUB(j)  (1280 + 64 * (j))
#define XB_XGEN(j)  (2304 + 64 * (j))
#define XB_TOP      3328
#define XB_TOPGEN   3392
#define XCD_BAR_WORDS 3456
#define XB_SPIN_CAP (1u << 18)

__device__ __forceinline__ unsigned xb_ld(unsigned* p)              { return __hip_atomic_load(p, __ATOMIC_RELAXED, __HIP_MEMORY_SCOPE_AGENT); }
__device__ __forceinline__ unsigned xb_add(unsigned* p, unsigned v) { return __hip_atomic_fetch_add(p, v, __ATOMIC_RELAXED, __HIP_MEMORY_SCOPE_AGENT); }
__device__ __forceinline__ unsigned xb_xcc_id() { return (unsigned)__builtin_amdgcn_s_getreg((3 << 11) | 20) & 0xFu; }
#define XB_SPIN(cond, bar) do { unsigned _sp = 0; while (cond) { __builtin_amdgcn_s_sleep(1); \
    if ((++_sp & 255u) == 0u) { if (xb_ld(&(bar)[XB_TMO])) break; if (_sp > XB_SPIN_CAP) { atomicAdd(&(bar)[XB_TMO], 1u); break; } } } } while (0)

struct XcdBarrier {
    unsigned* bar; unsigned x;
    volatile LAS unsigned* st;
};

__device__ __forceinline__ XcdBarrier xcd_barrier_post(unsigned* bar, volatile LAS unsigned* st) {
    XcdBarrier b; b.bar = bar; b.x = xb_xcc_id(); b.st = st;
    if (threadIdx.x == 0) (void)xb_add(&bar[XB_XCNT(b.x)], 1u);
    return b;
}
__device__ __forceinline__ void xcd_barrier_complete(unsigned* bar, unsigned x, unsigned& nloc, unsigned& nx) {
    const unsigned G = gridDim.x * gridDim.y * gridDim.z;
    unsigned sum, cnt, mine, sp = 0u;
    for (;;) {
        sum = 0u; cnt = 0u; mine = 0u;
#pragma unroll
        for (unsigned j = 0; j < 16; ++j) { const unsigned c = xb_ld(&bar[XB_XCNT(j)]); sum += c; cnt += (c > 0u) ? 1u : 0u; mine = (j == x) ? c : mine; }
        if (sum == G) break;
        __builtin_amdgcn_s_sleep(1);
        if ((++sp & 255u) == 0u) { if (xb_ld(&bar[XB_TMO])) break; if (sp > XB_SPIN_CAP) { atomicAdd(&bar[XB_TMO], 1u); break; } }
    }
    nloc = mine > 0u ? mine : 1u; nx = cnt > 0u ? cnt : 1u;
}

__device__ __forceinline__ void xcd_barrier(const XcdBarrier& b) {
    asm volatile("s_waitcnt vmcnt(0)" ::: "memory");
    __syncthreads();
    if (threadIdx.x == 0) {
        unsigned* bar = b.bar;
        __builtin_amdgcn_s_waitcnt(0);
        unsigned nloc = b.st[0], nx = b.st[1];
        if (nloc == 0u) { xcd_barrier_complete(bar, b.x, nloc, nx); b.st[0] = nloc; b.st[1] = nx; }
        const unsigned old = xb_add(&bar[XB_XSUB(b.x)], 1u);
        const unsigned gen = old / nloc;
        if (old + 1u == (gen + 1u) * nloc) {
            __builtin_amdgcn_fence(__ATOMIC_RELEASE, "agent");
            asm volatile("s_waitcnt vmcnt(0)" ::: "memory");
            const unsigned og = xb_add(&bar[XB_TOP], 1u);
            const unsigned tg = og / nx;
            if (og + 1u == (tg + 1u) * nx) xb_add(&bar[XB_TOPGEN], 1u);
            else XB_SPIN(xb_ld(&bar[XB_TOPGEN]) == tg, bar);
            __builtin_amdgcn_fence(__ATOMIC_ACQUIRE, "agent");
            xb_add(&bar[XB_XGEN(b.x)], 1u);
            asm volatile("s_waitcnt vmcnt(0)" ::: "memory");
        } else {
            XB_SPIN(xb_ld(&bar[XB_XGEN(b.x)]) == gen, bar);
            __builtin_amdgcn_fence(__ATOMIC_ACQUIRE, "agent");
            asm volatile("s_waitcnt vmcnt(0)" ::: "memory");
        }
    }
    __syncthreads();
}

__device__ __forceinline__ unsigned f2bf(float f) { unsigned u = __builtin_bit_cast(unsigned, f); return (u + 0x7fffu + ((u >> 16) & 1u)) >> 16; }
__device__ __forceinline__ unsigned pk2(float lo, float hi) { return f2bf(lo) | (f2bf(hi) << 16); }
__device__ __forceinline__ float bf2f(bf16 v) { return __uint_as_float(((unsigned)v) << 16); }
__device__ __forceinline__ float blo(unsigned u) { return __uint_as_float(u << 16); }
__device__ __forceinline__ float bhi(unsigned u) { return __uint_as_float(u & 0xffff0000u); }
__device__ __forceinline__ float wave_sum(float v) {
#pragma unroll
    for (int o = 1; o < 64; o <<= 1) v += __shfl_xor(v, o);
    return v;
}
__device__ __forceinline__ float wave_max(float v) {
#pragma unroll
    for (int o = 1; o < 64; o <<= 1) v = fmaxf(v, __shfl_xor(v, o));
    return v;
}
__device__ __forceinline__ void transpose_item(const float* W, int K, int N, bf16* WT, int ldw, LAS float* scr, int item, int lane, const float* gain = nullptr) {
    const int nblk = N / 32, kb = item / nblk, nb = item % nblk, k0 = 64 * kb, n0 = 32 * nb;
    f32x4 v[8]; float gk[8];
#pragma unroll
    for (int i = 0; i < 8; ++i) { const int kk = 8 * i + (lane >> 3); v[i] = __builtin_nontemporal_load((const f32x4*)(W + (size_t)(k0 + kk) * N + n0 + 4 * (lane & 7))); gk[i] = gain ? gain[k0 + kk] : 1.0f; }
#pragma unroll
    for (int i = 0; i < 8; ++i) { const int kk = 8 * i + (lane >> 3); LAS float* d = scr + kk * 33 + 4 * (lane & 7); d[0] = v[i].x * gk[i]; d[1] = v[i].y * gk[i]; d[2] = v[i].z * gk[i]; d[3] = v[i].w * gk[i]; }
    asm volatile("s_waitcnt lgkmcnt(0)" ::: "memory");
    const int c = lane & 7;
#pragma unroll
    for (int j = 0; j < 4; ++j) { const int n = (lane >> 3) + 8 * j; const LAS float* s = scr + (8 * c) * 33 + n;
        v4u o; o.x = pk2(s[0 * 33], s[1 * 33]); o.y = pk2(s[2 * 33], s[3 * 33]); o.z = pk2(s[4 * 33], s[5 * 33]); o.w = pk2(s[6 * 33], s[7 * 33]);
        *(v4u*)(WT + (size_t)(n0 + n) * ldw + k0 + 8 * c) = o; }
    asm volatile("s_waitcnt lgkmcnt(0)" ::: "memory");
}
template <bool OUT_BF16> __device__ __forceinline__ void rms_row(const float* xrow, const float* g, void* orow, int lane) {
    const f32x4* xr = (const f32x4*)xrow + lane; const f32x4* gr = (const f32x4*)g + lane;
    f32x4 v[4]; float s = 0.f;
#pragma unroll
    for (int j = 0; j < 4; ++j) { v[j] = xr[64 * j]; s += (v[j].x * v[j].x + v[j].y * v[j].y) + (v[j].z * v[j].z + v[j].w * v[j].w); }
    const float rstd = 1.0f / sqrtf(wave_sum(s) * (1.f / DM) + RMS_EPS);
#pragma unroll
    for (int j = 0; j < 4; ++j) { const f32x4 gg = gr[64 * j]; v[j] = v[j] * rstd * gg; }
    if (OUT_BF16) { unsigned long long* o8 = (unsigned long long*)orow + lane;
#pragma unroll
        for (int j = 0; j < 4; ++j) o8[64 * j] = (unsigned long long)pk2(v[j].x, v[j].y) | ((unsigned long long)pk2(v[j].z, v[j].w) << 32);
    } else { f32x4* o = (f32x4*)orow + lane;
#pragma unroll
        for (int j = 0; j < 4; ++j) o[64 * j] = v[j]; }
}
__device__ __forceinline__ void raw_row(const float* xrow, bf16* orow, float* ss, int lane) {
    const f32x4* xr = (const f32x4*)xrow + lane; f32x4 v[4]; float s = 0.f;
#pragma unroll
    for (int j = 0; j < 4; ++j) { v[j] = __builtin_nontemporal_load(xr + 64 * j); s += (v[j].x * v[j].x + v[j].y * v[j].y) + (v[j].z * v[j].z + v[j].w * v[j].w); }
    s = wave_sum(s); if (lane < 16) ss[lane] = (lane == 0) ? s : 0.f;
    unsigned long long* o8 = (unsigned long long*)orow + lane;
#pragma unroll
    for (int j = 0; j < 4; ++j) o8[64 * j] = (unsigned long long)pk2(v[j].x, v[j].y) | ((unsigned long long)pk2(v[j].z, v[j].w) << 32);
}
__device__ __forceinline__ float dot64(const v4u (&q)[8], const bf16* krow) {
    const v4u* kp = (const v4u*)krow; float a0 = 0.f, a1 = 0.f;
#pragma unroll
    for (int i = 0; i < 8; ++i) { const v4u k = kp[i];
        a0 += blo(q[i].x) * blo(k.x) + blo(q[i].y) * blo(k.y) + blo(q[i].z) * blo(k.z) + blo(q[i].w) * blo(k.w);
        a1 += bhi(q[i].x) * bhi(k.x) + bhi(q[i].y) * bhi(k.y) + bhi(q[i].z) * bhi(k.z) + bhi(q[i].w) * bhi(k.w); }
    return a0 + a1;
}

struct Args { const float* x; const float* norm_g; const float* w_in; const float* b_merge; const float* w_pa; const float* w_pb; const float* w_out; const float* final_g;
              float* out; unsigned char* ws; };

#define PHASE_VARS() \
    int tid_ = threadIdx.x; asm volatile("" : "+v"(tid_)); \
    const int lane = tid_ & 63, wave = __builtin_amdgcn_readfirstlane(tid_ >> 6); \
    const int G = gridDim.x, gw = blockIdx.x * NWAVES + wave, NGW = G * NWAVES; \
    unsigned long long wsb_ = (unsigned long long)a.ws; asm volatile("" : "+s"(wsb_)); \
    unsigned char* const ws = (unsigned char*)(__attribute__((address_space(1))) unsigned char*)wsb_;     \
    bf16* const Win = (bf16*)(ws + (layer == 0 ? WS_WIN : WS_WIN1)); float* const rowss = (float*)(ws + WS_ROWSS); bf16* const Wcat = (bf16*)(ws + WS_WCAT); bf16* const Wout = (bf16*)(ws + WS_WOUT); \
    bf16* const XB = (bf16*)(ws + WS_XB); bf16* const P = (bf16*)(ws + WS_PROJ); float* const kmean = (float*)(ws + WS_KMEAN); unsigned char* const gatesb = ws + WS_GATES; \
    (void)lane; (void)wave; (void)G; (void)gw; (void)NGW; (void)Win; (void)Wcat; (void)Wout; (void)rowss; (void)XB; (void)P; (void)kmean; (void)gatesb;

#define GRID_BAR() do { unsigned long long wb_ = (unsigned long long)a.ws; asm volatile("" : "+s"(wb_)); XcdBarrier bb_; bb_.bar = (unsigned*)(__attribute__((address_space(1))) unsigned*)wb_; \
    bb_.x = xb_xcc_id(); bb_.st = (volatile LAS unsigned*)(L + LDS_MISC); xcd_barrier(bb_); } while (0)
template <int layer> __device__ __forceinline__ void layer_fwd(const Args& a, unsigned char* lds, LAS unsigned char* L) {
    if (layer == 0) {
        PHASE_VARS();
        LAS float* scr = (LAS float*)(L + wave * 16384);
        constexpr int I_IN = (DM / 64) * (INC / 32), I_PA = (256 / 64) * (DM / 32), I_PB = (512 / 64) * (DM / 32), I_OUT = (DM / 64) * (DM / 32);
        const int nitems = 2 * (I_IN + I_PA + I_PB + I_OUT);
        for (int it = gw; it < nitems; it += NGW) {
            const int l2 = it / (I_IN + I_PA + I_PB + I_OUT); int r = it - l2 * (I_IN + I_PA + I_PB + I_OUT);
            if (r < I_IN) { transpose_item(a.w_in + (size_t)l2 * DM * INC, DM, INC, (bf16*)(ws + (l2 == 0 ? WS_WIN : WS_WIN1)), DM, scr, r, lane, a.norm_g + l2 * DM); continue; } r -= I_IN;
            if (r < I_PA) { transpose_item(a.w_pa + (size_t)l2 * 256 * DM, 256, DM, Wcat + (size_t)l2 * DM * 768, 768, scr, r, lane); continue; } r -= I_PA;
            if (r < I_PB) { transpose_item(a.w_pb + (size_t)l2 * 512 * DM, 512, DM, Wcat + (size_t)l2 * DM * 768 + 256, 768, scr, r, lane); continue; } r -= I_PB;
            transpose_item(a.w_out + (size_t)l2 * DM * DM, DM, DM, Wout + (size_t)l2 * DM * DM, DM, scr, r, lane);
        }
        for (int i = gw * 64 + lane; i < 2 * 128 * 512; i += NGW * 64) kmean[i] = 0.f;
        for (int m = gw; m < M; m += NGW) raw_row(a.x + (size_t)m * DM, XB + (size_t)m * DM, rowss + (size_t)m * 16, lane);
    }
    if (layer == 0) GRID_BAR();
    {
        PHASE_VARS();
        if (threadIdx.x == 0) ((LAS int*)(L + LDS_RSTAB))[256] = -1;
        __syncthreads();
        pg8::Gemm g{XB, Win, M, INC, DM, DM}; pg8::StaticOrder S; S.init(M, INC, G, (int)blockIdx.x);
        pg8::EpiProj E{P, LDP, a.b_merge + layer * 2 * DM, kmean + layer * 128 * 512, gatesb, rowss + (size_t)layer * M * 16};
        pg8::gemm_phase<pg8::EpiProj, pg8::StaticOrder, true, true>(L, g, S, E);
    }
    GRID_BAR();
    {
        PHASE_VARS();
        const int vcu = (G % 8 == 0) ? ((int)blockIdx.x % 8) * (G / 8) + (int)blockIdx.x / 8 : (int)blockIdx.x;
#pragma unroll 1
        for (int pass = 0; pass < 2; ++pass) {
            if ((pass ^ (vcu >> 2)) & 1) {
                for (int it = (int)blockIdx.x; it < BATCH * 4 * 4; it += G) attna::wg_item((attna::bf16*)P, it >> 4, (it >> 2) & 3, it & 3, (char*)lds);
            } else {
                for (int p = vcu; p < BATCH * 8 * 4; p += G) {
                    const int bh = p >> 2, s = p & 3;
#pragma unroll 1
                    for (int u = 0; u < 2; ++u)
                        moba::moba_unit<8>(bh >> 3, bh & 7, u ? 7 - s : s, (const moba::bf16*)(P + C_BQKV), (const moba::bf16*)(P + C_BQKV + 512), (const moba::bf16*)(P + C_BQKV + 1024), (const moba::bf16*)(P + C_ZB), (moba::bf16*)(P + C_BQKV), kmean + layer * 128 * 512, (char*)lds);
                }
            }
        }
    }
    GRID_BAR();
    {
        PHASE_VARS();
        pg8::StaticOrder S; S.init(M, DM, G, (int)blockIdx.x);
        pg8::Gemm g{P + C_ZA, Wcat + (size_t)layer * DM * 768, M, DM, 768, LDP}; pg8::EpiMerge E{P + C_MERGED, gatesb, LDP};
        pg8::gemm_phase<pg8::EpiMerge, pg8::StaticOrder, true, true>(L, g, S, E);
    }
    GRID_BAR();
    {
        PHASE_VARS();
        pg8::Gemm g{P + C_MERGED, Wout + (size_t)layer * DM * DM, M, DM, DM, LDP}; pg8::StaticOrder S; S.init(M, DM, G, (int)blockIdx.x);
        pg8::EpiResid<layer> E{a.x, XB, rowss + (layer == 0 ? (size_t)M * 16 : 0), DM};
        pg8::gemm_phase<pg8::EpiResid<layer>, pg8::StaticOrder, true, true>(L, g, S, E);
    }
    GRID_BAR();
}

__global__ void __launch_bounds__(NWAVES * 64, 2) hybrid_fwd(Args a) {
    extern __shared__ __attribute__((aligned(16))) unsigned char lds[];
    LAS unsigned char* L = (LAS unsigned char*)lds;
    if (threadIdx.x < 16) ((LAS unsigned*)(L + LDS_MISC))[threadIdx.x] = 0u;
    __syncthreads();
    (void)xcd_barrier_post((unsigned*)a.ws, (volatile LAS unsigned*)(L + LDS_MISC));
    layer_fwd<0>(a, lds, L);
    layer_fwd<1>(a, lds, L);
    {
        constexpr int layer = 1; (void)layer;
        PHASE_VARS();
        typedef unsigned u32x2_t __attribute__((ext_vector_type(2)));
        f32x4 gg[4];
#pragma unroll
        for (int j = 0; j < 4; ++j) gg[j] = *((const f32x4*)a.final_g + lane + 64 * j);
        for (int m = gw; m < M; m += NGW) {
            const f32x4* pp = (const f32x4*)(rowss + (size_t)m * 16); const f32x4 s4 = (pp[0] + pp[1]) + (pp[2] + pp[3]);
            const float rstd = __builtin_amdgcn_rsqf(((s4[0] + s4[1]) + (s4[2] + s4[3])) * (1.0f / 1024.0f) + RMS_EPS);
            const u32x2_t* xb = (const u32x2_t*)(XB + (size_t)m * DM) + lane; f32x4* o = (f32x4*)(a.out + (size_t)m * DM) + lane;
            u32x2_t bv[4];
#pragma unroll
            for (int j = 0; j < 4; ++j) bv[j] = __builtin_nontemporal_load(xb + 64 * j);
#pragma unroll
            for (int j = 0; j < 4; ++j) __builtin_nontemporal_store((f32x4){blo(bv[j].x), bhi(bv[j].x), blo(bv[j].y), bhi(bv[j].y)} * rstd * gg[j], o + 64 * j);
        }
    }
}

extern "C" void kernel_launch(void* const* d_in, const int* in_sizes, int n_in, void* d_out, int out_size, void* d_ws, size_t ws_size, hipStream_t stream) {
    static int grid = 0;
    if (grid == 0) {
        if (n_in != 8 || in_sizes[0] != M * DM || out_size != M * DM || ws_size < WS_END) { fprintf(stderr, "kernel_launch: unexpected shapes / workspace (n_in %d, ws %zu)\n", n_in, ws_size); grid = -1; return; }
        int dev = 0, cus = 0, per_cu = 0;
        hipGetDevice(&dev); hipDeviceGetAttribute(&cus, hipDeviceAttributeMultiprocessorCount, dev);
        if (hipFuncSetAttribute((const void*)hybrid_fwd, hipFuncAttributeMaxDynamicSharedMemorySize, LDS_BYTES) != hipSuccess) { fprintf(stderr, "kernel_launch: hipFuncSetAttribute failed\n"); grid = -1; return; }
        if (hipOccupancyMaxActiveBlocksPerMultiprocessor(&per_cu, (const void*)hybrid_fwd, NWAVES * 64, LDS_BYTES) != hipSuccess || per_cu < 1) { fprintf(stderr, "kernel_launch: the occupancy query admits %d workgroups per CU; nothing launched\n", per_cu); grid = -1; return; }
        (void)hipGetLastError();
        grid = cus;
    }
    if (grid < 0) return;
    if (hipMemsetAsync((char*)d_ws + WS_BAR, 0, WS_BAR_BYTES, stream) != hipSuccess) { fprintf(stderr, "kernel_launch: hipMemsetAsync failed\n"); return; }
    Args a{};
    a.x = (const float*)d_in[0]; a.norm_g = (const float*)d_in[1]; a.w_in = (const float*)d_in[2]; a.b_merge = (const float*)d_in[3];
    a.w_pa = (const float*)d_in[4]; a.w_pb = (const float*)d_in[5]; a.w_out = (const float*)d_in[6]; a.final_g = (const float*)d_in[7];
    a.out = (float*)d_out; a.ws = (unsigned char*)d_ws;
    hipLaunchKernelGGL(hybrid_fwd, dim3(grid), dim3(NWAVES * 64), LDS_BYTES, stream, a);
    const hipError_t e = hipPeekAtLastError();
    if (e != hipSuccess) fprintf(stderr, "kernel_launch: launch failed: %s (grid %d)\n", hipGetErrorString(e), grid);
}
```

```cpp
#include <hip/hip_runtime.h>
#include <cstdio>
#include <cstdint>
namespace pg8 {
#define PG8_LAS __attribute__((address_space(3)))
typedef unsigned short bf16_t;
typedef short bf16x8 __attribute__((ext_vector_type(8)));
typedef float f32x4 __attribute__((ext_vector_type(4)));
typedef unsigned u32x4 __attribute__((ext_vector_type(4)));
constexpr int BM = 256, BK = 64, HALF = 128, HTB = HALF * BK * 2  , STAGE_BYTES = 8 * HTB, NXCD = 8, WGM = 8;
constexpr int EPI_OFF = STAGE_BYTES, EPI_PITCH = 144, EPI_WAVE = 16 * EPI_PITCH;

__host__ __device__ __forceinline__ int lds_byte(int r, int c) { const int st = (r >> 4) * 2 + (c >> 5), rr = r & 15, cc = c & 31, ob = rr * 64 + cc * 2; return st * 1024 + (ob ^ (((ob >> 9) & 1) << 5)); }
__host__ __device__ __forceinline__ void stage_rc(int b, int& R, int& C) { const int st = b / 1024, sb = b % 1024, swz = sb ^ (((sb >> 9) & 1) << 5); R = (st >> 1) * 16 + swz / 64; C = (st & 1) * 32 + (swz % 64) / 2; }
__host__ __device__ __forceinline__ int perm32(int rho) { const int n = rho >> 4, i = rho & 15; return 8 * (i >> 2) + 4 * n + (i & 3); }

struct Unit { int pm, pn; };
struct Gemm { const bf16_t* A; const bf16_t* Bt; int M, N, K, lda; };

struct StaticOrder {
    int nM, nN, nwg, G, c;
    __host__ __device__ void init(int M, int N, int G_, int c_) { nM = M / BM; nN = N / BM; nwg = nM * nN; G = G_; c = c_; }
    __host__ __device__ bool next(int i, Unit& u) const {
        const long L = (long)i * G + c; if (L >= nwg) return false;
        int wgid = (int)L; { const int q = nwg / NXCD, r = nwg % NXCD, xcd = wgid % NXCD, off = wgid / NXCD; wgid = (xcd < r ? xcd * (q + 1) : r * (q + 1) + (xcd - r) * q) + off; }
        const int nig = WGM * nN, gid = wgid / nig, fm = gid * WGM, gsz = (nM - fm) < WGM ? (nM - fm) : WGM;
        u.pm = fm + ((wgid % nig) % gsz); u.pn = (wgid % nig) / gsz; return true;
    }
    __device__ __forceinline__ void a_ready(const Unit&) const {}
    __device__ __forceinline__ void done(const Unit&) const {}
};


typedef int i32x4 __attribute__((ext_vector_type(4)));
__device__ __forceinline__ f32x4 mma16(bf16x8 a, bf16x8 b, f32x4 c) { return __builtin_amdgcn_mfma_f32_16x16x32_bf16(a, b, c, 0, 0, 0); }
__device__ __forceinline__ i32x4 mma16(bf16x8 a, bf16x8 b, i32x4 c) { return __builtin_amdgcn_mfma_i32_16x16x64_i8(__builtin_bit_cast(i32x4, a), __builtin_bit_cast(i32x4, b), c, 0, 0, 0); }
template <class Epi, class Sched, bool ALIGN_EPI = false, bool SP2 = false>
__device__ __forceinline__ void gemm_phase(PG8_LAS unsigned char* lds, const Gemm g, const Sched& S, const Epi& E) {
    int tid_ = threadIdx.x; asm volatile("" : "+v"(tid_));
    const int tid = tid_, wid = __builtin_amdgcn_readfirstlane(tid >> 6), lane = tid & 63, wr = wid >> 2, wc = wid & 3, fr = lane & 15, fq = lane >> 4;
    const int K = g.K, nt = K / BK;
    unsigned voffA[2], voffB[2];
#pragma unroll
    for (int i = 0; i < 2; ++i) { int R, C; stage_rc(tid * 16 + i * 8192, R, C); const int Rb = 64 * (R >> 5) + (Epi::PERM ? perm32(R & 31) : (R & 31));
        voffA[i] = (unsigned)(R * g.lda + C) * 2u; voffB[i] = (unsigned)(Rb * K + C) * 2u; }
    const size_t kstep = (size_t)(BK * 2);
    const size_t hstepB = (size_t)32 * K * 2, hstepA = (size_t)HALF * g.lda * 2;
    const size_t tstepB = (size_t)BM * K * 2, tstepA = 2 * hstepA;
    const unsigned ldsw = (unsigned)wid * 1024u;
    const int aoff = lds_byte(wr * 64 + fr, fq * 8), boff = lds_byte(wc * 32 + fr, fq * 8);
#define PG8_SA(b, h) (((b) * 2 + (h)) * HTB)
#define PG8_SB(b, h) ((4 + (b) * 2 + (h)) * HTB)
#define PG8_STAGE(bufoff, gbase, voff) do { _Pragma("unroll") for (int _i = 0; _i < 2; ++_i) \
        __builtin_amdgcn_global_load_lds((const unsigned*)((const char*)(gbase) + (voff)[_i]), (PG8_LAS unsigned*)(lds + (bufoff) + ldsw + _i * 8192), 16, 0, 0); } while (0)
#define PG8_LDA(dst, b, h) do { _Pragma("unroll") for (int m = 0; m < 4; ++m) _Pragma("unroll") for (int k = 0; k < 2; ++k) dst[m][k] = *(const PG8_LAS bf16x8*)(lds + PG8_SA(b, h) + aoff + m * 2048 + k * 1024); } while (0)
#define PG8_LDB(dst, b, h) do { _Pragma("unroll") for (int n = 0; n < 2; ++n) _Pragma("unroll") for (int k = 0; k < 2; ++k) dst[n][k] = *(const PG8_LAS bf16x8*)(lds + PG8_SB(b, h) + boff + n * 2048 + k * 1024); } while (0)
#define PG8_MMA(ai, bj, At, Bt) do { __builtin_amdgcn_s_setprio(1); _Pragma("unroll") for (int m = 0; m < 4; ++m) _Pragma("unroll") for (int n = 0; n < 2; ++n) _Pragma("unroll") for (int k = 0; k < 2; ++k) \
        acc[ai][bj][m][n] = mma16(Bt[n][k], At[m][k], acc[ai][bj][m][n]); __builtin_amdgcn_s_setprio(0); } while (0)
#define PG8_WAIT_V(n) asm volatile("s_waitcnt vmcnt(" #n ")" ::: "memory")
#define PG8_WAIT_L(n) asm volatile("s_waitcnt lgkmcnt(" #n ")" ::: "memory")
#define PG8_BAR __builtin_amdgcn_s_barrier()
#define PG8_SCHED __builtin_amdgcn_sched_barrier(0)
    Unit cur, nxt; int ui = 0;
    if (!S.next(0, cur)) return;
    typename Epi::acc_t acc[2][2][4][2];
#pragma unroll
    for (int a = 0; a < 2; ++a)
#pragma unroll
        for (int b = 0; b < 2; ++b)
#pragma unroll
            for (int m = 0; m < 4; ++m)
#pragma unroll
                for (int n = 0; n < 2; ++n) acc[a][b][m][n] = (typename Epi::acc_t){0, 0, 0, 0};
    bf16x8 At[4][2], B0[2][2], B1[2][2];
    const char* cA = (const char*)g.A + (size_t)cur.pm * tstepA; const char* cB = (const char*)g.Bt + (size_t)cur.pn * tstepB;
    S.a_ready(cur);
    if constexpr (SP2) {
        PG8_STAGE(PG8_SB(0, 0), cB, voffB); PG8_STAGE(PG8_SB(0, 1), cB + hstepB, voffB); PG8_STAGE(PG8_SA(0, 0), cA, voffA); PG8_STAGE(PG8_SA(0, 1), cA + hstepA, voffA);
        if (wr == 1) PG8_BAR;
        PG8_WAIT_V(2); PG8_BAR;
        PG8_STAGE(PG8_SB(1, 0), cB + kstep, voffB); PG8_STAGE(PG8_SA(1, 0), cA + kstep, voffA); PG8_STAGE(PG8_SB(1, 1), cB + hstepB + kstep, voffB);
        PG8_WAIT_V(6); PG8_BAR;
    } else {
        PG8_STAGE(PG8_SB(0, 0), cB, voffB); PG8_STAGE(PG8_SA(0, 0), cA, voffA); PG8_STAGE(PG8_SB(0, 1), cB + hstepB, voffB); PG8_STAGE(PG8_SA(0, 1), cA + hstepA, voffA);
        if (wr == 1) PG8_BAR;
        PG8_WAIT_V(4); PG8_BAR;
        PG8_STAGE(PG8_SB(1, 0), cB + kstep, voffB); PG8_STAGE(PG8_SA(1, 0), cA + kstep, voffA); PG8_STAGE(PG8_SB(1, 1), cB + hstepB + kstep, voffB);
        PG8_WAIT_V(6); PG8_BAR;
    }
    for (;;) {
        const bool has_next = S.next(ui + 1, nxt);
        const char* nA = has_next ? (const char*)g.A + (size_t)nxt.pm * tstepA : cA; const char* nB = has_next ? (const char*)g.Bt + (size_t)nxt.pn * tstepB : cB;
        for (int t = 0; t < nt; t += 2) {
            const bool last = (t == nt - 2);
            const char* a1 = cA + (size_t)(t + 1) * kstep;
            const char* a2 = last ? nA : cA + (size_t)(t + 2) * kstep; const char* b2 = last ? nB : cB + (size_t)(t + 2) * kstep;
            const char* a3 = a2 + kstep; const char* b3 = b2 + kstep;
            if (last && has_next) S.a_ready(nxt);
            if constexpr (SP2) {
            PG8_LDB(B0, 0, 0); PG8_LDB(B1, 0, 1); PG8_SCHED; PG8_LDA(At, 0, 0); PG8_STAGE(PG8_SA(1, 1), a1 + hstepA, voffA);
            PG8_WAIT_V(8); PG8_WAIT_L(0); PG8_BAR; PG8_MMA(0, 0, At, B0); PG8_MMA(0, 1, At, B1); PG8_BAR; PG8_SCHED;
            PG8_LDA(At, 0, 1); PG8_STAGE(PG8_SB(0, 0), b2, voffB); PG8_STAGE(PG8_SB(0, 1), b2 + hstepB, voffB); PG8_STAGE(PG8_SA(0, 0), a2, voffA);
            PG8_WAIT_V(8); PG8_WAIT_L(0); PG8_BAR; PG8_MMA(1, 0, At, B0); PG8_MMA(1, 1, At, B1); PG8_BAR; PG8_SCHED;
            PG8_LDB(B0, 1, 0); PG8_LDB(B1, 1, 1); PG8_SCHED; PG8_LDA(At, 1, 0); PG8_STAGE(PG8_SA(0, 1), a2 + hstepA, voffA);
            PG8_WAIT_V(8); PG8_WAIT_L(0); PG8_BAR; PG8_MMA(0, 0, At, B0); PG8_MMA(0, 1, At, B1); PG8_BAR; PG8_SCHED;
            PG8_LDA(At, 1, 1); PG8_STAGE(PG8_SB(1, 0), b3, voffB); PG8_STAGE(PG8_SB(1, 1), b3 + hstepB, voffB); PG8_STAGE(PG8_SA(1, 0), a3, voffA);
            PG8_WAIT_V(8); PG8_WAIT_L(0); PG8_BAR; PG8_MMA(1, 0, At, B0); PG8_MMA(1, 1, At, B1); PG8_BAR; PG8_SCHED;
            if constexpr (Epi::HAS_MID) { if (t == Epi::MID_T) { E.mid(acc, cur, wr, wc, fr, fq, wid); PG8_SCHED; } }
            } else {
            PG8_LDB(B0, 0, 0); PG8_SCHED; PG8_LDA(At, 0, 0); PG8_STAGE(PG8_SA(1, 1), a1 + hstepA, voffA);
            PG8_WAIT_L(8); PG8_BAR; PG8_WAIT_L(0); PG8_MMA(0, 0, At, B0); PG8_BAR; PG8_SCHED;
            PG8_LDB(B1, 0, 1); PG8_STAGE(PG8_SB(0, 0), b2, voffB);
            PG8_BAR; PG8_WAIT_L(0); PG8_MMA(0, 1, At, B1); PG8_BAR;
            PG8_LDA(At, 0, 1); PG8_STAGE(PG8_SA(0, 0), a2, voffA);
            PG8_BAR; PG8_WAIT_L(0); PG8_MMA(1, 0, At, B0); PG8_BAR; PG8_SCHED;
            PG8_STAGE(PG8_SB(0, 1), b2 + hstepB, voffB);
            PG8_WAIT_V(6); PG8_BAR; PG8_MMA(1, 1, At, B1); PG8_BAR;
            PG8_LDB(B0, 1, 0); PG8_SCHED; PG8_LDA(At, 1, 0); PG8_STAGE(PG8_SA(0, 1), a2 + hstepA, voffA);
            PG8_WAIT_L(8); PG8_BAR; PG8_WAIT_L(0); PG8_MMA(0, 0, At, B0); PG8_BAR; PG8_SCHED;
            PG8_LDB(B1, 1, 1); PG8_STAGE(PG8_SB(1, 0), b3, voffB);
            PG8_BAR; PG8_WAIT_L(0); PG8_MMA(0, 1, At, B1); PG8_BAR;
            PG8_LDA(At, 1, 1); PG8_STAGE(PG8_SA(1, 0), a3, voffA);
            PG8_BAR; PG8_WAIT_L(0); PG8_MMA(1, 0, At, B0); PG8_BAR; PG8_SCHED;
            PG8_STAGE(PG8_SB(1, 1), b3 + hstepB, voffB);
            PG8_WAIT_V(6); PG8_BAR; PG8_MMA(1, 1, At, B1); PG8_BAR;
            }
        }
        if constexpr (ALIGN_EPI) { if (wr == 0) PG8_BAR; }
        if constexpr (!Epi::AFTER_DRAIN) { E(acc, cur, wr, wc, fr, fq, lds + EPI_OFF + wid * EPI_WAVE, lane, wid); S.done(cur); }
        if (!has_next) break;
#pragma unroll
        for (int a = 0; a < 2; ++a)
#pragma unroll
            for (int b = 0; b < 2; ++b)
#pragma unroll
                for (int m = 0; m < 4; ++m)
#pragma unroll
                    for (int n = 0; n < 2; ++n) acc[a][b][m][n] = (typename Epi::acc_t){0, 0, 0, 0};
        cur = nxt; cA = nA; cB = nB; ++ui;
        if constexpr (ALIGN_EPI) { if (wr == 1) PG8_BAR; }
    }
    PG8_WAIT_V(0);
    if constexpr (!ALIGN_EPI) { if (wr == 0) PG8_BAR; }
    PG8_BAR;
    if constexpr (Epi::AFTER_DRAIN) { E.fused(acc, cur, wr, wc, fr, fq, lds, wid, lane); S.done(cur); }
#undef PG8_SA
#undef PG8_SB
#undef PG8_STAGE
#undef PG8_LDA
#undef PG8_LDB
#undef PG8_MMA
#undef PG8_WAIT_V
#undef PG8_WAIT_L
#undef PG8_BAR
#undef PG8_SCHED
}
}


namespace pg8 {
__device__ __forceinline__ unsigned cvt_pk_bf16(float lo, float hi) { unsigned r; asm volatile("v_cvt_pk_bf16_f32 %0, %1, %2" : "=v"(r) : "v"(lo), "v"(hi)); return r; }
__device__ __forceinline__ float bflo(unsigned u) { return __uint_as_float(u << 16); }
__device__ __forceinline__ float bfhi(unsigned u) { return __uint_as_float(u & 0xffff0000u); }
__device__ __forceinline__ float sigmoidf_(float v) { return __builtin_amdgcn_rcpf(1.0f + __expf(-v)); }
typedef unsigned u32x2 __attribute__((ext_vector_type(2)));
__device__ __forceinline__ void piece_xpose(PG8_LAS unsigned char* stg, u32x4 in0, u32x4 in1, u32x4& out0, u32x4& out1, int fr, int fq, int lane) {
    *(PG8_LAS u32x4*)(stg + fr * EPI_PITCH + fq * 16) = in0; *(PG8_LAS u32x4*)(stg + fr * EPI_PITCH + 64 + fq * 16) = in1;
    out0 = *(const PG8_LAS u32x4*)(stg + (lane >> 3) * EPI_PITCH + (lane & 7) * 16); out1 = *(const PG8_LAS u32x4*)(stg + ((lane >> 3) + 8) * EPI_PITCH + (lane & 7) * 16);
}

struct EpiProj {
    typedef f32x4 acc_t; static constexpr bool PERM = true, AFTER_DRAIN = false, HAS_MID = false; static constexpr int MID_T = 0;
    bf16_t* O; int ldc; float* kmean; const float* rowss;
    __device__ __forceinline__ void operator()(const f32x4 (&acc)[2][2][4][2], const Unit& u, int wr, int wc, int fr, int fq, PG8_LAS unsigned char* stg, int lane, int wid) const {
        asm volatile("" : "+v"(fr), "+v"(fq), "+v"(lane));
        const int col0 = u.pn * BM + wc * 64 + 8 * fq;
        const int kind = (u.pn == 9 || u.pn == 16 || u.pn == 17) ? 1 : 0;
        PG8_LAS float* const tab = (PG8_LAS float*)(stg - wid * EPI_WAVE + 8 * EPI_WAVE + 256);
        if (__builtin_amdgcn_readfirstlane(((const PG8_LAS int*)tab)[256]) != u.pm) {
            asm volatile("s_waitcnt lgkmcnt(0)" ::: "memory"); __builtin_amdgcn_s_barrier(); asm volatile("" ::: "memory");
            const int t_ = wid * 64 + lane;
            if (t_ < 256) { const f32x4* pp = (const f32x4*)(rowss + (size_t)(u.pm * BM + t_) * 16); const f32x4 s4 = (pp[0] + pp[1]) + (pp[2] + pp[3]);
                tab[t_] = __builtin_amdgcn_rsqf(((s4[0] + s4[1]) + (s4[2] + s4[3])) * (1.0f / 1024.0f) + 1e-6f); }
            if (t_ == 0) ((PG8_LAS int*)tab)[256] = u.pm;
            asm volatile("s_waitcnt vmcnt(0) lgkmcnt(0)" ::: "memory"); __builtin_amdgcn_s_barrier(); asm volatile("" ::: "memory");
        }
        float rs[2][4];
#pragma unroll
        for (int ai = 0; ai < 2; ++ai)
#pragma unroll
            for (int m = 0; m < 4; ++m) rs[ai][m] = tab[ai * HALF + wr * 64 + m * 16 + fr];
        const float qs = (u.pn == 0 || u.pn == 3 || u.pn == 6 || u.pn == 10 || u.pn == 11) ? 0.18033688011112042f : 1.0f;
        const size_t rbase = (size_t)(u.pm * BM + wr * 64 + (lane >> 3)); bf16_t* const op = O + u.pn * BM + wc * 64 + 8 * (lane & 7);
#pragma unroll
        for (int ai = 0; ai < 2; ++ai)
#pragma unroll
            for (int m = 0; m < 4; ++m) { u32x4 w[2];
#pragma unroll
                for (int bj = 0; bj < 2; ++bj) { f32x4 v0 = acc[ai][bj][m][0] * rs[ai][m], v1 = acc[ai][bj][m][1] * rs[ai][m];
                    if (kind == 1) {
#pragma unroll
                        for (int e = 0; e < 4; ++e) { v0[e] = v0[e] * sigmoidf_(v0[e]); v1[e] = v1[e] * sigmoidf_(v1[e]); } }
                    v0 = v0 * qs; v1 = v1 * qs;
                    w[bj].x = cvt_pk_bf16(v0[0], v0[1]); w[bj].y = cvt_pk_bf16(v0[2], v0[3]); w[bj].z = cvt_pk_bf16(v1[0], v1[1]); w[bj].w = cvt_pk_bf16(v1[2], v1[3]); }
                u32x4 o0, o1; piece_xpose(stg, w[0], w[1], o0, o1, fr, fq, lane);
                bf16_t* rp = op + (rbase + ai * HALF + m * 16) * ldc;
                __builtin_nontemporal_store(o0, (u32x4*)rp); __builtin_nontemporal_store(o1, (u32x4*)(rp + (size_t)8 * ldc));
                asm volatile("" ::: "memory"); }
        if (u.pn == 12 || u.pn == 13) {
#pragma unroll
            for (int bj = 0; bj < 2; ++bj)
#pragma unroll
                for (int n = 0; n < 2; ++n) { f32x4 cs = (f32x4){0.f, 0.f, 0.f, 0.f};
#pragma unroll
                    for (int ai = 0; ai < 2; ++ai)
#pragma unroll
                        for (int m = 0; m < 4; ++m) { float r2 = rs[ai][m]; asm volatile("" : "+v"(r2)); cs += acc[ai][bj][m][n] * r2; }
#pragma unroll
                    for (int e = 0; e < 4; ++e) { float v = cs[e]; v += __shfl_xor(v, 1); v += __shfl_xor(v, 2); v += __shfl_xor(v, 4); v += __shfl_xor(v, 8); cs[e] = v; }
                    if (fr == 0) { float* kp = kmean + (size_t)u.pm * 512 + (u.pn - 12) * 256 + wc * 64 + bj * 32 + 8 * fq + 4 * n;
#pragma unroll
                        for (int e = 0; e < 4; ++e) atomicAdd(kp + e, cs[e] * (1.0f / 256.0f)); } }
        }
    }
};
struct EpiGate {
    typedef i32x4 acc_t; static constexpr bool PERM = true, AFTER_DRAIN = false, HAS_MID = false; static constexpr int MID_T = 0;
    const float* bmerge; const float* wscale; const float* xscale; const float* rowss; unsigned char* gates;
    __device__ __forceinline__ void operator()(const i32x4 (&acc)[2][2][4][2], const Unit& u, int wr, int wc, int fr, int fq, PG8_LAS unsigned char* stg, int lane, int wid) const {
        asm volatile("" : "+v"(fr), "+v"(fq), "+v"(lane));
        const int col0 = u.pn * BM + wc * 64 + 8 * fq;
        PG8_LAS float* const tab = (PG8_LAS float*)(stg - wid * EPI_WAVE + 8 * EPI_WAVE + 256);
        if (__builtin_amdgcn_readfirstlane(((const PG8_LAS int*)tab)[256]) != u.pm) {
            asm volatile("s_waitcnt lgkmcnt(0)" ::: "memory"); __builtin_amdgcn_s_barrier(); asm volatile("" ::: "memory");
            const int t_ = wid * 64 + lane;
            if (t_ < 256) { const f32x4* pp = (const f32x4*)(rowss + (size_t)(u.pm * BM + t_) * 16); const f32x4 s4 = (pp[0] + pp[1]) + (pp[2] + pp[3]);
                tab[t_] = xscale[u.pm * BM + t_] * __builtin_amdgcn_rsqf(((s4[0] + s4[1]) + (s4[2] + s4[3])) * (1.0f / 1024.0f) + 1e-6f) * (-1.4426950408889634f); }
            if (t_ == 0) ((PG8_LAS int*)tab)[256] = u.pm;
            asm volatile("s_waitcnt vmcnt(0) lgkmcnt(0)" ::: "memory"); __builtin_amdgcn_s_barrier(); asm volatile("" ::: "memory");
        }
        f32x4 bv[2][2], wv[2][2];
#pragma unroll
        for (int bj = 0; bj < 2; ++bj)
#pragma unroll
            for (int n = 0; n < 2; ++n) { bv[bj][n] = *(const f32x4*)(bmerge + col0 + bj * 32 + 4 * n) * (-1.4426950408889634f); wv[bj][n] = *(const f32x4*)(wscale + col0 + bj * 32 + 4 * n); }
        unsigned char* gp = gates + ((size_t)((u.pm * 8 + u.pn) * 8 + wid) * 8) * 1024 + fr * 64 + fq * 16;
#pragma unroll
        for (int ai = 0; ai < 2; ++ai)
#pragma unroll
            for (int m = 0; m < 4; ++m) { const float rf = tab[ai * HALF + wr * 64 + m * 16 + fr]; u32x4 q;
#pragma unroll
                for (int bj = 0; bj < 2; ++bj)
#pragma unroll
                    for (int n = 0; n < 2; ++n) { unsigned w = 0u;
#pragma unroll
                        for (int e = 0; e < 4; ++e) { const float x2 = (float)acc[ai][bj][m][n][e] * (rf * wv[bj][n][e]) + bv[bj][n][e];
                            w = __builtin_amdgcn_cvt_pk_u8_f32(__builtin_fmaxf(255.0f * __builtin_amdgcn_rcpf(1.0f + __builtin_amdgcn_exp2f(x2)), 1.0f), e, w); }
                        q[2 * bj + n] = w; }
                __builtin_nontemporal_store(q, (u32x4*)(gp + (ai * 4 + m) * 1024)); }
    }
};
struct EpiMerge {
    typedef f32x4 acc_t; static constexpr bool PERM = true, AFTER_DRAIN = false, HAS_MID = true; static constexpr int MID_T = 2;
    bf16_t* O; const unsigned char* gates; int ldc;
    __device__ __forceinline__ static float ub(unsigned w, int i) { return (float)((w >> (8 * i)) & 0xffu); }
    __device__ __forceinline__ void mid(f32x4 (&acc)[2][2][4][2], const Unit& u, int wr, int wc, int fr, int fq, int wid) const {
        asm volatile("" : "+v"(fr), "+v"(fq));
        const unsigned char* ga = gates + ((size_t)((u.pm * 8 + u.pn) * 8 + wid) * 8) * 1024 + fr * 64 + fq * 16; const unsigned char* gb = ga + (size_t)4 * 8 * 8 * 1024;
        u32x4 av[2][4], bv[2][4];
#pragma unroll
        for (int ai = 0; ai < 2; ++ai)
#pragma unroll
            for (int m = 0; m < 4; ++m) { av[ai][m] = __builtin_nontemporal_load((const u32x4*)(ga + (ai * 4 + m) * 1024)); bv[ai][m] = *(const u32x4*)(gb + (ai * 4 + m) * 1024); }
#pragma unroll
        for (int ai = 0; ai < 2; ++ai)
#pragma unroll
            for (int m = 0; m < 4; ++m)
#pragma unroll
                for (int bj = 0; bj < 2; ++bj)
#pragma unroll
                    for (int n = 0; n < 2; ++n)
#pragma unroll
                        for (int e = 0; e < 4; ++e) acc[ai][bj][m][n][e] *= ub(av[ai][m][2 * bj + n], e) * __builtin_amdgcn_rcpf(ub(bv[ai][m][2 * bj + n], e));
    }
    __device__ __forceinline__ void operator()(const f32x4 (&acc)[2][2][4][2], const Unit& u, int wr, int wc, int fr, int fq, PG8_LAS unsigned char* stg, int lane, int wid) const {
        asm volatile("" : "+v"(fr), "+v"(fq), "+v"(lane));
        const unsigned char* gb = gates + ((size_t)((u.pm * 8 + 4 + u.pn) * 8 + wid) * 8) * 1024 + fr * 64 + fq * 16;
        const size_t rbase = (size_t)(u.pm * BM + wr * 64 + (lane >> 3)); bf16_t* const op = O + u.pn * BM + wc * 64 + 8 * (lane & 7);
        u32x4 gvv[2][4];
#pragma unroll
        for (int ai = 0; ai < 2; ++ai)
#pragma unroll
            for (int m = 0; m < 4; ++m) gvv[ai][m] = __builtin_nontemporal_load((const u32x4*)(gb + (ai * 4 + m) * 1024));
#pragma unroll
        for (int ai = 0; ai < 2; ++ai)
#pragma unroll
            for (int m = 0; m < 4; ++m) { const u32x4 gv = gvv[ai][m]; u32x4 w[2];
#pragma unroll
                for (int bj = 0; bj < 2; ++bj) { f32x4 v0 = acc[ai][bj][m][0], v1 = acc[ai][bj][m][1];
#pragma unroll
                    for (int e = 0; e < 4; ++e) { v0[e] *= ub(gv[2 * bj], e) * (1.0f / 255.0f); v1[e] *= ub(gv[2 * bj + 1], e) * (1.0f / 255.0f); }
                    w[bj].x = cvt_pk_bf16(v0[0], v0[1]); w[bj].y = cvt_pk_bf16(v0[2], v0[3]); w[bj].z = cvt_pk_bf16(v1[0], v1[1]); w[bj].w = cvt_pk_bf16(v1[2], v1[3]); }
                u32x4 o0, o1; piece_xpose(stg, w[0], w[1], o0, o1, fr, fq, lane);
                bf16_t* rp = op + (rbase + ai * HALF + m * 16) * ldc;
                __builtin_nontemporal_store(o0, (u32x4*)rp); __builtin_nontemporal_store(o1, (u32x4*)(rp + (size_t)8 * ldc));
                if (m & 1) asm volatile("" ::: "memory"); }
    }
};
template <int MODE> struct EpiResid {
    typedef f32x4 acc_t; static constexpr bool PERM = false, AFTER_DRAIN = false, HAS_MID = false; static constexpr int MID_T = 0;
    const float* R; bf16_t* XB; float* rowss; int ldc;
    __device__ __forceinline__ void operator()(const f32x4 (&acc)[2][2][4][2], const Unit& u, int wr, int wc, int fr, int fq, PG8_LAS unsigned char* stg, int lane, int wid) const {
        asm volatile("" : "+v"(fr), "+v"(fq), "+v"(lane));
        const size_t rbase = (size_t)(u.pm * BM + wr * 64 + (lane >> 3)); const int cb = u.pn * BM + wc * 64 + 4 * (lane & 7);
#pragma unroll
        for (int ai = 0; ai < 2; ++ai) {
            f32x4 rr[4][2][2];
#pragma unroll
            for (int m = 0; m < 4; ++m)
#pragma unroll
                for (int bj = 0; bj < 2; ++bj) { const size_t ro = (rbase + ai * HALF + m * 16) * ldc + cb + bj * 32;
                    if (MODE == 0) { rr[m][bj][0] = __builtin_nontemporal_load((const f32x4*)(R + ro)); rr[m][bj][1] = __builtin_nontemporal_load((const f32x4*)(R + ro + (size_t)8 * ldc)); }
                    else { const u32x2 b0 = __builtin_nontemporal_load((const u32x2*)(XB + ro)), b1 = __builtin_nontemporal_load((const u32x2*)(XB + ro + (size_t)8 * ldc));
                        rr[m][bj][0] = __builtin_bit_cast(f32x4, (u32x4){b0.x, b0.y, b1.x, b1.y}); } }
#pragma unroll
            for (int m = 0; m < 4; ++m) { float ss0 = 0.f, ss1 = 0.f;
#pragma unroll
                for (int bj = 0; bj < 2; ++bj) { const size_t ro = (rbase + ai * HALF + m * 16) * ldc + cb + bj * 32;
                    f32x4 r0, r1;
                    if (MODE == 0) { r0 = rr[m][bj][0]; r1 = rr[m][bj][1]; }
                    else { const u32x4 pk = __builtin_bit_cast(u32x4, rr[m][bj][0]);
                        r0 = (f32x4){bflo(pk.x), bfhi(pk.x), bflo(pk.y), bfhi(pk.y)}; r1 = (f32x4){bflo(pk.z), bfhi(pk.z), bflo(pk.w), bfhi(pk.w)}; }
                    u32x4 o0, o1; piece_xpose(stg, __builtin_bit_cast(u32x4, acc[ai][bj][m][0]), __builtin_bit_cast(u32x4, acc[ai][bj][m][1]), o0, o1, fr, fq, lane);
                    const f32x4 x0 = r0 + __builtin_bit_cast(f32x4, o0), x1 = r1 + __builtin_bit_cast(f32x4, o1);
                    *(u32x2*)(XB + ro) = (u32x2){cvt_pk_bf16(x0[0], x0[1]), cvt_pk_bf16(x0[2], x0[3])}; *(u32x2*)(XB + ro + (size_t)8 * ldc) = (u32x2){cvt_pk_bf16(x1[0], x1[1]), cvt_pk_bf16(x1[2], x1[3])};
                    ss0 += (x0[0] * x0[0] + x0[1] * x0[1]) + (x0[2] * x0[2] + x0[3] * x0[3]); ss1 += (x1[0] * x1[0] + x1[1] * x1[1]) + (x1[2] * x1[2] + x1[3] * x1[3]); }
                ss0 += __shfl_xor(ss0, 1); ss0 += __shfl_xor(ss0, 2); ss0 += __shfl_xor(ss0, 4); ss1 += __shfl_xor(ss1, 1); ss1 += __shfl_xor(ss1, 2); ss1 += __shfl_xor(ss1, 4);
                if ((lane & 7) == 0) { rowss[(rbase + ai * HALF + m * 16) * 16 + u.pn * 4 + wc] = ss0; rowss[(rbase + ai * HALF + m * 16 + 8) * 16 + u.pn * 4 + wc] = ss1; } }
            asm volatile("" ::: "memory");
        }
    }
};
}
#include <hip/hip_bf16.h>
#include <cmath>
namespace moba {
using bf16=__hip_bfloat16;
using bf16x8=__attribute__((ext_vector_type(8)))short;
using s16x4=__attribute__((ext_vector_type(4)))short;
using f32x16=__attribute__((ext_vector_type(16)))float;
using u32x4=__attribute__((ext_vector_type(4)))unsigned;
constexpr int SEQ=2048,D=64,PITCH=4608;
constexpr int NW=8,QBLK=32,QB=QBLK*NW,KVBLK=64;
__device__ __forceinline__ int crow(int r,int hi){return (r&3)+8*(r>>2)+4*hi;}
#define SBAR() __builtin_amdgcn_sched_barrier(0)
__device__ __forceinline__ void cmask(f32x16&p0,f32x16&p1,int jb,int qrel,int hi){
  const float NEG=-INFINITY; int kb=64*jb+4*hi;
  #pragma unroll
  for(int r=0;r<16;++r){int kv=kb+(r&3)+8*(r>>2); if(kv>qrel)p0[r]=NEG; if(kv+32>qrel)p1[r]=NEG;}
}

constexpr int NSLOT=3, SLOTB=8192;
constexpr int NVSLOT=4;
constexpr int LDS_K=0, LDS_V=NSLOT*SLOTB, LDS_WS=LDS_V+NVSLOT*SLOTB, LDS_OST=LDS_WS+NW*64*4, LDS_KM=LDS_OST+NW*4096, LDS_BYTES=LDS_KM+8*64*4;
__device__ __forceinline__ void glds16(const void*gsrc,unsigned lds_dst){unsigned keep;
  asm volatile("s_mov_b32 %0, m0\n\ts_mov_b32 m0, %2\n\ts_nop 0\n\tglobal_load_lds_dwordx4 %1, off\n\ts_mov_b32 m0, %0":"=&s"(keep):"v"(gsrc),"s"(lds_dst):"memory");}
__device__ __forceinline__ float max3f(float a,float b,float c){float r;asm("v_max3_f32 %0, %1, %2, %3":"=v"(r):"v"(a),"v"(b),"v"(c));return r;}
__device__ __forceinline__ float max2f(float a,float b){float r;asm("v_max_f32_e32 %0, %1, %2":"=v"(r):"v"(a),"v"(b));return r;}
typedef float f32x2_t __attribute__((ext_vector_type(2))); typedef __bf16 bf16x2_t __attribute__((ext_vector_type(2)));
__device__ __forceinline__ unsigned cvtpk_s(float lo,float hi){f32x2_t v={lo,hi};bf16x2_t b=__builtin_convertvector(v,bf16x2_t);return __builtin_bit_cast(unsigned,b);}
__device__ __forceinline__ float bl(unsigned u){return __uint_as_float(u<<16);}
__device__ __forceinline__ float bh(unsigned u){return __uint_as_float(u&0xffff0000u);}
#define WAIT_BAR(N) asm volatile("s_waitcnt vmcnt(" #N ") lgkmcnt(0)\n\ts_barrier":::"memory")

__device__ __forceinline__ void qkt(f32x16&p0,f32x16&p1,const char*Kslot,const bf16x8*qr,const f32x16&negm,int r32,int hi){
  const char*kb=Kslot+hi*1024+r32*16;
  #pragma unroll
  for(int d0=0;d0<4;++d0){
    const bf16x8 b0=*reinterpret_cast<const bf16x8*>(kb+d0*2048);
    const bf16x8 b1=*reinterpret_cast<const bf16x8*>(kb+d0*2048+512);
    if(d0==0){p0=__builtin_amdgcn_mfma_f32_32x32x16_bf16(b0,qr[0],negm,0,0,0);p1=__builtin_amdgcn_mfma_f32_32x32x16_bf16(b1,qr[0],negm,0,0,0);}
    else{p0=__builtin_amdgcn_mfma_f32_32x32x16_bf16(b0,qr[d0],p0,0,0,0);p1=__builtin_amdgcn_mfma_f32_32x32x16_bf16(b1,qr[d0],p1,0,0,0);}}
}
typedef __attribute__((address_space(3))) const char* lds_cptr;
typedef short v4i16_t __attribute__((ext_vector_type(4)));
__device__ __forceinline__ void kload8(bf16x8*kf,lds_cptr kp){
  kf[0]=*(const __attribute__((address_space(3))) bf16x8*)(kp);      kf[1]=*(const __attribute__((address_space(3))) bf16x8*)(kp+512);
  kf[2]=*(const __attribute__((address_space(3))) bf16x8*)(kp+2048); kf[3]=*(const __attribute__((address_space(3))) bf16x8*)(kp+2560);
  kf[4]=*(const __attribute__((address_space(3))) bf16x8*)(kp+4096); kf[5]=*(const __attribute__((address_space(3))) bf16x8*)(kp+4608);
  kf[6]=*(const __attribute__((address_space(3))) bf16x8*)(kp+6144); kf[7]=*(const __attribute__((address_space(3))) bf16x8*)(kp+6656);
}
__device__ __forceinline__ void kload2(bf16x8*kf,lds_cptr kp,int j){ kf[2*j]=*(const __attribute__((address_space(3))) bf16x8*)(kp+j*2048); kf[2*j+1]=*(const __attribute__((address_space(3))) bf16x8*)(kp+j*2048+512); }
__device__ __forceinline__ s16x4 vtr(lds_cptr p){ return __builtin_bit_cast(s16x4,__builtin_amdgcn_ds_read_tr16_b64_v4i16((__attribute__((address_space(3))) v4i16_t*)p)); }
__device__ __forceinline__ float rowmax(const f32x16&p0,const f32x16&p1){
  float a=max3f(p0[0],p0[1],p1[0]),b=max3f(p0[2],p0[3],p1[1]);a=max3f(a,p1[2],p1[3]);
  #pragma unroll
  for(int r=4;r<16;r+=4){a=max3f(a,p0[r],p0[r+1]);b=max3f(b,p0[r+2],p0[r+3]);a=max3f(a,p1[r],p1[r+1]);b=max3f(b,p1[r+2],p1[r+3]);}
  const float m=max2f(a,b);
  auto rr=__builtin_amdgcn_permlane32_swap(__float_as_uint(m),__float_as_uint(m),false,false);
  return max2f(__uint_as_float(rr[0]),__uint_as_float(rr[1]));
}
__device__ __forceinline__ float xhalf_sum(float v){ auto rr=__builtin_amdgcn_permlane32_swap(__float_as_uint(v),__float_as_uint(v),false,false); return __uint_as_float(rr[0])+__uint_as_float(rr[1]); }
__device__ __forceinline__ void pv(f32x16*o,int vb,bf16x8 pa0,bf16x8 pa1,bf16x8 pa2,bf16x8 pa3){
  #pragma unroll
  for(int d0=0;d0<2;++d0){s16x4 lo[4],hi[4];
    #pragma unroll
    for(int ks=0;ks<4;++ks){
      asm volatile("ds_read_b64_tr_b16 %0,%1 offset:%c2":"=&v"(lo[ks]):"v"(vb),"i"(d0*4096+ks*1024):"memory");
      asm volatile("ds_read_b64_tr_b16 %0,%1 offset:%c2":"=&v"(hi[ks]):"v"(vb),"i"(d0*4096+ks*1024+512):"memory");}
    asm volatile("s_waitcnt lgkmcnt(0)":::"memory");SBAR();
    #define PK(k) (bf16x8){lo[k][0],lo[k][1],lo[k][2],lo[k][3],hi[k][0],hi[k][1],hi[k][2],hi[k][3]}
    o[d0]=__builtin_amdgcn_mfma_f32_32x32x16_bf16(pa0,PK(0),o[d0],0,0,0);
    o[d0]=__builtin_amdgcn_mfma_f32_32x32x16_bf16(pa1,PK(1),o[d0],0,0,0);
    o[d0]=__builtin_amdgcn_mfma_f32_32x32x16_bf16(pa2,PK(2),o[d0],0,0,0);
    o[d0]=__builtin_amdgcn_mfma_f32_32x32x16_bf16(pa3,PK(3),o[d0],0,0,0);
    #undef PK
  }
}

template<int THRL> __device__ __forceinline__ void moba_unit(int b,int h,int c,const bf16*Pq,const bf16*__restrict__ Pk,const bf16*__restrict__ Pv,const bf16*Pz,bf16*Po,const float*__restrict__ kmean,char*shm){
  int tid_=threadIdx.x; asm volatile("":"+v"(tid_));
  const int tid=tid_,lane=tid&63,r32=lane&31,hi=lane>>5; const int wid=__builtin_amdgcn_readfirstlane(tid>>6);
  const long rowbase=(long)b*SEQ; const int q0=c*QB;
  const bf16*Qw=Pq+(rowbase+q0+wid*QBLK)*PITCH+h*D;
  const bf16*Kh=Pk+rowbase*PITCH+h*D,*Vh=Pv+rowbase*PITCH+h*D;
  const unsigned lds0=(unsigned)(uintptr_t)shm;
  float*wsf=(float*)(shm+LDS_WS)+wid*64;
  float*kml=(float*)(shm+LDS_KM);
  const int NT=(q0+QB)/KVBLK;
  const bf16*ksrc=Kh+(long)lane*PITCH+wid*8;
  const bf16*vsrc=Vh+(long)(16*(wid&3)+(lane>>2))*PITCH+(wid>>2)*32+(lane&3)*8;
  const unsigned kdst=lds0+LDS_K+wid*1024, vdst=lds0+LDS_V+wid*1024;
  #define DMA_K(t,slot) glds16(ksrc+(long)(NT-1-(t))*KVBLK*PITCH,(unsigned)__builtin_amdgcn_readfirstlane(kdst+(slot)))
  #define DMA_V(t,slot) glds16(vsrc+(long)(NT-1-(t))*KVBLK*PITCH,(unsigned)__builtin_amdgcn_readfirstlane(vdst+(slot)))
  const int vb0=(int)(lds0+LDS_V)+((lane>>4)&1)*32+(lane&3)*8+(4*hi+((lane&15)>>2))*64;
  const char*Kbase=shm+LDS_K; bf16x8 kf[8];
  const lds_cptr shm3=(lds_cptr)shm; const lds_cptr kp0=shm3+LDS_K+hi*1024+r32*16; const lds_cptr vp0=shm3+LDS_V+((lane>>4)&1)*32+(lane&3)*8+(4*hi+((lane&15)>>2))*64;
  #define VS(t) ((((t))&3)*SLOTB)
  DMA_K(0,0);DMA_V(0,VS(0));DMA_K(1,SLOTB);
  bf16x8 qr[4];
  #pragma unroll
  for(int d0=0;d0<4;++d0)qr[d0]=*reinterpret_cast<const bf16x8*>(&Qw[(long)r32*PITCH+d0*16+hi*8]);
  const int qrel=wid*QBLK+r32;
  u32x4 kdg[4];
  { const bf16*Kd=Kh+(long)(q0+qrel)*PITCH;
    #pragma unroll
    for(int d0=0;d0<4;++d0)kdg[d0]=*reinterpret_cast<const u32x4*>(&Kd[d0*16+hi*8]); }
  const float sl2=__uint_as_float(__builtin_amdgcn_readfirstlane(__float_as_uint(__builtin_amdgcn_exp2f(-(float)(h+1))*1.4426950408889634f)));
  unsigned sel=0u;
  if(c>0){
    if(tid<c*64) kml[tid]=kmean[((long)(b*8)+(tid>>6))*512+h*64+(tid&63)];
    asm volatile("s_waitcnt vmcnt(0) lgkmcnt(0)\n\ts_barrier":::"memory");
    if(c<=3) sel=(1u<<c)-1u;
    else{
      float g[8];
      #pragma unroll
      for(int j=0;j<8;++j){ g[j]=-INFINITY;
        if(j<c){ float a=0.f;
          #pragma unroll
          for(int d0=0;d0<4;++d0){ const u32x4 qv=__builtin_bit_cast(u32x4,qr[d0]); const float*km=kml+j*64+d0*16+hi*8;
            const float4 k0=*(const float4*)km, k1=*(const float4*)(km+4);
            a+=bl(qv.x)*k0.x+bh(qv.x)*k0.y+bl(qv.y)*k0.z+bh(qv.y)*k0.w+bl(qv.z)*k1.x+bh(qv.z)*k1.y+bl(qv.w)*k1.z+bh(qv.w)*k1.w; }
          g[j]=xhalf_sum(a); } }
      #pragma unroll
      for(int j=0;j<8;++j){ int rank=0;
        #pragma unroll
        for(int j2=0;j2<8;++j2){ if(j2!=j) rank+=((g[j2]>g[j])||(g[j2]==g[j]&&j2<j))?1:0; }
        if(j<c&&rank<3) sel|=(1u<<j); }
    }
  }
  float mhat;
  { float a=0.f;
    #pragma unroll
    for(int d0=0;d0<4;++d0){ const u32x4 kv=kdg[d0]; const u32x4 qv=__builtin_bit_cast(u32x4,qr[d0]);
      a+=bl(qv.x)*bl(kv.x)+bh(qv.x)*bh(kv.x)+bl(qv.y)*bl(kv.y)+bh(qv.y)*bh(kv.y)+bl(qv.z)*bl(kv.z)+bh(qv.z)*bh(kv.z)+bl(qv.w)*bl(kv.w)+bh(qv.w)*bh(kv.w); }
    mhat=xhalf_sum(a)+sl2*(float)qrel; }
  float l_reg=0.f;f32x16 o[2];o[0]=f32x16{};o[1]=f32x16{};
  f32x16 negm;
  #pragma unroll
  for(int r=0;r<16;++r)negm[r]=sl2*(float)((r&3)+8*(r>>2))-mhat;
  asm volatile("":"+v"(negm));
  #define MBIAS(P0,P1,t) do{ const int T_=NT-1-(t); const int jb_=T_-(NT-4); float a0_=sl2*(float)(64*jb_+4*hi); \
      if(jb_<0){ if(!((sel>>(T_>>2))&1u)) a0_=-INFINITY; } const float a1_=a0_+32.f*sl2; \
      _Pragma("unroll") for(int r=0;r<16;++r){P0[r]+=a0_;P1[r]+=a1_;} \
      if(jb_>=0)cmask(P0,P1,jb_,qrel,hi); }while(0)
  bool resc=false;
  #define RESC() do{ if(resc){ asm volatile("s_waitcnt lgkmcnt(0)":::"memory"); \
      _Pragma("unroll") for(int d_=0;d_<2;++d_) _Pragma("unroll") for(int r=0;r<16;++r)o[d_][r]*=wsf[crow(r,hi)]; } }while(0)
  f32x16 pA0,pA1,pB0,pB1;
  int sl_prev=0,sl_cur=0,sl_next=SLOTB;
  #define ROT() do{sl_prev=sl_cur;sl_cur=sl_next;sl_next=(sl_next==(NSLOT-1)*SLOTB)?0:sl_next+SLOTB;}while(0)
  DMA_K(2,2*SLOTB);DMA_V(1,VS(1));
  WAIT_BAR(2);
  qkt(pA0,pA1,Kbase,qr,negm,r32,hi);asm volatile("s_nop 15\n\ts_nop 7":"+v"(pA0),"+v"(pA1));MBIAS(pA0,pA1,0);
  { const float rm=rowmax(pA0,pA1);
    if(__any(rm>(float)THRL)){ const float dl=__builtin_fmaxf(rm,0.f);
      _Pragma("unroll") for(int r=0;r<16;++r){pA0[r]-=dl;pA1[r]-=dl;negm[r]-=dl;}
      asm volatile("":"+v"(negm)); } }
  _Pragma("unroll") for(int r=0;r<16;++r){pA0[r]=__builtin_amdgcn_exp2f(pA0[r]);pA1[r]=__builtin_amdgcn_exp2f(pA1[r]);}
  WAIT_BAR(2);
  DMA_K(3,0);DMA_V(2,VS(2));
  ROT();
  kload8(kf,kp0+sl_cur);
  WAIT_BAR(3);
  s16x4 vlo[8],vhi[8]; u32x4 pw0,pw1,pw2,pw3;
  #define PKW(P,B) cvtpk_s(P[B],P[B+1])
  #define PAF(k) __builtin_bit_cast(bf16x8,pw##k)
  #define VFR(i) (bf16x8){vlo[i][0],vlo[i][1],vlo[i][2],vlo[i][3],vhi[i][0],vhi[i][1],vhi[i][2],vhi[i][3]}
  #define PIN(x) asm volatile("":"+v"(x))
  #define MX3(a,b,c) __builtin_fmaxf(__builtin_fmaxf((a),(b)),(c))
  #define GAPA(MF,A0,A1,A2,A3,W0,W1,PW) do{ MF; sacc+=A0; sacc+=A1; sacc+=A2; sacc+=A3; PIN(sacc); W0; W1; PIN(PW); SBAR(); }while(0)
  #define EX(v) __builtin_amdgcn_exp2f(v)
  #define GAPB(MF,X,B) do{ MF; X[B]=EX(X[B]); X[B+1]=EX(X[B+1]); X[B+2]=EX(X[B+2]); X[B+3]=EX(X[B+3]); PIN(X); SBAR(); }while(0)
  #define VRD(i) do{ vlo[i]=vtr(vp_+(((i)>>2)*4096+((i)&3)*1024)); vhi[i]=vtr(vp_+(((i)>>2)*4096+((i)&3)*1024+512)); }while(0)
  #define KRD(G,j) do{ if(G){ kload2(kf,kp0+sl_next,j); SBAR(); } }while(0)
  #define STEP(C0,C1,P0,P1,t,GK,GV,GL) do{ SBAR(); \
    const lds_cptr vp_=vp0+VS((t)-1); \
    VRD(0); SBAR(); float sacc=(P0[0]+P0[1]); \
    GAPA(C0=__builtin_amdgcn_mfma_f32_32x32x16_bf16(kf[0],qr[0],negm,0,0,0), P0[2],P0[3],P0[4],P0[5],     pw0[0]=PKW(P0,0), pw0[1]=PKW(P0,2), pw0); \
    VRD(4); SBAR(); GAPA(C1=__builtin_amdgcn_mfma_f32_32x32x16_bf16(kf[1],qr[0],negm,0,0,0), P0[6],P0[7],P0[8],P0[9],     pw0[2]=PKW(P0,4), pw0[3]=PKW(P0,6), pw0); \
    VRD(1); SBAR(); GAPA(C0=__builtin_amdgcn_mfma_f32_32x32x16_bf16(kf[2],qr[1],C0,0,0,0),   P0[10],P0[11],P0[12],P0[13], pw1[0]=PKW(P0,8), pw1[1]=PKW(P0,10), pw1); \
    VRD(5); SBAR(); GAPA(C1=__builtin_amdgcn_mfma_f32_32x32x16_bf16(kf[3],qr[1],C1,0,0,0),   P0[14],P0[15],P1[0],P1[1],   pw1[2]=PKW(P0,12),pw1[3]=PKW(P0,14), pw1); \
    VRD(2); SBAR(); GAPA(C0=__builtin_amdgcn_mfma_f32_32x32x16_bf16(kf[4],qr[2],C0,0,0,0),   P1[2],P1[3],P1[4],P1[5],     pw2[0]=PKW(P1,0), pw2[1]=PKW(P1,2), pw2); \
    VRD(6); SBAR(); GAPA(C1=__builtin_amdgcn_mfma_f32_32x32x16_bf16(kf[5],qr[2],C1,0,0,0),   P1[6],P1[7],P1[8],P1[9],     pw2[2]=PKW(P1,4), pw2[3]=PKW(P1,6), pw2); \
    VRD(3); SBAR(); GAPA(C0=__builtin_amdgcn_mfma_f32_32x32x16_bf16(kf[6],qr[3],C0,0,0,0),   P1[10],P1[11],P1[12],P1[13], pw3[0]=PKW(P1,8), pw3[1]=PKW(P1,10), pw3); \
    VRD(7); SBAR(); GAPA(C1=__builtin_amdgcn_mfma_f32_32x32x16_bf16(kf[7],qr[3],C1,0,0,0),   P1[14],P1[15],0.f,0.f,       pw3[2]=PKW(P1,12),pw3[3]=PKW(P1,14), pw3); \
    l_reg+=sacc; \
    if(GK){DMA_K((t)+3,sl_cur);} if(GV){DMA_V((t)+2,VS((t)+2));} \
    MBIAS(C0,C1,t); \
    { float a=MX3(C0[0],C0[1],C1[0]),b=MX3(C0[2],C0[3],C1[1]); a=MX3(a,C1[2],C1[3]); \
      _Pragma("unroll") for(int r=4;r<16;r+=4){a=MX3(a,C0[r],C0[r+1]);b=MX3(b,C0[r+2],C0[r+3]);a=MX3(a,C1[r],C1[r+1]);b=MX3(b,C1[r+2],C1[r+3]);} \
      float rm=__builtin_fmaxf(a,b); { auto rr=__builtin_amdgcn_permlane32_swap(__float_as_uint(rm),__float_as_uint(rm),false,false); rm=__builtin_fmaxf(__uint_as_float(rr[0]),__uint_as_float(rr[1])); } \
      resc=false; \
      if(__builtin_expect(__any(rm>(float)THRL),0)){ const float dl=__builtin_fmaxf(rm,0.f); \
        _Pragma("unroll") for(int r=0;r<16;++r){C0[r]-=dl;C1[r]-=dl;} \
        _Pragma("unroll") for(int r=0;r<16;++r)negm[r]-=dl; asm volatile("":"+v"(negm)); \
        const float f=__builtin_amdgcn_exp2f(-dl); l_reg*=f; if(hi==0)wsf[r32]=f; resc=true; } } \
    SBAR(); \
    GAPB(o[0]=__builtin_amdgcn_mfma_f32_32x32x16_bf16(PAF(0),VFR(0),o[0],0,0,0), C0,0); \
    GAPB(o[1]=__builtin_amdgcn_mfma_f32_32x32x16_bf16(PAF(0),VFR(4),o[1],0,0,0), C0,4); \
    KRD(GL,0); GAPB(o[0]=__builtin_amdgcn_mfma_f32_32x32x16_bf16(PAF(1),VFR(1),o[0],0,0,0), C0,8); \
    KRD(GL,1); GAPB(o[1]=__builtin_amdgcn_mfma_f32_32x32x16_bf16(PAF(1),VFR(5),o[1],0,0,0), C0,12); \
    KRD(GL,2); GAPB(o[0]=__builtin_amdgcn_mfma_f32_32x32x16_bf16(PAF(2),VFR(2),o[0],0,0,0), C1,0); \
    KRD(GL,3); GAPB(o[1]=__builtin_amdgcn_mfma_f32_32x32x16_bf16(PAF(2),VFR(6),o[1],0,0,0), C1,4); \
    GAPB(o[0]=__builtin_amdgcn_mfma_f32_32x32x16_bf16(PAF(3),VFR(3),o[0],0,0,0), C1,8); \
    GAPB(o[1]=__builtin_amdgcn_mfma_f32_32x32x16_bf16(PAF(3),VFR(7),o[1],0,0,0), C1,12); \
    }while(0)
  int t=1;
  for(;t+5<NT;t+=2){
    STEP(pB0,pB1,pA0,pA1,t,true,true,true);     WAIT_BAR(3); RESC(); ROT();
    STEP(pA0,pA1,pB0,pB1,t+1,true,true,true);   WAIT_BAR(3); RESC(); ROT();
  }
  #define ENDW(tt) do{ if((tt)+3<NT){WAIT_BAR(3);} else if((tt)+2<NT){WAIT_BAR(2);} else {WAIT_BAR(0);} }while(0)
  for(;t+1<NT;t+=2){
    STEP(pB0,pB1,pA0,pA1,t,(t+3<NT),(t+2<NT),(t+1<NT));       ENDW(t);   RESC(); ROT();
    STEP(pA0,pA1,pB0,pB1,t+1,(t+4<NT),(t+3<NT),(t+2<NT));     ENDW(t+1); RESC(); ROT();
  }
  STEP(pB0,pB1,pA0,pA1,NT-1,false,false,false); RESC();
  { float sacc=pB0[0]+pB0[1]; _Pragma("unroll") for(int r=2;r<16;++r)sacc+=pB0[r]; _Pragma("unroll") for(int r=0;r<16;++r)sacc+=pB1[r]; l_reg+=sacc;
    pw0=(u32x4){PKW(pB0,0),PKW(pB0,2),PKW(pB0,4),PKW(pB0,6)};pw1=(u32x4){PKW(pB0,8),PKW(pB0,10),PKW(pB0,12),PKW(pB0,14)};pw2=(u32x4){PKW(pB1,0),PKW(pB1,2),PKW(pB1,4),PKW(pB1,6)};pw3=(u32x4){PKW(pB1,8),PKW(pB1,10),PKW(pB1,12),PKW(pB1,14)};
    SBAR(); pv(o,vb0+VS(NT-1),PAF(0),PAF(1),PAF(2),PAF(3)); }
  #undef PKW
  #undef PAF
  #undef VFR
  #undef PIN
  #undef MX3
  #undef GAPA
  #undef GAPB
  #undef EX
  #undef VRD
  #undef KRD
  #undef STEP
  #undef ENDW
  l_reg=xhalf_sum(l_reg);
  if(hi==0)wsf[32+r32]=l_reg;asm volatile("s_waitcnt lgkmcnt(0)":::"memory");
  float rli[16];
  #pragma unroll
  for(int r=0;r<16;++r)rli[r]=__builtin_amdgcn_rcpf(wsf[32+crow(r,hi)]);
  const bf16*Zw=Pz+(rowbase+q0+wid*QBLK)*PITCH+h*D; bf16*Ow=Po+(rowbase+q0+wid*QBLK)*PITCH+h*D;
  { bf16*stg=(bf16*)(shm+LDS_OST)+wid*2048;
    #pragma unroll
    for(int r=0;r<16;++r){const int orow=crow(r,hi);
      #pragma unroll
      for(int d0=0;d0<2;++d0)((unsigned short*)stg)[orow*64+d0*32+r32]=(unsigned short)cvtpk_s(o[d0][r]*rli[r],0.f);}
    asm volatile("s_waitcnt lgkmcnt(0)":::"memory");
    #pragma unroll
    for(int i=0;i<4;++i){const int row=i*8+(lane>>3),ch=lane&7; const u32x4 v=*(const u32x4*)(stg+row*64+ch*8);
      const u32x4 z=__builtin_nontemporal_load((const u32x4*)(Zw+(long)row*PITCH+ch*8)); u32x4*zp=(u32x4*)(Ow+(long)row*PITCH+ch*8); u32x4 w;
      w.x=cvtpk_s(bl(v.x)*bl(z.x),bh(v.x)*bh(z.x)); w.y=cvtpk_s(bl(v.y)*bl(z.y),bh(v.y)*bh(z.y)); w.z=cvtpk_s(bl(v.z)*bl(z.z),bh(v.z)*bh(z.z)); w.w=cvtpk_s(bl(v.w)*bl(z.w),bh(v.w)*bh(z.w));
      *zp=w; } }
  asm volatile("s_waitcnt lgkmcnt(0)\n\ts_barrier":::"memory");
  #undef DMA_K
  #undef DMA_V
  #undef VS
  #undef MBIAS
  #undef RESC
  #undef ROT
}
constexpr int ATTN_LDS_BYTES=LDS_BYTES;
#undef SBAR
#undef WAIT_BAR
}
namespace attna {
using moba::bf16; using moba::bf16x8; using moba::s16x4; using moba::f32x16; using moba::u32x4; using moba::lds_cptr;
using moba::crow; using moba::cvtpk_s; using moba::bl; using moba::bh; using moba::vtr; using moba::xhalf_sum;
constexpr int SEQ=2048,PITCH=4608;
constexpr int WK=0,WV=4608,WO=12800,WSC=16896,WBYTES=17152,LSE_OFF=8*WBYTES,LDS_BYTES=LSE_OFF+3*512*4;
#define AMFMA(a,b,c) __builtin_amdgcn_mfma_f32_32x32x16_bf16(a,b,c,0,0,0)

__device__ __forceinline__ void sub_item(bf16*P,int b,int hs,int g,int res,int l0,int chunk,char*wl,float*lse_l,int lane){
  asm volatile("":"+v"(lane));
  const int r32=lane&31,hi=lane>>5;
  const int dsh=2*g;
  const long rowb=(long)b*SEQ+res;
  const int qcol=g*768+hs*64;
  const float sl2=__builtin_amdgcn_exp2f(-(2.0f/3.0f)*(float)(4*g+hs+1))*(float)(1<<dsh)*1.4426950408889634f;
  #define AROW(l) ((rowb+((long)(l)<<dsh))*PITCH)
  #define KL(i,x) ((l0-128+32*(i)+(x))<0?0:(l0-128+32*(i)+(x)))
  const int i0=(l0>=128)?0:(4-(l0>>5));
  const int lrow=lane>>3, lch=lane&7;
  u32x4 qg[4],kg[5][4],vg[5][4];
  #pragma unroll
  for(int j=0;j<4;++j)qg[j]=*reinterpret_cast<const u32x4*>(P+AROW(l0+lrow+8*j)+qcol+lch*8);
  #pragma unroll
  for(int i=4;i>=0;--i)
    #pragma unroll
    for(int j=0;j<4;++j)kg[i][j]=*reinterpret_cast<const u32x4*>(P+AROW(KL(i,lrow+8*j))+qcol+256+lch*8);
  #pragma unroll
  for(int i=4;i>=0;--i)
    #pragma unroll
    for(int j=0;j<4;++j)vg[i][j]=*reinterpret_cast<const u32x4*>(P+AROW(KL(i,lrow+8*j))+qcol+512+lch*8);
  __builtin_amdgcn_sched_barrier(0);
  char*kb=wl+WK; const int kwoff=lrow*144+lch*16, kroff=r32*144+hi*16;
  bf16x8 qf[4];
  #pragma unroll
  for(int j=0;j<4;++j)*reinterpret_cast<u32x4*>(kb+kwoff+j*8*144)=qg[j];
  #pragma unroll
  for(int d0=0;d0<4;++d0)qf[d0]=*reinterpret_cast<const bf16x8*>(kb+kroff+d0*32);
  f32x16 S[5];
  #pragma unroll
  for(int i=4;i>=0;--i){
    #pragma unroll
    for(int j=0;j<4;++j)*reinterpret_cast<u32x4*>(kb+kwoff+j*8*144)=kg[i][j];
    bf16x8 kf[4];
    #pragma unroll
    for(int d0=0;d0<4;++d0)kf[d0]=*reinterpret_cast<const bf16x8*>(kb+kroff+d0*32);
    f32x16 acc=f32x16{};
    #pragma unroll
    for(int d0=0;d0<4;++d0)acc=AMFMA(kf[d0],qf[d0],acc);
    const float sbi=((i<i0)?-INFINITY:0.f)-sl2*(float)(32*(4-i)+r32-4*hi);
    #pragma unroll
    for(int r=0;r<16;++r){ const int kc=(r&3)+8*(r>>2); float v=__builtin_fmaf(sl2,(float)kc,acc[r]+sbi);
      if(i==4&&kc+4*hi>r32)v=-INFINITY; if(i==0&&kc+4*hi<r32)v=-INFINITY; acc[r]=v; }
    S[i]=acc;
  }
  float mx=-INFINITY;
  #pragma unroll
  for(int i=0;i<5;++i)
    #pragma unroll
    for(int r=0;r<16;++r)mx=fmaxf(mx,S[i][r]);
  { auto rr=__builtin_amdgcn_permlane32_swap(__float_as_uint(mx),__float_as_uint(mx),false,false); mx=fmaxf(__uint_as_float(rr[0]),__uint_as_float(rr[1])); }
  float ls=0.f;
  #pragma unroll
  for(int i=0;i<5;++i)
    #pragma unroll
    for(int r=0;r<16;++r){ const float p=__builtin_amdgcn_exp2f(S[i][r]-mx); S[i][r]=p; ls+=p; }
  ls=xhalf_sum(ls);
  f32x16 o[2]; o[0]=f32x16{}; o[1]=f32x16{};
  const lds_cptr wl3=(lds_cptr)wl;
  const int vtoff=((lane>>4)&1)*32+(lane&3)*8+(4*hi+((lane&15)>>2))*64;
  const int vwoff=(lch>>2)*2048+lrow*64+(lch&3)*16;
  #define PVSTEP(i) do{ char*vb_=wl+WV+((i)&1)*4096; \
      _Pragma("unroll") for(int j=0;j<4;++j)*reinterpret_cast<u32x4*>(vb_+vwoff+j*8*64)=vg[i][j]; \
      const u32x4 pw0=(u32x4){cvtpk_s(S[i][0],S[i][1]),cvtpk_s(S[i][2],S[i][3]),cvtpk_s(S[i][4],S[i][5]),cvtpk_s(S[i][6],S[i][7])}; \
      const u32x4 pw1=(u32x4){cvtpk_s(S[i][8],S[i][9]),cvtpk_s(S[i][10],S[i][11]),cvtpk_s(S[i][12],S[i][13]),cvtpk_s(S[i][14],S[i][15])}; \
      const lds_cptr vp=wl3+WV+((i)&1)*4096+vtoff; \
      _Pragma("unroll") for(int d0=0;d0<2;++d0){ \
        const s16x4 a0=vtr(vp+d0*2048),a1=vtr(vp+d0*2048+512),b0=vtr(vp+d0*2048+1024),b1=vtr(vp+d0*2048+1536); \
        const bf16x8 f0=(bf16x8){a0[0],a0[1],a0[2],a0[3],a1[0],a1[1],a1[2],a1[3]}, f1=(bf16x8){b0[0],b0[1],b0[2],b0[3],b1[0],b1[1],b1[2],b1[3]}; \
        o[d0]=AMFMA(__builtin_bit_cast(bf16x8,pw0),f0,o[d0]); \
        o[d0]=AMFMA(__builtin_bit_cast(bf16x8,pw1),f1,o[d0]); } }while(0)
  PVSTEP(4); PVSTEP(3); PVSTEP(2); PVSTEP(1); PVSTEP(0);
  float*ws=(float*)(wl+WSC);
  const int tokc=((l0+r32)<<dsh)+res-chunk*512;
  if(hi==0){ ws[r32]=__builtin_amdgcn_rcpf(ls); lse_l[g*512+tokc]=mx+__builtin_amdgcn_logf(ls); }
  bf16*stg=(bf16*)(wl+WO);
  #pragma unroll
  for(int r=0;r<16;++r){ const int orow=crow(r,hi); const float il=ws[orow];
    #pragma unroll
    for(int d0=0;d0<2;++d0)((unsigned short*)stg)[orow*64+d0*32+r32]=(unsigned short)cvtpk_s(o[d0][r]*il,0.f); }
  #pragma unroll
  for(int i=0;i<4;++i){ const int row=i*8+(lane>>3),ch=lane&7; const u32x4 v=*reinterpret_cast<const u32x4*>(stg+row*64+ch*8);
    *reinterpret_cast<u32x4*>(P+AROW(l0+row)+qcol+ch*8)=v; }
  #undef AROW
  #undef KL
  #undef PVSTEP
}

__device__ __forceinline__ void wg_item(bf16*P,int b,int hs,int chunk,char*shm){
  int tid_=threadIdx.x; asm volatile("":"+v"(tid_));
  const int tid=tid_,lane=tid&63; const int wid=__builtin_amdgcn_readfirstlane(tid>>6);
  char*wl=shm+wid*WBYTES; float*lse_l=(float*)(shm+LSE_OFF);
  #pragma unroll 1
  for(int i6=0;i6<6;++i6){
    const int si=wid+8*i6, g=si>>4, k=si&15;
    int res,l0;
    if(g==0){res=0;l0=32*(chunk*16+k);} else if(g==1){res=k>>2;l0=128*chunk+32*(k&3);} else {res=k;l0=32*chunk;}
    sub_item(P,b,hs,g,res,l0,chunk,wl,lse_l,lane);
  }
  __syncthreads();
  #pragma unroll
  for(int idx=tid;idx<512*8;idx+=512){
    const int tok=idx>>3,ch=idx&7; const long row=((long)b*SEQ+chunk*512+tok)*PITCH;
    const float e0=lse_l[tok],e1=lse_l[512+tok],e2=lse_l[1024+tok]; const float em=fmaxf(e0,fmaxf(e1,e2));
    float w0=__builtin_amdgcn_exp2f(e0-em),w1=__builtin_amdgcn_exp2f(e1-em),w2=__builtin_amdgcn_exp2f(e2-em); const float iw=__builtin_amdgcn_rcpf(w0+w1+w2); w0*=iw;w1*=iw;w2*=iw;
    const u32x4 a=*reinterpret_cast<const u32x4*>(P+row+hs*64+ch*8), bq=*reinterpret_cast<const u32x4*>(P+row+768+hs*64+ch*8), cq=*reinterpret_cast<const u32x4*>(P+row+1536+hs*64+ch*8);
    u32x4*zp=reinterpret_cast<u32x4*>(P+row+2304+hs*64+ch*8); const u32x4 z=__builtin_nontemporal_load(zp); u32x4 w;
    #define CMB(f) cvtpk_s((w0*bl(a.f)+w1*bl(bq.f)+w2*bl(cq.f))*bl(z.f),(w0*bh(a.f)+w1*bh(bq.f)+w2*bh(cq.f))*bh(z.f))
    w.x=CMB(x); w.y=CMB(y); w.z=CMB(z); w.w=CMB(w);
    #undef CMB
    *zp=w;
  }
  __syncthreads();
}
#undef AMFMA
}

constexpr int NWAVES = 8;
constexpr int BATCH = 16, SEQ = 2048, DM = 1024, M = BATCH * SEQ, DEPTH = 2;
constexpr int INC = 6656;
constexpr int LDP = 4608;
constexpr int C_AQKV = 0, C_ZA = 2304, C_BQKV = 2560, C_ZB = 4096, C_RA = 4608, C_RB = 5632;
constexpr int C_MERGED = 0;
constexpr float RMS_EPS = 1e-6f;
constexpr size_t MiB = 1u << 20;
constexpr size_t WS_CTL = 0;
constexpr size_t WS_BAR = 0, WS_BAR_BYTES = 64 * 1024;
constexpr size_t WS_KMEAN = 256 * 1024;
constexpr size_t WS_WIN = 1 * MiB;
constexpr size_t WS_WCAT = 14 * MiB;
constexpr size_t WS_WOUT = 17 * MiB;
constexpr size_t WS_XB = 21 * MiB;
constexpr size_t WS_PROJ = 85 * MiB;
constexpr size_t WS_GATES = 373 * MiB;
constexpr size_t WS_WIN1 = 437 * MiB;
constexpr size_t WS_ROWSS = 450 * MiB;
constexpr size_t WS_XB8 = 454 * MiB;
constexpr size_t WS_W8 = 486 * MiB;
constexpr size_t WS_COLMAX = 32 * 1024;
constexpr size_t WS_XSCALE = 128 * 1024;
constexpr size_t WS_END = 490 * MiB;
static_assert(WS_PROJ + (size_t)M * LDP * 2 == WS_GATES && WS_GATES + (size_t)M * 2048 == WS_WIN1, "ws map");
constexpr int LDS_MISC = pg8::EPI_OFF + 8 * pg8::EPI_WAVE;
constexpr int LDS_RSTAB = LDS_MISC + 256;
constexpr int LDS_BYTES = LDS_RSTAB + 1024 + 64;

#define LAS __attribute__((address_space(3)))
typedef unsigned short bf16;
typedef unsigned v4u __attribute__((ext_vector_type(4)));
typedef float f32x4 __attribute__((ext_vector_type(4)));
#define RLX_AGENT __ATOMIC_RELAXED, __HIP_MEMORY_SCOPE_AGENT
#define XB_TMO      128
#define XB_XCNT(j)  (256  + 64 * (j))
#define XB_XSUB(j)  (1280 + 64 * (j))
#define XB_XGEN(j)  (2304 + 64 * (j))
#define XB_TOP      3328
#define XB_TOPGEN   3392
#define XCD_BAR_WORDS 3456
#define XB_SPIN_CAP (1u << 18)

__device__ __forceinline__ unsigned xb_ld(unsigned* p)              { return __hip_atomic_load(p, __ATOMIC_RELAXED, __HIP_MEMORY_SCOPE_AGENT); }
__device__ __forceinline__ unsigned xb_add(unsigned* p, unsigned v) { return __hip_atomic_fetch_add(p, v, __ATOMIC_RELAXED, __HIP_MEMORY_SCOPE_AGENT); }
__device__ __forceinline__ unsigned xb_xcc_id() { return (unsigned)__builtin_amdgcn_s_getreg((3 << 11) | 20) & 0xFu; }
#define XB_SPIN(cond, bar) do { unsigned _sp = 0; while (cond) { __builtin_amdgcn_s_sleep(1); \
    if ((++_sp & 255u) == 0u) { if (xb_ld(&(bar)[XB_TMO])) break; if (_sp > XB_SPIN_CAP) { atomicAdd(&(bar)[XB_TMO], 1u); break; } } } } while (0)

struct XcdBarrier {
    unsigned* bar; unsigned x;
    volatile LAS unsigned* st;
};

__device__ __forceinline__ XcdBarrier xcd_barrier_post(unsigned* bar, volatile LAS unsigned* st) {
    XcdBarrier b; b.bar = bar; b.x = xb_xcc_id(); b.st = st;
    if (threadIdx.x == 0) (void)xb_add(&bar[XB_XCNT(b.x)], 1u);
    return b;
}
__device__ __forceinline__ void xcd_barrier_complete(unsigned* bar, unsigned x, unsigned& nloc, unsigned& nx) {
    const unsigned G = gridDim.x * gridDim.y * gridDim.z;
    unsigned sum, cnt, mine, sp = 0u;
    for (;;) {
        sum = 0u; cnt = 0u; mine = 0u;
#pragma unroll
        for (unsigned j = 0; j < 16; ++j) { const unsigned c = xb_ld(&bar[XB_XCNT(j)]); sum += c; cnt += (c > 0u) ? 1u : 0u; mine = (j == x) ? c : mine; }
        if (sum == G) break;
        __builtin_amdgcn_s_sleep(1);
        if ((++sp & 255u) == 0u) { if (xb_ld(&bar[XB_TMO])) break; if (sp > XB_SPIN_CAP) { atomicAdd(&bar[XB_TMO], 1u); break; } }
    }
    nloc = mine > 0u ? mine : 1u; nx = cnt > 0u ? cnt : 1u;
}

__device__ __forceinline__ void xcd_barrier(const XcdBarrier& b) {
    asm volatile("s_waitcnt vmcnt(0)" ::: "memory");
    __syncthreads();
    if (threadIdx.x == 0) {
        unsigned* bar = b.bar;
        __builtin_amdgcn_s_waitcnt(0);
        unsigned nloc = b.st[0], nx = b.st[1];
        if (nloc == 0u) { xcd_barrier_complete(bar, b.x, nloc, nx); b.st[0] = nloc; b.st[1] = nx; }
        const unsigned old = xb_add(&bar[XB_XSUB(b.x)], 1u);
        const unsigned gen = old / nloc;
        if (old + 1u == (gen + 1u) * nloc) {
            __builtin_amdgcn_fence(__ATOMIC_RELEASE, "agent");
            asm volatile("s_waitcnt vmcnt(0)" ::: "memory");
            const unsigned og = xb_add(&bar[XB_TOP], 1u);
            const unsigned tg = og / nx;
            if (og + 1u == (tg + 1u) * nx) xb_add(&bar[XB_TOPGEN], 1u);
            else XB_SPIN(xb_ld(&bar[XB_TOPGEN]) == tg, bar);
            __builtin_amdgcn_fence(__ATOMIC_ACQUIRE, "agent");
            xb_add(&bar[XB_XGEN(b.x)], 1u);
            asm volatile("s_waitcnt vmcnt(0)" ::: "memory");
        } else {
            XB_SPIN(xb_ld(&bar[XB_XGEN(b.x)]) == gen, bar);
            __builtin_amdgcn_fence(__ATOMIC_ACQUIRE, "agent");
            asm volatile("s_waitcnt vmcnt(0)" ::: "memory");
        }
    }
    __syncthreads();
}

__device__ __forceinline__ unsigned f2bf(float f) { unsigned u = __builtin_bit_cast(unsigned, f); return (u + 0x7fffu + ((u >> 16) & 1u)) >> 16; }
__device__ __forceinline__ unsigned pk2(float lo, float hi) { return f2bf(lo) | (f2bf(hi) << 16); }
__device__ __forceinline__ float bf2f(bf16 v) { return __uint_as_float(((unsigned)v) << 16); }
__device__ __forceinline__ float blo(unsigned u) { return __uint_as_float(u << 16); }
__device__ __forceinline__ float bhi(unsigned u) { return __uint_as_float(u & 0xffff0000u); }
__device__ __forceinline__ float wave_sum(float v) {
#pragma unroll
    for (int o = 1; o < 64; o <<= 1) v += __shfl_xor(v, o);
    return v;
}
__device__ __forceinline__ float wave_max(float v) {
#pragma unroll
    for (int o = 1; o < 64; o <<= 1) v = fmaxf(v, __shfl_xor(v, o));
    return v;
}
__device__ __forceinline__ void transpose_item(const float* W, int K, int N, bf16* WT, int ldw, LAS float* scr, int item, int lane, const float* gain = nullptr) {
    const int nblk = N / 32, kb = item / nblk, nb = item % nblk, k0 = 64 * kb, n0 = 32 * nb;
    f32x4 v[8]; float gk[8];
#pragma unroll
    for (int i = 0; i < 8; ++i) { const int kk = 8 * i + (lane >> 3); v[i] = __builtin_nontemporal_load((const f32x4*)(W + (size_t)(k0 + kk) * N + n0 + 4 * (lane & 7))); gk[i] = gain ? gain[k0 + kk] : 1.0f; }
#pragma unroll
    for (int i = 0; i < 8; ++i) { const int kk = 8 * i + (lane >> 3); LAS float* d = scr + kk * 33 + 4 * (lane & 7); d[0] = v[i].x * gk[i]; d[1] = v[i].y * gk[i]; d[2] = v[i].z * gk[i]; d[3] = v[i].w * gk[i]; }
    asm volatile("s_waitcnt lgkmcnt(0)" ::: "memory");
    const int c = lane & 7;
#pragma unroll
    for (int j = 0; j < 4; ++j) { const int n = (lane >> 3) + 8 * j; const LAS float* s = scr + (8 * c) * 33 + n;
        v4u o; o.x = pk2(s[0 * 33], s[1 * 33]); o.y = pk2(s[2 * 33], s[3 * 33]); o.z = pk2(s[4 * 33], s[5 * 33]); o.w = pk2(s[6 * 33], s[7 * 33]);
        *(v4u*)(WT + (size_t)(n0 + n) * ldw + k0 + 8 * c) = o; }
    asm volatile("s_waitcnt lgkmcnt(0)" ::: "memory");
}
template <bool OUT_BF16> __device__ __forceinline__ void rms_row(const float* xrow, const float* g, void* orow, int lane) {
    const f32x4* xr = (const f32x4*)xrow + lane; const f32x4* gr = (const f32x4*)g + lane;
    f32x4 v[4]; float s = 0.f;
#pragma unroll
    for (int j = 0; j < 4; ++j) { v[j] = xr[64 * j]; s += (v[j].x * v[j].x + v[j].y * v[j].y) + (v[j].z * v[j].z + v[j].w * v[j].w); }
    const float rstd = 1.0f / sqrtf(wave_sum(s) * (1.f / DM) + RMS_EPS);
#pragma unroll
    for (int j = 0; j < 4; ++j) { const f32x4 gg = gr[64 * j]; v[j] = v[j] * rstd * gg; }
    if (OUT_BF16) { unsigned long long* o8 = (unsigned long long*)orow + lane;
#pragma unroll
        for (int j = 0; j < 4; ++j) o8[64 * j] = (unsigned long long)pk2(v[j].x, v[j].y) | ((unsigned long long)pk2(v[j].z, v[j].w) << 32);
    } else { f32x4* o = (f32x4*)orow + lane;
#pragma unroll
        for (int j = 0; j < 4; ++j) o[64 * j] = v[j]; }
}
__device__ __forceinline__ unsigned pack_i8x4(float a, float b, float c, float d) {
    const int ia = (int)__builtin_rintf(fminf(fmaxf(a, -127.f), 127.f)), ib = (int)__builtin_rintf(fminf(fmaxf(b, -127.f), 127.f)), ic = (int)__builtin_rintf(fminf(fmaxf(c, -127.f), 127.f)), id = (int)__builtin_rintf(fminf(fmaxf(d, -127.f), 127.f));
    return (unsigned)(ia & 255) | ((unsigned)(ib & 255) << 8) | ((unsigned)(ic & 255) << 16) | ((unsigned)(id & 255) << 24);
}
__device__ __forceinline__ void raw_row(const float* xrow, bf16* orow, float* ss, signed char* o8row, float* xs, int lane) {
    const f32x4* xr = (const f32x4*)xrow + lane; f32x4 v[4]; float s = 0.f, mx = 0.f;
#pragma unroll
    for (int j = 0; j < 4; ++j) { v[j] = __builtin_nontemporal_load(xr + 64 * j); s += (v[j].x * v[j].x + v[j].y * v[j].y) + (v[j].z * v[j].z + v[j].w * v[j].w);
        mx = fmaxf(mx, fmaxf(fmaxf(fabsf(v[j].x), fabsf(v[j].y)), fmaxf(fabsf(v[j].z), fabsf(v[j].w)))); }
    s = wave_sum(s); if (lane < 16) ss[lane] = (lane == 0) ? s : 0.f;
    mx = wave_max(mx); const float sc = mx > 0.f ? mx * (1.0f / 127.0f) : 1.0f, isc = 1.0f / sc; if (lane == 0) *xs = sc;
    unsigned long long* o8 = (unsigned long long*)orow + lane; unsigned* q8 = (unsigned*)o8row + lane;
#pragma unroll
    for (int j = 0; j < 4; ++j) { o8[64 * j] = (unsigned long long)pk2(v[j].x, v[j].y) | ((unsigned long long)pk2(v[j].z, v[j].w) << 32);
        q8[64 * j] = pack_i8x4(v[j].x * isc, v[j].y * isc, v[j].z * isc, v[j].w * isc); }
}
__device__ __forceinline__ void quant_row(const bf16* xrow, signed char* o8row, float* xs, int lane) {
    typedef unsigned u32x2_t __attribute__((ext_vector_type(2)));
    const u32x2_t* xr = (const u32x2_t*)xrow + lane; u32x2_t b[4]; float mx = 0.f;
#pragma unroll
    for (int j = 0; j < 4; ++j) { b[j] = xr[64 * j]; mx = fmaxf(mx, fmaxf(fmaxf(fabsf(blo(b[j].x)), fabsf(bhi(b[j].x))), fmaxf(fabsf(blo(b[j].y)), fabsf(bhi(b[j].y))))); }
    mx = wave_max(mx); const float sc = mx > 0.f ? mx * (1.0f / 127.0f) : 1.0f, isc = 1.0f / sc; if (lane == 0) *xs = sc;
    unsigned* q8 = (unsigned*)o8row + lane;
#pragma unroll
    for (int j = 0; j < 4; ++j) q8[64 * j] = pack_i8x4(blo(b[j].x) * isc, bhi(b[j].x) * isc, blo(b[j].y) * isc, bhi(b[j].y) * isc);
}
__device__ __forceinline__ void colmax_item(const float* W, const float* gain, unsigned* cmax, int item, int lane) {
    const int kb = item / 64, nb = item % 64, k0 = 64 * kb, n0 = 32 * nb; f32x4 m4 = (f32x4){0.f, 0.f, 0.f, 0.f};
#pragma unroll
    for (int i = 0; i < 8; ++i) { const int kk = 8 * i + (lane >> 3); const f32x4 v = __builtin_nontemporal_load((const f32x4*)(W + (size_t)(k0 + kk) * INC + 4608 + n0 + 4 * (lane & 7))); const float gk = gain[k0 + kk];
        m4.x = fmaxf(m4.x, fabsf(v.x * gk)); m4.y = fmaxf(m4.y, fabsf(v.y * gk)); m4.z = fmaxf(m4.z, fabsf(v.z * gk)); m4.w = fmaxf(m4.w, fabsf(v.w * gk)); }
#pragma unroll
    for (int o = 8; o < 64; o <<= 1) { m4.x = fmaxf(m4.x, __shfl_xor(m4.x, o)); m4.y = fmaxf(m4.y, __shfl_xor(m4.y, o)); m4.z = fmaxf(m4.z, __shfl_xor(m4.z, o)); m4.w = fmaxf(m4.w, __shfl_xor(m4.w, o)); }
    if (lane < 8) { unsigned* c = cmax + n0 + 4 * lane; atomicMax(c, __float_as_uint(m4.x)); atomicMax(c + 1, __float_as_uint(m4.y)); atomicMax(c + 2, __float_as_uint(m4.z)); atomicMax(c + 3, __float_as_uint(m4.w)); }
}
__device__ __forceinline__ void quant_w_item(const float* W, const float* gain, const unsigned* cmax, signed char* W8, float* wscale, LAS float* scr, int item, int lane) {
    const int kb = item / 64, nb = item % 64, k0 = 64 * kb, n0 = 32 * nb;
    f32x4 v[8]; float gk[8];
#pragma unroll
    for (int i = 0; i < 8; ++i) { const int kk = 8 * i + (lane >> 3); v[i] = __builtin_nontemporal_load((const f32x4*)(W + (size_t)(k0 + kk) * INC + 4608 + n0 + 4 * (lane & 7))); gk[i] = gain[k0 + kk]; }
#pragma unroll
    for (int i = 0; i < 8; ++i) { const int kk = 8 * i + (lane >> 3); LAS float* d = scr + kk * 33 + 4 * (lane & 7); d[0] = v[i].x * gk[i]; d[1] = v[i].y * gk[i]; d[2] = v[i].z * gk[i]; d[3] = v[i].w * gk[i]; }
    asm volatile("s_waitcnt lgkmcnt(0)" ::: "memory");
    const int n = lane & 31, kh = lane >> 5; const float cm = __uint_as_float(cmax[n0 + n]); const float sc = cm > 0.f ? cm * (1.0f / 127.0f) : 1.0f, isc = 1.0f / sc;
    if (kb == 0 && kh == 0) wscale[n0 + n] = sc;
    const LAS float* s = scr + (32 * kh) * 33 + n; v4u o0, o1;
    o0.x = pack_i8x4(s[0 * 33] * isc, s[1 * 33] * isc, s[2 * 33] * isc, s[3 * 33] * isc); o0.y = pack_i8x4(s[4 * 33] * isc, s[5 * 33] * isc, s[6 * 33] * isc, s[7 * 33] * isc);
    o0.z = pack_i8x4(s[8 * 33] * isc, s[9 * 33] * isc, s[10 * 33] * isc, s[11 * 33] * isc); o0.w = pack_i8x4(s[12 * 33] * isc, s[13 * 33] * isc, s[14 * 33] * isc, s[15 * 33] * isc);
    o1.x = pack_i8x4(s[16 * 33] * isc, s[17 * 33] * isc, s[18 * 33] * isc, s[19 * 33] * isc); o1.y = pack_i8x4(s[20 * 33] * isc, s[21 * 33] * isc, s[22 * 33] * isc, s[23 * 33] * isc);
    o1.z = pack_i8x4(s[24 * 33] * isc, s[25 * 33] * isc, s[26 * 33] * isc, s[27 * 33] * isc); o1.w = pack_i8x4(s[28 * 33] * isc, s[29 * 33] * isc, s[30 * 33] * isc, s[31 * 33] * isc);
    v4u* dst = (v4u*)(W8 + (size_t)(n0 + n) * 1024 + k0 + 32 * kh); dst[0] = o0; dst[1] = o1;
    asm volatile("s_waitcnt lgkmcnt(0)" ::: "memory");
}
__device__ __forceinline__ float dot64(const v4u (&q)[8], const bf16* krow) {
    const v4u* kp = (const v4u*)krow; float a0 = 0.f, a1 = 0.f;
#pragma unroll
    for (int i = 0; i < 8; ++i) { const v4u k = kp[i];
        a0 += blo(q[i].x) * blo(k.x) + blo(q[i].y) * blo(k.y) + blo(q[i].z) * blo(k.z) + blo(q[i].w) * blo(k.w);
        a1 += bhi(q[i].x) * bhi(k.x) + bhi(q[i].y) * bhi(k.y) + bhi(q[i].z) * bhi(k.z) + bhi(q[i].w) * bhi(k.w); }
    return a0 + a1;
}

struct Args { const float* x; const float* norm_g; const float* w_in; const float* b_merge; const float* w_pa; const float* w_pb; const float* w_out; const float* final_g;
              float* out; unsigned char* ws; };

#define PHASE_VARS() \
    int tid_ = threadIdx.x; asm volatile("" : "+v"(tid_)); \
    const int lane = tid_ & 63, wave = __builtin_amdgcn_readfirstlane(tid_ >> 6); \
    const int G = gridDim.x, gw = blockIdx.x * NWAVES + wave, NGW = G * NWAVES; \
    unsigned long long wsb_ = (unsigned long long)a.ws; asm volatile("" : "+s"(wsb_)); \
    unsigned char* const ws = (unsigned char*)(__attribute__((address_space(1))) unsigned char*)wsb_;     \
    bf16* const Win = (bf16*)(ws + (layer == 0 ? WS_WIN : WS_WIN1)); float* const rowss = (float*)(ws + WS_ROWSS); signed char* const XB8 = (signed char*)(ws + WS_XB8); signed char* const W8 = (signed char*)(ws + WS_W8); unsigned* const colmax = (unsigned*)(ws + WS_COLMAX); float* const xscale = (float*)(ws + WS_XSCALE); bf16* const Wcat = (bf16*)(ws + WS_WCAT); bf16* const Wout = (bf16*)(ws + WS_WOUT); \
    bf16* const XB = (bf16*)(ws + WS_XB); bf16* const P = (bf16*)(ws + WS_PROJ); float* const kmean = (float*)(ws + WS_KMEAN); unsigned char* const gatesb = ws + WS_GATES; \
    (void)lane; (void)wave; (void)G; (void)gw; (void)NGW; (void)Win; (void)Wcat; (void)Wout; (void)rowss; (void)XB8; (void)W8; (void)colmax; (void)xscale; (void)XB; (void)P; (void)kmean; (void)gatesb;

#define GRID_BAR() do { unsigned long long wb_ = (unsigned long long)a.ws; asm volatile("" : "+s"(wb_)); XcdBarrier bb_; bb_.bar = (unsigned*)(__attribute__((address_space(1))) unsigned*)wb_; \
    bb_.x = xb_xcc_id(); bb_.st = (volatile LAS unsigned*)(L + LDS_MISC); xcd_barrier(bb_); } while (0)
template <int layer> __device__ __forceinline__ void layer_fwd(const Args& a, unsigned char* lds, LAS unsigned char* L) {
    if (layer == 0) {
        PHASE_VARS();
        LAS float* scr = (LAS float*)(L + wave * 16384);
        constexpr int I_IN = (DM / 64) * (4608 / 32), I_PA = (256 / 64) * (DM / 32), I_PB = (512 / 64) * (DM / 32), I_OUT = (DM / 64) * (DM / 32);
        const int nitems = 2 * (I_IN + I_PA + I_PB + I_OUT);
        for (int it = gw; it < nitems; it += NGW) {
            const int l2 = it / (I_IN + I_PA + I_PB + I_OUT); int r = it - l2 * (I_IN + I_PA + I_PB + I_OUT);
            if (r < I_IN) { const int kb_ = r / (4608 / 32), nb_ = r % (4608 / 32); transpose_item(a.w_in + (size_t)l2 * DM * INC, DM, INC, (bf16*)(ws + (l2 == 0 ? WS_WIN : WS_WIN1)), DM, scr, kb_ * (INC / 32) + nb_, lane, a.norm_g + l2 * DM); continue; } r -= I_IN;
            if (r < I_PA) { transpose_item(a.w_pa + (size_t)l2 * 256 * DM, 256, DM, Wcat + (size_t)l2 * DM * 768, 768, scr, r, lane); continue; } r -= I_PA;
            if (r < I_PB) { transpose_item(a.w_pb + (size_t)l2 * 512 * DM, 512, DM, Wcat + (size_t)l2 * DM * 768 + 256, 768, scr, r, lane); continue; } r -= I_PB;
            transpose_item(a.w_out + (size_t)l2 * DM * DM, DM, DM, Wout + (size_t)l2 * DM * DM, DM, scr, r, lane);
        }
        for (int i = gw * 64 + lane; i < 2 * 128 * 512; i += NGW * 64) kmean[i] = 0.f;
        for (int it = gw; it < 2 * 16 * 64; it += NGW) colmax_item(a.w_in + (size_t)(it >> 10) * DM * INC, a.norm_g + (it >> 10) * DM, colmax + (it >> 10) * 2048, it & 1023, lane);
        for (int m = gw; m < M; m += NGW) raw_row(a.x + (size_t)m * DM, XB + (size_t)m * DM, rowss + (size_t)m * 16, XB8 + (size_t)m * DM, xscale + m, lane);
    }
    if (layer == 0) GRID_BAR();
    {
        PHASE_VARS();
        if (threadIdx.x == 0) ((LAS int*)(L + LDS_RSTAB))[256] = -1;
        __syncthreads();
        pg8::Gemm g{XB, Win, M, 4608, DM, DM}; pg8::StaticOrder S; S.init(M, 4608, G, (int)blockIdx.x);
        pg8::EpiProj E{P, LDP, kmean + layer * 128 * 512, rowss + (size_t)layer * M * 16};
        pg8::gemm_phase<pg8::EpiProj, pg8::StaticOrder, true, true>(L, g, S, E);
    }
    GRID_BAR();
    {
        PHASE_VARS();
        if (layer == 0) { LAS float* scr = (LAS float*)(L + wave * 16384);
            for (int it = gw; it < 2 * 16 * 64; it += NGW) quant_w_item(a.w_in + (size_t)(it >> 10) * DM * INC, a.norm_g + (it >> 10) * DM, colmax + (it >> 10) * 2048, W8 + (size_t)(it >> 10) * 2048 * 1024, (float*)(colmax + 4096) + (it >> 10) * 2048, scr, it & 1023, lane);
            __syncthreads(); }
        else for (int m = gw; m < M; m += NGW) quant_row(XB + (size_t)m * DM, XB8 + (size_t)m * DM, xscale + m, lane);
        const int vcu = (G % 8 == 0) ? ((int)blockIdx.x % 8) * (G / 8) + (int)blockIdx.x / 8 : (int)blockIdx.x;
#pragma unroll 1
        for (int pass = 0; pass < 2; ++pass) {
            if ((pass ^ (vcu >> 2)) & 1) {
                for (int it = (int)blockIdx.x; it < BATCH * 4 * 4; it += G) attna::wg_item((attna::bf16*)P, it >> 4, (it >> 2) & 3, it & 3, (char*)lds);
            } else {
                for (int p = vcu; p < BATCH * 8 * 4; p += G) {
                    const int bh = p >> 2, s = p & 3;
#pragma unroll 1
                    for (int u = 0; u < 2; ++u)
                        moba::moba_unit<8>(bh >> 3, bh & 7, u ? 7 - s : s, (const moba::bf16*)(P + C_BQKV), (const moba::bf16*)(P + C_BQKV + 512), (const moba::bf16*)(P + C_BQKV + 1024), (const moba::bf16*)(P + C_ZB), (moba::bf16*)(P + C_BQKV), kmean + layer * 128 * 512, (char*)lds);
                }
            }
        }
    }
    GRID_BAR();
    {
        PHASE_VARS();
        pg8::StaticOrder S; S.init(M, DM, G, (int)blockIdx.x);
        {
            struct GateOrder { pg8::StaticOrder S;
                __device__ __forceinline__ bool next(int i, pg8::Unit& u) const { if (!S.next(i >> 1, u)) return false; u.pn += 4 * (i & 1); return true; }
                __device__ __forceinline__ void a_ready(const pg8::Unit&) const {} __device__ __forceinline__ void done(const pg8::Unit&) const {} } GS{S};
            if (threadIdx.x == 0) ((LAS int*)(L + LDS_RSTAB))[256] = -1;
            __syncthreads();
            pg8::Gemm gg{(const pg8::bf16_t*)XB8, (const pg8::bf16_t*)(W8 + (size_t)layer * 2048 * 1024), M, 2048, 512, 512};
            pg8::EpiGate EG{a.b_merge + layer * 2 * DM, (const float*)(colmax + 4096) + layer * 2048, xscale, rowss + (size_t)layer * M * 16, gatesb};
            pg8::gemm_phase<pg8::EpiGate, GateOrder, true, true>(L, gg, GS, EG);
        }
        pg8::Gemm g{P + C_ZA, Wcat + (size_t)layer * DM * 768, M, DM, 768, LDP}; pg8::EpiMerge E{P + C_MERGED, gatesb, LDP};
        pg8::gemm_phase<pg8::EpiMerge, pg8::StaticOrder, true, true>(L, g, S, E);
    }
    GRID_BAR();
    {
        PHASE_VARS();
        pg8::Gemm g{P + C_MERGED, Wout + (size_t)layer * DM * DM, M, DM, DM, LDP}; pg8::StaticOrder S; S.init(M, DM, G, (int)blockIdx.x);
        pg8::EpiResid<layer> E{a.x, XB, rowss + (layer == 0 ? (size_t)M * 16 : 0), DM};
        pg8::gemm_phase<pg8::EpiResid<layer>, pg8::StaticOrder, true, true>(L, g, S, E);
    }
    GRID_BAR();
}

__global__ void __launch_bounds__(NWAVES * 64, 2) hybrid_fwd(Args a) {
    extern __shared__ __attribute__((aligned(16))) unsigned char lds[];
    LAS unsigned char* L = (LAS unsigned char*)lds;
    if (threadIdx.x < 16) ((LAS unsigned*)(L + LDS_MISC))[threadIdx.x] = 0u;
    __syncthreads();
    (void)xcd_barrier_post((unsigned*)a.ws, (volatile LAS unsigned*)(L + LDS_MISC));
    layer_fwd<0>(a, lds, L);
    layer_fwd<1>(a, lds, L);
    {
        constexpr int layer = 1; (void)layer;
        PHASE_VARS();
        typedef unsigned u32x2_t __attribute__((ext_vector_type(2)));
        f32x4 gg[4];
#pragma unroll
        for (int j = 0; j < 4; ++j) gg[j] = *((const f32x4*)a.final_g + lane + 64 * j);
        for (int m = gw; m < M; m += NGW) {
            const f32x4* pp = (const f32x4*)(rowss + (size_t)m * 16); const f32x4 s4 = (pp[0] + pp[1]) + (pp[2] + pp[3]);
            const float rstd = __builtin_amdgcn_rsqf(((s4[0] + s4[1]) + (s4[2] + s4[3])) * (1.0f / 1024.0f) + RMS_EPS);
            const u32x2_t* xb = (const u32x2_t*)(XB + (size_t)m * DM) + lane; f32x4* o = (f32x4*)(a.out + (size_t)m * DM) + lane;
            u32x2_t bv[4];
#pragma unroll
            for (int j = 0; j < 4; ++j) bv[j] = __builtin_nontemporal_load(xb + 64 * j);
#pragma unroll
            for (int j = 0; j < 4; ++j) __builtin_nontemporal_store((f32x4){blo(bv[j].x), bhi(bv[j].x), blo(bv[j].y), bhi(bv[j].y)} * rstd * gg[j], o + 64 * j);
        }
    }
}

extern "C" void kernel_launch(void* const* d_in, const int* in_sizes, int n_in, void* d_out, int out_size, void* d_ws, size_t ws_size, hipStream_t stream) {
    static int grid = 0;
    if (grid == 0) {
        if (n_in != 8 || in_sizes[0] != M * DM || out_size != M * DM || ws_size < WS_END) { fprintf(stderr, "kernel_launch: unexpected shapes / workspace (n_in %d, ws %zu)\n", n_in, ws_size); grid = -1; return; }
        int dev = 0, cus = 0, per_cu = 0;
        hipGetDevice(&dev); hipDeviceGetAttribute(&cus, hipDeviceAttributeMultiprocessorCount, dev);
        if (hipFuncSetAttribute((const void*)hybrid_fwd, hipFuncAttributeMaxDynamicSharedMemorySize, LDS_BYTES) != hipSuccess) { fprintf(stderr, "kernel_launch: hipFuncSetAttribute failed\n"); grid = -1; return; }
        if (hipOccupancyMaxActiveBlocksPerMultiprocessor(&per_cu, (const void*)hybrid_fwd, NWAVES * 64, LDS_BYTES) != hipSuccess || per_cu < 1) { fprintf(stderr, "kernel_launch: the occupancy query admits %d workgroups per CU; nothing launched\n", per_cu); grid = -1; return; }
        (void)hipGetLastError();
        grid = cus;
    }
    if (grid < 0) return;
    if (hipMemsetAsync((char*)d_ws + WS_BAR, 0, WS_BAR_BYTES, stream) != hipSuccess) { fprintf(stderr, "kernel_launch: hipMemsetAsync failed\n"); return; }
    Args a{};
    a.x = (const float*)d_in[0]; a.norm_g = (const float*)d_in[1]; a.w_in = (const float*)d_in[2]; a.b_merge = (const float*)d_in[3];
    a.w_pa = (const float*)d_in[4]; a.w_pb = (const float*)d_in[5]; a.w_out = (const float*)d_in[6]; a.final_g = (const float*)d_in[7];
    a.out = (float*)d_out; a.ws = (unsigned char*)d_ws;
    hipLaunchKernelGGL(hybrid_fwd, dim3(grid), dim3(NWAVES * 64), LDS_BYTES, stream, a);
    const hipError_t e = hipPeekAtLastError();
    if (e != hipSuccess) fprintf(stderr, "kernel_launch: launch failed: %s (grid %d)\n", hipGetErrorString(e), grid);
}
```

```cpp
#include <hip/hip_runtime.h>
#include <cstdio>
#include <cstdint>
namespace pg8 {
#define PG8_LAS __attribute__((address_space(3)))
typedef unsigned short bf16_t;
typedef short bf16x8 __attribute__((ext_vector_type(8)));
typedef float f32x4 __attribute__((ext_vector_type(4)));
typedef unsigned u32x4 __attribute__((ext_vector_type(4)));
constexpr int BM = 256, BK = 64, HALF = 128, HTB = HALF * BK * 2  , STAGE_BYTES = 8 * HTB, NXCD = 8, WGM = 8;
constexpr int EPI_OFF = STAGE_BYTES, EPI_PITCH = 144, EPI_WAVE = 16 * EPI_PITCH;

__host__ __device__ __forceinline__ int lds_byte(int r, int c) { const int st = (r >> 4) * 2 + (c >> 5), rr = r & 15, cc = c & 31, ob = rr * 64 + cc * 2; return st * 1024 + (ob ^ (((ob >> 9) & 1) << 5)); }
__host__ __device__ __forceinline__ void stage_rc(int b, int& R, int& C) { const int st = b / 1024, sb = b % 1024, swz = sb ^ (((sb >> 9) & 1) << 5); R = (st >> 1) * 16 + swz / 64; C = (st & 1) * 32 + (swz % 64) / 2; }
__host__ __device__ __forceinline__ int perm32(int rho) { const int n = rho >> 4, i = rho & 15; return 8 * (i >> 2) + 4 * n + (i & 3); }

struct Unit { int pm, pn; };
struct Gemm { const bf16_t* A; const bf16_t* Bt; int M, N, K, lda; };

struct StaticOrder {
    int nM, nN, nwg, G, c;
    __host__ __device__ void init(int M, int N, int G_, int c_) { nM = M / BM; nN = N / BM; nwg = nM * nN; G = G_; c = c_; }
    __host__ __device__ bool next(int i, Unit& u) const {
        const long L = (long)i * G + c; if (L >= nwg) return false;
        int wgid = (int)L; { const int q = nwg / NXCD, r = nwg % NXCD, xcd = wgid % NXCD, off = wgid / NXCD; wgid = (xcd < r ? xcd * (q + 1) : r * (q + 1) + (xcd - r) * q) + off; }
        const int nig = WGM * nN, gid = wgid / nig, fm = gid * WGM, gsz = (nM - fm) < WGM ? (nM - fm) : WGM;
        u.pm = fm + ((wgid % nig) % gsz); u.pn = (wgid % nig) / gsz; return true;
    }
    __device__ __forceinline__ void a_ready(const Unit&) const {}
    __device__ __forceinline__ void done(const Unit&) const {}
};


typedef int i32x4 __attribute__((ext_vector_type(4)));
__device__ __forceinline__ f32x4 mma16(bf16x8 a, bf16x8 b, f32x4 c) { return __builtin_amdgcn_mfma_f32_16x16x32_bf16(a, b, c, 0, 0, 0); }
__device__ __forceinline__ i32x4 mma16(bf16x8 a, bf16x8 b, i32x4 c) { return __builtin_amdgcn_mfma_i32_16x16x64_i8(__builtin_bit_cast(i32x4, a), __builtin_bit_cast(i32x4, b), c, 0, 0, 0); }
template <class Epi, class Sched, bool ALIGN_EPI = false, bool SP2 = false>
__device__ __forceinline__ void gemm_phase(PG8_LAS unsigned char* lds, const Gemm g, const Sched& S, const Epi& E) {
    int tid_ = threadIdx.x; asm volatile("" : "+v"(tid_));
    const int tid = tid_, wid = __builtin_amdgcn_readfirstlane(tid >> 6), lane = tid & 63, wr = wid >> 2, wc = wid & 3, fr = lane & 15, fq = lane >> 4;
    const int K = g.K, nt = K / BK;
    unsigned voffA[2], voffB[2];
#pragma unroll
    for (int i = 0; i < 2; ++i) { int R, C; stage_rc(tid * 16 + i * 8192, R, C); const int Rb = 64 * (R >> 5) + (Epi::PERM ? perm32(R & 31) : (R & 31));
        voffA[i] = (unsigned)(R * g.lda + C) * 2u; voffB[i] = (unsigned)(Rb * K + C) * 2u; }
    const size_t kstep = (size_t)(BK * 2);
    const size_t hstepB = (size_t)32 * K * 2, hstepA = (size_t)HALF * g.lda * 2;
    const size_t tstepB = (size_t)BM * K * 2, tstepA = 2 * hstepA;
    const unsigned ldsw = (unsigned)wid * 1024u;
    const int aoff = lds_byte(wr * 64 + fr, fq * 8), boff = lds_byte(wc * 32 + fr, fq * 8);
#define PG8_SA(b, h) (((b) * 2 + (h)) * HTB)
#define PG8_SB(b, h) ((4 + (b) * 2 + (h)) * HTB)
#define PG8_STAGE(bufoff, gbase, voff) do { _Pragma("unroll") for (int _i = 0; _i < 2; ++_i) \
        __builtin_amdgcn_global_load_lds((const unsigned*)((const char*)(gbase) + (voff)[_i]), (PG8_LAS unsigned*)(lds + (bufoff) + ldsw + _i * 8192), 16, 0, 0); } while (0)
#define PG8_LDA(dst, b, h) do { _Pragma("unroll") for (int m = 0; m < 4; ++m) _Pragma("unroll") for (int k = 0; k < 2; ++k) dst[m][k] = *(const PG8_LAS bf16x8*)(lds + PG8_SA(b, h) + aoff + m * 2048 + k * 1024); } while (0)
#define PG8_LDB(dst, b, h) do { _Pragma("unroll") for (int n = 0; n < 2; ++n) _Pragma("unroll") for (int k = 0; k < 2; ++k) dst[n][k] = *(const PG8_LAS bf16x8*)(lds + PG8_SB(b, h) + boff + n * 2048 + k * 1024); } while (0)
#define PG8_MMA(ai, bj, At, Bt) do { __builtin_amdgcn_s_setprio(1); _Pragma("unroll") for (int m = 0; m < 4; ++m) _Pragma("unroll") for (int n = 0; n < 2; ++n) _Pragma("unroll") for (int k = 0; k < 2; ++k) \
        acc[ai][bj][m][n] = mma16(Bt[n][k], At[m][k], acc[ai][bj][m][n]); __builtin_amdgcn_s_setprio(0); } while (0)
#define PG8_WAIT_V(n) asm volatile("s_waitcnt vmcnt(" #n ")" ::: "memory")
#define PG8_WAIT_L(n) asm volatile("s_waitcnt lgkmcnt(" #n ")" ::: "memory")
#define PG8_BAR __builtin_amdgcn_s_barrier()
#define PG8_SCHED __builtin_amdgcn_sched_barrier(0)
    Unit cur, nxt; int ui = 0;
    if (!S.next(0, cur)) return;
    typename Epi::acc_t acc[2][2][4][2];
#pragma unroll
    for (int a = 0; a < 2; ++a)
#pragma unroll
        for (int b = 0; b < 2; ++b)
#pragma unroll
            for (int m = 0; m < 4; ++m)
#pragma unroll
                for (int n = 0; n < 2; ++n) acc[a][b][m][n] = (typename Epi::acc_t){0, 0, 0, 0};
    bf16x8 At[4][2], B0[2][2], B1[2][2];
    const char* cA = (const char*)g.A + (size_t)cur.pm * tstepA; const char* cB = (const char*)g.Bt + (size_t)cur.pn * tstepB;
    S.a_ready(cur);
    if constexpr (SP2) {
        PG8_STAGE(PG8_SB(0, 0), cB, voffB); PG8_STAGE(PG8_SB(0, 1), cB + hstepB, voffB); PG8_STAGE(PG8_SA(0, 0), cA, voffA); PG8_STAGE(PG8_SA(0, 1), cA + hstepA, voffA);
        if (wr == 1) PG8_BAR;
        PG8_WAIT_V(2); PG8_BAR;
        PG8_STAGE(PG8_SB(1, 0), cB + kstep, voffB); PG8_STAGE(PG8_SA(1, 0), cA + kstep, voffA); PG8_STAGE(PG8_SB(1, 1), cB + hstepB + kstep, voffB);
        PG8_WAIT_V(6); PG8_BAR;
    } else {
        PG8_STAGE(PG8_SB(0, 0), cB, voffB); PG8_STAGE(PG8_SA(0, 0), cA, voffA); PG8_STAGE(PG8_SB(0, 1), cB + hstepB, voffB); PG8_STAGE(PG8_SA(0, 1), cA + hstepA, voffA);
        if (wr == 1) PG8_BAR;
        PG8_WAIT_V(4); PG8_BAR;
        PG8_STAGE(PG8_SB(1, 0), cB + kstep, voffB); PG8_STAGE(PG8_SA(1, 0), cA + kstep, voffA); PG8_STAGE(PG8_SB(1, 1), cB + hstepB + kstep, voffB);
        PG8_WAIT_V(6); PG8_BAR;
    }
    for (;;) {
        const bool has_next = S.next(ui + 1, nxt);
        const char* nA = has_next ? (const char*)g.A + (size_t)nxt.pm * tstepA : cA; const char* nB = has_next ? (const char*)g.Bt + (size_t)nxt.pn * tstepB : cB;
        for (int t = 0; t < nt; t += 2) {
            const bool last = (t == nt - 2);
            const char* a1 = cA + (size_t)(t + 1) * kstep;
            const char* a2 = last ? nA : cA + (size_t)(t + 2) * kstep; const char* b2 = last ? nB : cB + (size_t)(t + 2) * kstep;
            const char* a3 = a2 + kstep; const char* b3 = b2 + kstep;
            if (last && has_next) S.a_ready(nxt);
            if constexpr (SP2) {
            PG8_LDB(B0, 0, 0); PG8_LDB(B1, 0, 1); PG8_SCHED; PG8_LDA(At, 0, 0); PG8_STAGE(PG8_SA(1, 1), a1 + hstepA, voffA);
            PG8_WAIT_V(8); PG8_WAIT_L(0); PG8_BAR; PG8_MMA(0, 0, At, B0); PG8_MMA(0, 1, At, B1); PG8_BAR; PG8_SCHED;
            PG8_LDA(At, 0, 1); PG8_STAGE(PG8_SB(0, 0), b2, voffB); PG8_STAGE(PG8_SB(0, 1), b2 + hstepB, voffB); PG8_STAGE(PG8_SA(0, 0), a2, voffA);
            PG8_WAIT_V(8); PG8_WAIT_L(0); PG8_BAR; PG8_MMA(1, 0, At, B0); PG8_MMA(1, 1, At, B1); PG8_BAR; PG8_SCHED;
            PG8_LDB(B0, 1, 0); PG8_LDB(B1, 1, 1); PG8_SCHED; PG8_LDA(At, 1, 0); PG8_STAGE(PG8_SA(0, 1), a2 + hstepA, voffA);
            PG8_WAIT_V(8); PG8_WAIT_L(0); PG8_BAR; PG8_MMA(0, 0, At, B0); PG8_MMA(0, 1, At, B1); PG8_BAR; PG8_SCHED;
            PG8_LDA(At, 1, 1); PG8_STAGE(PG8_SB(1, 0), b3, voffB); PG8_STAGE(PG8_SB(1, 1), b3 + hstepB, voffB); PG8_STAGE(PG8_SA(1, 0), a3, voffA);
            PG8_WAIT_V(8); PG8_WAIT_L(0); PG8_BAR; PG8_MMA(1, 0, At, B0); PG8_MMA(1, 1, At, B1); PG8_BAR; PG8_SCHED;
            if constexpr (Epi::HAS_MID) { if (t == Epi::MID_T) { E.mid(acc, cur, wr, wc, fr, fq, wid); PG8_SCHED; } }
            } else {
            PG8_LDB(B0, 0, 0); PG8_SCHED; PG8_LDA(At, 0, 0); PG8_STAGE(PG8_SA(1, 1), a1 + hstepA, voffA);
            PG8_WAIT_L(8); PG8_BAR; PG8_WAIT_L(0); PG8_MMA(0, 0, At, B0); PG8_BAR; PG8_SCHED;
            PG8_LDB(B1, 0, 1); PG8_STAGE(PG8_SB(0, 0), b2, voffB);
            PG8_BAR; PG8_WAIT_L(0); PG8_MMA(0, 1, At, B1); PG8_BAR;
            PG8_LDA(At, 0, 1); PG8_STAGE(PG8_SA(0, 0), a2, voffA);
            PG8_BAR; PG8_WAIT_L(0); PG8_MMA(1, 0, At, B0); PG8_BAR; PG8_SCHED;
            PG8_STAGE(PG8_SB(0, 1), b2 + hstepB, voffB);
            PG8_WAIT_V(6); PG8_BAR; PG8_MMA(1, 1, At, B1); PG8_BAR;
            PG8_LDB(B0, 1, 0); PG8_SCHED; PG8_LDA(At, 1, 0); PG8_STAGE(PG8_SA(0, 1), a2 + hstepA, voffA);
            PG8_WAIT_L(8); PG8_BAR; PG8_WAIT_L(0); PG8_MMA(0, 0, At, B0); PG8_BAR; PG8_SCHED;
            PG8_LDB(B1, 1, 1); PG8_STAGE(PG8_SB(1, 0), b3, voffB);
            PG8_BAR; PG8_WAIT_L(0); PG8_MMA(0, 1, At, B1); PG8_BAR;
            PG8_LDA(At, 1, 1); PG8_STAGE(PG8_SA(1, 0), a3, voffA);
            PG8_BAR; PG8_WAIT_L(0); PG8_MMA(1, 0, At, B0); PG8_BAR; PG8_SCHED;
            PG8_STAGE(PG8_SB(1, 1), b3 + hstepB, voffB);
            PG8_WAIT_V(6); PG8_BAR; PG8_MMA(1, 1, At, B1); PG8_BAR;
            }
        }
        if constexpr (ALIGN_EPI) { if (wr == 0) PG8_BAR; }
        if constexpr (!Epi::AFTER_DRAIN) { E(acc, cur, wr, wc, fr, fq, lds + EPI_OFF + wid * EPI_WAVE, lane, wid); S.done(cur); }
        if (!has_next) break;
#pragma unroll
        for (int a = 0; a < 2; ++a)
#pragma unroll
            for (int b = 0; b < 2; ++b)
#pragma unroll
                for (int m = 0; m < 4; ++m)
#pragma unroll
                    for (int n = 0; n < 2; ++n) acc[a][b][m][n] = (typename Epi::acc_t){0, 0, 0, 0};
        cur = nxt; cA = nA; cB = nB; ++ui;
        if constexpr (ALIGN_EPI) { if (wr == 1) PG8_BAR; }
    }
    PG8_WAIT_V(0);
    if constexpr (!ALIGN_EPI) { if (wr == 0) PG8_BAR; }
    PG8_BAR;
    if constexpr (Epi::AFTER_DRAIN) { E.fused(acc, cur, wr, wc, fr, fq, lds, wid, lane); S.done(cur); }
#undef PG8_SA
#undef PG8_SB
#undef PG8_STAGE
#undef PG8_LDA
#undef PG8_LDB
#undef PG8_MMA
#undef PG8_WAIT_V
#undef PG8_WAIT_L
#undef PG8_BAR
#undef PG8_SCHED
}
}


namespace pg8 {
__device__ __forceinline__ unsigned cvt_pk_bf16(float lo, float hi) { unsigned r; asm volatile("v_cvt_pk_bf16_f32 %0, %1, %2" : "=v"(r) : "v"(lo), "v"(hi)); return r; }
__device__ __forceinline__ float bflo(unsigned u) { return __uint_as_float(u << 16); }
__device__ __forceinline__ float bfhi(unsigned u) { return __uint_as_float(u & 0xffff0000u); }
__device__ __forceinline__ float sigmoidf_(float v) { return __builtin_amdgcn_rcpf(1.0f + __expf(-v)); }
typedef unsigned u32x2 __attribute__((ext_vector_type(2)));
__device__ __forceinline__ void piece_xpose(PG8_LAS unsigned char* stg, u32x4 in0, u32x4 in1, u32x4& out0, u32x4& out1, int fr, int fq, int lane) {
    *(PG8_LAS u32x4*)(stg + fr * EPI_PITCH + fq * 16) = in0; *(PG8_LAS u32x4*)(stg + fr * EPI_PITCH + 64 + fq * 16) = in1;
    out0 = *(const PG8_LAS u32x4*)(stg + (lane >> 3) * EPI_PITCH + (lane & 7) * 16); out1 = *(const PG8_LAS u32x4*)(stg + ((lane >> 3) + 8) * EPI_PITCH + (lane & 7) * 16);
}

struct EpiProj {
    typedef f32x4 acc_t; static constexpr bool PERM = true, AFTER_DRAIN = false, HAS_MID = false; static constexpr int MID_T = 0;
    bf16_t* O; int ldc; float* kmean; const float* rowss;
    __device__ __forceinline__ void operator()(const f32x4 (&acc)[2][2][4][2], const Unit& u, int wr, int wc, int fr, int fq, PG8_LAS unsigned char* stg, int lane, int wid) const {
        asm volatile("" : "+v"(fr), "+v"(fq), "+v"(lane));
        const int tl = u.pn < 3 ? 3 * u.pn + 2 : u.pn + 6;
        const int kind = (tl == 9 || tl == 16 || tl == 17) ? 1 : 0;
        PG8_LAS float* const tab = (PG8_LAS float*)(stg - wid * EPI_WAVE + 8 * EPI_WAVE + 256);
        if (__builtin_amdgcn_readfirstlane(((const PG8_LAS int*)tab)[256]) != u.pm) {
            asm volatile("s_waitcnt lgkmcnt(0)" ::: "memory"); __builtin_amdgcn_s_barrier(); asm volatile("" ::: "memory");
            const int t_ = wid * 64 + lane;
            if (t_ < 256) { const f32x4* pp = (const f32x4*)(rowss + (size_t)(u.pm * BM + t_) * 16); const f32x4 s4 = (pp[0] + pp[1]) + (pp[2] + pp[3]);
                tab[t_] = __builtin_amdgcn_rsqf(((s4[0] + s4[1]) + (s4[2] + s4[3])) * (1.0f / 1024.0f) + 1e-6f); }
            if (t_ == 0) ((PG8_LAS int*)tab)[256] = u.pm;
            asm volatile("s_waitcnt vmcnt(0) lgkmcnt(0)" ::: "memory"); __builtin_amdgcn_s_barrier(); asm volatile("" ::: "memory");
        }
        float rs[2][4];
#pragma unroll
        for (int ai = 0; ai < 2; ++ai)
#pragma unroll
            for (int m = 0; m < 4; ++m) rs[ai][m] = tab[ai * HALF + wr * 64 + m * 16 + fr];
        const float qs = (tl == 10 || tl == 11) ? 0.18033688011112042f : 1.0f;
        const size_t rbase = (size_t)(u.pm * BM + wr * 64 + (lane >> 3)); bf16_t* const op = O + tl * BM + wc * 64 + 8 * (lane & 7);
#pragma unroll
        for (int ai = 0; ai < 2; ++ai)
#pragma unroll
            for (int m = 0; m < 4; ++m) { u32x4 w[2];
#pragma unroll
                for (int bj = 0; bj < 2; ++bj) { f32x4 v0 = acc[ai][bj][m][0] * rs[ai][m], v1 = acc[ai][bj][m][1] * rs[ai][m];
                    if (kind == 1) {
#pragma unroll
                        for (int e = 0; e < 4; ++e) { v0[e] = v0[e] * sigmoidf_(v0[e]); v1[e] = v1[e] * sigmoidf_(v1[e]); } }
                    v0 = v0 * qs; v1 = v1 * qs;
                    w[bj].x = cvt_pk_bf16(v0[0], v0[1]); w[bj].y = cvt_pk_bf16(v0[2], v0[3]); w[bj].z = cvt_pk_bf16(v1[0], v1[1]); w[bj].w = cvt_pk_bf16(v1[2], v1[3]); }
                u32x4 o0, o1; piece_xpose(stg, w[0], w[1], o0, o1, fr, fq, lane);
                bf16_t* rp = op + (rbase + ai * HALF + m * 16) * ldc;
                __builtin_nontemporal_store(o0, (u32x4*)rp); __builtin_nontemporal_store(o1, (u32x4*)(rp + (size_t)8 * ldc));
                asm volatile("" ::: "memory"); }
        if (tl == 12 || tl == 13) {
#pragma unroll
            for (int bj = 0; bj < 2; ++bj)
#pragma unroll
                for (int n = 0; n < 2; ++n) { f32x4 cs = (f32x4){0.f, 0.f, 0.f, 0.f};
#pragma unroll
                    for (int ai = 0; ai < 2; ++ai)
#pragma unroll
                        for (int m = 0; m < 4; ++m) { float r2 = rs[ai][m]; asm volatile("" : "+v"(r2)); cs += acc[ai][bj][m][n] * r2; }
#pragma unroll
                    for (int e = 0; e < 4; ++e) { float v = cs[e]; v += __shfl_xor(v, 1); v += __shfl_xor(v, 2); v += __shfl_xor(v, 4); v += __shfl_xor(v, 8); cs[e] = v; }
                    if (fr == 0) { float* kp = kmean + (size_t)u.pm * 512 + (tl - 12) * 256 + wc * 64 + bj * 32 + 8 * fq + 4 * n;
#pragma unroll
                        for (int e = 0; e < 4; ++e) atomicAdd(kp + e, cs[e] * (1.0f / 256.0f)); } }
        }
    }
};
struct EpiProjQ8 {
    typedef i32x4 acc_t; static constexpr bool PERM = true, AFTER_DRAIN = false, HAS_MID = false; static constexpr int MID_T = 0;
    bf16_t* O; int ldc; const float* wscale; const float* xscale; const float* rowss;
    __device__ __forceinline__ void operator()(const i32x4 (&acc)[2][2][4][2], const Unit& u, int wr, int wc, int fr, int fq, PG8_LAS unsigned char* stg, int lane, int wid) const {
        asm volatile("" : "+v"(fr), "+v"(fq), "+v"(lane));
        const int tl = u.pn + (u.pn >> 1);
        const float qs = (u.pn & 1) ? 1.0f : 0.18033688011112042f;
        PG8_LAS float* const tab = (PG8_LAS float*)(stg - wid * EPI_WAVE + 8 * EPI_WAVE + 256);
        if (__builtin_amdgcn_readfirstlane(((const PG8_LAS int*)tab)[256]) != u.pm) {
            asm volatile("s_waitcnt lgkmcnt(0)" ::: "memory"); __builtin_amdgcn_s_barrier(); asm volatile("" ::: "memory");
            const int t_ = wid * 64 + lane;
            if (t_ < 256) { const f32x4* pp = (const f32x4*)(rowss + (size_t)(u.pm * BM + t_) * 16); const f32x4 s4 = (pp[0] + pp[1]) + (pp[2] + pp[3]);
                tab[t_] = xscale[u.pm * BM + t_] * __builtin_amdgcn_rsqf(((s4[0] + s4[1]) + (s4[2] + s4[3])) * (1.0f / 1024.0f) + 1e-6f); }
            if (t_ == 0) ((PG8_LAS int*)tab)[256] = u.pm;
            asm volatile("s_waitcnt vmcnt(0) lgkmcnt(0)" ::: "memory"); __builtin_amdgcn_s_barrier(); asm volatile("" ::: "memory");
        }
        f32x4 wv[2][2];
#pragma unroll
        for (int bj = 0; bj < 2; ++bj)
#pragma unroll
            for (int n = 0; n < 2; ++n) wv[bj][n] = *(const f32x4*)(wscale + u.pn * BM + wc * 64 + 8 * fq + bj * 32 + 4 * n) * qs;
        const size_t rbase = (size_t)(u.pm * BM + wr * 64 + (lane >> 3)); bf16_t* const op = O + tl * BM + wc * 64 + 8 * (lane & 7);
#pragma unroll
        for (int ai = 0; ai < 2; ++ai)
#pragma unroll
            for (int m = 0; m < 4; ++m) { const float rf = tab[ai * HALF + wr * 64 + m * 16 + fr]; u32x4 w[2];
#pragma unroll
                for (int bj = 0; bj < 2; ++bj) { f32x4 v0, v1;
#pragma unroll
                    for (int e = 0; e < 4; ++e) { v0[e] = (float)acc[ai][bj][m][0][e] * (rf * wv[bj][0][e]); v1[e] = (float)acc[ai][bj][m][1][e] * (rf * wv[bj][1][e]); }
                    w[bj].x = cvt_pk_bf16(v0[0], v0[1]); w[bj].y = cvt_pk_bf16(v0[2], v0[3]); w[bj].z = cvt_pk_bf16(v1[0], v1[1]); w[bj].w = cvt_pk_bf16(v1[2], v1[3]); }
                u32x4 o0, o1; piece_xpose(stg, w[0], w[1], o0, o1, fr, fq, lane);
                bf16_t* rp = op + (rbase + ai * HALF + m * 16) * ldc;
                __builtin_nontemporal_store(o0, (u32x4*)rp); __builtin_nontemporal_store(o1, (u32x4*)(rp + (size_t)8 * ldc));
                asm volatile("" ::: "memory"); }
    }
};
struct EpiGate {
    typedef i32x4 acc_t; static constexpr bool PERM = true, AFTER_DRAIN = false, HAS_MID = false; static constexpr int MID_T = 0;
    const float* bmerge; const float* wscale; const float* xscale; const float* rowss; unsigned char* gates;
    __device__ __forceinline__ void operator()(const i32x4 (&acc)[2][2][4][2], const Unit& u, int wr, int wc, int fr, int fq, PG8_LAS unsigned char* stg, int lane, int wid) const {
        asm volatile("" : "+v"(fr), "+v"(fq), "+v"(lane));
        const int col0 = u.pn * BM + wc * 64 + 8 * fq;
        PG8_LAS float* const tab = (PG8_LAS float*)(stg - wid * EPI_WAVE + 8 * EPI_WAVE + 256);
        if (__builtin_amdgcn_readfirstlane(((const PG8_LAS int*)tab)[256]) != u.pm) {
            asm volatile("s_waitcnt lgkmcnt(0)" ::: "memory"); __builtin_amdgcn_s_barrier(); asm volatile("" ::: "memory");
            const int t_ = wid * 64 + lane;
            if (t_ < 256) { const f32x4* pp = (const f32x4*)(rowss + (size_t)(u.pm * BM + t_) * 16); const f32x4 s4 = (pp[0] + pp[1]) + (pp[2] + pp[3]);
                tab[t_] = xscale[u.pm * BM + t_] * __builtin_amdgcn_rsqf(((s4[0] + s4[1]) + (s4[2] + s4[3])) * (1.0f / 1024.0f) + 1e-6f) * (-1.4426950408889634f); }
            if (t_ == 0) ((PG8_LAS int*)tab)[256] = u.pm;
            asm volatile("s_waitcnt vmcnt(0) lgkmcnt(0)" ::: "memory"); __builtin_amdgcn_s_barrier(); asm volatile("" ::: "memory");
        }
        f32x4 bv[2][2], wv[2][2];
#pragma unroll
        for (int bj = 0; bj < 2; ++bj)
#pragma unroll
            for (int n = 0; n < 2; ++n) { bv[bj][n] = *(const f32x4*)(bmerge + col0 + bj * 32 + 4 * n) * (-1.4426950408889634f); wv[bj][n] = *(const f32x4*)(wscale + col0 + bj * 32 + 4 * n); }
        unsigned char* gp = gates + ((size_t)((u.pm * 8 + u.pn) * 8 + wid) * 8) * 1024 + fr * 64 + fq * 16;
#pragma unroll
        for (int ai = 0; ai < 2; ++ai)
#pragma unroll
            for (int m = 0; m < 4; ++m) { const float rf = tab[ai * HALF + wr * 64 + m * 16 + fr]; u32x4 q;
#pragma unroll
                for (int bj = 0; bj < 2; ++bj)
#pragma unroll
                    for (int n = 0; n < 2; ++n) { unsigned w = 0u;
#pragma unroll
                        for (int e = 0; e < 4; ++e) { const float x2 = (float)acc[ai][bj][m][n][e] * (rf * wv[bj][n][e]) + bv[bj][n][e];
                            w = __builtin_amdgcn_cvt_pk_u8_f32(__builtin_fmaxf(255.0f * __builtin_amdgcn_rcpf(1.0f + __builtin_amdgcn_exp2f(x2)), 1.0f), e, w); }
                        q[2 * bj + n] = w; }
                __builtin_nontemporal_store(q, (u32x4*)(gp + (ai * 4 + m) * 1024)); }
    }
};
struct EpiMerge {
    typedef f32x4 acc_t; static constexpr bool PERM = true, AFTER_DRAIN = false, HAS_MID = true; static constexpr int MID_T = 2;
    bf16_t* O; const unsigned char* gates; int ldc;
    __device__ __forceinline__ static float ub(unsigned w, int i) { return (float)((w >> (8 * i)) & 0xffu); }
    __device__ __forceinline__ void mid(f32x4 (&acc)[2][2][4][2], const Unit& u, int wr, int wc, int fr, int fq, int wid) const {
        asm volatile("" : "+v"(fr), "+v"(fq));
        const unsigned char* ga = gates + ((size_t)((u.pm * 8 + u.pn) * 8 + wid) * 8) * 1024 + fr * 64 + fq * 16; const unsigned char* gb = ga + (size_t)4 * 8 * 8 * 1024;
        u32x4 av[2][4], bv[2][4];
#pragma unroll
        for (int ai = 0; ai < 2; ++ai)
#pragma unroll
            for (int m = 0; m < 4; ++m) { av[ai][m] = __builtin_nontemporal_load((const u32x4*)(ga + (ai * 4 + m) * 1024)); bv[ai][m] = *(const u32x4*)(gb + (ai * 4 + m) * 1024); }
#pragma unroll
        for (int ai = 0; ai < 2; ++ai)
#pragma unroll
            for (int m = 0; m < 4; ++m)
#pragma unroll
                for (int bj = 0; bj < 2; ++bj)
#pragma unroll
                    for (int n = 0; n < 2; ++n)
#pragma unroll
                        for (int e = 0; e < 4; ++e) acc[ai][bj][m][n][e] *= ub(av[ai][m][2 * bj + n], e) * __builtin_amdgcn_rcpf(ub(bv[ai][m][2 * bj + n], e));
    }
    __device__ __forceinline__ void operator()(const f32x4 (&acc)[2][2][4][2], const Unit& u, int wr, int wc, int fr, int fq, PG8_LAS unsigned char* stg, int lane, int wid) const {
        asm volatile("" : "+v"(fr), "+v"(fq), "+v"(lane));
        const unsigned char* gb = gates + ((size_t)((u.pm * 8 + 4 + u.pn) * 8 + wid) * 8) * 1024 + fr * 64 + fq * 16;
        const size_t rbase = (size_t)(u.pm * BM + wr * 64 + (lane >> 3)); bf16_t* const op = O + u.pn * BM + wc * 64 + 8 * (lane & 7);
        u32x4 gvv[2][4];
#pragma unroll
        for (int ai = 0; ai < 2; ++ai)
#pragma unroll
            for (int m = 0; m < 4; ++m) gvv[ai][m] = __builtin_nontemporal_load((const u32x4*)(gb + (ai * 4 + m) * 1024));
#pragma unroll
        for (int ai = 0; ai < 2; ++ai)
#pragma unroll
            for (int m = 0; m < 4; ++m) { const u32x4 gv = gvv[ai][m]; u32x4 w[2];
#pragma unroll
                for (int bj = 0; bj < 2; ++bj) { f32x4 v0 = acc[ai][bj][m][0], v1 = acc[ai][bj][m][1];
#pragma unroll
                    for (int e = 0; e < 4; ++e) { v0[e] *= ub(gv[2 * bj], e) * (1.0f / 255.0f); v1[e] *= ub(gv[2 * bj + 1], e) * (1.0f / 255.0f); }
                    w[bj].x = cvt_pk_bf16(v0[0], v0[1]); w[bj].y = cvt_pk_bf16(v0[2], v0[3]); w[bj].z = cvt_pk_bf16(v1[0], v1[1]); w[bj].w = cvt_pk_bf16(v1[2], v1[3]); }
                u32x4 o0, o1; piece_xpose(stg, w[0], w[1], o0, o1, fr, fq, lane);
                bf16_t* rp = op + (rbase + ai * HALF + m * 16) * ldc;
                __builtin_nontemporal_store(o0, (u32x4*)rp); __builtin_nontemporal_store(o1, (u32x4*)(rp + (size_t)8 * ldc));
                if (m & 1) asm volatile("" ::: "memory"); }
    }
};
template <int MODE> struct EpiResid {
    typedef f32x4 acc_t; static constexpr bool PERM = false, AFTER_DRAIN = false, HAS_MID = false; static constexpr int MID_T = 0;
    const float* R; bf16_t* XB; float* rowss; int ldc;
    __device__ __forceinline__ void operator()(const f32x4 (&acc)[2][2][4][2], const Unit& u, int wr, int wc, int fr, int fq, PG8_LAS unsigned char* stg, int lane, int wid) const {
        asm volatile("" : "+v"(fr), "+v"(fq), "+v"(lane));
        const size_t rbase = (size_t)(u.pm * BM + wr * 64 + (lane >> 3)); const int cb = u.pn * BM + wc * 64 + 4 * (lane & 7);
#pragma unroll
        for (int ai = 0; ai < 2; ++ai) {
            f32x4 rr[4][2][2];
#pragma unroll
            for (int m = 0; m < 4; ++m)
#pragma unroll
                for (int bj = 0; bj < 2; ++bj) { const size_t ro = (rbase + ai * HALF + m * 16) * ldc + cb + bj * 32;
                    if (MODE == 0) { rr[m][bj][0] = __builtin_nontemporal_load((const f32x4*)(R + ro)); rr[m][bj][1] = __builtin_nontemporal_load((const f32x4*)(R + ro + (size_t)8 * ldc)); }
                    else { const u32x2 b0 = __builtin_nontemporal_load((const u32x2*)(XB + ro)), b1 = __builtin_nontemporal_load((const u32x2*)(XB + ro + (size_t)8 * ldc));
                        rr[m][bj][0] = __builtin_bit_cast(f32x4, (u32x4){b0.x, b0.y, b1.x, b1.y}); } }
#pragma unroll
            for (int m = 0; m < 4; ++m) { float ss0 = 0.f, ss1 = 0.f;
#pragma unroll
                for (int bj = 0; bj < 2; ++bj) { const size_t ro = (rbase + ai * HALF + m * 16) * ldc + cb + bj * 32;
                    f32x4 r0, r1;
                    if (MODE == 0) { r0 = rr[m][bj][0]; r1 = rr[m][bj][1]; }
                    else { const u32x4 pk = __builtin_bit_cast(u32x4, rr[m][bj][0]);
                        r0 = (f32x4){bflo(pk.x), bfhi(pk.x), bflo(pk.y), bfhi(pk.y)}; r1 = (f32x4){bflo(pk.z), bfhi(pk.z), bflo(pk.w), bfhi(pk.w)}; }
                    u32x4 o0, o1; piece_xpose(stg, __builtin_bit_cast(u32x4, acc[ai][bj][m][0]), __builtin_bit_cast(u32x4, acc[ai][bj][m][1]), o0, o1, fr, fq, lane);
                    const f32x4 x0 = r0 + __builtin_bit_cast(f32x4, o0), x1 = r1 + __builtin_bit_cast(f32x4, o1);
                    *(u32x2*)(XB + ro) = (u32x2){cvt_pk_bf16(x0[0], x0[1]), cvt_pk_bf16(x0[2], x0[3])}; *(u32x2*)(XB + ro + (size_t)8 * ldc) = (u32x2){cvt_pk_bf16(x1[0], x1[1]), cvt_pk_bf16(x1[2], x1[3])};
                    ss0 += (x0[0] * x0[0] + x0[1] * x0[1]) + (x0[2] * x0[2] + x0[3] * x0[3]); ss1 += (x1[0] * x1[0] + x1[1] * x1[1]) + (x1[2] * x1[2] + x1[3] * x1[3]); }
                ss0 += __shfl_xor(ss0, 1); ss0 += __shfl_xor(ss0, 2); ss0 += __shfl_xor(ss0, 4); ss1 += __shfl_xor(ss1, 1); ss1 += __shfl_xor(ss1, 2); ss1 += __shfl_xor(ss1, 4);
                if ((lane & 7) == 0) { rowss[(rbase + ai * HALF + m * 16) * 16 + u.pn * 4 + wc] = ss0; rowss[(rbase + ai * HALF + m * 16 + 8) * 16 + u.pn * 4 + wc] = ss1; } }
            asm volatile("" ::: "memory");
        }
    }
};
}
#include <hip/hip_bf16.h>
#include <cmath>
namespace moba {
using bf16=__hip_bfloat16;
using bf16x8=__attribute__((ext_vector_type(8)))short;
using s16x4=__attribute__((ext_vector_type(4)))short;
using f32x16=__attribute__((ext_vector_type(16)))float;
using u32x4=__attribute__((ext_vector_type(4)))unsigned;
constexpr int SEQ=2048,D=64,PITCH=4608;
constexpr int NW=8,QBLK=32,QB=QBLK*NW,KVBLK=64;
__device__ __forceinline__ int crow(int r,int hi){return (r&3)+8*(r>>2)+4*hi;}
#define SBAR() __builtin_amdgcn_sched_barrier(0)
__device__ __forceinline__ void cmask(f32x16&p0,f32x16&p1,int jb,int qrel,int hi){
  const float NEG=-INFINITY; int kb=64*jb+4*hi;
  #pragma unroll
  for(int r=0;r<16;++r){int kv=kb+(r&3)+8*(r>>2); if(kv>qrel)p0[r]=NEG; if(kv+32>qrel)p1[r]=NEG;}
}

constexpr int NSLOT=3, SLOTB=8192;
constexpr int NVSLOT=4;
constexpr int LDS_K=0, LDS_V=NSLOT*SLOTB, LDS_WS=LDS_V+NVSLOT*SLOTB, LDS_OST=LDS_WS+NW*64*4, LDS_KM=LDS_OST+NW*4096, LDS_BYTES=LDS_KM+8*64*4;
__device__ __forceinline__ void glds16(const void*gsrc,unsigned lds_dst){unsigned keep;
  asm volatile("s_mov_b32 %0, m0\n\ts_mov_b32 m0, %2\n\ts_nop 0\n\tglobal_load_lds_dwordx4 %1, off\n\ts_mov_b32 m0, %0":"=&s"(keep):"v"(gsrc),"s"(lds_dst):"memory");}
__device__ __forceinline__ float max3f(float a,float b,float c){float r;asm("v_max3_f32 %0, %1, %2, %3":"=v"(r):"v"(a),"v"(b),"v"(c));return r;}
__device__ __forceinline__ float max2f(float a,float b){float r;asm("v_max_f32_e32 %0, %1, %2":"=v"(r):"v"(a),"v"(b));return r;}
typedef float f32x2_t __attribute__((ext_vector_type(2))); typedef __bf16 bf16x2_t __attribute__((ext_vector_type(2)));
__device__ __forceinline__ unsigned cvtpk_s(float lo,float hi){f32x2_t v={lo,hi};bf16x2_t b=__builtin_convertvector(v,bf16x2_t);return __builtin_bit_cast(unsigned,b);}
__device__ __forceinline__ float bl(unsigned u){return __uint_as_float(u<<16);}
__device__ __forceinline__ float bh(unsigned u){return __uint_as_float(u&0xffff0000u);}
#define WAIT_BAR(N) asm volatile("s_waitcnt vmcnt(" #N ") lgkmcnt(0)\n\ts_barrier":::"memory")

__device__ __forceinline__ void qkt(f32x16&p0,f32x16&p1,const char*Kslot,const bf16x8*qr,const f32x16&negm,int r32,int hi){
  const char*kb=Kslot+hi*1024+r32*16;
  #pragma unroll
  for(int d0=0;d0<4;++d0){
    const bf16x8 b0=*reinterpret_cast<const bf16x8*>(kb+d0*2048);
    const bf16x8 b1=*reinterpret_cast<const bf16x8*>(kb+d0*2048+512);
    if(d0==0){p0=__builtin_amdgcn_mfma_f32_32x32x16_bf16(b0,qr[0],negm,0,0,0);p1=__builtin_amdgcn_mfma_f32_32x32x16_bf16(b1,qr[0],negm,0,0,0);}
    else{p0=__builtin_amdgcn_mfma_f32_32x32x16_bf16(b0,qr[d0],p0,0,0,0);p1=__builtin_amdgcn_mfma_f32_32x32x16_bf16(b1,qr[d0],p1,0,0,0);}}
}
typedef __attribute__((address_space(3))) const char* lds_cptr;
typedef short v4i16_t __attribute__((ext_vector_type(4)));
__device__ __forceinline__ void kload8(bf16x8*kf,lds_cptr kp){
  kf[0]=*(const __attribute__((address_space(3))) bf16x8*)(kp);      kf[1]=*(const __attribute__((address_space(3))) bf16x8*)(kp+512);
  kf[2]=*(const __attribute__((address_space(3))) bf16x8*)(kp+2048); kf[3]=*(const __attribute__((address_space(3))) bf16x8*)(kp+2560);
  kf[4]=*(const __attribute__((address_space(3))) bf16x8*)(kp+4096); kf[5]=*(const __attribute__((address_space(3))) bf16x8*)(kp+4608);
  kf[6]=*(const __attribute__((address_space(3))) bf16x8*)(kp+6144); kf[7]=*(const __attribute__((address_space(3))) bf16x8*)(kp+6656);
}
__device__ __forceinline__ void kload2(bf16x8*kf,lds_cptr kp,int j){ kf[2*j]=*(const __attribute__((address_space(3))) bf16x8*)(kp+j*2048); kf[2*j+1]=*(const __attribute__((address_space(3))) bf16x8*)(kp+j*2048+512); }
__device__ __forceinline__ s16x4 vtr(lds_cptr p){ return __builtin_bit_cast(s16x4,__builtin_amdgcn_ds_read_tr16_b64_v4i16((__attribute__((address_space(3))) v4i16_t*)p)); }
__device__ __forceinline__ float rowmax(const f32x16&p0,const f32x16&p1){
  float a=max3f(p0[0],p0[1],p1[0]),b=max3f(p0[2],p0[3],p1[1]);a=max3f(a,p1[2],p1[3]);
  #pragma unroll
  for(int r=4;r<16;r+=4){a=max3f(a,p0[r],p0[r+1]);b=max3f(b,p0[r+2],p0[r+3]);a=max3f(a,p1[r],p1[r+1]);b=max3f(b,p1[r+2],p1[r+3]);}
  const float m=max2f(a,b);
  auto rr=__builtin_amdgcn_permlane32_swap(__float_as_uint(m),__float_as_uint(m),false,false);
  return max2f(__uint_as_float(rr[0]),__uint_as_float(rr[1]));
}
__device__ __forceinline__ float xhalf_sum(float v){ auto rr=__builtin_amdgcn_permlane32_swap(__float_as_uint(v),__float_as_uint(v),false,false); return __uint_as_float(rr[0])+__uint_as_float(rr[1]); }
__device__ __forceinline__ void pv(f32x16*o,int vb,bf16x8 pa0,bf16x8 pa1,bf16x8 pa2,bf16x8 pa3){
  #pragma unroll
  for(int d0=0;d0<2;++d0){s16x4 lo[4],hi[4];
    #pragma unroll
    for(int ks=0;ks<4;++ks){
      asm volatile("ds_read_b64_tr_b16 %0,%1 offset:%c2":"=&v"(lo[ks]):"v"(vb),"i"(d0*4096+ks*1024):"memory");
      asm volatile("ds_read_b64_tr_b16 %0,%1 offset:%c2":"=&v"(hi[ks]):"v"(vb),"i"(d0*4096+ks*1024+512):"memory");}
    asm volatile("s_waitcnt lgkmcnt(0)":::"memory");SBAR();
    #define PK(k) (bf16x8){lo[k][0],lo[k][1],lo[k][2],lo[k][3],hi[k][0],hi[k][1],hi[k][2],hi[k][3]}
    o[d0]=__builtin_amdgcn_mfma_f32_32x32x16_bf16(pa0,PK(0),o[d0],0,0,0);
    o[d0]=__builtin_amdgcn_mfma_f32_32x32x16_bf16(pa1,PK(1),o[d0],0,0,0);
    o[d0]=__builtin_amdgcn_mfma_f32_32x32x16_bf16(pa2,PK(2),o[d0],0,0,0);
    o[d0]=__builtin_amdgcn_mfma_f32_32x32x16_bf16(pa3,PK(3),o[d0],0,0,0);
    #undef PK
  }
}

template<int THRL> __device__ __forceinline__ void moba_unit(int b,int h,int c,const bf16*Pq,const bf16*__restrict__ Pk,const bf16*__restrict__ Pv,const bf16*Pz,bf16*Po,const float*__restrict__ kmean,char*shm){
  int tid_=threadIdx.x; asm volatile("":"+v"(tid_));
  const int tid=tid_,lane=tid&63,r32=lane&31,hi=lane>>5; const int wid=__builtin_amdgcn_readfirstlane(tid>>6);
  const long rowbase=(long)b*SEQ; const int q0=c*QB;
  const bf16*Qw=Pq+(rowbase+q0+wid*QBLK)*PITCH+h*D;
  const bf16*Kh=Pk+rowbase*PITCH+h*D,*Vh=Pv+rowbase*PITCH+h*D;
  const unsigned lds0=(unsigned)(uintptr_t)shm;
  float*wsf=(float*)(shm+LDS_WS)+wid*64;
  float*kml=(float*)(shm+LDS_KM);
  const int NT=(q0+QB)/KVBLK;
  const bf16*ksrc=Kh+(long)lane*PITCH+wid*8;
  const bf16*vsrc=Vh+(long)(16*(wid&3)+(lane>>2))*PITCH+(wid>>2)*32+(lane&3)*8;
  const unsigned kdst=lds0+LDS_K+wid*1024, vdst=lds0+LDS_V+wid*1024;
  #define DMA_K(t,slot) glds16(ksrc+(long)(NT-1-(t))*KVBLK*PITCH,(unsigned)__builtin_amdgcn_readfirstlane(kdst+(slot)))
  #define DMA_V(t,slot) glds16(vsrc+(long)(NT-1-(t))*KVBLK*PITCH,(unsigned)__builtin_amdgcn_readfirstlane(vdst+(slot)))
  const int vb0=(int)(lds0+LDS_V)+((lane>>4)&1)*32+(lane&3)*8+(4*hi+((lane&15)>>2))*64;
  const char*Kbase=shm+LDS_K; bf16x8 kf[8];
  const lds_cptr shm3=(lds_cptr)shm; const lds_cptr kp0=shm3+LDS_K+hi*1024+r32*16; const lds_cptr vp0=shm3+LDS_V+((lane>>4)&1)*32+(lane&3)*8+(4*hi+((lane&15)>>2))*64;
  #define VS(t) ((((t))&3)*SLOTB)
  DMA_K(0,0);DMA_V(0,VS(0));DMA_K(1,SLOTB);
  bf16x8 qr[4];
  #pragma unroll
  for(int d0=0;d0<4;++d0)qr[d0]=*reinterpret_cast<const bf16x8*>(&Qw[(long)r32*PITCH+d0*16+hi*8]);
  const int qrel=wid*QBLK+r32;
  u32x4 kdg[4];
  { const bf16*Kd=Kh+(long)(q0+qrel)*PITCH;
    #pragma unroll
    for(int d0=0;d0<4;++d0)kdg[d0]=*reinterpret_cast<const u32x4*>(&Kd[d0*16+hi*8]); }
  const float sl2=__uint_as_float(__builtin_amdgcn_readfirstlane(__float_as_uint(__builtin_amdgcn_exp2f(-(float)(h+1))*1.4426950408889634f)));
  unsigned sel=0u;
  if(c>0){
    if(tid<c*64) kml[tid]=kmean[((long)(b*8)+(tid>>6))*512+h*64+(tid&63)];
    asm volatile("s_waitcnt vmcnt(0) lgkmcnt(0)\n\ts_barrier":::"memory");
    if(c<=3) sel=(1u<<c)-1u;
    else{
      float g[8];
      #pragma unroll
      for(int j=0;j<8;++j){ g[j]=-INFINITY;
        if(j<c){ float a=0.f;
          #pragma unroll
          for(int d0=0;d0<4;++d0){ const u32x4 qv=__builtin_bit_cast(u32x4,qr[d0]); const float*km=kml+j*64+d0*16+hi*8;
            const float4 k0=*(const float4*)km, k1=*(const float4*)(km+4);
            a+=bl(qv.x)*k0.x+bh(qv.x)*k0.y+bl(qv.y)*k0.z+bh(qv.y)*k0.w+bl(qv.z)*k1.x+bh(qv.z)*k1.y+bl(qv.w)*k1.z+bh(qv.w)*k1.w; }
          g[j]=xhalf_sum(a); } }
      #pragma unroll
      for(int j=0;j<8;++j){ int rank=0;
        #pragma unroll
        for(int j2=0;j2<8;++j2){ if(j2!=j) rank+=((g[j2]>g[j])||(g[j2]==g[j]&&j2<j))?1:0; }
        if(j<c&&rank<3) sel|=(1u<<j); }
    }
  }
  float mhat;
  { float a=0.f;
    #pragma unroll
    for(int d0=0;d0<4;++d0){ const u32x4 kv=kdg[d0]; const u32x4 qv=__builtin_bit_cast(u32x4,qr[d0]);
      a+=bl(qv.x)*bl(kv.x)+bh(qv.x)*bh(kv.x)+bl(qv.y)*bl(kv.y)+bh(qv.y)*bh(kv.y)+bl(qv.z)*bl(kv.z)+bh(qv.z)*bh(kv.z)+bl(qv.w)*bl(kv.w)+bh(qv.w)*bh(kv.w); }
    mhat=xhalf_sum(a)+sl2*(float)qrel; }
  float l_reg=0.f;f32x16 o[2];o[0]=f32x16{};o[1]=f32x16{};
  f32x16 negm;
  #pragma unroll
  for(int r=0;r<16;++r)negm[r]=sl2*(float)((r&3)+8*(r>>2))-mhat;
  asm volatile("":"+v"(negm));
  #define MBIAS(P0,P1,t) do{ const int T_=NT-1-(t); const int jb_=T_-(NT-4); float a0_=sl2*(float)(64*jb_+4*hi); \
      if(jb_<0){ if(!((sel>>(T_>>2))&1u)) a0_=-INFINITY; } const float a1_=a0_+32.f*sl2; \
      _Pragma("unroll") for(int r=0;r<16;++r){P0[r]+=a0_;P1[r]+=a1_;} \
      if(jb_>=0)cmask(P0,P1,jb_,qrel,hi); }while(0)
  bool resc=false;
  #define RESC() do{ if(resc){ asm volatile("s_waitcnt lgkmcnt(0)":::"memory"); \
      _Pragma("unroll") for(int d_=0;d_<2;++d_) _Pragma("unroll") for(int r=0;r<16;++r)o[d_][r]*=wsf[crow(r,hi)]; } }while(0)
  f32x16 pA0,pA1,pB0,pB1;
  int sl_prev=0,sl_cur=0,sl_next=SLOTB;
  #define ROT() do{sl_prev=sl_cur;sl_cur=sl_next;sl_next=(sl_next==(NSLOT-1)*SLOTB)?0:sl_next+SLOTB;}while(0)
  DMA_K(2,2*SLOTB);DMA_V(1,VS(1));
  WAIT_BAR(2);
  qkt(pA0,pA1,Kbase,qr,negm,r32,hi);asm volatile("s_nop 15\n\ts_nop 7":"+v"(pA0),"+v"(pA1));MBIAS(pA0,pA1,0);
  { const float rm=rowmax(pA0,pA1);
    if(__any(rm>(float)THRL)){ const float dl=__builtin_fmaxf(rm,0.f);
      _Pragma("unroll") for(int r=0;r<16;++r){pA0[r]-=dl;pA1[r]-=dl;negm[r]-=dl;}
      asm volatile("":"+v"(negm)); } }
  _Pragma("unroll") for(int r=0;r<16;++r){pA0[r]=__builtin_amdgcn_exp2f(pA0[r]);pA1[r]=__builtin_amdgcn_exp2f(pA1[r]);}
  WAIT_BAR(2);
  DMA_K(3,0);DMA_V(2,VS(2));
  ROT();
  kload8(kf,kp0+sl_cur);
  WAIT_BAR(3);
  s16x4 vlo[8],vhi[8]; u32x4 pw0,pw1,pw2,pw3;
  #define PKW(P,B) cvtpk_s(P[B],P[B+1])
  #define PAF(k) __builtin_bit_cast(bf16x8,pw##k)
  #define VFR(i) (bf16x8){vlo[i][0],vlo[i][1],vlo[i][2],vlo[i][3],vhi[i][0],vhi[i][1],vhi[i][2],vhi[i][3]}
  #define PIN(x) asm volatile("":"+v"(x))
  #define MX3(a,b,c) __builtin_fmaxf(__builtin_fmaxf((a),(b)),(c))
  #define GAPA(MF,A0,A1,A2,A3,W0,W1,PW) do{ MF; sacc+=A0; sacc+=A1; sacc+=A2; sacc+=A3; PIN(sacc); W0; W1; PIN(PW); SBAR(); }while(0)
  #define EX(v) __builtin_amdgcn_exp2f(v)
  #define GAPB(MF,X,B) do{ MF; X[B]=EX(X[B]); X[B+1]=EX(X[B+1]); X[B+2]=EX(X[B+2]); X[B+3]=EX(X[B+3]); PIN(X); SBAR(); }while(0)
  #define VRD(i) do{ vlo[i]=vtr(vp_+(((i)>>2)*4096+((i)&3)*1024)); vhi[i]=vtr(vp_+(((i)>>2)*4096+((i)&3)*1024+512)); }while(0)
  #define KRD(G,j) do{ if(G){ kload2(kf,kp0+sl_next,j); SBAR(); } }while(0)
  #define STEP(C0,C1,P0,P1,t,GK,GV,GL) do{ SBAR(); \
    const lds_cptr vp_=vp0+VS((t)-1); \
    VRD(0); SBAR(); float sacc=(P0[0]+P0[1]); \
    GAPA(C0=__builtin_amdgcn_mfma_f32_32x32x16_bf16(kf[0],qr[0],negm,0,0,0), P0[2],P0[3],P0[4],P0[5],     pw0[0]=PKW(P0,0), pw0[1]=PKW(P0,2), pw0); \
    VRD(4); SBAR(); GAPA(C1=__builtin_amdgcn_mfma_f32_32x32x16_bf16(kf[1],qr[0],negm,0,0,0), P0[6],P0[7],P0[8],P0[9],     pw0[2]=PKW(P0,4), pw0[3]=PKW(P0,6), pw0); \
    VRD(1); SBAR(); GAPA(C0=__builtin_amdgcn_mfma_f32_32x32x16_bf16(kf[2],qr[1],C0,0,0,0),   P0[10],P0[11],P0[12],P0[13], pw1[0]=PKW(P0,8), pw1[1]=PKW(P0,10), pw1); \
    VRD(5); SBAR(); GAPA(C1=__builtin_amdgcn_mfma_f32_32x32x16_bf16(kf[3],qr[1],C1,0,0,0),   P0[14],P0[15],P1[0],P1[1],   pw1[2]=PKW(P0,12),pw1[3]=PKW(P0,14), pw1); \
    VRD(2); SBAR(); GAPA(C0=__builtin_amdgcn_mfma_f32_32x32x16_bf16(kf[4],qr[2],C0,0,0,0),   P1[2],P1[3],P1[4],P1[5],     pw2[0]=PKW(P1,0), pw2[1]=PKW(P1,2), pw2); \
    VRD(6); SBAR(); GAPA(C1=__builtin_amdgcn_mfma_f32_32x32x16_bf16(kf[5],qr[2],C1,0,0,0),   P1[6],P1[7],P1[8],P1[9],     pw2[2]=PKW(P1,4), pw2[3]=PKW(P1,6), pw2); \
    VRD(3); SBAR(); GAPA(C0=__builtin_amdgcn_mfma_f32_32x32x16_bf16(kf[6],qr[3],C0,0,0,0),   P1[10],P1[11],P1[12],P1[13], pw3[0]=PKW(P1,8), pw3[1]=PKW(P1,10), pw3); \
    VRD(7); SBAR(); GAPA(C1=__builtin_amdgcn_mfma_f32_32x32x16_bf16(kf[7],qr[3],C1,0,0,0),   P1[14],P1[15],0.f,0.f,       pw3[2]=PKW(P1,12),pw3[3]=PKW(P1,14), pw3); \
    l_reg+=sacc; \
    if(GK){DMA_K((t)+3,sl_cur);} if(GV){DMA_V((t)+2,VS((t)+2));} \
    MBIAS(C0,C1,t); \
    { float a=MX3(C0[0],C0[1],C1[0]),b=MX3(C0[2],C0[3],C1[1]); a=MX3(a,C1[2],C1[3]); \
      _Pragma("unroll") for(int r=4;r<16;r+=4){a=MX3(a,C0[r],C0[r+1]);b=MX3(b,C0[r+2],C0[r+3]);a=MX3(a,C1[r],C1[r+1]);b=MX3(b,C1[r+2],C1[r+3]);} \
      float rm=__builtin_fmaxf(a,b); { auto rr=__builtin_amdgcn_permlane32_swap(__float_as_uint(rm),__float_as_uint(rm),false,false); rm=__builtin_fmaxf(__uint_as_float(rr[0]),__uint_as_float(rr[1])); } \
      resc=false; \
      if(__builtin_expect(__any(rm>(float)THRL),0)){ const float dl=__builtin_fmaxf(rm,0.f); \
        _Pragma("unroll") for(int r=0;r<16;++r){C0[r]-=dl;C1[r]-=dl;} \
        _Pragma("unroll") for(int r=0;r<16;++r)negm[r]-=dl; asm volatile("":"+v"(negm)); \
        const float f=__builtin_amdgcn_exp2f(-dl); l_reg*=f; if(hi==0)wsf[r32]=f; resc=true; } } \
    SBAR(); \
    GAPB(o[0]=__builtin_amdgcn_mfma_f32_32x32x16_bf16(PAF(0),VFR(0),o[0],0,0,0), C0,0); \
    GAPB(o[1]=__builtin_amdgcn_mfma_f32_32x32x16_bf16(PAF(0),VFR(4),o[1],0,0,0), C0,4); \
    KRD(GL,0); GAPB(o[0]=__builtin_amdgcn_mfma_f32_32x32x16_bf16(PAF(1),VFR(1),o[0],0,0,0), C0,8); \
    KRD(GL,1); GAPB(o[1]=__builtin_amdgcn_mfma_f32_32x32x16_bf16(PAF(1),VFR(5),o[1],0,0,0), C0,12); \
    KRD(GL,2); GAPB(o[0]=__builtin_amdgcn_mfma_f32_32x32x16_bf16(PAF(2),VFR(2),o[0],0,0,0), C1,0); \
    KRD(GL,3); GAPB(o[1]=__builtin_amdgcn_mfma_f32_32x32x16_bf16(PAF(2),VFR(6),o[1],0,0,0), C1,4); \
    GAPB(o[0]=__builtin_amdgcn_mfma_f32_32x32x16_bf16(PAF(3),VFR(3),o[0],0,0,0), C1,8); \
    GAPB(o[1]=__builtin_amdgcn_mfma_f32_32x32x16_bf16(PAF(3),VFR(7),o[1],0,0,0), C1,12); \
    }while(0)
  int t=1;
  for(;t+5<NT;t+=2){
    STEP(pB0,pB1,pA0,pA1,t,true,true,true);     WAIT_BAR(3); RESC(); ROT();
    STEP(pA0,pA1,pB0,pB1,t+1,true,true,true);   WAIT_BAR(3); RESC(); ROT();
  }
  #define ENDW(tt) do{ if((tt)+3<NT){WAIT_BAR(3);} else if((tt)+2<NT){WAIT_BAR(2);} else {WAIT_BAR(0);} }while(0)
  for(;t+1<NT;t+=2){
    STEP(pB0,pB1,pA0,pA1,t,(t+3<NT),(t+2<NT),(t+1<NT));       ENDW(t);   RESC(); ROT();
    STEP(pA0,pA1,pB0,pB1,t+1,(t+4<NT),(t+3<NT),(t+2<NT));     ENDW(t+1); RESC(); ROT();
  }
  STEP(pB0,pB1,pA0,pA1,NT-1,false,false,false); RESC();
  { float sacc=pB0[0]+pB0[1]; _Pragma("unroll") for(int r=2;r<16;++r)sacc+=pB0[r]; _Pragma("unroll") for(int r=0;r<16;++r)sacc+=pB1[r]; l_reg+=sacc;
    pw0=(u32x4){PKW(pB0,0),PKW(pB0,2),PKW(pB0,4),PKW(pB0,6)};pw1=(u32x4){PKW(pB0,8),PKW(pB0,10),PKW(pB0,12),PKW(pB0,14)};pw2=(u32x4){PKW(pB1,0),PKW(pB1,2),PKW(pB1,4),PKW(pB1,6)};pw3=(u32x4){PKW(pB1,8),PKW(pB1,10),PKW(pB1,12),PKW(pB1,14)};
    SBAR(); pv(o,vb0+VS(NT-1),PAF(0),PAF(1),PAF(2),PAF(3)); }
  #undef PKW
  #undef PAF
  #undef VFR
  #undef PIN
  #undef MX3
  #undef GAPA
  #undef GAPB
  #undef EX
  #undef VRD
  #undef KRD
  #undef STEP
  #undef ENDW
  l_reg=xhalf_sum(l_reg);
  if(hi==0)wsf[32+r32]=l_reg;asm volatile("s_waitcnt lgkmcnt(0)":::"memory");
  float rli[16];
  #pragma unroll
  for(int r=0;r<16;++r)rli[r]=__builtin_amdgcn_rcpf(wsf[32+crow(r,hi)]);
  const bf16*Zw=Pz+(rowbase+q0+wid*QBLK)*PITCH+h*D; bf16*Ow=Po+(rowbase+q0+wid*QBLK)*PITCH+h*D;
  { bf16*stg=(bf16*)(shm+LDS_OST)+wid*2048;
    #pragma unroll
    for(int r=0;r<16;++r){const int orow=crow(r,hi);
      #pragma unroll
      for(int d0=0;d0<2;++d0)((unsigned short*)stg)[orow*64+d0*32+r32]=(unsigned short)cvtpk_s(o[d0][r]*rli[r],0.f);}
    asm volatile("s_waitcnt lgkmcnt(0)":::"memory");
    #pragma unroll
    for(int i=0;i<4;++i){const int row=i*8+(lane>>3),ch=lane&7; const u32x4 v=*(const u32x4*)(stg+row*64+ch*8);
      const u32x4 z=__builtin_nontemporal_load((const u32x4*)(Zw+(long)row*PITCH+ch*8)); u32x4*zp=(u32x4*)(Ow+(long)row*PITCH+ch*8); u32x4 w;
      w.x=cvtpk_s(bl(v.x)*bl(z.x),bh(v.x)*bh(z.x)); w.y=cvtpk_s(bl(v.y)*bl(z.y),bh(v.y)*bh(z.y)); w.z=cvtpk_s(bl(v.z)*bl(z.z),bh(v.z)*bh(z.z)); w.w=cvtpk_s(bl(v.w)*bl(z.w),bh(v.w)*bh(z.w));
      *zp=w; } }
  asm volatile("s_waitcnt lgkmcnt(0)\n\ts_barrier":::"memory");
  #undef DMA_K
  #undef DMA_V
  #undef VS
  #undef MBIAS
  #undef RESC
  #undef ROT
}
constexpr int ATTN_LDS_BYTES=LDS_BYTES;
#undef SBAR
#undef WAIT_BAR
}
namespace attna {
using moba::bf16; using moba::bf16x8; using moba::s16x4; using moba::f32x16; using moba::u32x4; using moba::lds_cptr;
using moba::crow; using moba::cvtpk_s; using moba::bl; using moba::bh; using moba::vtr; using moba::xhalf_sum;
constexpr int SEQ=2048,PITCH=4608;
constexpr int WK=0,WV=4608,WO=12800,WSC=16896,WBYTES=17152,LSE_OFF=8*WBYTES,LDS_BYTES=LSE_OFF+3*512*4;
#define AMFMA(a,b,c) __builtin_amdgcn_mfma_f32_32x32x16_bf16(a,b,c,0,0,0)

__device__ __forceinline__ void sub_item(bf16*P,int b,int hs,int g,int res,int l0,int chunk,char*wl,float*lse_l,int lane){
  asm volatile("":"+v"(lane));
  const int r32=lane&31,hi=lane>>5;
  const int dsh=2*g;
  const long rowb=(long)b*SEQ+res;
  const int qcol=g*768+hs*64;
  const float sl2=__builtin_amdgcn_exp2f(-(2.0f/3.0f)*(float)(4*g+hs+1))*(float)(1<<dsh)*1.4426950408889634f;
  #define AROW(l) ((rowb+((long)(l)<<dsh))*PITCH)
  #define KL(i,x) ((l0-128+32*(i)+(x))<0?0:(l0-128+32*(i)+(x)))
  const int i0=(l0>=128)?0:(4-(l0>>5));
  const int lrow=lane>>3, lch=lane&7;
  u32x4 qg[4],kg[5][4],vg[5][4];
  #pragma unroll
  for(int j=0;j<4;++j)qg[j]=*reinterpret_cast<const u32x4*>(P+AROW(l0+lrow+8*j)+qcol+lch*8);
  #pragma unroll
  for(int i=4;i>=0;--i)
    #pragma unroll
    for(int j=0;j<4;++j)kg[i][j]=*reinterpret_cast<const u32x4*>(P+AROW(KL(i,lrow+8*j))+qcol+256+lch*8);
  #pragma unroll
  for(int i=4;i>=0;--i)
    #pragma unroll
    for(int j=0;j<4;++j)vg[i][j]=*reinterpret_cast<const u32x4*>(P+AROW(KL(i,lrow+8*j))+qcol+512+lch*8);
  __builtin_amdgcn_sched_barrier(0);
  char*kb=wl+WK; const int kwoff=lrow*144+lch*16, kroff=r32*144+hi*16;
  bf16x8 qf[4];
  #pragma unroll
  for(int j=0;j<4;++j)*reinterpret_cast<u32x4*>(kb+kwoff+j*8*144)=qg[j];
  #pragma unroll
  for(int d0=0;d0<4;++d0)qf[d0]=*reinterpret_cast<const bf16x8*>(kb+kroff+d0*32);
  f32x16 S[5];
  #pragma unroll
  for(int i=4;i>=0;--i){
    #pragma unroll
    for(int j=0;j<4;++j)*reinterpret_cast<u32x4*>(kb+kwoff+j*8*144)=kg[i][j];
    bf16x8 kf[4];
    #pragma unroll
    for(int d0=0;d0<4;++d0)kf[d0]=*reinterpret_cast<const bf16x8*>(kb+kroff+d0*32);
    f32x16 acc=f32x16{};
    #pragma unroll
    for(int d0=0;d0<4;++d0)acc=AMFMA(kf[d0],qf[d0],acc);
    const float sbi=((i<i0)?-INFINITY:0.f)-sl2*(float)(32*(4-i)+r32-4*hi);
    #pragma unroll
    for(int r=0;r<16;++r){ const int kc=(r&3)+8*(r>>2); float v=__builtin_fmaf(sl2,(float)kc,acc[r]+sbi);
      if(i==4&&kc+4*hi>r32)v=-INFINITY; if(i==0&&kc+4*hi<r32)v=-INFINITY; acc[r]=v; }
    S[i]=acc;
  }
  float mx=-INFINITY;
  #pragma unroll
  for(int i=0;i<5;++i)
    #pragma unroll
    for(int r=0;r<16;++r)mx=fmaxf(mx,S[i][r]);
  { auto rr=__builtin_amdgcn_permlane32_swap(__float_as_uint(mx),__float_as_uint(mx),false,false); mx=fmaxf(__uint_as_float(rr[0]),__uint_as_float(rr[1])); }
  float ls=0.f;
  #pragma unroll
  for(int i=0;i<5;++i)
    #pragma unroll
    for(int r=0;r<16;++r){ const float p=__builtin_amdgcn_exp2f(S[i][r]-mx); S[i][r]=p; ls+=p; }
  ls=xhalf_sum(ls);
  f32x16 o[2]; o[0]=f32x16{}; o[1]=f32x16{};
  const lds_cptr wl3=(lds_cptr)wl;
  const int vtoff=((lane>>4)&1)*32+(lane&3)*8+(4*hi+((lane&15)>>2))*64;
  const int vwoff=(lch>>2)*2048+lrow*64+(lch&3)*16;
  #define PVSTEP(i) do{ char*vb_=wl+WV+((i)&1)*4096; \
      _Pragma("unroll") for(int j=0;j<4;++j)*reinterpret_cast<u32x4*>(vb_+vwoff+j*8*64)=vg[i][j]; \
      const u32x4 pw0=(u32x4){cvtpk_s(S[i][0],S[i][1]),cvtpk_s(S[i][2],S[i][3]),cvtpk_s(S[i][4],S[i][5]),cvtpk_s(S[i][6],S[i][7])}; \
      const u32x4 pw1=(u32x4){cvtpk_s(S[i][8],S[i][9]),cvtpk_s(S[i][10],S[i][11]),cvtpk_s(S[i][12],S[i][13]),cvtpk_s(S[i][14],S[i][15])}; \
      const lds_cptr vp=wl3+WV+((i)&1)*4096+vtoff; \
      _Pragma("unroll") for(int d0=0;d0<2;++d0){ \
        const s16x4 a0=vtr(vp+d0*2048),a1=vtr(vp+d0*2048+512),b0=vtr(vp+d0*2048+1024),b1=vtr(vp+d0*2048+1536); \
        const bf16x8 f0=(bf16x8){a0[0],a0[1],a0[2],a0[3],a1[0],a1[1],a1[2],a1[3]}, f1=(bf16x8){b0[0],b0[1],b0[2],b0[3],b1[0],b1[1],b1[2],b1[3]}; \
        o[d0]=AMFMA(__builtin_bit_cast(bf16x8,pw0),f0,o[d0]); \
        o[d0]=AMFMA(__builtin_bit_cast(bf16x8,pw1),f1,o[d0]); } }while(0)
  PVSTEP(4); PVSTEP(3); PVSTEP(2); PVSTEP(1); PVSTEP(0);
  float*ws=(float*)(wl+WSC);
  const int tokc=((l0+r32)<<dsh)+res-chunk*512;
  if(hi==0){ ws[r32]=__builtin_amdgcn_rcpf(ls); lse_l[g*512+tokc]=mx+__builtin_amdgcn_logf(ls); }
  bf16*stg=(bf16*)(wl+WO);
  #pragma unroll
  for(int r=0;r<16;++r){ const int orow=crow(r,hi); const float il=ws[orow];
    #pragma unroll
    for(int d0=0;d0<2;++d0)((unsigned short*)stg)[orow*64+d0*32+r32]=(unsigned short)cvtpk_s(o[d0][r]*il,0.f); }
  #pragma unroll
  for(int i=0;i<4;++i){ const int row=i*8+(lane>>3),ch=lane&7; const u32x4 v=*reinterpret_cast<const u32x4*>(stg+row*64+ch*8);
    *reinterpret_cast<u32x4*>(P+AROW(l0+row)+qcol+ch*8)=v; }
  #undef AROW
  #undef KL
  #undef PVSTEP
}

__device__ __forceinline__ void wg_item(bf16*P,int b,int hs,int chunk,char*shm){
  int tid_=threadIdx.x; asm volatile("":"+v"(tid_));
  const int tid=tid_,lane=tid&63; const int wid=__builtin_amdgcn_readfirstlane(tid>>6);
  char*wl=shm+wid*WBYTES; float*lse_l=(float*)(shm+LSE_OFF);
  #pragma unroll 1
  for(int i6=0;i6<6;++i6){
    const int si=wid+8*i6, g=si>>4, k=si&15;
    int res,l0;
    if(g==0){res=0;l0=32*(chunk*16+k);} else if(g==1){res=k>>2;l0=128*chunk+32*(k&3);} else {res=k;l0=32*chunk;}
    sub_item(P,b,hs,g,res,l0,chunk,wl,lse_l,lane);
  }
  __syncthreads();
  #pragma unroll
  for(int idx=tid;idx<512*8;idx+=512){
    const int tok=idx>>3,ch=idx&7; const long row=((long)b*SEQ+chunk*512+tok)*PITCH;
    const float e0=lse_l[tok],e1=lse_l[512+tok],e2=lse_l[1024+tok]; const float em=fmaxf(e0,fmaxf(e1,e2));
    float w0=__builtin_amdgcn_exp2f(e0-em),w1=__builtin_amdgcn_exp2f(e1-em),w2=__builtin_amdgcn_exp2f(e2-em); const float iw=__builtin_amdgcn_rcpf(w0+w1+w2); w0*=iw;w1*=iw;w2*=iw;
    const u32x4 a=*reinterpret_cast<const u32x4*>(P+row+hs*64+ch*8), bq=*reinterpret_cast<const u32x4*>(P+row+768+hs*64+ch*8), cq=*reinterpret_cast<const u32x4*>(P+row+1536+hs*64+ch*8);
    u32x4*zp=reinterpret_cast<u32x4*>(P+row+2304+hs*64+ch*8); const u32x4 z=__builtin_nontemporal_load(zp); u32x4 w;
    #define CMB(f) cvtpk_s((w0*bl(a.f)+w1*bl(bq.f)+w2*bl(cq.f))*bl(z.f),(w0*bh(a.f)+w1*bh(bq.f)+w2*bh(cq.f))*bh(z.f))
    w.x=CMB(x); w.y=CMB(y); w.z=CMB(z); w.w=CMB(w);
    #undef CMB
    *zp=w;
  }
  __syncthreads();
}
#undef AMFMA
}

constexpr int NWAVES = 8;
constexpr int BATCH = 16, SEQ = 2048, DM = 1024, M = BATCH * SEQ, DEPTH = 2;
constexpr int INC = 6656;
constexpr int LDP = 4608;
constexpr int C_AQKV = 0, C_ZA = 2304, C_BQKV = 2560, C_ZB = 4096, C_RA = 4608, C_RB = 5632;
constexpr int C_MERGED = 0;
constexpr float RMS_EPS = 1e-6f;
constexpr size_t MiB = 1u << 20;
constexpr size_t WS_CTL = 0;
constexpr size_t WS_BAR = 0, WS_BAR_BYTES = 64 * 1024;
constexpr size_t WS_KMEAN = 256 * 1024;
constexpr size_t WS_WIN = 1 * MiB;
constexpr size_t WS_WCAT = 14 * MiB;
constexpr size_t WS_WOUT = 17 * MiB;
constexpr size_t WS_XB = 21 * MiB;
constexpr size_t WS_PROJ = 85 * MiB;
constexpr size_t WS_GATES = 373 * MiB;
constexpr size_t WS_WIN1 = 437 * MiB;
constexpr size_t WS_ROWSS = 450 * MiB;
constexpr size_t WS_XB8 = 454 * MiB;
constexpr size_t WS_W8 = 486 * MiB;
constexpr size_t WS_COLMAX = 32 * 1024;
constexpr size_t WS_XSCALE = 128 * 1024;
constexpr size_t WS_END = 493 * MiB;
static_assert(WS_PROJ + (size_t)M * LDP * 2 == WS_GATES && WS_GATES + (size_t)M * 2048 == WS_WIN1, "ws map");
constexpr int LDS_MISC = pg8::EPI_OFF + 8 * pg8::EPI_WAVE;
constexpr int LDS_RSTAB = LDS_MISC + 256;
constexpr int LDS_BYTES = LDS_RSTAB + 1024 + 64;

#define LAS __attribute__((address_space(3)))
typedef unsigned short bf16;
typedef unsigned v4u __attribute__((ext_vector_type(4)));
typedef float f32x4 __attribute__((ext_vector_type(4)));
#define RLX_AGENT __ATOMIC_RELAXED, __HIP_MEMORY_SCOPE_AGENT
#define XB_TMO      128
#define XB_XCNT(j)  (256  + 64 * (j))
#define XB_XSUB(j)  (1280 + 64 * (j))
#define XB_XGEN(j)  (2304 + 64 * (j))
#define XB_TOP      3328
#define XB_TOPGEN   3392
#define XCD_BAR_WORDS 3456
#define XB_SPIN_CAP (1u << 18)

__device__ __forceinline__ unsigned xb_ld(unsigned* p)              { return __hip_atomic_load(p, __ATOMIC_RELAXED, __HIP_MEMORY_SCOPE_AGENT); }
__device__ __forceinline__ unsigned xb_add(unsigned* p, unsigned v) { return __hip_atomic_fetch_add(p, v, __ATOMIC_RELAXED, __HIP_MEMORY_SCOPE_AGENT); }
__device__ __forceinline__ unsigned xb_xcc_id() { return (unsigned)__builtin_amdgcn_s_getreg((3 << 11) | 20) & 0xFu; }
#define XB_SPIN(cond, bar) do { unsigned _sp = 0; while (cond) { __builtin_amdgcn_s_sleep(1); \
    if ((++_sp & 255u) == 0u) { if (xb_ld(&(bar)[XB_TMO])) break; if (_sp > XB_SPIN_CAP) { atomicAdd(&(bar)[XB_TMO], 1u); break; } } } } while (0)

struct XcdBarrier {
    unsigned* bar; unsigned x;
    volatile LAS unsigned* st;
};

__device__ __forceinline__ XcdBarrier xcd_barrier_post(unsigned* bar, volatile LAS unsigned* st) {
    XcdBarrier b; b.bar = bar; b.x = xb_xcc_id(); b.st = st;
    if (threadIdx.x == 0) (void)xb_add(&bar[XB_XCNT(b.x)], 1u);
    return b;
}
__device__ __forceinline__ void xcd_barrier_complete(unsigned* bar, unsigned x, unsigned& nloc, unsigned& nx) {
    const unsigned G = gridDim.x * gridDim.y * gridDim.z;
    unsigned sum, cnt, mine, sp = 0u;
    for (;;) {
        sum = 0u; cnt = 0u; mine = 0u;
#pragma unroll
        for (unsigned j = 0; j < 16; ++j) { const unsigned c = xb_ld(&bar[XB_XCNT(j)]); sum += c; cnt += (c > 0u) ? 1u : 0u; mine = (j == x) ? c : mine; }
        if (sum == G) break;
        __builtin_amdgcn_s_sleep(1);
        if ((++sp & 255u) == 0u) { if (xb_ld(&bar[XB_TMO])) break; if (sp > XB_SPIN_CAP) { atomicAdd(&bar[XB_TMO], 1u); break; } }
    }
    nloc = mine > 0u ? mine : 1u; nx = cnt > 0u ? cnt : 1u;
}

__device__ __forceinline__ void xcd_barrier(const XcdBarrier& b) {
    asm volatile("s_waitcnt vmcnt(0)" ::: "memory");
    __syncthreads();
    if (threadIdx.x == 0) {
        unsigned* bar = b.bar;
        __builtin_amdgcn_s_waitcnt(0);
        unsigned nloc = b.st[0], nx = b.st[1];
        if (nloc == 0u) { xcd_barrier_complete(bar, b.x, nloc, nx); b.st[0] = nloc; b.st[1] = nx; }
        const unsigned old = xb_add(&bar[XB_XSUB(b.x)], 1u);
        const unsigned gen = old / nloc;
        if (old + 1u == (gen + 1u) * nloc) {
            __builtin_amdgcn_fence(__ATOMIC_RELEASE, "agent");
            asm volatile("s_waitcnt vmcnt(0)" ::: "memory");
            const unsigned og = xb_add(&bar[XB_TOP], 1u);
            const unsigned tg = og / nx;
            if (og + 1u == (tg + 1u) * nx) xb_add(&bar[XB_TOPGEN], 1u);
            else XB_SPIN(xb_ld(&bar[XB_TOPGEN]) == tg, bar);
            __builtin_amdgcn_fence(__ATOMIC_ACQUIRE, "agent");
            xb_add(&bar[XB_XGEN(b.x)], 1u);
            asm volatile("s_waitcnt vmcnt(0)" ::: "memory");
        } else {
            XB_SPIN(xb_ld(&bar[XB_XGEN(b.x)]) == gen, bar);
            __builtin_amdgcn_fence(__ATOMIC_ACQUIRE, "agent");
            asm volatile("s_waitcnt vmcnt(0)" ::: "memory");
        }
    }
    __syncthreads();
}

__device__ __forceinline__ unsigned f2bf(float f) { unsigned u = __builtin_bit_cast(unsigned, f); return (u + 0x7fffu + ((u >> 16) & 1u)) >> 16; }
__device__ __forceinline__ unsigned pk2(float lo, float hi) { return f2bf(lo) | (f2bf(hi) << 16); }
__device__ __forceinline__ float bf2f(bf16 v) { return __uint_as_float(((unsigned)v) << 16); }
__device__ __forceinline__ float blo(unsigned u) { return __uint_as_float(u << 16); }
__device__ __forceinline__ float bhi(unsigned u) { return __uint_as_float(u & 0xffff0000u); }
__device__ __forceinline__ float wave_sum(float v) {
#pragma unroll
    for (int o = 1; o < 64; o <<= 1) v += __shfl_xor(v, o);
    return v;
}
__device__ __forceinline__ float wave_max(float v) {
#pragma unroll
    for (int o = 1; o < 64; o <<= 1) v = fmaxf(v, __shfl_xor(v, o));
    return v;
}
__device__ __forceinline__ void transpose_item(const float* W, int K, int N, bf16* WT, int ldw, LAS float* scr, int item, int lane, const float* gain = nullptr, int nsrc = -1) {
    const int nblk = N / 32, kb = item / nblk, nb = item % nblk, k0 = 64 * kb, n0 = 32 * nb; W += (nsrc >= 0 ? nsrc - n0 : 0);
    f32x4 v[8]; float gk[8];
#pragma unroll
    for (int i = 0; i < 8; ++i) { const int kk = 8 * i + (lane >> 3); v[i] = __builtin_nontemporal_load((const f32x4*)(W + (size_t)(k0 + kk) * N + n0 + 4 * (lane & 7))); gk[i] = gain ? gain[k0 + kk] : 1.0f; }
#pragma unroll
    for (int i = 0; i < 8; ++i) { const int kk = 8 * i + (lane >> 3); LAS float* d = scr + kk * 33 + 4 * (lane & 7); d[0] = v[i].x * gk[i]; d[1] = v[i].y * gk[i]; d[2] = v[i].z * gk[i]; d[3] = v[i].w * gk[i]; }
    asm volatile("s_waitcnt lgkmcnt(0)" ::: "memory");
    const int c = lane & 7;
#pragma unroll
    for (int j = 0; j < 4; ++j) { const int n = (lane >> 3) + 8 * j; const LAS float* s = scr + (8 * c) * 33 + n;
        v4u o; o.x = pk2(s[0 * 33], s[1 * 33]); o.y = pk2(s[2 * 33], s[3 * 33]); o.z = pk2(s[4 * 33], s[5 * 33]); o.w = pk2(s[6 * 33], s[7 * 33]);
        *(v4u*)(WT + (size_t)(n0 + n) * ldw + k0 + 8 * c) = o; }
    asm volatile("s_waitcnt lgkmcnt(0)" ::: "memory");
}
template <bool OUT_BF16> __device__ __forceinline__ void rms_row(const float* xrow, const float* g, void* orow, int lane) {
    const f32x4* xr = (const f32x4*)xrow + lane; const f32x4* gr = (const f32x4*)g + lane;
    f32x4 v[4]; float s = 0.f;
#pragma unroll
    for (int j = 0; j < 4; ++j) { v[j] = xr[64 * j]; s += (v[j].x * v[j].x + v[j].y * v[j].y) + (v[j].z * v[j].z + v[j].w * v[j].w); }
    const float rstd = 1.0f / sqrtf(wave_sum(s) * (1.f / DM) + RMS_EPS);
#pragma unroll
    for (int j = 0; j < 4; ++j) { const f32x4 gg = gr[64 * j]; v[j] = v[j] * rstd * gg; }
    if (OUT_BF16) { unsigned long long* o8 = (unsigned long long*)orow + lane;
#pragma unroll
        for (int j = 0; j < 4; ++j) o8[64 * j] = (unsigned long long)pk2(v[j].x, v[j].y) | ((unsigned long long)pk2(v[j].z, v[j].w) << 32);
    } else { f32x4* o = (f32x4*)orow + lane;
#pragma unroll
        for (int j = 0; j < 4; ++j) o[64 * j] = v[j]; }
}
__device__ __forceinline__ unsigned pack_i8x4(float a, float b, float c, float d) {
    const int ia = (int)__builtin_rintf(fminf(fmaxf(a, -127.f), 127.f)), ib = (int)__builtin_rintf(fminf(fmaxf(b, -127.f), 127.f)), ic = (int)__builtin_rintf(fminf(fmaxf(c, -127.f), 127.f)), id = (int)__builtin_rintf(fminf(fmaxf(d, -127.f), 127.f));
    return (unsigned)(ia & 255) | ((unsigned)(ib & 255) << 8) | ((unsigned)(ic & 255) << 16) | ((unsigned)(id & 255) << 24);
}
__device__ __forceinline__ void raw_row(const float* xrow, bf16* orow, float* ss, signed char* o8row, float* xs, int lane) {
    const f32x4* xr = (const f32x4*)xrow + lane; f32x4 v[4]; float s = 0.f, mx = 0.f;
#pragma unroll
    for (int j = 0; j < 4; ++j) { v[j] = __builtin_nontemporal_load(xr + 64 * j); s += (v[j].x * v[j].x + v[j].y * v[j].y) + (v[j].z * v[j].z + v[j].w * v[j].w);
        mx = fmaxf(mx, fmaxf(fmaxf(fabsf(v[j].x), fabsf(v[j].y)), fmaxf(fabsf(v[j].z), fabsf(v[j].w)))); }
    s = wave_sum(s); if (lane < 16) ss[lane] = (lane == 0) ? s : 0.f;
    mx = wave_max(mx); const float sc = mx > 0.f ? mx * (1.0f / 127.0f) : 1.0f, isc = 1.0f / sc; if (lane == 0) *xs = sc;
    unsigned long long* o8 = (unsigned long long*)orow + lane; unsigned* q8 = (unsigned*)o8row + lane;
#pragma unroll
    for (int j = 0; j < 4; ++j) { o8[64 * j] = (unsigned long long)pk2(v[j].x, v[j].y) | ((unsigned long long)pk2(v[j].z, v[j].w) << 32);
        q8[64 * j] = pack_i8x4(v[j].x * isc, v[j].y * isc, v[j].z * isc, v[j].w * isc); }
}
__device__ __forceinline__ void quant_row(const bf16* xrow, signed char* o8row, float* xs, int lane) {
    typedef unsigned u32x2_t __attribute__((ext_vector_type(2)));
    const u32x2_t* xr = (const u32x2_t*)xrow + lane; u32x2_t b[4]; float mx = 0.f;
#pragma unroll
    for (int j = 0; j < 4; ++j) { b[j] = xr[64 * j]; mx = fmaxf(mx, fmaxf(fmaxf(fabsf(blo(b[j].x)), fabsf(bhi(b[j].x))), fmaxf(fabsf(blo(b[j].y)), fabsf(bhi(b[j].y))))); }
    mx = wave_max(mx); const float sc = mx > 0.f ? mx * (1.0f / 127.0f) : 1.0f, isc = 1.0f / sc; if (lane == 0) *xs = sc;
    unsigned* q8 = (unsigned*)o8row + lane;
#pragma unroll
    for (int j = 0; j < 4; ++j) q8[64 * j] = pack_i8x4(blo(b[j].x) * isc, bhi(b[j].x) * isc, blo(b[j].y) * isc, bhi(b[j].y) * isc);
}
__device__ __forceinline__ void quant_strip_wg(const float* W, const float* gain, signed char* W8, float* wscale, LAS float* scr, LAS float* cmw, int strip, int lane, int wave) {
    const int n0 = 32 * strip; const int tj = n0 >> 8; const int src0 = n0 < 1536 ? 256 * (tj + (tj >> 1)) + (n0 & 255) : 4608 + (n0 - 1536);
    const float* Wc = W + src0 + 4 * (lane & 7);
    f32x4 v[2][8]; float gk[2][8]; f32x4 m4 = (f32x4){0.f, 0.f, 0.f, 0.f};
#pragma unroll
    for (int q = 0; q < 2; ++q)
#pragma unroll
        for (int i = 0; i < 8; ++i) { const int kk = 64 * (2 * wave + q) + 8 * i + (lane >> 3); v[q][i] = *(const f32x4*)(Wc + (size_t)kk * INC); gk[q][i] = gain[kk]; }
#pragma unroll
    for (int q = 0; q < 2; ++q)
#pragma unroll
        for (int i = 0; i < 8; ++i) { v[q][i] = v[q][i] * gk[q][i]; m4.x = fmaxf(m4.x, fabsf(v[q][i].x)); m4.y = fmaxf(m4.y, fabsf(v[q][i].y)); m4.z = fmaxf(m4.z, fabsf(v[q][i].z)); m4.w = fmaxf(m4.w, fabsf(v[q][i].w)); }
#pragma unroll
    for (int o = 8; o < 64; o <<= 1) { m4.x = fmaxf(m4.x, __shfl_xor(m4.x, o)); m4.y = fmaxf(m4.y, __shfl_xor(m4.y, o)); m4.z = fmaxf(m4.z, __shfl_xor(m4.z, o)); m4.w = fmaxf(m4.w, __shfl_xor(m4.w, o)); }
    if (lane < 8) { LAS float* c = cmw + wave * 32 + 4 * lane; c[0] = m4.x; c[1] = m4.y; c[2] = m4.z; c[3] = m4.w; }
    __syncthreads();
    const int n = lane & 31, kh = lane >> 5; float cmx = 0.f;
#pragma unroll
    for (int w = 0; w < 8; ++w) cmx = fmaxf(cmx, cmw[w * 32 + n]);
    const float sc = cmx > 0.f ? cmx * (1.0f / 127.0f) : 1.0f, isc = 1.0f / sc;
    if (wave == 0 && kh == 0) wscale[n0 + n] = sc;
#pragma unroll
    for (int q = 0; q < 2; ++q) {
#pragma unroll
        for (int i = 0; i < 8; ++i) { const int kk = 8 * i + (lane >> 3); LAS float* d = scr + kk * 33 + 4 * (lane & 7); d[0] = v[q][i].x; d[1] = v[q][i].y; d[2] = v[q][i].z; d[3] = v[q][i].w; }
        asm volatile("s_waitcnt lgkmcnt(0)" ::: "memory");
        const LAS float* s = scr + (32 * kh) * 33 + n; v4u o0, o1;
        o0.x = pack_i8x4(s[0 * 33] * isc, s[1 * 33] * isc, s[2 * 33] * isc, s[3 * 33] * isc); o0.y = pack_i8x4(s[4 * 33] * isc, s[5 * 33] * isc, s[6 * 33] * isc, s[7 * 33] * isc);
        o0.z = pack_i8x4(s[8 * 33] * isc, s[9 * 33] * isc, s[10 * 33] * isc, s[11 * 33] * isc); o0.w = pack_i8x4(s[12 * 33] * isc, s[13 * 33] * isc, s[14 * 33] * isc, s[15 * 33] * isc);
        o1.x = pack_i8x4(s[16 * 33] * isc, s[17 * 33] * isc, s[18 * 33] * isc, s[19 * 33] * isc); o1.y = pack_i8x4(s[20 * 33] * isc, s[21 * 33] * isc, s[22 * 33] * isc, s[23 * 33] * isc);
        o1.z = pack_i8x4(s[24 * 33] * isc, s[25 * 33] * isc, s[26 * 33] * isc, s[27 * 33] * isc); o1.w = pack_i8x4(s[28 * 33] * isc, s[29 * 33] * isc, s[30 * 33] * isc, s[31 * 33] * isc);
        v4u* dst = (v4u*)(W8 + (size_t)(n0 + n) * 1024 + 64 * (2 * wave + q) + 32 * kh); dst[0] = o0; dst[1] = o1;
        asm volatile("s_waitcnt lgkmcnt(0)" ::: "memory");
    }
    __syncthreads();
}
__device__ __forceinline__ float dot64(const v4u (&q)[8], const bf16* krow) {
    const v4u* kp = (const v4u*)krow; float a0 = 0.f, a1 = 0.f;
#pragma unroll
    for (int i = 0; i < 8; ++i) { const v4u k = kp[i];
        a0 += blo(q[i].x) * blo(k.x) + blo(q[i].y) * blo(k.y) + blo(q[i].z) * blo(k.z) + blo(q[i].w) * blo(k.w);
        a1 += bhi(q[i].x) * bhi(k.x) + bhi(q[i].y) * bhi(k.y) + bhi(q[i].z) * bhi(k.z) + bhi(q[i].w) * bhi(k.w); }
    return a0 + a1;
}

struct Args { const float* x; const float* norm_g; const float* w_in; const float* b_merge; const float* w_pa; const float* w_pb; const float* w_out; const float* final_g;
              float* out; unsigned char* ws; };

#define PHASE_VARS() \
    int tid_ = threadIdx.x; asm volatile("" : "+v"(tid_)); \
    const int lane = tid_ & 63, wave = __builtin_amdgcn_readfirstlane(tid_ >> 6); \
    const int G = gridDim.x, gw = blockIdx.x * NWAVES + wave, NGW = G * NWAVES; \
    unsigned long long wsb_ = (unsigned long long)a.ws; asm volatile("" : "+s"(wsb_)); \
    unsigned char* const ws = (unsigned char*)(__attribute__((address_space(1))) unsigned char*)wsb_;     \
    bf16* const Win = (bf16*)(ws + (layer == 0 ? WS_WIN : WS_WIN1)); float* const rowss = (float*)(ws + WS_ROWSS); signed char* const XB8 = (signed char*)(ws + WS_XB8); signed char* const W8 = (signed char*)(ws + WS_W8); float* const wscale = (float*)(ws + WS_COLMAX); float* const xscale = (float*)(ws + WS_XSCALE); bf16* const Wcat = (bf16*)(ws + WS_WCAT); bf16* const Wout = (bf16*)(ws + WS_WOUT); \
    bf16* const XB = (bf16*)(ws + WS_XB); bf16* const P = (bf16*)(ws + WS_PROJ); float* const kmean = (float*)(ws + WS_KMEAN); unsigned char* const gatesb = ws + WS_GATES; \
    (void)lane; (void)wave; (void)G; (void)gw; (void)NGW; (void)Win; (void)Wcat; (void)Wout; (void)rowss; (void)XB8; (void)W8; (void)wscale; (void)xscale; (void)XB; (void)P; (void)kmean; (void)gatesb;

#define GRID_BAR() do { unsigned long long wb_ = (unsigned long long)a.ws; asm volatile("" : "+s"(wb_)); XcdBarrier bb_; bb_.bar = (unsigned*)(__attribute__((address_space(1))) unsigned*)wb_; \
    bb_.x = xb_xcc_id(); bb_.st = (volatile LAS unsigned*)(L + LDS_MISC); xcd_barrier(bb_); } while (0)
template <int layer> __device__ __forceinline__ void layer_fwd(const Args& a, unsigned char* lds, LAS unsigned char* L) {
    if (layer == 0) {
        PHASE_VARS();
        LAS float* scr = (LAS float*)(L + wave * 16384);
        constexpr int I_IN = (DM / 64) * (3072 / 32), I_PA = (256 / 64) * (DM / 32), I_PB = (512 / 64) * (DM / 32), I_OUT = (DM / 64) * (DM / 32);
        const int nitems = 2 * (I_IN + I_PA + I_PB + I_OUT);
        for (int it = gw; it < nitems; it += NGW) {
            const int l2 = it / (I_IN + I_PA + I_PB + I_OUT); int r = it - l2 * (I_IN + I_PA + I_PB + I_OUT);
            if (r < I_IN) { const int kb_ = r / 96, nb_ = r % 96, tj_ = nb_ >> 3, tl_ = tj_ < 3 ? 3 * tj_ + 2 : tj_ + 6;
                transpose_item(a.w_in + (size_t)l2 * DM * INC, DM, INC, (bf16*)(ws + (l2 == 0 ? WS_WIN : WS_WIN1)), DM, scr, kb_ * (INC / 32) + nb_, lane, a.norm_g + l2 * DM, 256 * tl_ + 32 * (nb_ & 7)); continue; } r -= I_IN;
            if (r < I_PA) { transpose_item(a.w_pa + (size_t)l2 * 256 * DM, 256, DM, Wcat + (size_t)l2 * DM * 768, 768, scr, r, lane); continue; } r -= I_PA;
            if (r < I_PB) { transpose_item(a.w_pb + (size_t)l2 * 512 * DM, 512, DM, Wcat + (size_t)l2 * DM * 768 + 256, 768, scr, r, lane); continue; } r -= I_PB;
            transpose_item(a.w_out + (size_t)l2 * DM * DM, DM, DM, Wout + (size_t)l2 * DM * DM, DM, scr, r, lane);
        }
        for (int i = gw * 64 + lane; i < 2 * 128 * 512; i += NGW * 64) kmean[i] = 0.f;
        for (int it = (int)blockIdx.x; it < 2 * 112; it += G) { const int l2 = it / 112;
            quant_strip_wg(a.w_in + (size_t)l2 * DM * INC, a.norm_g + l2 * DM, W8 + (size_t)l2 * 3584 * 1024, wscale + l2 * 3584, scr, (LAS float*)(L + 12288), it % 112, lane, wave); }
        for (int m = gw; m < M; m += NGW) raw_row(a.x + (size_t)m * DM, XB + (size_t)m * DM, rowss + (size_t)m * 16, XB8 + (size_t)m * DM, xscale + m, lane);
    }
    if (layer == 0) GRID_BAR();
    if (layer == 1) {
        PHASE_VARS();
        for (int m = gw; m < M; m += NGW) quant_row(XB + (size_t)m * DM, XB8 + (size_t)m * DM, xscale + m, lane);
    }
    if (layer == 1) GRID_BAR();
    {
        PHASE_VARS();
        if (threadIdx.x == 0) ((LAS int*)(L + LDS_RSTAB))[256] = -1;
        __syncthreads();
        {
            pg8::Gemm g8{(const pg8::bf16_t*)XB8, (const pg8::bf16_t*)(W8 + (size_t)layer * 3584 * 1024), M, 1536, 512, 512}; pg8::StaticOrder S8; S8.init(M, 1536, G, (int)blockIdx.x);
            pg8::EpiProjQ8 E8{P, LDP, wscale + layer * 3584, xscale, rowss + (size_t)layer * M * 16};
            pg8::gemm_phase<pg8::EpiProjQ8, pg8::StaticOrder, true, true>(L, g8, S8, E8);
        }
        if (threadIdx.x == 0) ((LAS int*)(L + LDS_RSTAB))[256] = -1;
        __syncthreads();
        pg8::Gemm g{XB, Win, M, 3072, DM, DM}; pg8::StaticOrder S; S.init(M, 3072, G, (int)blockIdx.x);
        pg8::EpiProj E{P, LDP, kmean + layer * 128 * 512, rowss + (size_t)layer * M * 16};
        pg8::gemm_phase<pg8::EpiProj, pg8::StaticOrder, true, true>(L, g, S, E);
    }
    GRID_BAR();
    {
        PHASE_VARS();
        const int vcu = (G % 8 == 0) ? ((int)blockIdx.x % 8) * (G / 8) + (int)blockIdx.x / 8 : (int)blockIdx.x;
#pragma unroll 1
        for (int pass = 0; pass < 2; ++pass) {
            if ((pass ^ (vcu >> 2)) & 1) {
                for (int it = (int)blockIdx.x; it < BATCH * 4 * 4; it += G) attna::wg_item((attna::bf16*)P, it >> 4, (it >> 2) & 3, it & 3, (char*)lds);
            } else {
                for (int p = vcu; p < BATCH * 8 * 4; p += G) {
                    const int bh = p >> 2, s = p & 3;
#pragma unroll 1
                    for (int u = 0; u < 2; ++u)
                        moba::moba_unit<8>(bh >> 3, bh & 7, u ? 7 - s : s, (const moba::bf16*)(P + C_BQKV), (const moba::bf16*)(P + C_BQKV + 512), (const moba::bf16*)(P + C_BQKV + 1024), (const moba::bf16*)(P + C_ZB), (moba::bf16*)(P + C_BQKV), kmean + layer * 128 * 512, (char*)lds);
                }
            }
        }
    }
    GRID_BAR();
    {
        PHASE_VARS();
        pg8::StaticOrder S; S.init(M, DM, G, (int)blockIdx.x);
        {
            struct GateOrder { pg8::StaticOrder S;
                __device__ __forceinline__ bool next(int i, pg8::Unit& u) const { if (!S.next(i >> 1, u)) return false; u.pn += 4 * (i & 1); return true; }
                __device__ __forceinline__ void a_ready(const pg8::Unit&) const {} __device__ __forceinline__ void done(const pg8::Unit&) const {} } GS{S};
            if (threadIdx.x == 0) ((LAS int*)(L + LDS_RSTAB))[256] = -1;
            __syncthreads();
            pg8::Gemm gg{(const pg8::bf16_t*)XB8, (const pg8::bf16_t*)(W8 + ((size_t)layer * 3584 + 1536) * 1024), M, 2048, 512, 512};
            pg8::EpiGate EG{a.b_merge + layer * 2 * DM, wscale + layer * 3584 + 1536, xscale, rowss + (size_t)layer * M * 16, gatesb};
            pg8::gemm_phase<pg8::EpiGate, GateOrder, true, true>(L, gg, GS, EG);
        }
        pg8::Gemm g{P + C_ZA, Wcat + (size_t)layer * DM * 768, M, DM, 768, LDP}; pg8::EpiMerge E{P + C_MERGED, gatesb, LDP};
        pg8::gemm_phase<pg8::EpiMerge, pg8::StaticOrder, true, true>(L, g, S, E);
    }
    GRID_BAR();
    {
        PHASE_VARS();
        pg8::Gemm g{P + C_MERGED, Wout + (size_t)layer * DM * DM, M, DM, DM, LDP}; pg8::StaticOrder S; S.init(M, DM, G, (int)blockIdx.x);
        pg8::EpiResid<layer> E{a.x, XB, rowss + (layer == 0 ? (size_t)M * 16 : 0), DM};
        pg8::gemm_phase<pg8::EpiResid<layer>, pg8::StaticOrder, true, true>(L, g, S, E);
    }
    GRID_BAR();
}

__global__ void __launch_bounds__(NWAVES * 64, 2) hybrid_fwd(Args a) {
    extern __shared__ __attribute__((aligned(16))) unsigned char lds[];
    LAS unsigned char* L = (LAS unsigned char*)lds;
    if (threadIdx.x < 16) ((LAS unsigned*)(L + LDS_MISC))[threadIdx.x] = 0u;
    __syncthreads();
    (void)xcd_barrier_post((unsigned*)a.ws, (volatile LAS unsigned*)(L + LDS_MISC));
    layer_fwd<0>(a, lds, L);
    layer_fwd<1>(a, lds, L);
    {
        constexpr int layer = 1; (void)layer;
        PHASE_VARS();
        typedef unsigned u32x2_t __attribute__((ext_vector_type(2)));
        f32x4 gg[4];
#pragma unroll
        for (int j = 0; j < 4; ++j) gg[j] = *((const f32x4*)a.final_g + lane + 64 * j);
        for (int m = gw; m < M; m += NGW) {
            const f32x4* pp = (const f32x4*)(rowss + (size_t)m * 16); const f32x4 s4 = (pp[0] + pp[1]) + (pp[2] + pp[3]);
            const float rstd = __builtin_amdgcn_rsqf(((s4[0] + s4[1]) + (s4[2] + s4[3])) * (1.0f / 1024.0f) + RMS_EPS);
            const u32x2_t* xb = (const u32x2_t*)(XB + (size_t)m * DM) + lane; f32x4* o = (f32x4*)(a.out + (size_t)m * DM) + lane;
            u32x2_t bv[4];
#pragma unroll
            for (int j = 0; j < 4; ++j) bv[j] = __builtin_nontemporal_load(xb + 64 * j);
#pragma unroll
            for (int j = 0; j < 4; ++j) __builtin_nontemporal_store((f32x4){blo(bv[j].x), bhi(bv[j].x), blo(bv[j].y), bhi(bv[j].y)} * rstd * gg[j], o + 64 * j);
        }
    }
}

extern "C" void kernel_launch(void* const* d_in, const int* in_sizes, int n_in, void* d_out, int out_size, void* d_ws, size_t ws_size, hipStream_t stream) {
    static int grid = 0;
    if (grid == 0) {
        if (n_in != 8 || in_sizes[0] != M * DM || out_size != M * DM || ws_size < WS_END) { fprintf(stderr, "kernel_launch: unexpected shapes / workspace (n_in %d, ws %zu)\n", n_in, ws_size); grid = -1; return; }
        int dev = 0, cus = 0, per_cu = 0;
        hipGetDevice(&dev); hipDeviceGetAttribute(&cus, hipDeviceAttributeMultiprocessorCount, dev);
        if (hipFuncSetAttribute((const void*)hybrid_fwd, hipFuncAttributeMaxDynamicSharedMemorySize, LDS_BYTES) != hipSuccess) { fprintf(stderr, "kernel_launch: hipFuncSetAttribute failed\n"); grid = -1; return; }
        if (hipOccupancyMaxActiveBlocksPerMultiprocessor(&per_cu, (const void*)hybrid_fwd, NWAVES * 64, LDS_BYTES) != hipSuccess || per_cu < 1) { fprintf(stderr, "kernel_launch: the occupancy query admits %d workgroups per CU; nothing launched\n", per_cu); grid = -1; return; }
        (void)hipGetLastError();
        grid = cus;
    }
    if (grid < 0) return;
    if (hipMemsetAsync((char*)d_ws + WS_BAR, 0, WS_BAR_BYTES, stream) != hipSuccess) { fprintf(stderr, "kernel_launch: hipMemsetAsync failed\n"); return; }
    Args a{};
    a.x = (const float*)d_in[0]; a.norm_g = (const float*)d_in[1]; a.w_in = (const float*)d_in[2]; a.b_merge = (const float*)d_in[3];
    a.w_pa = (const float*)d_in[4]; a.w_pb = (const float*)d_in[5]; a.w_out = (const float*)d_in[6]; a.final_g = (const float*)d_in[7];
    a.out = (float*)d_out; a.ws = (unsigned char*)d_ws;
    hipLaunchKernelGGL(hybrid_fwd, dim3(grid), dim3(NWAVES * 64), LDS_BYTES, stream, a);
    const hipError_t e = hipPeekAtLastError();
    if (e != hipSuccess) fprintf(stderr, "kernel_launch: launch failed: %s (grid %d)\n", hipGetErrorString(e), grid);
}
```

```cpp
#include <hip/hip_runtime.h>
#include <cstdio>
#include <cstdint>
namespace pg8 {
#define PG8_LAS __attribute__((address_space(3)))
typedef unsigned short bf16_t;
typedef short bf16x8 __attribute__((ext_vector_type(8)));
typedef float f32x4 __attribute__((ext_vector_type(4)));
typedef unsigned u32x4 __attribute__((ext_vector_type(4)));
constexpr int BM = 256, BK = 64, HALF = 128, HTB = HALF * BK * 2  , STAGE_BYTES = 8 * HTB, NXCD = 8, WGM = 8;
constexpr int EPI_OFF = STAGE_BYTES, EPI_PITCH = 144, EPI_WAVE = 16 * EPI_PITCH;

__host__ __device__ __forceinline__ int lds_byte(int r, int c) { const int st = (r >> 4) * 2 + (c >> 5), rr = r & 15, cc = c & 31, ob = rr * 64 + cc * 2; return st * 1024 + (ob ^ (((ob >> 9) & 1) << 5)); }
__host__ __device__ __forceinline__ void stage_rc(int b, int& R, int& C) { const int st = b / 1024, sb = b % 1024, swz = sb ^ (((sb >> 9) & 1) << 5); R = (st >> 1) * 16 + swz / 64; C = (st & 1) * 32 + (swz % 64) / 2; }
__host__ __device__ __forceinline__ int perm32(int rho) { const int n = rho >> 4, i = rho & 15; return 8 * (i >> 2) + 4 * n + (i & 3); }

struct Unit { int pm, pn; };
struct Gemm { const bf16_t* A; const bf16_t* Bt; int M, N, K, lda; };

struct StaticOrder {
    int nM, nN, nwg, G, c;
    __host__ __device__ void init(int M, int N, int G_, int c_) { nM = M / BM; nN = N / BM; nwg = nM * nN; G = G_; c = c_; }
    __host__ __device__ bool next(int i, Unit& u) const {
        const long L = (long)i * G + c; if (L >= nwg) return false;
        int wgid = (int)L; { const int q = nwg / NXCD, r = nwg % NXCD, xcd = wgid % NXCD, off = wgid / NXCD; wgid = (xcd < r ? xcd * (q + 1) : r * (q + 1) + (xcd - r) * q) + off; }
        const int nig = WGM * nN, gid = wgid / nig, fm = gid * WGM, gsz = (nM - fm) < WGM ? (nM - fm) : WGM;
        u.pm = fm + ((wgid % nig) % gsz); u.pn = (wgid % nig) / gsz; return true;
    }
    __device__ __forceinline__ void a_ready(const Unit&) const {}
    __device__ __forceinline__ void done(const Unit&) const {}
};


typedef int i32x4 __attribute__((ext_vector_type(4)));
__device__ __forceinline__ f32x4 mma16(bf16x8 a, bf16x8 b, f32x4 c) { return __builtin_amdgcn_mfma_f32_16x16x32_bf16(a, b, c, 0, 0, 0); }
__device__ __forceinline__ i32x4 mma16(bf16x8 a, bf16x8 b, i32x4 c) { return __builtin_amdgcn_mfma_i32_16x16x64_i8(__builtin_bit_cast(i32x4, a), __builtin_bit_cast(i32x4, b), c, 0, 0, 0); }
template <class Epi, class Sched, bool ALIGN_EPI = false, bool SP2 = false>
__device__ __forceinline__ void gemm_phase(PG8_LAS unsigned char* lds, const Gemm g, const Sched& S, const Epi& E) {
    int tid_ = threadIdx.x; asm volatile("" : "+v"(tid_));
    const int tid = tid_, wid = __builtin_amdgcn_readfirstlane(tid >> 6), lane = tid & 63, wr = wid >> 2, wc = wid & 3, fr = lane & 15, fq = lane >> 4;
    const int K = g.K, nt = K / BK;
    unsigned voffA[2], voffB[2];
#pragma unroll
    for (int i = 0; i < 2; ++i) { int R, C; stage_rc(tid * 16 + i * 8192, R, C); const int Rb = 64 * (R >> 5) + (Epi::PERM ? perm32(R & 31) : (R & 31));
        voffA[i] = (unsigned)(R * g.lda + C) * 2u; voffB[i] = (unsigned)(Rb * K + C) * 2u; }
    const size_t kstep = (size_t)(BK * 2);
    const size_t hstepB = (size_t)32 * K * 2, hstepA = (size_t)HALF * g.lda * 2;
    const size_t tstepB = (size_t)BM * K * 2, tstepA = 2 * hstepA;
    const unsigned ldsw = (unsigned)wid * 1024u;
    const int aoff = lds_byte(wr * 64 + fr, fq * 8), boff = lds_byte(wc * 32 + fr, fq * 8);
#define PG8_SA(b, h) (((b) * 2 + (h)) * HTB)
#define PG8_SB(b, h) ((4 + (b) * 2 + (h)) * HTB)
#define PG8_STAGE(bufoff, gbase, voff) do { _Pragma("unroll") for (int _i = 0; _i < 2; ++_i) \
        __builtin_amdgcn_global_load_lds((const unsigned*)((const char*)(gbase) + (voff)[_i]), (PG8_LAS unsigned*)(lds + (bufoff) + ldsw + _i * 8192), 16, 0, 0); } while (0)
#define PG8_LDA(dst, b, h) do { _Pragma("unroll") for (int m = 0; m < 4; ++m) _Pragma("unroll") for (int k = 0; k < 2; ++k) dst[m][k] = *(const PG8_LAS bf16x8*)(lds + PG8_SA(b, h) + aoff + m * 2048 + k * 1024); } while (0)
#define PG8_LDB(dst, b, h) do { _Pragma("unroll") for (int n = 0; n < 2; ++n) _Pragma("unroll") for (int k = 0; k < 2; ++k) dst[n][k] = *(const PG8_LAS bf16x8*)(lds + PG8_SB(b, h) + boff + n * 2048 + k * 1024); } while (0)
#define PG8_MMA(ai, bj, At, Bt) do { __builtin_amdgcn_s_setprio(1); _Pragma("unroll") for (int m = 0; m < 4; ++m) _Pragma("unroll") for (int n = 0; n < 2; ++n) _Pragma("unroll") for (int k = 0; k < 2; ++k) \
        acc[ai][bj][m][n] = mma16(Bt[n][k], At[m][k], acc[ai][bj][m][n]); __builtin_amdgcn_s_setprio(0); } while (0)
#define PG8_WAIT_V(n) asm volatile("s_waitcnt vmcnt(" #n ")" ::: "memory")
#define PG8_WAIT_L(n) asm volatile("s_waitcnt lgkmcnt(" #n ")" ::: "memory")
#define PG8_BAR __builtin_amdgcn_s_barrier()
#define PG8_SCHED __builtin_amdgcn_sched_barrier(0)
    Unit cur, nxt; int ui = 0;
    if (!S.next(0, cur)) return;
    typename Epi::acc_t acc[2][2][4][2];
#pragma unroll
    for (int a = 0; a < 2; ++a)
#pragma unroll
        for (int b = 0; b < 2; ++b)
#pragma unroll
            for (int m = 0; m < 4; ++m)
#pragma unroll
                for (int n = 0; n < 2; ++n) acc[a][b][m][n] = (typename Epi::acc_t){0, 0, 0, 0};
    bf16x8 At[4][2], B0[2][2], B1[2][2];
    const char* cA = (const char*)g.A + (size_t)cur.pm * tstepA; const char* cB = (const char*)g.Bt + (size_t)cur.pn * tstepB;
    S.a_ready(cur);
    if constexpr (SP2) {
        PG8_STAGE(PG8_SB(0, 0), cB, voffB); PG8_STAGE(PG8_SB(0, 1), cB + hstepB, voffB); PG8_STAGE(PG8_SA(0, 0), cA, voffA); PG8_STAGE(PG8_SA(0, 1), cA + hstepA, voffA);
        if (wr == 1) PG8_BAR;
        PG8_WAIT_V(2); PG8_BAR;
        PG8_STAGE(PG8_SB(1, 0), cB + kstep, voffB); PG8_STAGE(PG8_SA(1, 0), cA + kstep, voffA); PG8_STAGE(PG8_SB(1, 1), cB + hstepB + kstep, voffB);
        PG8_WAIT_V(6); PG8_BAR;
    } else {
        PG8_STAGE(PG8_SB(0, 0), cB, voffB); PG8_STAGE(PG8_SA(0, 0), cA, voffA); PG8_STAGE(PG8_SB(0, 1), cB + hstepB, voffB); PG8_STAGE(PG8_SA(0, 1), cA + hstepA, voffA);
        if (wr == 1) PG8_BAR;
        PG8_WAIT_V(4); PG8_BAR;
        PG8_STAGE(PG8_SB(1, 0), cB + kstep, voffB); PG8_STAGE(PG8_SA(1, 0), cA + kstep, voffA); PG8_STAGE(PG8_SB(1, 1), cB + hstepB + kstep, voffB);
        PG8_WAIT_V(6); PG8_BAR;
    }
    for (;;) {
        const bool has_next = S.next(ui + 1, nxt);
        const char* nA = has_next ? (const char*)g.A + (size_t)nxt.pm * tstepA : cA; const char* nB = has_next ? (const char*)g.Bt + (size_t)nxt.pn * tstepB : cB;
        for (int t = 0; t < nt; t += 2) {
            const bool last = (t == nt - 2);
            const char* a1 = cA + (size_t)(t + 1) * kstep;
            const char* a2 = last ? nA : cA + (size_t)(t + 2) * kstep; const char* b2 = last ? nB : cB + (size_t)(t + 2) * kstep;
            const char* a3 = a2 + kstep; const char* b3 = b2 + kstep;
            if (last && has_next) S.a_ready(nxt);
            if constexpr (SP2) {
            PG8_LDB(B0, 0, 0); PG8_LDB(B1, 0, 1); PG8_SCHED; PG8_LDA(At, 0, 0); PG8_STAGE(PG8_SA(1, 1), a1 + hstepA, voffA);
            PG8_WAIT_V(8); PG8_WAIT_L(0); PG8_BAR; PG8_MMA(0, 0, At, B0); PG8_MMA(0, 1, At, B1); PG8_BAR; PG8_SCHED;
            PG8_LDA(At, 0, 1); PG8_STAGE(PG8_SB(0, 0), b2, voffB); PG8_STAGE(PG8_SB(0, 1), b2 + hstepB, voffB); PG8_STAGE(PG8_SA(0, 0), a2, voffA);
            PG8_WAIT_V(8); PG8_WAIT_L(0); PG8_BAR; PG8_MMA(1, 0, At, B0); PG8_MMA(1, 1, At, B1); PG8_BAR; PG8_SCHED;
            PG8_LDB(B0, 1, 0); PG8_LDB(B1, 1, 1); PG8_SCHED; PG8_LDA(At, 1, 0); PG8_STAGE(PG8_SA(0, 1), a2 + hstepA, voffA);
            PG8_WAIT_V(8); PG8_WAIT_L(0); PG8_BAR; PG8_MMA(0, 0, At, B0); PG8_MMA(0, 1, At, B1); PG8_BAR; PG8_SCHED;
            PG8_LDA(At, 1, 1); PG8_STAGE(PG8_SB(1, 0), b3, voffB); PG8_STAGE(PG8_SB(1, 1), b3 + hstepB, voffB); PG8_STAGE(PG8_SA(1, 0), a3, voffA);
            PG8_WAIT_V(8); PG8_WAIT_L(0); PG8_BAR; PG8_MMA(1, 0, At, B0); PG8_MMA(1, 1, At, B1); PG8_BAR; PG8_SCHED;
            if constexpr (Epi::HAS_MID) { if (t == Epi::MID_T) { E.mid(acc, cur, wr, wc, fr, fq, wid); PG8_SCHED; } }
            } else {
            PG8_LDB(B0, 0, 0); PG8_SCHED; PG8_LDA(At, 0, 0); PG8_STAGE(PG8_SA(1, 1), a1 + hstepA, voffA);
            PG8_WAIT_L(8); PG8_BAR; PG8_WAIT_L(0); PG8_MMA(0, 0, At, B0); PG8_BAR; PG8_SCHED;
            PG8_LDB(B1, 0, 1); PG8_STAGE(PG8_SB(0, 0), b2, voffB);
            PG8_BAR; PG8_WAIT_L(0); PG8_MMA(0, 1, At, B1); PG8_BAR;
            PG8_LDA(At, 0, 1); PG8_STAGE(PG8_SA(0, 0), a2, voffA);
            PG8_BAR; PG8_WAIT_L(0); PG8_MMA(1, 0, At, B0); PG8_BAR; PG8_SCHED;
            PG8_STAGE(PG8_SB(0, 1), b2 + hstepB, voffB);
            PG8_WAIT_V(6); PG8_BAR; PG8_MMA(1, 1, At, B1); PG8_BAR;
            PG8_LDB(B0, 1, 0); PG8_SCHED; PG8_LDA(At, 1, 0); PG8_STAGE(PG8_SA(0, 1), a2 + hstepA, voffA);
            PG8_WAIT_L(8); PG8_BAR; PG8_WAIT_L(0); PG8_MMA(0, 0, At, B0); PG8_BAR; PG8_SCHED;
            PG8_LDB(B1, 1, 1); PG8_STAGE(PG8_SB(1, 0), b3, voffB);
            PG8_BAR; PG8_WAIT_L(0); PG8_MMA(0, 1, At, B1); PG8_BAR;
            PG8_LDA(At, 1, 1); PG8_STAGE(PG8_SA(1, 0), a3, voffA);
            PG8_BAR; PG8_WAIT_L(0); PG8_MMA(1, 0, At, B0); PG8_BAR; PG8_SCHED;
            PG8_STAGE(PG8_SB(1, 1), b3 + hstepB, voffB);
            PG8_WAIT_V(6); PG8_BAR; PG8_MMA(1, 1, At, B1); PG8_BAR;
            }
        }
        if constexpr (ALIGN_EPI) { if (wr == 0) PG8_BAR; }
        if constexpr (!Epi::AFTER_DRAIN) { E(acc, cur, wr, wc, fr, fq, lds + EPI_OFF + wid * EPI_WAVE, lane, wid); S.done(cur); }
        if (!has_next) break;
#pragma unroll
        for (int a = 0; a < 2; ++a)
#pragma unroll
            for (int b = 0; b < 2; ++b)
#pragma unroll
                for (int m = 0; m < 4; ++m)
#pragma unroll
                    for (int n = 0; n < 2; ++n) acc[a][b][m][n] = (typename Epi::acc_t){0, 0, 0, 0};
        cur = nxt; cA = nA; cB = nB; ++ui;
        if constexpr (ALIGN_EPI) { if (wr == 1) PG8_BAR; }
    }
    PG8_WAIT_V(0);
    if constexpr (!ALIGN_EPI) { if (wr == 0) PG8_BAR; }
    PG8_BAR;
    if constexpr (Epi::AFTER_DRAIN) { E.fused(acc, cur, wr, wc, fr, fq, lds, wid, lane); S.done(cur); }
#undef PG8_SA
#undef PG8_SB
#undef PG8_STAGE
#undef PG8_LDA
#undef PG8_LDB
#undef PG8_MMA
#undef PG8_WAIT_V
#undef PG8_WAIT_L
#undef PG8_BAR
#undef PG8_SCHED
}
}


namespace pg8 {
__device__ __forceinline__ unsigned cvt_pk_bf16(float lo, float hi) { unsigned r; asm volatile("v_cvt_pk_bf16_f32 %0, %1, %2" : "=v"(r) : "v"(lo), "v"(hi)); return r; }
__device__ __forceinline__ float bflo(unsigned u) { return __uint_as_float(u << 16); }
__device__ __forceinline__ float bfhi(unsigned u) { return __uint_as_float(u & 0xffff0000u); }
__device__ __forceinline__ float sigmoidf_(float v) { return __builtin_amdgcn_rcpf(1.0f + __expf(-v)); }
typedef unsigned u32x2 __attribute__((ext_vector_type(2)));
__device__ __forceinline__ void piece_xpose(PG8_LAS unsigned char* stg, u32x4 in0, u32x4 in1, u32x4& out0, u32x4& out1, int fr, int fq, int lane) {
    *(PG8_LAS u32x4*)(stg + fr * EPI_PITCH + fq * 16) = in0; *(PG8_LAS u32x4*)(stg + fr * EPI_PITCH + 64 + fq * 16) = in1;
    out0 = *(const PG8_LAS u32x4*)(stg + (lane >> 3) * EPI_PITCH + (lane & 7) * 16); out1 = *(const PG8_LAS u32x4*)(stg + ((lane >> 3) + 8) * EPI_PITCH + (lane & 7) * 16);
}

struct EpiProj {
    typedef f32x4 acc_t; static constexpr bool PERM = true, AFTER_DRAIN = false, HAS_MID = false; static constexpr int MID_T = 0;
    bf16_t* O; int ldc; float* kmean; const float* rowss;
    __device__ __forceinline__ void operator()(const f32x4 (&acc)[2][2][4][2], const Unit& u, int wr, int wc, int fr, int fq, PG8_LAS unsigned char* stg, int lane, int wid) const {
        asm volatile("" : "+v"(fr), "+v"(fq), "+v"(lane));
        const int tl = u.pn < 5 ? u.pn + 9 : u.pn + 10;
        const int kind = (tl == 9 || tl == 16 || tl == 17) ? 1 : 0;
        PG8_LAS float* const tab = (PG8_LAS float*)(stg - wid * EPI_WAVE + 8 * EPI_WAVE + 256);
        if (__builtin_amdgcn_readfirstlane(((const PG8_LAS int*)tab)[256]) != u.pm) {
            asm volatile("s_waitcnt lgkmcnt(0)" ::: "memory"); __builtin_amdgcn_s_barrier(); asm volatile("" ::: "memory");
            const int t_ = wid * 64 + lane;
            if (t_ < 256) { const f32x4* pp = (const f32x4*)(rowss + (size_t)(u.pm * BM + t_) * 16); const f32x4 s4 = (pp[0] + pp[1]) + (pp[2] + pp[3]);
                tab[t_] = __builtin_amdgcn_rsqf(((s4[0] + s4[1]) + (s4[2] + s4[3])) * (1.0f / 1024.0f) + 1e-6f); }
            if (t_ == 0) ((PG8_LAS int*)tab)[256] = u.pm;
            asm volatile("s_waitcnt vmcnt(0) lgkmcnt(0)" ::: "memory"); __builtin_amdgcn_s_barrier(); asm volatile("" ::: "memory");
        }
        float rs[2][4];
#pragma unroll
        for (int ai = 0; ai < 2; ++ai)
#pragma unroll
            for (int m = 0; m < 4; ++m) rs[ai][m] = tab[ai * HALF + wr * 64 + m * 16 + fr];
        const float qs = (tl == 10 || tl == 11) ? 0.18033688011112042f : 1.0f;
        const size_t rbase = (size_t)(u.pm * BM + wr * 64 + (lane >> 3)); bf16_t* const op = O + tl * BM + wc * 64 + 8 * (lane & 7);
#pragma unroll
        for (int ai = 0; ai < 2; ++ai)
#pragma unroll
            for (int m = 0; m < 4; ++m) { u32x4 w[2];
#pragma unroll
                for (int bj = 0; bj < 2; ++bj) { f32x4 v0 = acc[ai][bj][m][0] * rs[ai][m], v1 = acc[ai][bj][m][1] * rs[ai][m];
                    if (kind == 1) {
#pragma unroll
                        for (int e = 0; e < 4; ++e) { v0[e] = v0[e] * sigmoidf_(v0[e]); v1[e] = v1[e] * sigmoidf_(v1[e]); } }
                    v0 = v0 * qs; v1 = v1 * qs;
                    w[bj].x = cvt_pk_bf16(v0[0], v0[1]); w[bj].y = cvt_pk_bf16(v0[2], v0[3]); w[bj].z = cvt_pk_bf16(v1[0], v1[1]); w[bj].w = cvt_pk_bf16(v1[2], v1[3]); }
                u32x4 o0, o1; piece_xpose(stg, w[0], w[1], o0, o1, fr, fq, lane);
                bf16_t* rp = op + (rbase + ai * HALF + m * 16) * ldc;
                __builtin_nontemporal_store(o0, (u32x4*)rp); __builtin_nontemporal_store(o1, (u32x4*)(rp + (size_t)8 * ldc));
                asm volatile("" ::: "memory"); }
        if (tl == 12 || tl == 13) {
#pragma unroll
            for (int bj = 0; bj < 2; ++bj)
#pragma unroll
                for (int n = 0; n < 2; ++n) { f32x4 cs = (f32x4){0.f, 0.f, 0.f, 0.f};
#pragma unroll
                    for (int ai = 0; ai < 2; ++ai)
#pragma unroll
                        for (int m = 0; m < 4; ++m) { float r2 = rs[ai][m]; asm volatile("" : "+v"(r2)); cs += acc[ai][bj][m][n] * r2; }
#pragma unroll
                    for (int e = 0; e < 4; ++e) { float v = cs[e]; v += __shfl_xor(v, 1); v += __shfl_xor(v, 2); v += __shfl_xor(v, 4); v += __shfl_xor(v, 8); cs[e] = v; }
                    if (fr == 0) { float* kp = kmean + (size_t)u.pm * 512 + (tl - 12) * 256 + wc * 64 + bj * 32 + 8 * fq + 4 * n;
#pragma unroll
                        for (int e = 0; e < 4; ++e) atomicAdd(kp + e, cs[e] * (1.0f / 256.0f)); } }
        }
    }
};
struct EpiProjQ8 {
    typedef i32x4 acc_t; static constexpr bool PERM = true, AFTER_DRAIN = false, HAS_MID = false; static constexpr int MID_T = 0;
    bf16_t* O; int ldc; const float* wscale; const float* xscale; const float* rowss;
    __device__ __forceinline__ void operator()(const i32x4 (&acc)[2][2][4][2], const Unit& u, int wr, int wc, int fr, int fq, PG8_LAS unsigned char* stg, int lane, int wid) const {
        asm volatile("" : "+v"(fr), "+v"(fq), "+v"(lane));
        const int tl = u.pn < 6 ? u.pn + (u.pn >> 1) : (u.pn < 9 ? 3 * (u.pn - 6) + 2 : 14);
        const float qs = (u.pn < 6 && !(u.pn & 1)) ? 0.18033688011112042f : 1.0f;
        PG8_LAS float* const tab = (PG8_LAS float*)(stg - wid * EPI_WAVE + 8 * EPI_WAVE + 256);
        if (__builtin_amdgcn_readfirstlane(((const PG8_LAS int*)tab)[256]) != u.pm) {
            asm volatile("s_waitcnt lgkmcnt(0)" ::: "memory"); __builtin_amdgcn_s_barrier(); asm volatile("" ::: "memory");
            const int t_ = wid * 64 + lane;
            if (t_ < 256) { const f32x4* pp = (const f32x4*)(rowss + (size_t)(u.pm * BM + t_) * 16); const f32x4 s4 = (pp[0] + pp[1]) + (pp[2] + pp[3]);
                tab[t_] = xscale[u.pm * BM + t_] * __builtin_amdgcn_rsqf(((s4[0] + s4[1]) + (s4[2] + s4[3])) * (1.0f / 1024.0f) + 1e-6f); }
            if (t_ == 0) ((PG8_LAS int*)tab)[256] = u.pm;
            asm volatile("s_waitcnt vmcnt(0) lgkmcnt(0)" ::: "memory"); __builtin_amdgcn_s_barrier(); asm volatile("" ::: "memory");
        }
        f32x4 wv[2][2];
#pragma unroll
        for (int bj = 0; bj < 2; ++bj)
#pragma unroll
            for (int n = 0; n < 2; ++n) wv[bj][n] = *(const f32x4*)(wscale + u.pn * BM + wc * 64 + 8 * fq + bj * 32 + 4 * n) * qs;
        const size_t rbase = (size_t)(u.pm * BM + wr * 64 + (lane >> 3)); bf16_t* const op = O + tl * BM + wc * 64 + 8 * (lane & 7);
#pragma unroll
        for (int ai = 0; ai < 2; ++ai)
#pragma unroll
            for (int m = 0; m < 4; ++m) { const float rf = tab[ai * HALF + wr * 64 + m * 16 + fr]; u32x4 w[2];
#pragma unroll
                for (int bj = 0; bj < 2; ++bj) { f32x4 v0, v1;
#pragma unroll
                    for (int e = 0; e < 4; ++e) { v0[e] = (float)acc[ai][bj][m][0][e] * (rf * wv[bj][0][e]); v1[e] = (float)acc[ai][bj][m][1][e] * (rf * wv[bj][1][e]); }
                    w[bj].x = cvt_pk_bf16(v0[0], v0[1]); w[bj].y = cvt_pk_bf16(v0[2], v0[3]); w[bj].z = cvt_pk_bf16(v1[0], v1[1]); w[bj].w = cvt_pk_bf16(v1[2], v1[3]); }
                u32x4 o0, o1; piece_xpose(stg, w[0], w[1], o0, o1, fr, fq, lane);
                bf16_t* rp = op + (rbase + ai * HALF + m * 16) * ldc;
                __builtin_nontemporal_store(o0, (u32x4*)rp); __builtin_nontemporal_store(o1, (u32x4*)(rp + (size_t)8 * ldc));
                asm volatile("" ::: "memory"); }
    }
};
struct EpiGate {
    typedef i32x4 acc_t; static constexpr bool PERM = true, AFTER_DRAIN = false, HAS_MID = false; static constexpr int MID_T = 0;
    const float* bmerge; const float* wscale; const float* xscale; const float* rowss; unsigned char* gates;
    __device__ __forceinline__ void operator()(const i32x4 (&acc)[2][2][4][2], const Unit& u, int wr, int wc, int fr, int fq, PG8_LAS unsigned char* stg, int lane, int wid) const {
        asm volatile("" : "+v"(fr), "+v"(fq), "+v"(lane));
        const int col0 = u.pn * BM + wc * 64 + 8 * fq;
        PG8_LAS float* const tab = (PG8_LAS float*)(stg - wid * EPI_WAVE + 8 * EPI_WAVE + 256);
        if (__builtin_amdgcn_readfirstlane(((const PG8_LAS int*)tab)[256]) != u.pm) {
            asm volatile("s_waitcnt lgkmcnt(0)" ::: "memory"); __builtin_amdgcn_s_barrier(); asm volatile("" ::: "memory");
            const int t_ = wid * 64 + lane;
            if (t_ < 256) { const f32x4* pp = (const f32x4*)(rowss + (size_t)(u.pm * BM + t_) * 16); const f32x4 s4 = (pp[0] + pp[1]) + (pp[2] + pp[3]);
                tab[t_] = xscale[u.pm * BM + t_] * __builtin_amdgcn_rsqf(((s4[0] + s4[1]) + (s4[2] + s4[3])) * (1.0f / 1024.0f) + 1e-6f) * (-1.4426950408889634f); }
            if (t_ == 0) ((PG8_LAS int*)tab)[256] = u.pm;
            asm volatile("s_waitcnt vmcnt(0) lgkmcnt(0)" ::: "memory"); __builtin_amdgcn_s_barrier(); asm volatile("" ::: "memory");
        }
        f32x4 bv[2][2], wv[2][2];
#pragma unroll
        for (int bj = 0; bj < 2; ++bj)
#pragma unroll
            for (int n = 0; n < 2; ++n) { bv[bj][n] = *(const f32x4*)(bmerge + col0 + bj * 32 + 4 * n) * (-1.4426950408889634f); wv[bj][n] = *(const f32x4*)(wscale + col0 + bj * 32 + 4 * n); }
        unsigned char* gp = gates + ((size_t)((u.pm * 8 + u.pn) * 8 + wid) * 8) * 1024 + fr * 64 + fq * 16;
#pragma unroll
        for (int ai = 0; ai < 2; ++ai)
#pragma unroll
            for (int m = 0; m < 4; ++m) { const float rf = tab[ai * HALF + wr * 64 + m * 16 + fr]; u32x4 q;
#pragma unroll
                for (int bj = 0; bj < 2; ++bj)
#pragma unroll
                    for (int n = 0; n < 2; ++n) { unsigned w = 0u;
#pragma unroll
                        for (int e = 0; e < 4; ++e) { const float x2 = (float)acc[ai][bj][m][n][e] * (rf * wv[bj][n][e]) + bv[bj][n][e];
                            w = __builtin_amdgcn_cvt_pk_u8_f32(__builtin_fmaxf(255.0f * __builtin_amdgcn_rcpf(1.0f + __builtin_amdgcn_exp2f(x2)), 1.0f), e, w); }
                        q[2 * bj + n] = w; }
                __builtin_nontemporal_store(q, (u32x4*)(gp + (ai * 4 + m) * 1024)); }
    }
};
struct EpiMerge {
    typedef f32x4 acc_t; static constexpr bool PERM = true, AFTER_DRAIN = false, HAS_MID = true; static constexpr int MID_T = 2;
    bf16_t* O; const unsigned char* gates; int ldc;
    __device__ __forceinline__ static float ub(unsigned w, int i) { return (float)((w >> (8 * i)) & 0xffu); }
    __device__ __forceinline__ void mid(f32x4 (&acc)[2][2][4][2], const Unit& u, int wr, int wc, int fr, int fq, int wid) const {
        asm volatile("" : "+v"(fr), "+v"(fq));
        const unsigned char* ga = gates + ((size_t)((u.pm * 8 + u.pn) * 8 + wid) * 8) * 1024 + fr * 64 + fq * 16; const unsigned char* gb = ga + (size_t)4 * 8 * 8 * 1024;
        u32x4 av[2][4], bv[2][4];
#pragma unroll
        for (int ai = 0; ai < 2; ++ai)
#pragma unroll
            for (int m = 0; m < 4; ++m) { av[ai][m] = __builtin_nontemporal_load((const u32x4*)(ga + (ai * 4 + m) * 1024)); bv[ai][m] = *(const u32x4*)(gb + (ai * 4 + m) * 1024); }
#pragma unroll
        for (int ai = 0; ai < 2; ++ai)
#pragma unroll
            for (int m = 0; m < 4; ++m)
#pragma unroll
                for (int bj = 0; bj < 2; ++bj)
#pragma unroll
                    for (int n = 0; n < 2; ++n)
#pragma unroll
                        for (int e = 0; e < 4; ++e) acc[ai][bj][m][n][e] *= ub(av[ai][m][2 * bj + n], e) * __builtin_amdgcn_rcpf(ub(bv[ai][m][2 * bj + n], e));
    }
    __device__ __forceinline__ void operator()(const f32x4 (&acc)[2][2][4][2], const Unit& u, int wr, int wc, int fr, int fq, PG8_LAS unsigned char* stg, int lane, int wid) const {
        asm volatile("" : "+v"(fr), "+v"(fq), "+v"(lane));
        const unsigned char* gb = gates + ((size_t)((u.pm * 8 + 4 + u.pn) * 8 + wid) * 8) * 1024 + fr * 64 + fq * 16;
        const size_t rbase = (size_t)(u.pm * BM + wr * 64 + (lane >> 3)); bf16_t* const op = O + u.pn * BM + wc * 64 + 8 * (lane & 7);
        u32x4 gvv[2][4];
#pragma unroll
        for (int ai = 0; ai < 2; ++ai)
#pragma unroll
            for (int m = 0; m < 4; ++m) gvv[ai][m] = __builtin_nontemporal_load((const u32x4*)(gb + (ai * 4 + m) * 1024));
#pragma unroll
        for (int ai = 0; ai < 2; ++ai)
#pragma unroll
            for (int m = 0; m < 4; ++m) { const u32x4 gv = gvv[ai][m]; u32x4 w[2];
#pragma unroll
                for (int bj = 0; bj < 2; ++bj) { f32x4 v0 = acc[ai][bj][m][0], v1 = acc[ai][bj][m][1];
#pragma unroll
                    for (int e = 0; e < 4; ++e) { v0[e] *= ub(gv[2 * bj], e) * (1.0f / 255.0f); v1[e] *= ub(gv[2 * bj + 1], e) * (1.0f / 255.0f); }
                    w[bj].x = cvt_pk_bf16(v0[0], v0[1]); w[bj].y = cvt_pk_bf16(v0[2], v0[3]); w[bj].z = cvt_pk_bf16(v1[0], v1[1]); w[bj].w = cvt_pk_bf16(v1[2], v1[3]); }
                u32x4 o0, o1; piece_xpose(stg, w[0], w[1], o0, o1, fr, fq, lane);
                bf16_t* rp = op + (rbase + ai * HALF + m * 16) * ldc;
                __builtin_nontemporal_store(o0, (u32x4*)rp); __builtin_nontemporal_store(o1, (u32x4*)(rp + (size_t)8 * ldc));
                if (m & 1) asm volatile("" ::: "memory"); }
    }
};
template <int MODE> struct EpiResid {
    typedef f32x4 acc_t; static constexpr bool PERM = false, AFTER_DRAIN = false, HAS_MID = false; static constexpr int MID_T = 0;
    const float* R; bf16_t* XB; float* rowss; int ldc;
    __device__ __forceinline__ void operator()(const f32x4 (&acc)[2][2][4][2], const Unit& u, int wr, int wc, int fr, int fq, PG8_LAS unsigned char* stg, int lane, int wid) const {
        asm volatile("" : "+v"(fr), "+v"(fq), "+v"(lane));
        const size_t rbase = (size_t)(u.pm * BM + wr * 64 + (lane >> 3)); const int cb = u.pn * BM + wc * 64 + 4 * (lane & 7);
#pragma unroll
        for (int ai = 0; ai < 2; ++ai) {
            f32x4 rr[4][2][2];
#pragma unroll
            for (int m = 0; m < 4; ++m)
#pragma unroll
                for (int bj = 0; bj < 2; ++bj) { const size_t ro = (rbase + ai * HALF + m * 16) * ldc + cb + bj * 32;
                    if (MODE == 0) { rr[m][bj][0] = __builtin_nontemporal_load((const f32x4*)(R + ro)); rr[m][bj][1] = __builtin_nontemporal_load((const f32x4*)(R + ro + (size_t)8 * ldc)); }
                    else { const u32x2 b0 = __builtin_nontemporal_load((const u32x2*)(XB + ro)), b1 = __builtin_nontemporal_load((const u32x2*)(XB + ro + (size_t)8 * ldc));
                        rr[m][bj][0] = __builtin_bit_cast(f32x4, (u32x4){b0.x, b0.y, b1.x, b1.y}); } }
#pragma unroll
            for (int m = 0; m < 4; ++m) { float ss0 = 0.f, ss1 = 0.f;
#pragma unroll
                for (int bj = 0; bj < 2; ++bj) { const size_t ro = (rbase + ai * HALF + m * 16) * ldc + cb + bj * 32;
                    f32x4 r0, r1;
                    if (MODE == 0) { r0 = rr[m][bj][0]; r1 = rr[m][bj][1]; }
                    else { const u32x4 pk = __builtin_bit_cast(u32x4, rr[m][bj][0]);
                        r0 = (f32x4){bflo(pk.x), bfhi(pk.x), bflo(pk.y), bfhi(pk.y)}; r1 = (f32x4){bflo(pk.z), bfhi(pk.z), bflo(pk.w), bfhi(pk.w)}; }
                    u32x4 o0, o1; piece_xpose(stg, __builtin_bit_cast(u32x4, acc[ai][bj][m][0]), __builtin_bit_cast(u32x4, acc[ai][bj][m][1]), o0, o1, fr, fq, lane);
                    const f32x4 x0 = r0 + __builtin_bit_cast(f32x4, o0), x1 = r1 + __builtin_bit_cast(f32x4, o1);
                    *(u32x2*)(XB + ro) = (u32x2){cvt_pk_bf16(x0[0], x0[1]), cvt_pk_bf16(x0[2], x0[3])}; *(u32x2*)(XB + ro + (size_t)8 * ldc) = (u32x2){cvt_pk_bf16(x1[0], x1[1]), cvt_pk_bf16(x1[2], x1[3])};
                    ss0 += (x0[0] * x0[0] + x0[1] * x0[1]) + (x0[2] * x0[2] + x0[3] * x0[3]); ss1 += (x1[0] * x1[0] + x1[1] * x1[1]) + (x1[2] * x1[2] + x1[3] * x1[3]); }
                ss0 += __shfl_xor(ss0, 1); ss0 += __shfl_xor(ss0, 2); ss0 += __shfl_xor(ss0, 4); ss1 += __shfl_xor(ss1, 1); ss1 += __shfl_xor(ss1, 2); ss1 += __shfl_xor(ss1, 4);
                if ((lane & 7) == 0) { rowss[(rbase + ai * HALF + m * 16) * 16 + u.pn * 4 + wc] = ss0; rowss[(rbase + ai * HALF + m * 16 + 8) * 16 + u.pn * 4 + wc] = ss1; } }
            asm volatile("" ::: "memory");
        }
    }
};
}
#include <hip/hip_bf16.h>
#include <cmath>
namespace moba {
using bf16=__hip_bfloat16;
using bf16x8=__attribute__((ext_vector_type(8)))short;
using s16x4=__attribute__((ext_vector_type(4)))short;
using f32x16=__attribute__((ext_vector_type(16)))float;
using u32x4=__attribute__((ext_vector_type(4)))unsigned;
constexpr int SEQ=2048,D=64,PITCH=4608;
constexpr int NW=8,QBLK=32,QB=QBLK*NW,KVBLK=64;
__device__ __forceinline__ int crow(int r,int hi){return (r&3)+8*(r>>2)+4*hi;}
#define SBAR() __builtin_amdgcn_sched_barrier(0)
__device__ __forceinline__ void cmask(f32x16&p0,f32x16&p1,int jb,int qrel,int hi){
  const float NEG=-INFINITY; int kb=64*jb+4*hi;
  #pragma unroll
  for(int r=0;r<16;++r){int kv=kb+(r&3)+8*(r>>2); if(kv>qrel)p0[r]=NEG; if(kv+32>qrel)p1[r]=NEG;}
}

constexpr int NSLOT=3, SLOTB=8192;
constexpr int NVSLOT=4;
constexpr int LDS_K=0, LDS_V=NSLOT*SLOTB, LDS_WS=LDS_V+NVSLOT*SLOTB, LDS_OST=LDS_WS+NW*64*4, LDS_KM=LDS_OST+NW*4096, LDS_BYTES=LDS_KM+8*64*4;
__device__ __forceinline__ void glds16(const void*gsrc,unsigned lds_dst){unsigned keep;
  asm volatile("s_mov_b32 %0, m0\n\ts_mov_b32 m0, %2\n\ts_nop 0\n\tglobal_load_lds_dwordx4 %1, off\n\ts_mov_b32 m0, %0":"=&s"(keep):"v"(gsrc),"s"(lds_dst):"memory");}
__device__ __forceinline__ float max3f(float a,float b,float c){float r;asm("v_max3_f32 %0, %1, %2, %3":"=v"(r):"v"(a),"v"(b),"v"(c));return r;}
__device__ __forceinline__ float max2f(float a,float b){float r;asm("v_max_f32_e32 %0, %1, %2":"=v"(r):"v"(a),"v"(b));return r;}
typedef float f32x2_t __attribute__((ext_vector_type(2))); typedef __bf16 bf16x2_t __attribute__((ext_vector_type(2)));
__device__ __forceinline__ unsigned cvtpk_s(float lo,float hi){f32x2_t v={lo,hi};bf16x2_t b=__builtin_convertvector(v,bf16x2_t);return __builtin_bit_cast(unsigned,b);}
__device__ __forceinline__ float bl(unsigned u){return __uint_as_float(u<<16);}
__device__ __forceinline__ float bh(unsigned u){return __uint_as_float(u&0xffff0000u);}
#define WAIT_BAR(N) asm volatile("s_waitcnt vmcnt(" #N ") lgkmcnt(0)\n\ts_barrier":::"memory")

__device__ __forceinline__ void qkt(f32x16&p0,f32x16&p1,const char*Kslot,const bf16x8*qr,const f32x16&negm,int r32,int hi){
  const char*kb=Kslot+hi*1024+r32*16;
  #pragma unroll
  for(int d0=0;d0<4;++d0){
    const bf16x8 b0=*reinterpret_cast<const bf16x8*>(kb+d0*2048);
    const bf16x8 b1=*reinterpret_cast<const bf16x8*>(kb+d0*2048+512);
    if(d0==0){p0=__builtin_amdgcn_mfma_f32_32x32x16_bf16(b0,qr[0],negm,0,0,0);p1=__builtin_amdgcn_mfma_f32_32x32x16_bf16(b1,qr[0],negm,0,0,0);}
    else{p0=__builtin_amdgcn_mfma_f32_32x32x16_bf16(b0,qr[d0],p0,0,0,0);p1=__builtin_amdgcn_mfma_f32_32x32x16_bf16(b1,qr[d0],p1,0,0,0);}}
}
typedef __attribute__((address_space(3))) const char* lds_cptr;
typedef short v4i16_t __attribute__((ext_vector_type(4)));
__device__ __forceinline__ void kload8(bf16x8*kf,lds_cptr kp){
  kf[0]=*(const __attribute__((address_space(3))) bf16x8*)(kp);      kf[1]=*(const __attribute__((address_space(3))) bf16x8*)(kp+512);
  kf[2]=*(const __attribute__((address_space(3))) bf16x8*)(kp+2048); kf[3]=*(const __attribute__((address_space(3))) bf16x8*)(kp+2560);
  kf[4]=*(const __attribute__((address_space(3))) bf16x8*)(kp+4096); kf[5]=*(const __attribute__((address_space(3))) bf16x8*)(kp+4608);
  kf[6]=*(const __attribute__((address_space(3))) bf16x8*)(kp+6144); kf[7]=*(const __attribute__((address_space(3))) bf16x8*)(kp+6656);
}
__device__ __forceinline__ void kload2(bf16x8*kf,lds_cptr kp,int j){ kf[2*j]=*(const __attribute__((address_space(3))) bf16x8*)(kp+j*2048); kf[2*j+1]=*(const __attribute__((address_space(3))) bf16x8*)(kp+j*2048+512); }
__device__ __forceinline__ s16x4 vtr(lds_cptr p){ return __builtin_bit_cast(s16x4,__builtin_amdgcn_ds_read_tr16_b64_v4i16((__attribute__((address_space(3))) v4i16_t*)p)); }
__device__ __forceinline__ float rowmax(const f32x16&p0,const f32x16&p1){
  float a=max3f(p0[0],p0[1],p1[0]),b=max3f(p0[2],p0[3],p1[1]);a=max3f(a,p1[2],p1[3]);
  #pragma unroll
  for(int r=4;r<16;r+=4){a=max3f(a,p0[r],p0[r+1]);b=max3f(b,p0[r+2],p0[r+3]);a=max3f(a,p1[r],p1[r+1]);b=max3f(b,p1[r+2],p1[r+3]);}
  const float m=max2f(a,b);
  auto rr=__builtin_amdgcn_permlane32_swap(__float_as_uint(m),__float_as_uint(m),false,false);
  return max2f(__uint_as_float(rr[0]),__uint_as_float(rr[1]));
}
__device__ __forceinline__ float xhalf_sum(float v){ auto rr=__builtin_amdgcn_permlane32_swap(__float_as_uint(v),__float_as_uint(v),false,false); return __uint_as_float(rr[0])+__uint_as_float(rr[1]); }
__device__ __forceinline__ void pv(f32x16*o,int vb,bf16x8 pa0,bf16x8 pa1,bf16x8 pa2,bf16x8 pa3){
  #pragma unroll
  for(int d0=0;d0<2;++d0){s16x4 lo[4],hi[4];
    #pragma unroll
    for(int ks=0;ks<4;++ks){
      asm volatile("ds_read_b64_tr_b16 %0,%1 offset:%c2":"=&v"(lo[ks]):"v"(vb),"i"(d0*4096+ks*1024):"memory");
      asm volatile("ds_read_b64_tr_b16 %0,%1 offset:%c2":"=&v"(hi[ks]):"v"(vb),"i"(d0*4096+ks*1024+512):"memory");}
    asm volatile("s_waitcnt lgkmcnt(0)":::"memory");SBAR();
    #define PK(k) (bf16x8){lo[k][0],lo[k][1],lo[k][2],lo[k][3],hi[k][0],hi[k][1],hi[k][2],hi[k][3]}
    o[d0]=__builtin_amdgcn_mfma_f32_32x32x16_bf16(pa0,PK(0),o[d0],0,0,0);
    o[d0]=__builtin_amdgcn_mfma_f32_32x32x16_bf16(pa1,PK(1),o[d0],0,0,0);
    o[d0]=__builtin_amdgcn_mfma_f32_32x32x16_bf16(pa2,PK(2),o[d0],0,0,0);
    o[d0]=__builtin_amdgcn_mfma_f32_32x32x16_bf16(pa3,PK(3),o[d0],0,0,0);
    #undef PK
  }
}

template<int THRL> __device__ __forceinline__ void moba_unit(int b,int h,int c,const bf16*Pq,const bf16*__restrict__ Pk,const bf16*__restrict__ Pv,const bf16*Pz,bf16*Po,const float*__restrict__ kmean,char*shm){
  int tid_=threadIdx.x; asm volatile("":"+v"(tid_));
  const int tid=tid_,lane=tid&63,r32=lane&31,hi=lane>>5; const int wid=__builtin_amdgcn_readfirstlane(tid>>6);
  const long rowbase=(long)b*SEQ; const int q0=c*QB;
  const bf16*Qw=Pq+(rowbase+q0+wid*QBLK)*PITCH+h*D;
  const bf16*Kh=Pk+rowbase*PITCH+h*D,*Vh=Pv+rowbase*PITCH+h*D;
  const unsigned lds0=(unsigned)(uintptr_t)shm;
  float*wsf=(float*)(shm+LDS_WS)+wid*64;
  float*kml=(float*)(shm+LDS_KM);
  const int NT=(q0+QB)/KVBLK;
  const bf16*ksrc=Kh+(long)lane*PITCH+wid*8;
  const bf16*vsrc=Vh+(long)(16*(wid&3)+(lane>>2))*PITCH+(wid>>2)*32+(lane&3)*8;
  const unsigned kdst=lds0+LDS_K+wid*1024, vdst=lds0+LDS_V+wid*1024;
  #define DMA_K(t,slot) glds16(ksrc+(long)(NT-1-(t))*KVBLK*PITCH,(unsigned)__builtin_amdgcn_readfirstlane(kdst+(slot)))
  #define DMA_V(t,slot) glds16(vsrc+(long)(NT-1-(t))*KVBLK*PITCH,(unsigned)__builtin_amdgcn_readfirstlane(vdst+(slot)))
  const int vb0=(int)(lds0+LDS_V)+((lane>>4)&1)*32+(lane&3)*8+(4*hi+((lane&15)>>2))*64;
  const char*Kbase=shm+LDS_K; bf16x8 kf[8];
  const lds_cptr shm3=(lds_cptr)shm; const lds_cptr kp0=shm3+LDS_K+hi*1024+r32*16; const lds_cptr vp0=shm3+LDS_V+((lane>>4)&1)*32+(lane&3)*8+(4*hi+((lane&15)>>2))*64;
  #define VS(t) ((((t))&3)*SLOTB)
  DMA_K(0,0);DMA_V(0,VS(0));DMA_K(1,SLOTB);
  bf16x8 qr[4];
  #pragma unroll
  for(int d0=0;d0<4;++d0)qr[d0]=*reinterpret_cast<const bf16x8*>(&Qw[(long)r32*PITCH+d0*16+hi*8]);
  const int qrel=wid*QBLK+r32;
  u32x4 kdg[4];
  { const bf16*Kd=Kh+(long)(q0+qrel)*PITCH;
    #pragma unroll
    for(int d0=0;d0<4;++d0)kdg[d0]=*reinterpret_cast<const u32x4*>(&Kd[d0*16+hi*8]); }
  const float sl2=__uint_as_float(__builtin_amdgcn_readfirstlane(__float_as_uint(__builtin_amdgcn_exp2f(-(float)(h+1))*1.4426950408889634f)));
  unsigned sel=0u;
  if(c>0){
    if(tid<c*64) kml[tid]=kmean[((long)(b*8)+(tid>>6))*512+h*64+(tid&63)];
    asm volatile("s_waitcnt vmcnt(0) lgkmcnt(0)\n\ts_barrier":::"memory");
    if(c<=3) sel=(1u<<c)-1u;
    else{
      float g[8];
      #pragma unroll
      for(int j=0;j<8;++j){ g[j]=-INFINITY;
        if(j<c){ float a=0.f;
          #pragma unroll
          for(int d0=0;d0<4;++d0){ const u32x4 qv=__builtin_bit_cast(u32x4,qr[d0]); const float*km=kml+j*64+d0*16+hi*8;
            const float4 k0=*(const float4*)km, k1=*(const float4*)(km+4);
            a+=bl(qv.x)*k0.x+bh(qv.x)*k0.y+bl(qv.y)*k0.z+bh(qv.y)*k0.w+bl(qv.z)*k1.x+bh(qv.z)*k1.y+bl(qv.w)*k1.z+bh(qv.w)*k1.w; }
          g[j]=xhalf_sum(a); } }
      #pragma unroll
      for(int j=0;j<8;++j){ int rank=0;
        #pragma unroll
        for(int j2=0;j2<8;++j2){ if(j2!=j) rank+=((g[j2]>g[j])||(g[j2]==g[j]&&j2<j))?1:0; }
        if(j<c&&rank<3) sel|=(1u<<j); }
    }
  }
  float mhat;
  { float a=0.f;
    #pragma unroll
    for(int d0=0;d0<4;++d0){ const u32x4 kv=kdg[d0]; const u32x4 qv=__builtin_bit_cast(u32x4,qr[d0]);
      a+=bl(qv.x)*bl(kv.x)+bh(qv.x)*bh(kv.x)+bl(qv.y)*bl(kv.y)+bh(qv.y)*bh(kv.y)+bl(qv.z)*bl(kv.z)+bh(qv.z)*bh(kv.z)+bl(qv.w)*bl(kv.w)+bh(qv.w)*bh(kv.w); }
    mhat=xhalf_sum(a)+sl2*(float)qrel; }
  float l_reg=0.f;f32x16 o[2];o[0]=f32x16{};o[1]=f32x16{};
  f32x16 negm;
  #pragma unroll
  for(int r=0;r<16;++r)negm[r]=sl2*(float)((r&3)+8*(r>>2))-mhat;
  asm volatile("":"+v"(negm));
  #define MBIAS(P0,P1,t) do{ const int T_=NT-1-(t); const int jb_=T_-(NT-4); float a0_=sl2*(float)(64*jb_+4*hi); \
      if(jb_<0){ if(!((sel>>(T_>>2))&1u)) a0_=-INFINITY; } const float a1_=a0_+32.f*sl2; \
      _Pragma("unroll") for(int r=0;r<16;++r){P0[r]+=a0_;P1[r]+=a1_;} \
      if(jb_>=0)cmask(P0,P1,jb_,qrel,hi); }while(0)
  bool resc=false;
  #define RESC() do{ if(resc){ asm volatile("s_waitcnt lgkmcnt(0)":::"memory"); \
      _Pragma("unroll") for(int d_=0;d_<2;++d_) _Pragma("unroll") for(int r=0;r<16;++r)o[d_][r]*=wsf[crow(r,hi)]; } }while(0)
  f32x16 pA0,pA1,pB0,pB1;
  int sl_prev=0,sl_cur=0,sl_next=SLOTB;
  #define ROT() do{sl_prev=sl_cur;sl_cur=sl_next;sl_next=(sl_next==(NSLOT-1)*SLOTB)?0:sl_next+SLOTB;}while(0)
  DMA_K(2,2*SLOTB);DMA_V(1,VS(1));
  WAIT_BAR(2);
  qkt(pA0,pA1,Kbase,qr,negm,r32,hi);asm volatile("s_nop 15\n\ts_nop 7":"+v"(pA0),"+v"(pA1));MBIAS(pA0,pA1,0);
  { const float rm=rowmax(pA0,pA1);
    if(__any(rm>(float)THRL)){ const float dl=__builtin_fmaxf(rm,0.f);
      _Pragma("unroll") for(int r=0;r<16;++r){pA0[r]-=dl;pA1[r]-=dl;negm[r]-=dl;}
      asm volatile("":"+v"(negm)); } }
  _Pragma("unroll") for(int r=0;r<16;++r){pA0[r]=__builtin_amdgcn_exp2f(pA0[r]);pA1[r]=__builtin_amdgcn_exp2f(pA1[r]);}
  WAIT_BAR(2);
  DMA_K(3,0);DMA_V(2,VS(2));
  ROT();
  kload8(kf,kp0+sl_cur);
  WAIT_BAR(3);
  s16x4 vlo[8],vhi[8]; u32x4 pw0,pw1,pw2,pw3;
  #define PKW(P,B) cvtpk_s(P[B],P[B+1])
  #define PAF(k) __builtin_bit_cast(bf16x8,pw##k)
  #define VFR(i) (bf16x8){vlo[i][0],vlo[i][1],vlo[i][2],vlo[i][3],vhi[i][0],vhi[i][1],vhi[i][2],vhi[i][3]}
  #define PIN(x) asm volatile("":"+v"(x))
  #define MX3(a,b,c) __builtin_fmaxf(__builtin_fmaxf((a),(b)),(c))
  #define GAPA(MF,A0,A1,A2,A3,W0,W1,PW) do{ MF; sacc+=A0; sacc+=A1; sacc+=A2; sacc+=A3; PIN(sacc); W0; W1; PIN(PW); SBAR(); }while(0)
  #define EX(v) __builtin_amdgcn_exp2f(v)
  #define GAPB(MF,X,B) do{ MF; X[B]=EX(X[B]); X[B+1]=EX(X[B+1]); X[B+2]=EX(X[B+2]); X[B+3]=EX(X[B+3]); PIN(X); SBAR(); }while(0)
  #define VRD(i) do{ vlo[i]=vtr(vp_+(((i)>>2)*4096+((i)&3)*1024)); vhi[i]=vtr(vp_+(((i)>>2)*4096+((i)&3)*1024+512)); }while(0)
  #define KRD(G,j) do{ if(G){ kload2(kf,kp0+sl_next,j); SBAR(); } }while(0)
  #define STEP(C0,C1,P0,P1,t,GK,GV,GL) do{ SBAR(); \
    const lds_cptr vp_=vp0+VS((t)-1); \
    VRD(0); SBAR(); float sacc=(P0[0]+P0[1]); \
    GAPA(C0=__builtin_amdgcn_mfma_f32_32x32x16_bf16(kf[0],qr[0],negm,0,0,0), P0[2],P0[3],P0[4],P0[5],     pw0[0]=PKW(P0,0), pw0[1]=PKW(P0,2), pw0); \
    VRD(4); SBAR(); GAPA(C1=__builtin_amdgcn_mfma_f32_32x32x16_bf16(kf[1],qr[0],negm,0,0,0), P0[6],P0[7],P0[8],P0[9],     pw0[2]=PKW(P0,4), pw0[3]=PKW(P0,6), pw0); \
    VRD(1); SBAR(); GAPA(C0=__builtin_amdgcn_mfma_f32_32x32x16_bf16(kf[2],qr[1],C0,0,0,0),   P0[10],P0[11],P0[12],P0[13], pw1[0]=PKW(P0,8), pw1[1]=PKW(P0,10), pw1); \
    VRD(5); SBAR(); GAPA(C1=__builtin_amdgcn_mfma_f32_32x32x16_bf16(kf[3],qr[1],C1,0,0,0),   P0[14],P0[15],P1[0],P1[1],   pw1[2]=PKW(P0,12),pw1[3]=PKW(P0,14), pw1); \
    VRD(2); SBAR(); GAPA(C0=__builtin_amdgcn_mfma_f32_32x32x16_bf16(kf[4],qr[2],C0,0,0,0),   P1[2],P1[3],P1[4],P1[5],     pw2[0]=PKW(P1,0), pw2[1]=PKW(P1,2), pw2); \
    VRD(6); SBAR(); GAPA(C1=__builtin_amdgcn_mfma_f32_32x32x16_bf16(kf[5],qr[2],C1,0,0,0),   P1[6],P1[7],P1[8],P1[9],     pw2[2]=PKW(P1,4), pw2[3]=PKW(P1,6), pw2); \
    VRD(3); SBAR(); GAPA(C0=__builtin_amdgcn_mfma_f32_32x32x16_bf16(kf[6],qr[3],C0,0,0,0),   P1[10],P1[11],P1[12],P1[13], pw3[0]=PKW(P1,8), pw3[1]=PKW(P1,10), pw3); \
    VRD(7); SBAR(); GAPA(C1=__builtin_amdgcn_mfma_f32_32x32x16_bf16(kf[7],qr[3],C1,0,0,0),   P1[14],P1[15],0.f,0.f,       pw3[2]=PKW(P1,12),pw3[3]=PKW(P1,14), pw3); \
    l_reg+=sacc; \
    if(GK){DMA_K((t)+3,sl_cur);} if(GV){DMA_V((t)+2,VS((t)+2));} \
    MBIAS(C0,C1,t); \
    { float a=MX3(C0[0],C0[1],C1[0]),b=MX3(C0[2],C0[3],C1[1]); a=MX3(a,C1[2],C1[3]); \
      _Pragma("unroll") for(int r=4;r<16;r+=4){a=MX3(a,C0[r],C0[r+1]);b=MX3(b,C0[r+2],C0[r+3]);a=MX3(a,C1[r],C1[r+1]);b=MX3(b,C1[r+2],C1[r+3]);} \
      float rm=__builtin_fmaxf(a,b); { auto rr=__builtin_amdgcn_permlane32_swap(__float_as_uint(rm),__float_as_uint(rm),false,false); rm=__builtin_fmaxf(__uint_as_float(rr[0]),__uint_as_float(rr[1])); } \
      resc=false; \
      if(__builtin_expect(__any(rm>(float)THRL),0)){ const float dl=__builtin_fmaxf(rm,0.f); \
        _Pragma("unroll") for(int r=0;r<16;++r){C0[r]-=dl;C1[r]-=dl;} \
        _Pragma("unroll") for(int r=0;r<16;++r)negm[r]-=dl; asm volatile("":"+v"(negm)); \
        const float f=__builtin_amdgcn_exp2f(-dl); l_reg*=f; if(hi==0)wsf[r32]=f; resc=true; } } \
    SBAR(); \
    GAPB(o[0]=__builtin_amdgcn_mfma_f32_32x32x16_bf16(PAF(0),VFR(0),o[0],0,0,0), C0,0); \
    GAPB(o[1]=__builtin_amdgcn_mfma_f32_32x32x16_bf16(PAF(0),VFR(4),o[1],0,0,0), C0,4); \
    KRD(GL,0); GAPB(o[0]=__builtin_amdgcn_mfma_f32_32x32x16_bf16(PAF(1),VFR(1),o[0],0,0,0), C0,8); \
    KRD(GL,1); GAPB(o[1]=__builtin_amdgcn_mfma_f32_32x32x16_bf16(PAF(1),VFR(5),o[1],0,0,0), C0,12); \
    KRD(GL,2); GAPB(o[0]=__builtin_amdgcn_mfma_f32_32x32x16_bf16(PAF(2),VFR(2),o[0],0,0,0), C1,0); \
    KRD(GL,3); GAPB(o[1]=__builtin_amdgcn_mfma_f32_32x32x16_bf16(PAF(2),VFR(6),o[1],0,0,0), C1,4); \
    GAPB(o[0]=__builtin_amdgcn_mfma_f32_32x32x16_bf16(PAF(3),VFR(3),o[0],0,0,0), C1,8); \
    GAPB(o[1]=__builtin_amdgcn_mfma_f32_32x32x16_bf16(PAF(3),VFR(7),o[1],0,0,0), C1,12); \
    }while(0)
  int t=1;
  for(;t+5<NT;t+=2){
    STEP(pB0,pB1,pA0,pA1,t,true,true,true);     WAIT_BAR(3); RESC(); ROT();
    STEP(pA0,pA1,pB0,pB1,t+1,true,true,true);   WAIT_BAR(3); RESC(); ROT();
  }
  #define ENDW(tt) do{ if((tt)+3<NT){WAIT_BAR(3);} else if((tt)+2<NT){WAIT_BAR(2);} else {WAIT_BAR(0);} }while(0)
  for(;t+1<NT;t+=2){
    STEP(pB0,pB1,pA0,pA1,t,(t+3<NT),(t+2<NT),(t+1<NT));       ENDW(t);   RESC(); ROT();
    STEP(pA0,pA1,pB0,pB1,t+1,(t+4<NT),(t+3<NT),(t+2<NT));     ENDW(t+1); RESC(); ROT();
  }
  STEP(pB0,pB1,pA0,pA1,NT-1,false,false,false); RESC();
  { float sacc=pB0[0]+pB0[1]; _Pragma("unroll") for(int r=2;r<16;++r)sacc+=pB0[r]; _Pragma("unroll") for(int r=0;r<16;++r)sacc+=pB1[r]; l_reg+=sacc;
    pw0=(u32x4){PKW(pB0,0),PKW(pB0,2),PKW(pB0,4),PKW(pB0,6)};pw1=(u32x4){PKW(pB0,8),PKW(pB0,10),PKW(pB0,12),PKW(pB0,14)};pw2=(u32x4){PKW(pB1,0),PKW(pB1,2),PKW(pB1,4),PKW(pB1,6)};pw3=(u32x4){PKW(pB1,8),PKW(pB1,10),PKW(pB1,12),PKW(pB1,14)};
    SBAR(); pv(o,vb0+VS(NT-1),PAF(0),PAF(1),PAF(2),PAF(3)); }
  #undef PKW
  #undef PAF
  #undef VFR
  #undef PIN
  #undef MX3
  #undef GAPA
  #undef GAPB
  #undef EX
  #undef VRD
  #undef KRD
  #undef STEP
  #undef ENDW
  l_reg=xhalf_sum(l_reg);
  if(hi==0)wsf[32+r32]=l_reg;asm volatile("s_waitcnt lgkmcnt(0)":::"memory");
  float rli[16];
  #pragma unroll
  for(int r=0;r<16;++r)rli[r]=__builtin_amdgcn_rcpf(wsf[32+crow(r,hi)]);
  const bf16*Zw=Pz+(rowbase+q0+wid*QBLK)*PITCH+h*D; bf16*Ow=Po+(rowbase+q0+wid*QBLK)*PITCH+h*D;
  { bf16*stg=(bf16*)(shm+LDS_OST)+wid*2048;
    #pragma unroll
    for(int r=0;r<16;++r){const int orow=crow(r,hi);
      #pragma unroll
      for(int d0=0;d0<2;++d0)((unsigned short*)stg)[orow*64+d0*32+r32]=(unsigned short)cvtpk_s(o[d0][r]*rli[r],0.f);}
    asm volatile("s_waitcnt lgkmcnt(0)":::"memory");
    #pragma unroll
    for(int i=0;i<4;++i){const int row=i*8+(lane>>3),ch=lane&7; const u32x4 v=*(const u32x4*)(stg+row*64+ch*8);
      const u32x4 z=__builtin_nontemporal_load((const u32x4*)(Zw+(long)row*PITCH+ch*8)); u32x4*zp=(u32x4*)(Ow+(long)row*PITCH+ch*8); u32x4 w;
      w.x=cvtpk_s(bl(v.x)*bl(z.x),bh(v.x)*bh(z.x)); w.y=cvtpk_s(bl(v.y)*bl(z.y),bh(v.y)*bh(z.y)); w.z=cvtpk_s(bl(v.z)*bl(z.z),bh(v.z)*bh(z.z)); w.w=cvtpk_s(bl(v.w)*bl(z.w),bh(v.w)*bh(z.w));
      *zp=w; } }
  asm volatile("s_waitcnt lgkmcnt(0)\n\ts_barrier":::"memory");
  #undef DMA_K
  #undef DMA_V
  #undef VS
  #undef MBIAS
  #undef RESC
  #undef ROT
}
constexpr int ATTN_LDS_BYTES=LDS_BYTES;
#undef SBAR
#undef WAIT_BAR
}
namespace attna {
using moba::bf16; using moba::bf16x8; using moba::s16x4; using moba::f32x16; using moba::u32x4; using moba::lds_cptr;
using moba::crow; using moba::cvtpk_s; using moba::bl; using moba::bh; using moba::vtr; using moba::xhalf_sum;
constexpr int SEQ=2048,PITCH=4608;
constexpr int WK=0,WV=4608,WO=12800,WSC=16896,WBYTES=17152,LSE_OFF=8*WBYTES,LDS_BYTES=LSE_OFF+3*512*4;
#define AMFMA(a,b,c) __builtin_amdgcn_mfma_f32_32x32x16_bf16(a,b,c,0,0,0)

__device__ __forceinline__ void sub_item(bf16*P,int b,int hs,int g,int res,int l0,int chunk,char*wl,float*lse_l,int lane){
  asm volatile("":"+v"(lane));
  const int r32=lane&31,hi=lane>>5;
  const int dsh=2*g;
  const long rowb=(long)b*SEQ+res;
  const int qcol=g*768+hs*64;
  const float sl2=__builtin_amdgcn_exp2f(-(2.0f/3.0f)*(float)(4*g+hs+1))*(float)(1<<dsh)*1.4426950408889634f;
  #define AROW(l) ((rowb+((long)(l)<<dsh))*PITCH)
  #define KL(i,x) ((l0-128+32*(i)+(x))<0?0:(l0-128+32*(i)+(x)))
  const int i0=(l0>=128)?0:(4-(l0>>5));
  const int lrow=lane>>3, lch=lane&7;
  u32x4 qg[4],kg[5][4],vg[5][4];
  #pragma unroll
  for(int j=0;j<4;++j)qg[j]=*reinterpret_cast<const u32x4*>(P+AROW(l0+lrow+8*j)+qcol+lch*8);
  #pragma unroll
  for(int i=4;i>=0;--i)
    #pragma unroll
    for(int j=0;j<4;++j)kg[i][j]=*reinterpret_cast<const u32x4*>(P+AROW(KL(i,lrow+8*j))+qcol+256+lch*8);
  #pragma unroll
  for(int i=4;i>=0;--i)
    #pragma unroll
    for(int j=0;j<4;++j)vg[i][j]=*reinterpret_cast<const u32x4*>(P+AROW(KL(i,lrow+8*j))+qcol+512+lch*8);
  __builtin_amdgcn_sched_barrier(0);
  char*kb=wl+WK; const int kwoff=lrow*144+lch*16, kroff=r32*144+hi*16;
  bf16x8 qf[4];
  #pragma unroll
  for(int j=0;j<4;++j)*reinterpret_cast<u32x4*>(kb+kwoff+j*8*144)=qg[j];
  #pragma unroll
  for(int d0=0;d0<4;++d0)qf[d0]=*reinterpret_cast<const bf16x8*>(kb+kroff+d0*32);
  f32x16 S[5];
  #pragma unroll
  for(int i=4;i>=0;--i){
    #pragma unroll
    for(int j=0;j<4;++j)*reinterpret_cast<u32x4*>(kb+kwoff+j*8*144)=kg[i][j];
    bf16x8 kf[4];
    #pragma unroll
    for(int d0=0;d0<4;++d0)kf[d0]=*reinterpret_cast<const bf16x8*>(kb+kroff+d0*32);
    f32x16 acc=f32x16{};
    #pragma unroll
    for(int d0=0;d0<4;++d0)acc=AMFMA(kf[d0],qf[d0],acc);
    const float sbi=((i<i0)?-INFINITY:0.f)-sl2*(float)(32*(4-i)+r32-4*hi);
    #pragma unroll
    for(int r=0;r<16;++r){ const int kc=(r&3)+8*(r>>2); float v=__builtin_fmaf(sl2,(float)kc,acc[r]+sbi);
      if(i==4&&kc+4*hi>r32)v=-INFINITY; if(i==0&&kc+4*hi<r32)v=-INFINITY; acc[r]=v; }
    S[i]=acc;
  }
  float mx=-INFINITY;
  #pragma unroll
  for(int i=0;i<5;++i)
    #pragma unroll
    for(int r=0;r<16;++r)mx=fmaxf(mx,S[i][r]);
  { auto rr=__builtin_amdgcn_permlane32_swap(__float_as_uint(mx),__float_as_uint(mx),false,false); mx=fmaxf(__uint_as_float(rr[0]),__uint_as_float(rr[1])); }
  float ls=0.f;
  #pragma unroll
  for(int i=0;i<5;++i)
    #pragma unroll
    for(int r=0;r<16;++r){ const float p=__builtin_amdgcn_exp2f(S[i][r]-mx); S[i][r]=p; ls+=p; }
  ls=xhalf_sum(ls);
  f32x16 o[2]; o[0]=f32x16{}; o[1]=f32x16{};
  const lds_cptr wl3=(lds_cptr)wl;
  const int vtoff=((lane>>4)&1)*32+(lane&3)*8+(4*hi+((lane&15)>>2))*64;
  const int vwoff=(lch>>2)*2048+lrow*64+(lch&3)*16;
  #define PVSTEP(i) do{ char*vb_=wl+WV+((i)&1)*4096; \
      _Pragma("unroll") for(int j=0;j<4;++j)*reinterpret_cast<u32x4*>(vb_+vwoff+j*8*64)=vg[i][j]; \
      const u32x4 pw0=(u32x4){cvtpk_s(S[i][0],S[i][1]),cvtpk_s(S[i][2],S[i][3]),cvtpk_s(S[i][4],S[i][5]),cvtpk_s(S[i][6],S[i][7])}; \
      const u32x4 pw1=(u32x4){cvtpk_s(S[i][8],S[i][9]),cvtpk_s(S[i][10],S[i][11]),cvtpk_s(S[i][12],S[i][13]),cvtpk_s(S[i][14],S[i][15])}; \
      const lds_cptr vp=wl3+WV+((i)&1)*4096+vtoff; \
      _Pragma("unroll") for(int d0=0;d0<2;++d0){ \
        const s16x4 a0=vtr(vp+d0*2048),a1=vtr(vp+d0*2048+512),b0=vtr(vp+d0*2048+1024),b1=vtr(vp+d0*2048+1536); \
        const bf16x8 f0=(bf16x8){a0[0],a0[1],a0[2],a0[3],a1[0],a1[1],a1[2],a1[3]}, f1=(bf16x8){b0[0],b0[1],b0[2],b0[3],b1[0],b1[1],b1[2],b1[3]}; \
        o[d0]=AMFMA(__builtin_bit_cast(bf16x8,pw0),f0,o[d0]); \
        o[d0]=AMFMA(__builtin_bit_cast(bf16x8,pw1),f1,o[d0]); } }while(0)
  PVSTEP(4); PVSTEP(3); PVSTEP(2); PVSTEP(1); PVSTEP(0);
  float*ws=(float*)(wl+WSC);
  const int tokc=((l0+r32)<<dsh)+res-chunk*512;
  if(hi==0){ ws[r32]=__builtin_amdgcn_rcpf(ls); lse_l[g*512+tokc]=mx+__builtin_amdgcn_logf(ls); }
  bf16*stg=(bf16*)(wl+WO);
  #pragma unroll
  for(int r=0;r<16;++r){ const int orow=crow(r,hi); const float il=ws[orow];
    #pragma unroll
    for(int d0=0;d0<2;++d0)((unsigned short*)stg)[orow*64+d0*32+r32]=(unsigned short)cvtpk_s(o[d0][r]*il,0.f); }
  #pragma unroll
  for(int i=0;i<4;++i){ const int row=i*8+(lane>>3),ch=lane&7; const u32x4 v=*reinterpret_cast<const u32x4*>(stg+row*64+ch*8);
    *reinterpret_cast<u32x4*>(P+AROW(l0+row)+qcol+ch*8)=v; }
  #undef AROW
  #undef KL
  #undef PVSTEP
}

__device__ __forceinline__ void wg_item(bf16*P,int b,int hs,int chunk,char*shm){
  int tid_=threadIdx.x; asm volatile("":"+v"(tid_));
  const int tid=tid_,lane=tid&63; const int wid=__builtin_amdgcn_readfirstlane(tid>>6);
  char*wl=shm+wid*WBYTES; float*lse_l=(float*)(shm+LSE_OFF);
  #pragma unroll 1
  for(int i6=0;i6<6;++i6){
    const int si=wid+8*i6, g=si>>4, k=si&15;
    int res,l0;
    if(g==0){res=0;l0=32*(chunk*16+k);} else if(g==1){res=k>>2;l0=128*chunk+32*(k&3);} else {res=k;l0=32*chunk;}
    sub_item(P,b,hs,g,res,l0,chunk,wl,lse_l,lane);
  }
  __syncthreads();
  #pragma unroll
  for(int idx=tid;idx<512*8;idx+=512){
    const int tok=idx>>3,ch=idx&7; const long row=((long)b*SEQ+chunk*512+tok)*PITCH;
    const float e0=lse_l[tok],e1=lse_l[512+tok],e2=lse_l[1024+tok]; const float em=fmaxf(e0,fmaxf(e1,e2));
    float w0=__builtin_amdgcn_exp2f(e0-em),w1=__builtin_amdgcn_exp2f(e1-em),w2=__builtin_amdgcn_exp2f(e2-em); const float iw=__builtin_amdgcn_rcpf(w0+w1+w2); w0*=iw;w1*=iw;w2*=iw;
    const u32x4 a=*reinterpret_cast<const u32x4*>(P+row+hs*64+ch*8), bq=*reinterpret_cast<const u32x4*>(P+row+768+hs*64+ch*8), cq=*reinterpret_cast<const u32x4*>(P+row+1536+hs*64+ch*8);
    u32x4*zp=reinterpret_cast<u32x4*>(P+row+2304+hs*64+ch*8); const u32x4 z=__builtin_nontemporal_load(zp); u32x4 w;
    #define CMB(f) cvtpk_s((w0*bl(a.f)+w1*bl(bq.f)+w2*bl(cq.f))*bl(z.f),(w0*bh(a.f)+w1*bh(bq.f)+w2*bh(cq.f))*bh(z.f))
    w.x=CMB(x); w.y=CMB(y); w.z=CMB(z); w.w=CMB(w);
    #undef CMB
    *zp=w;
  }
  __syncthreads();
}
#undef AMFMA
}

constexpr int NWAVES = 8;
constexpr int BATCH = 16, SEQ = 2048, DM = 1024, M = BATCH * SEQ, DEPTH = 2;
constexpr int INC = 6656;
constexpr int LDP = 4608;
constexpr int C_AQKV = 0, C_ZA = 2304, C_BQKV = 2560, C_ZB = 4096, C_RA = 4608, C_RB = 5632;
constexpr int C_MERGED = 0;
constexpr float RMS_EPS = 1e-6f;
constexpr size_t MiB = 1u << 20;
constexpr size_t WS_CTL = 0;
constexpr size_t WS_BAR = 0, WS_BAR_BYTES = 64 * 1024;
constexpr size_t WS_KMEAN = 256 * 1024;
constexpr size_t WS_WIN = 1 * MiB;
constexpr size_t WS_WCAT = 14 * MiB;
constexpr size_t WS_WOUT = 17 * MiB;
constexpr size_t WS_XB = 21 * MiB;
constexpr size_t WS_PROJ = 85 * MiB;
constexpr size_t WS_GATES = 373 * MiB;
constexpr size_t WS_WIN1 = 437 * MiB;
constexpr size_t WS_ROWSS = 450 * MiB;
constexpr size_t WS_XB8 = 454 * MiB;
constexpr size_t WS_W8 = 486 * MiB;
constexpr size_t WS_COLMAX = 32 * 1024;
constexpr size_t WS_XSCALE = 128 * 1024;
constexpr size_t WS_END = 495 * MiB;
static_assert(WS_PROJ + (size_t)M * LDP * 2 == WS_GATES && WS_GATES + (size_t)M * 2048 == WS_WIN1, "ws map");
constexpr int LDS_MISC = pg8::EPI_OFF + 8 * pg8::EPI_WAVE;
constexpr int LDS_RSTAB = LDS_MISC + 256;
constexpr int LDS_BYTES = LDS_RSTAB + 1024 + 64;

#define LAS __attribute__((address_space(3)))
typedef unsigned short bf16;
typedef unsigned v4u __attribute__((ext_vector_type(4)));
typedef float f32x4 __attribute__((ext_vector_type(4)));
#define RLX_AGENT __ATOMIC_RELAXED, __HIP_MEMORY_SCOPE_AGENT
#define XB_TMO      128
#define XB_XCNT(j)  (256  + 64 * (j))
#define XB_XSUB(j)  (1280 + 64 * (j))
#define XB_XGEN(j)  (2304 + 64 * (j))
#define XB_TOP      3328
#define XB_TOPGEN   3392
#define XCD_BAR_WORDS 3456
#define XB_SPIN_CAP (1u << 18)

__device__ __forceinline__ unsigned xb_ld(unsigned* p)              { return __hip_atomic_load(p, __ATOMIC_RELAXED, __HIP_MEMORY_SCOPE_AGENT); }
__device__ __forceinline__ unsigned xb_add(unsigned* p, unsigned v) { return __hip_atomic_fetch_add(p, v, __ATOMIC_RELAXED, __HIP_MEMORY_SCOPE_AGENT); }
__device__ __forceinline__ unsigned xb_xcc_id() { return (unsigned)__builtin_amdgcn_s_getreg((3 << 11) | 20) & 0xFu; }
#define XB_SPIN(cond, bar) do { unsigned _sp = 0; while (cond) { __builtin_amdgcn_s_sleep(1); \
    if ((++_sp & 255u) == 0u) { if (xb_ld(&(bar)[XB_TMO])) break; if (_sp > XB_SPIN_CAP) { atomicAdd(&(bar)[XB_TMO], 1u); break; } } } } while (0)

struct XcdBarrier {
    unsigned* bar; unsigned x;
    volatile LAS unsigned* st;
};

__device__ __forceinline__ XcdBarrier xcd_barrier_post(unsigned* bar, volatile LAS unsigned* st) {
    XcdBarrier b; b.bar = bar; b.x = xb_xcc_id(); b.st = st;
    if (threadIdx.x == 0) (void)xb_add(&bar[XB_XCNT(b.x)], 1u);
    return b;
}
__device__ __forceinline__ void xcd_barrier_complete(unsigned* bar, unsigned x, unsigned& nloc, unsigned& nx) {
    const unsigned G = gridDim.x * gridDim.y * gridDim.z;
    unsigned sum, cnt, mine, sp = 0u;
    for (;;) {
        sum = 0u; cnt = 0u; mine = 0u;
#pragma unroll
        for (unsigned j = 0; j < 16; ++j) { const unsigned c = xb_ld(&bar[XB_XCNT(j)]); sum += c; cnt += (c > 0u) ? 1u : 0u; mine = (j == x) ? c : mine; }
        if (sum == G) break;
        __builtin_amdgcn_s_sleep(1);
        if ((++sp & 255u) == 0u) { if (xb_ld(&bar[XB_TMO])) break; if (sp > XB_SPIN_CAP) { atomicAdd(&bar[XB_TMO], 1u); break; } }
    }
    nloc = mine > 0u ? mine : 1u; nx = cnt > 0u ? cnt : 1u;
}

__device__ __forceinline__ void xcd_barrier(const XcdBarrier& b) {
    asm volatile("s_waitcnt vmcnt(0)" ::: "memory");
    __syncthreads();
    if (threadIdx.x == 0) {
        unsigned* bar = b.bar;
        __builtin_amdgcn_s_waitcnt(0);
        unsigned nloc = b.st[0], nx = b.st[1];
        if (nloc == 0u) { xcd_barrier_complete(bar, b.x, nloc, nx); b.st[0] = nloc; b.st[1] = nx; }
        const unsigned old = xb_add(&bar[XB_XSUB(b.x)], 1u);
        const unsigned gen = old / nloc;
        if (old + 1u == (gen + 1u) * nloc) {
            __builtin_amdgcn_fence(__ATOMIC_RELEASE, "agent");
            asm volatile("s_waitcnt vmcnt(0)" ::: "memory");
            const unsigned og = xb_add(&bar[XB_TOP], 1u);
            const unsigned tg = og / nx;
            if (og + 1u == (tg + 1u) * nx) xb_add(&bar[XB_TOPGEN], 1u);
            else XB_SPIN(xb_ld(&bar[XB_TOPGEN]) == tg, bar);
            __builtin_amdgcn_fence(__ATOMIC_ACQUIRE, "agent");
            xb_add(&bar[XB_XGEN(b.x)], 1u);
            asm volatile("s_waitcnt vmcnt(0)" ::: "memory");
        } else {
            XB_SPIN(xb_ld(&bar[XB_XGEN(b.x)]) == gen, bar);
            __builtin_amdgcn_fence(__ATOMIC_ACQUIRE, "agent");
            asm volatile("s_waitcnt vmcnt(0)" ::: "memory");
        }
    }
    __syncthreads();
}

__device__ __forceinline__ unsigned f2bf(float f) { unsigned u = __builtin_bit_cast(unsigned, f); return (u + 0x7fffu + ((u >> 16) & 1u)) >> 16; }
__device__ __forceinline__ unsigned pk2(float lo, float hi) { return f2bf(lo) | (f2bf(hi) << 16); }
__device__ __forceinline__ float bf2f(bf16 v) { return __uint_as_float(((unsigned)v) << 16); }
__device__ __forceinline__ float blo(unsigned u) { return __uint_as_float(u << 16); }
__device__ __forceinline__ float bhi(unsigned u) { return __uint_as_float(u & 0xffff0000u); }
__device__ __forceinline__ float wave_sum(float v) {
#pragma unroll
    for (int o = 1; o < 64; o <<= 1) v += __shfl_xor(v, o);
    return v;
}
__device__ __forceinline__ float wave_max(float v) {
#pragma unroll
    for (int o = 1; o < 64; o <<= 1) v = fmaxf(v, __shfl_xor(v, o));
    return v;
}
__device__ __forceinline__ void transpose_item(const float* W, int K, int N, bf16* WT, int ldw, LAS float* scr, int item, int lane, const float* gain = nullptr, int nsrc = -1) {
    const int nblk = N / 32, kb = item / nblk, nb = item % nblk, k0 = 64 * kb, n0 = 32 * nb; W += (nsrc >= 0 ? nsrc - n0 : 0);
    f32x4 v[8]; float gk[8];
#pragma unroll
    for (int i = 0; i < 8; ++i) { const int kk = 8 * i + (lane >> 3); v[i] = __builtin_nontemporal_load((const f32x4*)(W + (size_t)(k0 + kk) * N + n0 + 4 * (lane & 7))); gk[i] = gain ? gain[k0 + kk] : 1.0f; }
#pragma unroll
    for (int i = 0; i < 8; ++i) { const int kk = 8 * i + (lane >> 3); LAS float* d = scr + kk * 33 + 4 * (lane & 7); d[0] = v[i].x * gk[i]; d[1] = v[i].y * gk[i]; d[2] = v[i].z * gk[i]; d[3] = v[i].w * gk[i]; }
    asm volatile("s_waitcnt lgkmcnt(0)" ::: "memory");
    const int c = lane & 7;
#pragma unroll
    for (int j = 0; j < 4; ++j) { const int n = (lane >> 3) + 8 * j; const LAS float* s = scr + (8 * c) * 33 + n;
        v4u o; o.x = pk2(s[0 * 33], s[1 * 33]); o.y = pk2(s[2 * 33], s[3 * 33]); o.z = pk2(s[4 * 33], s[5 * 33]); o.w = pk2(s[6 * 33], s[7 * 33]);
        *(v4u*)(WT + (size_t)(n0 + n) * ldw + k0 + 8 * c) = o; }
    asm volatile("s_waitcnt lgkmcnt(0)" ::: "memory");
}
template <bool OUT_BF16> __device__ __forceinline__ void rms_row(const float* xrow, const float* g, void* orow, int lane) {
    const f32x4* xr = (const f32x4*)xrow + lane; const f32x4* gr = (const f32x4*)g + lane;
    f32x4 v[4]; float s = 0.f;
#pragma unroll
    for (int j = 0; j < 4; ++j) { v[j] = xr[64 * j]; s += (v[j].x * v[j].x + v[j].y * v[j].y) + (v[j].z * v[j].z + v[j].w * v[j].w); }
    const float rstd = 1.0f / sqrtf(wave_sum(s) * (1.f / DM) + RMS_EPS);
#pragma unroll
    for (int j = 0; j < 4; ++j) { const f32x4 gg = gr[64 * j]; v[j] = v[j] * rstd * gg; }
    if (OUT_BF16) { unsigned long long* o8 = (unsigned long long*)orow + lane;
#pragma unroll
        for (int j = 0; j < 4; ++j) o8[64 * j] = (unsigned long long)pk2(v[j].x, v[j].y) | ((unsigned long long)pk2(v[j].z, v[j].w) << 32);
    } else { f32x4* o = (f32x4*)orow + lane;
#pragma unroll
        for (int j = 0; j < 4; ++j) o[64 * j] = v[j]; }
}
__device__ __forceinline__ unsigned pack_i8x4(float a, float b, float c, float d) {
    const int ia = (int)__builtin_rintf(fminf(fmaxf(a, -127.f), 127.f)), ib = (int)__builtin_rintf(fminf(fmaxf(b, -127.f), 127.f)), ic = (int)__builtin_rintf(fminf(fmaxf(c, -127.f), 127.f)), id = (int)__builtin_rintf(fminf(fmaxf(d, -127.f), 127.f));
    return (unsigned)(ia & 255) | ((unsigned)(ib & 255) << 8) | ((unsigned)(ic & 255) << 16) | ((unsigned)(id & 255) << 24);
}
__device__ __forceinline__ void raw_row(const float* xrow, bf16* orow, float* ss, signed char* o8row, float* xs, int lane) {
    const f32x4* xr = (const f32x4*)xrow + lane; f32x4 v[4]; float s = 0.f, mx = 0.f;
#pragma unroll
    for (int j = 0; j < 4; ++j) { v[j] = __builtin_nontemporal_load(xr + 64 * j); s += (v[j].x * v[j].x + v[j].y * v[j].y) + (v[j].z * v[j].z + v[j].w * v[j].w);
        mx = fmaxf(mx, fmaxf(fmaxf(fabsf(v[j].x), fabsf(v[j].y)), fmaxf(fabsf(v[j].z), fabsf(v[j].w)))); }
    s = wave_sum(s); if (lane < 16) ss[lane] = (lane == 0) ? s : 0.f;
    mx = wave_max(mx); const float sc = mx > 0.f ? mx * (1.0f / 127.0f) : 1.0f, isc = 1.0f / sc; if (lane == 0) *xs = sc;
    unsigned long long* o8 = (unsigned long long*)orow + lane; unsigned* q8 = (unsigned*)o8row + lane;
#pragma unroll
    for (int j = 0; j < 4; ++j) { o8[64 * j] = (unsigned long long)pk2(v[j].x, v[j].y) | ((unsigned long long)pk2(v[j].z, v[j].w) << 32);
        q8[64 * j] = pack_i8x4(v[j].x * isc, v[j].y * isc, v[j].z * isc, v[j].w * isc); }
}
__device__ __forceinline__ void quant_row(const bf16* xrow, signed char* o8row, float* xs, int lane) {
    typedef unsigned u32x2_t __attribute__((ext_vector_type(2)));
    const u32x2_t* xr = (const u32x2_t*)xrow + lane; u32x2_t b[4]; float mx = 0.f;
#pragma unroll
    for (int j = 0; j < 4; ++j) { b[j] = xr[64 * j]; mx = fmaxf(mx, fmaxf(fmaxf(fabsf(blo(b[j].x)), fabsf(bhi(b[j].x))), fmaxf(fabsf(blo(b[j].y)), fabsf(bhi(b[j].y))))); }
    mx = wave_max(mx); const float sc = mx > 0.f ? mx * (1.0f / 127.0f) : 1.0f, isc = 1.0f / sc; if (lane == 0) *xs = sc;
    unsigned* q8 = (unsigned*)o8row + lane;
#pragma unroll
    for (int j = 0; j < 4; ++j) q8[64 * j] = pack_i8x4(blo(b[j].x) * isc, bhi(b[j].x) * isc, blo(b[j].y) * isc, bhi(b[j].y) * isc);
}
__device__ __forceinline__ void quant_strip_wg(const float* W, const float* gain, signed char* W8, float* wscale, LAS float* scr, LAS float* cmw, int strip, int lane, int wave) {
    const int n0 = 32 * strip; const int tj = n0 >> 8; const int tl8 = tj < 6 ? tj + (tj >> 1) : (tj < 9 ? 3 * (tj - 6) + 2 : 14); const int src0 = n0 < 2560 ? 256 * tl8 + (n0 & 255) : 4608 + (n0 - 2560);
    const float* Wc = W + src0 + 4 * (lane & 7);
    f32x4 v[2][8]; float gk[2][8]; f32x4 m4 = (f32x4){0.f, 0.f, 0.f, 0.f};
#pragma unroll
    for (int q = 0; q < 2; ++q)
#pragma unroll
        for (int i = 0; i < 8; ++i) { const int kk = 64 * (2 * wave + q) + 8 * i + (lane >> 3); v[q][i] = *(const f32x4*)(Wc + (size_t)kk * INC); gk[q][i] = gain[kk]; }
#pragma unroll
    for (int q = 0; q < 2; ++q)
#pragma unroll
        for (int i = 0; i < 8; ++i) { v[q][i] = v[q][i] * gk[q][i]; m4.x = fmaxf(m4.x, fabsf(v[q][i].x)); m4.y = fmaxf(m4.y, fabsf(v[q][i].y)); m4.z = fmaxf(m4.z, fabsf(v[q][i].z)); m4.w = fmaxf(m4.w, fabsf(v[q][i].w)); }
#pragma unroll
    for (int o = 8; o < 64; o <<= 1) { m4.x = fmaxf(m4.x, __shfl_xor(m4.x, o)); m4.y = fmaxf(m4.y, __shfl_xor(m4.y, o)); m4.z = fmaxf(m4.z, __shfl_xor(m4.z, o)); m4.w = fmaxf(m4.w, __shfl_xor(m4.w, o)); }
    if (lane < 8) { LAS float* c = cmw + wave * 32 + 4 * lane; c[0] = m4.x; c[1] = m4.y; c[2] = m4.z; c[3] = m4.w; }
    __syncthreads();
    const int n = lane & 31, kh = lane >> 5; float cmx = 0.f;
#pragma unroll
    for (int w = 0; w < 8; ++w) cmx = fmaxf(cmx, cmw[w * 32 + n]);
    const float sc = cmx > 0.f ? cmx * (1.0f / 127.0f) : 1.0f, isc = 1.0f / sc;
    if (wave == 0 && kh == 0) wscale[n0 + n] = sc;
#pragma unroll
    for (int q = 0; q < 2; ++q) {
#pragma unroll
        for (int i = 0; i < 8; ++i) { const int kk = 8 * i + (lane >> 3); LAS float* d = scr + kk * 33 + 4 * (lane & 7); d[0] = v[q][i].x; d[1] = v[q][i].y; d[2] = v[q][i].z; d[3] = v[q][i].w; }
        asm volatile("s_waitcnt lgkmcnt(0)" ::: "memory");
        const LAS float* s = scr + (32 * kh) * 33 + n; v4u o0, o1;
        o0.x = pack_i8x4(s[0 * 33] * isc, s[1 * 33] * isc, s[2 * 33] * isc, s[3 * 33] * isc); o0.y = pack_i8x4(s[4 * 33] * isc, s[5 * 33] * isc, s[6 * 33] * isc, s[7 * 33] * isc);
        o0.z = pack_i8x4(s[8 * 33] * isc, s[9 * 33] * isc, s[10 * 33] * isc, s[11 * 33] * isc); o0.w = pack_i8x4(s[12 * 33] * isc, s[13 * 33] * isc, s[14 * 33] * isc, s[15 * 33] * isc);
        o1.x = pack_i8x4(s[16 * 33] * isc, s[17 * 33] * isc, s[18 * 33] * isc, s[19 * 33] * isc); o1.y = pack_i8x4(s[20 * 33] * isc, s[21 * 33] * isc, s[22 * 33] * isc, s[23 * 33] * isc);
        o1.z = pack_i8x4(s[24 * 33] * isc, s[25 * 33] * isc, s[26 * 33] * isc, s[27 * 33] * isc); o1.w = pack_i8x4(s[28 * 33] * isc, s[29 * 33] * isc, s[30 * 33] * isc, s[31 * 33] * isc);
        v4u* dst = (v4u*)(W8 + (size_t)(n0 + n) * 1024 + 64 * (2 * wave + q) + 32 * kh); dst[0] = o0; dst[1] = o1;
        asm volatile("s_waitcnt lgkmcnt(0)" ::: "memory");
    }
    __syncthreads();
}
__device__ __forceinline__ float dot64(const v4u (&q)[8], const bf16* krow) {
    const v4u* kp = (const v4u*)krow; float a0 = 0.f, a1 = 0.f;
#pragma unroll
    for (int i = 0; i < 8; ++i) { const v4u k = kp[i];
        a0 += blo(q[i].x) * blo(k.x) + blo(q[i].y) * blo(k.y) + blo(q[i].z) * blo(k.z) + blo(q[i].w) * blo(k.w);
        a1 += bhi(q[i].x) * bhi(k.x) + bhi(q[i].y) * bhi(k.y) + bhi(q[i].z) * bhi(k.z) + bhi(q[i].w) * bhi(k.w); }
    return a0 + a1;
}

struct Args { const float* x; const float* norm_g; const float* w_in; const float* b_merge; const float* w_pa; const float* w_pb; const float* w_out; const float* final_g;
              float* out; unsigned char* ws; };

#define PHASE_VARS() \
    int tid_ = threadIdx.x; asm volatile("" : "+v"(tid_)); \
    const int lane = tid_ & 63, wave = __builtin_amdgcn_readfirstlane(tid_ >> 6); \
    const int G = gridDim.x, gw = blockIdx.x * NWAVES + wave, NGW = G * NWAVES; \
    unsigned long long wsb_ = (unsigned long long)a.ws; asm volatile("" : "+s"(wsb_)); \
    unsigned char* const ws = (unsigned char*)(__attribute__((address_space(1))) unsigned char*)wsb_;     \
    bf16* const Win = (bf16*)(ws + (layer == 0 ? WS_WIN : WS_WIN1)); float* const rowss = (float*)(ws + WS_ROWSS); signed char* const XB8 = (signed char*)(ws + WS_XB8); signed char* const W8 = (signed char*)(ws + WS_W8); float* const wscale = (float*)(ws + WS_COLMAX); float* const xscale = (float*)(ws + WS_XSCALE); bf16* const Wcat = (bf16*)(ws + WS_WCAT); bf16* const Wout = (bf16*)(ws + WS_WOUT); \
    bf16* const XB = (bf16*)(ws + WS_XB); bf16* const P = (bf16*)(ws + WS_PROJ); float* const kmean = (float*)(ws + WS_KMEAN); unsigned char* const gatesb = ws + WS_GATES; \
    (void)lane; (void)wave; (void)G; (void)gw; (void)NGW; (void)Win; (void)Wcat; (void)Wout; (void)rowss; (void)XB8; (void)W8; (void)wscale; (void)xscale; (void)XB; (void)P; (void)kmean; (void)gatesb;

#define GRID_BAR() do { unsigned long long wb_ = (unsigned long long)a.ws; asm volatile("" : "+s"(wb_)); XcdBarrier bb_; bb_.bar = (unsigned*)(__attribute__((address_space(1))) unsigned*)wb_; \
    bb_.x = xb_xcc_id(); bb_.st = (volatile LAS unsigned*)(L + LDS_MISC); xcd_barrier(bb_); } while (0)
template <int layer> __device__ __forceinline__ void layer_fwd(const Args& a, unsigned char* lds, LAS unsigned char* L) {
    if (layer == 0) {
        PHASE_VARS();
        LAS float* scr = (LAS float*)(L + wave * 16384);
        constexpr int I_IN = (DM / 64) * (2048 / 32), I_PA = (256 / 64) * (DM / 32), I_PB = (512 / 64) * (DM / 32), I_OUT = (DM / 64) * (DM / 32);
        const int nitems = 2 * (I_IN + I_PA + I_PB + I_OUT);
        for (int it = gw; it < nitems; it += NGW) {
            const int l2 = it / (I_IN + I_PA + I_PB + I_OUT); int r = it - l2 * (I_IN + I_PA + I_PB + I_OUT);
            if (r < I_IN) { const int kb_ = r / 64, nb_ = r % 64, tj_ = nb_ >> 3, tl_ = tj_ < 5 ? tj_ + 9 : tj_ + 10;
                transpose_item(a.w_in + (size_t)l2 * DM * INC, DM, INC, (bf16*)(ws + (l2 == 0 ? WS_WIN : WS_WIN1)), DM, scr, kb_ * (INC / 32) + nb_, lane, a.norm_g + l2 * DM, 256 * tl_ + 32 * (nb_ & 7)); continue; } r -= I_IN;
            if (r < I_PA) { transpose_item(a.w_pa + (size_t)l2 * 256 * DM, 256, DM, Wcat + (size_t)l2 * DM * 768, 768, scr, r, lane); continue; } r -= I_PA;
            if (r < I_PB) { transpose_item(a.w_pb + (size_t)l2 * 512 * DM, 512, DM, Wcat + (size_t)l2 * DM * 768 + 256, 768, scr, r, lane); continue; } r -= I_PB;
            transpose_item(a.w_out + (size_t)l2 * DM * DM, DM, DM, Wout + (size_t)l2 * DM * DM, DM, scr, r, lane);
        }
        for (int i = gw * 64 + lane; i < 2 * 128 * 512; i += NGW * 64) kmean[i] = 0.f;
        for (int it = (int)blockIdx.x; it < 2 * 144; it += G) { const int l2 = it / 144;
            quant_strip_wg(a.w_in + (size_t)l2 * DM * INC, a.norm_g + l2 * DM, W8 + (size_t)l2 * 4608 * 1024, wscale + l2 * 4608, scr, (LAS float*)(L + 12288), it % 144, lane, wave); }
        for (int m = gw; m < M; m += NGW) raw_row(a.x + (size_t)m * DM, XB + (size_t)m * DM, rowss + (size_t)m * 16, XB8 + (size_t)m * DM, xscale + m, lane);
    }
    if (layer == 0) GRID_BAR();
    if (layer == 1) {
        PHASE_VARS();
        for (int m = gw; m < M; m += NGW) quant_row(XB + (size_t)m * DM, XB8 + (size_t)m * DM, xscale + m, lane);
    }
    if (layer == 1) GRID_BAR();
    {
        PHASE_VARS();
        if (threadIdx.x == 0) ((LAS int*)(L + LDS_RSTAB))[256] = -1;
        __syncthreads();
        {
            pg8::Gemm g8{(const pg8::bf16_t*)XB8, (const pg8::bf16_t*)(W8 + (size_t)layer * 4608 * 1024), M, 2560, 512, 512}; pg8::StaticOrder S8; S8.init(M, 2560, G, (int)blockIdx.x);
            pg8::EpiProjQ8 E8{P, LDP, wscale + layer * 4608, xscale, rowss + (size_t)layer * M * 16};
            pg8::gemm_phase<pg8::EpiProjQ8, pg8::StaticOrder, true, true>(L, g8, S8, E8);
        }
        if (threadIdx.x == 0) ((LAS int*)(L + LDS_RSTAB))[256] = -1;
        __syncthreads();
        pg8::Gemm g{XB, Win, M, 2048, DM, DM}; pg8::StaticOrder S; S.init(M, 2048, G, (int)blockIdx.x);
        pg8::EpiProj E{P, LDP, kmean + layer * 128 * 512, rowss + (size_t)layer * M * 16};
        pg8::gemm_phase<pg8::EpiProj, pg8::StaticOrder, true, true>(L, g, S, E);
    }
    GRID_BAR();
    {
        PHASE_VARS();
        const int vcu = (G % 8 == 0) ? ((int)blockIdx.x % 8) * (G / 8) + (int)blockIdx.x / 8 : (int)blockIdx.x;
#pragma unroll 1
        for (int pass = 0; pass < 2; ++pass) {
            if ((pass ^ (vcu >> 2)) & 1) {
                for (int it = (int)blockIdx.x; it < BATCH * 4 * 4; it += G) attna::wg_item((attna::bf16*)P, it >> 4, (it >> 2) & 3, it & 3, (char*)lds);
            } else {
                for (int p = vcu; p < BATCH * 8 * 4; p += G) {
                    const int bh = p >> 2, s = p & 3;
#pragma unroll 1
                    for (int u = 0; u < 2; ++u)
                        moba::moba_unit<8>(bh >> 3, bh & 7, u ? 7 - s : s, (const moba::bf16*)(P + C_BQKV), (const moba::bf16*)(P + C_BQKV + 512), (const moba::bf16*)(P + C_BQKV + 1024), (const moba::bf16*)(P + C_ZB), (moba::bf16*)(P + C_BQKV), kmean + layer * 128 * 512, (char*)lds);
                }
            }
        }
    }
    GRID_BAR();
    {
        PHASE_VARS();
        pg8::StaticOrder S; S.init(M, DM, G, (int)blockIdx.x);
        {
            struct GateOrder { pg8::StaticOrder S;
                __device__ __forceinline__ bool next(int i, pg8::Unit& u) const { if (!S.next(i >> 1, u)) return false; u.pn += 4 * (i & 1); return true; }
                __device__ __forceinline__ void a_ready(const pg8::Unit&) const {} __device__ __forceinline__ void done(const pg8::Unit&) const {} } GS{S};
            if (threadIdx.x == 0) ((LAS int*)(L + LDS_RSTAB))[256] = -1;
            __syncthreads();
            pg8::Gemm gg{(const pg8::bf16_t*)XB8, (const pg8::bf16_t*)(W8 + ((size_t)layer * 4608 + 2560) * 1024), M, 2048, 512, 512};
            pg8::EpiGate EG{a.b_merge + layer * 2 * DM, wscale + layer * 4608 + 2560, xscale, rowss + (size_t)layer * M * 16, gatesb};
            pg8::gemm_phase<pg8::EpiGate, GateOrder, true, true>(L, gg, GS, EG);
        }
        pg8::Gemm g{P + C_ZA, Wcat + (size_t)layer * DM * 768, M, DM, 768, LDP}; pg8::EpiMerge E{P + C_MERGED, gatesb, LDP};
        pg8::gemm_phase<pg8::EpiMerge, pg8::StaticOrder, true, true>(L, g, S, E);
    }
    GRID_BAR();
    {
        PHASE_VARS();
        pg8::Gemm g{P + C_MERGED, Wout + (size_t)layer * DM * DM, M, DM, DM, LDP}; pg8::StaticOrder S; S.init(M, DM, G, (int)blockIdx.x);
        pg8::EpiResid<layer> E{a.x, XB, rowss + (layer == 0 ? (size_t)M * 16 : 0), DM};
        pg8::gemm_phase<pg8::EpiResid<layer>, pg8::StaticOrder, true, true>(L, g, S, E);
    }
    GRID_BAR();
}

__global__ void __launch_bounds__(NWAVES * 64, 2) hybrid_fwd(Args a) {
    extern __shared__ __attribute__((aligned(16))) unsigned char lds[];
    LAS unsigned char* L = (LAS unsigned char*)lds;
    if (threadIdx.x < 16) ((LAS unsigned*)(L + LDS_MISC))[threadIdx.x] = 0u;
    __syncthreads();
    (void)xcd_barrier_post((unsigned*)a.ws, (volatile LAS unsigned*)(L + LDS_MISC));
    layer_fwd<0>(a, lds, L);
    layer_fwd<1>(a, lds, L);
    {
        constexpr int layer = 1; (void)layer;
        PHASE_VARS();
        typedef unsigned u32x2_t __attribute__((ext_vector_type(2)));
        f32x4 gg[4];
#pragma unroll
        for (int j = 0; j < 4; ++j) gg[j] = *((const f32x4*)a.final_g + lane + 64 * j);
        for (int m = gw; m < M; m += NGW) {
            const f32x4* pp = (const f32x4*)(rowss + (size_t)m * 16); const f32x4 s4 = (pp[0] + pp[1]) + (pp[2] + pp[3]);
            const float rstd = __builtin_amdgcn_rsqf(((s4[0] + s4[1]) + (s4[2] + s4[3])) * (1.0f / 1024.0f) + RMS_EPS);
            const u32x2_t* xb = (const u32x2_t*)(XB + (size_t)m * DM) + lane; f32x4* o = (f32x4*)(a.out + (size_t)m * DM) + lane;
            u32x2_t bv[4];
#pragma unroll
            for (int j = 0; j < 4; ++j) bv[j] = __builtin_nontemporal_load(xb + 64 * j);
#pragma unroll
            for (int j = 0; j < 4; ++j) __builtin_nontemporal_store((f32x4){blo(bv[j].x), bhi(bv[j].x), blo(bv[j].y), bhi(bv[j].y)} * rstd * gg[j], o + 64 * j);
        }
    }
}

extern "C" void kernel_launch(void* const* d_in, const int* in_sizes, int n_in, void* d_out, int out_size, void* d_ws, size_t ws_size, hipStream_t stream) {
    static int grid = 0;
    if (grid == 0) {
        if (n_in != 8 || in_sizes[0] != M * DM || out_size != M * DM || ws_size < WS_END) { fprintf(stderr, "kernel_launch: unexpected shapes / workspace (n_in %d, ws %zu)\n", n_in, ws_size); grid = -1; return; }
        int dev = 0, cus = 0, per_cu = 0;
        hipGetDevice(&dev); hipDeviceGetAttribute(&cus, hipDeviceAttributeMultiprocessorCount, dev);
        if (hipFuncSetAttribute((const void*)hybrid_fwd, hipFuncAttributeMaxDynamicSharedMemorySize, LDS_BYTES) != hipSuccess) { fprintf(stderr, "kernel_launch: hipFuncSetAttribute failed\n"); grid = -1; return; }
        if (hipOccupancyMaxActiveBlocksPerMultiprocessor(&per_cu, (const void*)hybrid_fwd, NWAVES * 64, LDS_BYTES) != hipSuccess || per_cu < 1) { fprintf(stderr, "kernel_launch: the occupancy query admits %d workgroups per CU; nothing launched\n", per_cu); grid = -1; return; }
        (void)hipGetLastError();
        grid = cus;
    }
    if (grid < 0) return;
    if (hipMemsetAsync((char*)d_ws + WS_BAR, 0, WS_BAR_BYTES, stream) != hipSuccess) { fprintf(stderr, "kernel_launch: hipMemsetAsync failed\n"); return; }
    Args a{};
    a.x = (const float*)d_in[0]; a.norm_g = (const float*)d_in[1]; a.w_in = (const float*)d_in[2]; a.b_merge = (const float*)d_in[3];
    a.w_pa = (const float*)d_in[4]; a.w_pb = (const float*)d_in[5]; a.w_out = (const float*)d_in[6]; a.final_g = (const float*)d_in[7];
    a.out = (float*)d_out; a.ws = (unsigned char*)d_ws;
    hipLaunchKernelGGL(hybrid_fwd, dim3(grid), dim3(NWAVES * 64), LDS_BYTES, stream, a);
    const hipError_t e = hipPeekAtLastError();
    if (e != hipSuccess) fprintf(stderr, "kernel_launch: launch failed: %s (grid %d)\n", hipGetErrorString(e), grid);
}
```

```cpp
#include <hip/hip_runtime.h>
#include <cstdio>
#include <cstdint>
namespace pg8 {
#define PG8_LAS __attribute__((address_space(3)))
typedef unsigned short bf16_t;
typedef short bf16x8 __attribute__((ext_vector_type(8)));
typedef float f32x4 __attribute__((ext_vector_type(4)));
typedef unsigned u32x4 __attribute__((ext_vector_type(4)));
constexpr int BM = 256, BK = 64, HALF = 128, HTB = HALF * BK * 2  , STAGE_BYTES = 8 * HTB, NXCD = 8, WGM = 8;
constexpr int EPI_OFF = STAGE_BYTES, EPI_PITCH = 144, EPI_WAVE = 16 * EPI_PITCH;

__host__ __device__ __forceinline__ int lds_byte(int r, int c) { const int st = (r >> 4) * 2 + (c >> 5), rr = r & 15, cc = c & 31, ob = rr * 64 + cc * 2; return st * 1024 + (ob ^ (((ob >> 9) & 1) << 5)); }
__host__ __device__ __forceinline__ void stage_rc(int b, int& R, int& C) { const int st = b / 1024, sb = b % 1024, swz = sb ^ (((sb >> 9) & 1) << 5); R = (st >> 1) * 16 + swz / 64; C = (st & 1) * 32 + (swz % 64) / 2; }
__host__ __device__ __forceinline__ int perm32(int rho) { const int n = rho >> 4, i = rho & 15; return 8 * (i >> 2) + 4 * n + (i & 3); }

struct Unit { int pm, pn; };
struct Gemm { const bf16_t* A; const bf16_t* Bt; int M, N, K, lda; };

struct StaticOrder {
    int nM, nN, nwg, G, c;
    __host__ __device__ void init(int M, int N, int G_, int c_) { nM = M / BM; nN = N / BM; nwg = nM * nN; G = G_; c = c_; }
    __host__ __device__ bool next(int i, Unit& u) const {
        const long L = (long)i * G + c; if (L >= nwg) return false;
        int wgid = (int)L; { const int q = nwg / NXCD, r = nwg % NXCD, xcd = wgid % NXCD, off = wgid / NXCD; wgid = (xcd < r ? xcd * (q + 1) : r * (q + 1) + (xcd - r) * q) + off; }
        const int nig = WGM * nN, gid = wgid / nig, fm = gid * WGM, gsz = (nM - fm) < WGM ? (nM - fm) : WGM;
        u.pm = fm + ((wgid % nig) % gsz); u.pn = (wgid % nig) / gsz; return true;
    }
    __device__ __forceinline__ void a_ready(const Unit&) const {}
    __device__ __forceinline__ void done(const Unit&) const {}
};


typedef int i32x4 __attribute__((ext_vector_type(4)));
__device__ __forceinline__ f32x4 mma16(bf16x8 a, bf16x8 b, f32x4 c) { return __builtin_amdgcn_mfma_f32_16x16x32_bf16(a, b, c, 0, 0, 0); }
__device__ __forceinline__ i32x4 mma16(bf16x8 a, bf16x8 b, i32x4 c) { return __builtin_amdgcn_mfma_i32_16x16x64_i8(__builtin_bit_cast(i32x4, a), __builtin_bit_cast(i32x4, b), c, 0, 0, 0); }
template <class Epi, class Sched, bool ALIGN_EPI = false, bool SP2 = false>
__device__ __forceinline__ void gemm_phase(PG8_LAS unsigned char* lds, const Gemm g, const Sched& S, const Epi& E) {
    int tid_ = threadIdx.x; asm volatile("" : "+v"(tid_));
    const int tid = tid_, wid = __builtin_amdgcn_readfirstlane(tid >> 6), lane = tid & 63, wr = wid >> 2, wc = wid & 3, fr = lane & 15, fq = lane >> 4;
    const int K = g.K, nt = K / BK;
    unsigned voffA[2], voffB[2];
#pragma unroll
    for (int i = 0; i < 2; ++i) { int R, C; stage_rc(tid * 16 + i * 8192, R, C); const int Rb = 64 * (R >> 5) + (Epi::PERM ? perm32(R & 31) : (R & 31));
        voffA[i] = (unsigned)(R * g.lda + C) * 2u; voffB[i] = (unsigned)(Rb * K + C) * 2u; }
    const size_t kstep = (size_t)(BK * 2);
    const size_t hstepB = (size_t)32 * K * 2, hstepA = (size_t)HALF * g.lda * 2;
    const size_t tstepB = (size_t)BM * K * 2, tstepA = 2 * hstepA;
    const unsigned ldsw = (unsigned)wid * 1024u;
    const int aoff = lds_byte(wr * 64 + fr, fq * 8), boff = lds_byte(wc * 32 + fr, fq * 8);
#define PG8_SA(b, h) (((b) * 2 + (h)) * HTB)
#define PG8_SB(b, h) ((4 + (b) * 2 + (h)) * HTB)
#define PG8_STAGE(bufoff, gbase, voff) do { _Pragma("unroll") for (int _i = 0; _i < 2; ++_i) \
        __builtin_amdgcn_global_load_lds((const unsigned*)((const char*)(gbase) + (voff)[_i]), (PG8_LAS unsigned*)(lds + (bufoff) + ldsw + _i * 8192), 16, 0, 0); } while (0)
#define PG8_LDA(dst, b, h) do { _Pragma("unroll") for (int m = 0; m < 4; ++m) _Pragma("unroll") for (int k = 0; k < 2; ++k) dst[m][k] = *(const PG8_LAS bf16x8*)(lds + PG8_SA(b, h) + aoff + m * 2048 + k * 1024); } while (0)
#define PG8_LDB(dst, b, h) do { _Pragma("unroll") for (int n = 0; n < 2; ++n) _Pragma("unroll") for (int k = 0; k < 2; ++k) dst[n][k] = *(const PG8_LAS bf16x8*)(lds + PG8_SB(b, h) + boff + n * 2048 + k * 1024); } while (0)
#define PG8_MMA(ai, bj, At, Bt) do { __builtin_amdgcn_s_setprio(1); _Pragma("unroll") for (int m = 0; m < 4; ++m) _Pragma("unroll") for (int n = 0; n < 2; ++n) _Pragma("unroll") for (int k = 0; k < 2; ++k) \
        acc[ai][bj][m][n] = mma16(Bt[n][k], At[m][k], acc[ai][bj][m][n]); __builtin_amdgcn_s_setprio(0); } while (0)
#define PG8_WAIT_V(n) asm volatile("s_waitcnt vmcnt(" #n ")" ::: "memory")
#define PG8_WAIT_L(n) asm volatile("s_waitcnt lgkmcnt(" #n ")" ::: "memory")
#define PG8_BAR __builtin_amdgcn_s_barrier()
#define PG8_SCHED __builtin_amdgcn_sched_barrier(0)
    Unit cur, nxt; int ui = 0;
    if (!S.next(0, cur)) return;
    typename Epi::acc_t acc[2][2][4][2];
#pragma unroll
    for (int a = 0; a < 2; ++a)
#pragma unroll
        for (int b = 0; b < 2; ++b)
#pragma unroll
            for (int m = 0; m < 4; ++m)
#pragma unroll
                for (int n = 0; n < 2; ++n) acc[a][b][m][n] = (typename Epi::acc_t){0, 0, 0, 0};
    bf16x8 At[4][2], B0[2][2], B1[2][2];
    const char* cA = (const char*)g.A + (size_t)cur.pm * tstepA; const char* cB = (const char*)g.Bt + (size_t)cur.pn * tstepB;
    S.a_ready(cur);
    if constexpr (SP2) {
        PG8_STAGE(PG8_SB(0, 0), cB, voffB); PG8_STAGE(PG8_SB(0, 1), cB + hstepB, voffB); PG8_STAGE(PG8_SA(0, 0), cA, voffA); PG8_STAGE(PG8_SA(0, 1), cA + hstepA, voffA);
        if (wr == 1) PG8_BAR;
        PG8_WAIT_V(2); PG8_BAR;
        PG8_STAGE(PG8_SB(1, 0), cB + kstep, voffB); PG8_STAGE(PG8_SA(1, 0), cA + kstep, voffA); PG8_STAGE(PG8_SB(1, 1), cB + hstepB + kstep, voffB);
        PG8_WAIT_V(6); PG8_BAR;
    } else {
        PG8_STAGE(PG8_SB(0, 0), cB, voffB); PG8_STAGE(PG8_SA(0, 0), cA, voffA); PG8_STAGE(PG8_SB(0, 1), cB + hstepB, voffB); PG8_STAGE(PG8_SA(0, 1), cA + hstepA, voffA);
        if (wr == 1) PG8_BAR;
        PG8_WAIT_V(4); PG8_BAR;
        PG8_STAGE(PG8_SB(1, 0), cB + kstep, voffB); PG8_STAGE(PG8_SA(1, 0), cA + kstep, voffA); PG8_STAGE(PG8_SB(1, 1), cB + hstepB + kstep, voffB);
        PG8_WAIT_V(6); PG8_BAR;
    }
    for (;;) {
        const bool has_next = S.next(ui + 1, nxt);
        const char* nA = has_next ? (const char*)g.A + (size_t)nxt.pm * tstepA : cA; const char* nB = has_next ? (const char*)g.Bt + (size_t)nxt.pn * tstepB : cB;
        for (int t = 0; t < nt; t += 2) {
            const bool last = (t == nt - 2);
            const char* a1 = cA + (size_t)(t + 1) * kstep;
            const char* a2 = last ? nA : cA + (size_t)(t + 2) * kstep; const char* b2 = last ? nB : cB + (size_t)(t + 2) * kstep;
            const char* a3 = a2 + kstep; const char* b3 = b2 + kstep;
            if (last && has_next) S.a_ready(nxt);
            if constexpr (SP2) {
            PG8_LDB(B0, 0, 0); PG8_LDB(B1, 0, 1); PG8_SCHED; PG8_LDA(At, 0, 0); PG8_STAGE(PG8_SA(1, 1), a1 + hstepA, voffA);
            PG8_WAIT_V(8); PG8_WAIT_L(0); PG8_BAR; PG8_MMA(0, 0, At, B0); PG8_MMA(0, 1, At, B1); PG8_BAR; PG8_SCHED;
            PG8_LDA(At, 0, 1); PG8_STAGE(PG8_SB(0, 0), b2, voffB); PG8_STAGE(PG8_SB(0, 1), b2 + hstepB, voffB); PG8_STAGE(PG8_SA(0, 0), a2, voffA);
            PG8_WAIT_V(8); PG8_WAIT_L(0); PG8_BAR; PG8_MMA(1, 0, At, B0); PG8_MMA(1, 1, At, B1); PG8_BAR; PG8_SCHED;
            PG8_LDB(B0, 1, 0); PG8_LDB(B1, 1, 1); PG8_SCHED; PG8_LDA(At, 1, 0); PG8_STAGE(PG8_SA(0, 1), a2 + hstepA, voffA);
            PG8_WAIT_V(8); PG8_WAIT_L(0); PG8_BAR; PG8_MMA(0, 0, At, B0); PG8_MMA(0, 1, At, B1); PG8_BAR; PG8_SCHED;
            PG8_LDA(At, 1, 1); PG8_STAGE(PG8_SB(1, 0), b3, voffB); PG8_STAGE(PG8_SB(1, 1), b3 + hstepB, voffB); PG8_STAGE(PG8_SA(1, 0), a3, voffA);
            PG8_WAIT_V(8); PG8_WAIT_L(0); PG8_BAR; PG8_MMA(1, 0, At, B0); PG8_MMA(1, 1, At, B1); PG8_BAR; PG8_SCHED;
            if constexpr (Epi::HAS_MID) { if (t == Epi::MID_T) { E.mid(acc, cur, wr, wc, fr, fq, wid); PG8_SCHED; } }
            } else {
            PG8_LDB(B0, 0, 0); PG8_SCHED; PG8_LDA(At, 0, 0); PG8_STAGE(PG8_SA(1, 1), a1 + hstepA, voffA);
            PG8_WAIT_L(8); PG8_BAR; PG8_WAIT_L(0); PG8_MMA(0, 0, At, B0); PG8_BAR; PG8_SCHED;
            PG8_LDB(B1, 0, 1); PG8_STAGE(PG8_SB(0, 0), b2, voffB);
            PG8_BAR; PG8_WAIT_L(0); PG8_MMA(0, 1, At, B1); PG8_BAR;
            PG8_LDA(At, 0, 1); PG8_STAGE(PG8_SA(0, 0), a2, voffA);
            PG8_BAR; PG8_WAIT_L(0); PG8_MMA(1, 0, At, B0); PG8_BAR; PG8_SCHED;
            PG8_STAGE(PG8_SB(0, 1), b2 + hstepB, voffB);
            PG8_WAIT_V(6); PG8_BAR; PG8_MMA(1, 1, At, B1); PG8_BAR;
            PG8_LDB(B0, 1, 0); PG8_SCHED; PG8_LDA(At, 1, 0); PG8_STAGE(PG8_SA(0, 1), a2 + hstepA, voffA);
            PG8_WAIT_L(8); PG8_BAR; PG8_WAIT_L(0); PG8_MMA(0, 0, At, B0); PG8_BAR; PG8_SCHED;
            PG8_LDB(B1, 1, 1); PG8_STAGE(PG8_SB(1, 0), b3, voffB);
            PG8_BAR; PG8_WAIT_L(0); PG8_MMA(0, 1, At, B1); PG8_BAR;
            PG8_LDA(At, 1, 1); PG8_STAGE(PG8_SA(1, 0), a3, voffA);
            PG8_BAR; PG8_WAIT_L(0); PG8_MMA(1, 0, At, B0); PG8_BAR; PG8_SCHED;
            PG8_STAGE(PG8_SB(1, 1), b3 + hstepB, voffB);
            PG8_WAIT_V(6); PG8_BAR; PG8_MMA(1, 1, At, B1); PG8_BAR;
            }
        }
        if constexpr (ALIGN_EPI) { if (wr == 0) PG8_BAR; }
        if constexpr (!Epi::AFTER_DRAIN) { E(acc, cur, wr, wc, fr, fq, lds + EPI_OFF + wid * EPI_WAVE, lane, wid); S.done(cur); }
        if (!has_next) break;
#pragma unroll
        for (int a = 0; a < 2; ++a)
#pragma unroll
            for (int b = 0; b < 2; ++b)
#pragma unroll
                for (int m = 0; m < 4; ++m)
#pragma unroll
                    for (int n = 0; n < 2; ++n) acc[a][b][m][n] = (typename Epi::acc_t){0, 0, 0, 0};
        cur = nxt; cA = nA; cB = nB; ++ui;
        if constexpr (ALIGN_EPI) { if (wr == 1) PG8_BAR; }
    }
    PG8_WAIT_V(0);
    if constexpr (!ALIGN_EPI) { if (wr == 0) PG8_BAR; }
    PG8_BAR;
    if constexpr (Epi::AFTER_DRAIN) { E.fused(acc, cur, wr, wc, fr, fq, lds, wid, lane); S.done(cur); }
#undef PG8_SA
#undef PG8_SB
#undef PG8_STAGE
#undef PG8_LDA
#undef PG8_LDB
#undef PG8_MMA
#undef PG8_WAIT_V
#undef PG8_WAIT_L
#undef PG8_BAR
#undef PG8_SCHED
}
}


namespace pg8 {
__device__ __forceinline__ unsigned cvt_pk_bf16(float lo, float hi) { unsigned r; asm volatile("v_cvt_pk_bf16_f32 %0, %1, %2" : "=v"(r) : "v"(lo), "v"(hi)); return r; }
__device__ __forceinline__ float bflo(unsigned u) { return __uint_as_float(u << 16); }
__device__ __forceinline__ float bfhi(unsigned u) { return __uint_as_float(u & 0xffff0000u); }
__device__ __forceinline__ float sigmoidf_(float v) { return __builtin_amdgcn_rcpf(1.0f + __expf(-v)); }
typedef unsigned u32x2 __attribute__((ext_vector_type(2)));
__device__ __forceinline__ void piece_xpose(PG8_LAS unsigned char* stg, u32x4 in0, u32x4 in1, u32x4& out0, u32x4& out1, int fr, int fq, int lane) {
    *(PG8_LAS u32x4*)(stg + fr * EPI_PITCH + fq * 16) = in0; *(PG8_LAS u32x4*)(stg + fr * EPI_PITCH + 64 + fq * 16) = in1;
    out0 = *(const PG8_LAS u32x4*)(stg + (lane >> 3) * EPI_PITCH + (lane & 7) * 16); out1 = *(const PG8_LAS u32x4*)(stg + ((lane >> 3) + 8) * EPI_PITCH + (lane & 7) * 16);
}

constexpr int N8T = 14, NBT = 18 - N8T;
constexpr unsigned long long TORD_LO = 0x4bdc8288e620c20ull, TORD_HI = 0x1ac5aa30ull;
__device__ __forceinline__ int tile_of(int i) { return i < 12 ? (int)((TORD_LO >> (5 * i)) & 31) : (int)((TORD_HI >> (5 * (i - 12))) & 31); }
struct EpiProj {
    typedef f32x4 acc_t; static constexpr bool PERM = true, AFTER_DRAIN = false, HAS_MID = false; static constexpr int MID_T = 0;
    bf16_t* O; int ldc; float* kmean; const float* rowss;
    __device__ __forceinline__ void operator()(const f32x4 (&acc)[2][2][4][2], const Unit& u, int wr, int wc, int fr, int fq, PG8_LAS unsigned char* stg, int lane, int wid) const {
        asm volatile("" : "+v"(fr), "+v"(fq), "+v"(lane));
        const int tl = tile_of(u.pn + N8T);
        const int kind = (tl == 9 || tl == 16 || tl == 17) ? 1 : 0;
        PG8_LAS float* const tab = (PG8_LAS float*)(stg - wid * EPI_WAVE + 8 * EPI_WAVE + 256);
        if (__builtin_amdgcn_readfirstlane(((const PG8_LAS int*)tab)[256]) != u.pm) {
            asm volatile("s_waitcnt lgkmcnt(0)" ::: "memory"); __builtin_amdgcn_s_barrier(); asm volatile("" ::: "memory");
            const int t_ = wid * 64 + lane;
            if (t_ < 256) { const f32x4* pp = (const f32x4*)(rowss + (size_t)(u.pm * BM + t_) * 16); const f32x4 s4 = (pp[0] + pp[1]) + (pp[2] + pp[3]);
                tab[t_] = __builtin_amdgcn_rsqf(((s4[0] + s4[1]) + (s4[2] + s4[3])) * (1.0f / 1024.0f) + 1e-6f); }
            if (t_ == 0) ((PG8_LAS int*)tab)[256] = u.pm;
            asm volatile("s_waitcnt vmcnt(0) lgkmcnt(0)" ::: "memory"); __builtin_amdgcn_s_barrier(); asm volatile("" ::: "memory");
        }
        float rs[2][4];
#pragma unroll
        for (int ai = 0; ai < 2; ++ai)
#pragma unroll
            for (int m = 0; m < 4; ++m) rs[ai][m] = tab[ai * HALF + wr * 64 + m * 16 + fr];
        const float qs = (tl == 10 || tl == 11) ? 0.18033688011112042f : 1.0f;
        const size_t rbase = (size_t)(u.pm * BM + wr * 64 + (lane >> 3)); bf16_t* const op = O + tl * BM + wc * 64 + 8 * (lane & 7);
#pragma unroll
        for (int ai = 0; ai < 2; ++ai)
#pragma unroll
            for (int m = 0; m < 4; ++m) { u32x4 w[2];
#pragma unroll
                for (int bj = 0; bj < 2; ++bj) { f32x4 v0 = acc[ai][bj][m][0] * rs[ai][m], v1 = acc[ai][bj][m][1] * rs[ai][m];
                    if (kind == 1) {
#pragma unroll
                        for (int e = 0; e < 4; ++e) { v0[e] = v0[e] * sigmoidf_(v0[e]); v1[e] = v1[e] * sigmoidf_(v1[e]); } }
                    v0 = v0 * qs; v1 = v1 * qs;
                    w[bj].x = cvt_pk_bf16(v0[0], v0[1]); w[bj].y = cvt_pk_bf16(v0[2], v0[3]); w[bj].z = cvt_pk_bf16(v1[0], v1[1]); w[bj].w = cvt_pk_bf16(v1[2], v1[3]); }
                u32x4 o0, o1; piece_xpose(stg, w[0], w[1], o0, o1, fr, fq, lane);
                bf16_t* rp = op + (rbase + ai * HALF + m * 16) * ldc;
                __builtin_nontemporal_store(o0, (u32x4*)rp); __builtin_nontemporal_store(o1, (u32x4*)(rp + (size_t)8 * ldc));
                asm volatile("" ::: "memory"); }
        if (tl == 12 || tl == 13) {
#pragma unroll
            for (int bj = 0; bj < 2; ++bj)
#pragma unroll
                for (int n = 0; n < 2; ++n) { f32x4 cs = (f32x4){0.f, 0.f, 0.f, 0.f};
#pragma unroll
                    for (int ai = 0; ai < 2; ++ai)
#pragma unroll
                        for (int m = 0; m < 4; ++m) { float r2 = rs[ai][m]; asm volatile("" : "+v"(r2)); cs += acc[ai][bj][m][n] * r2; }
#pragma unroll
                    for (int e = 0; e < 4; ++e) { float v = cs[e]; v += __shfl_xor(v, 1); v += __shfl_xor(v, 2); v += __shfl_xor(v, 4); v += __shfl_xor(v, 8); cs[e] = v; }
                    if (fr == 0) { float* kp = kmean + (size_t)u.pm * 512 + (tl - 12) * 256 + wc * 64 + bj * 32 + 8 * fq + 4 * n;
#pragma unroll
                        for (int e = 0; e < 4; ++e) atomicAdd(kp + e, cs[e] * (1.0f / 256.0f)); } }
        }
    }
};
struct EpiProjQ8 {
    typedef i32x4 acc_t; static constexpr bool PERM = true, AFTER_DRAIN = false, HAS_MID = false; static constexpr int MID_T = 0;
    bf16_t* O; int ldc; const float* wscale; const float* xscale; const float* rowss; float* kmean;
    __device__ __forceinline__ void operator()(const i32x4 (&acc)[2][2][4][2], const Unit& u, int wr, int wc, int fr, int fq, PG8_LAS unsigned char* stg, int lane, int wid) const {
        asm volatile("" : "+v"(fr), "+v"(fq), "+v"(lane));
        const int tl = tile_of(u.pn);
        const int kind = (tl == 9 || tl == 16 || tl == 17) ? 1 : 0;
        const float qs = (tl == 0 || tl == 3 || tl == 6 || tl == 10 || tl == 11) ? 0.18033688011112042f : 1.0f;
        PG8_LAS float* const tab = (PG8_LAS float*)(stg - wid * EPI_WAVE + 8 * EPI_WAVE + 256);
        if (__builtin_amdgcn_readfirstlane(((const PG8_LAS int*)tab)[256]) != u.pm) {
            asm volatile("s_waitcnt lgkmcnt(0)" ::: "memory"); __builtin_amdgcn_s_barrier(); asm volatile("" ::: "memory");
            const int t_ = wid * 64 + lane;
            if (t_ < 256) { const f32x4* pp = (const f32x4*)(rowss + (size_t)(u.pm * BM + t_) * 16); const f32x4 s4 = (pp[0] + pp[1]) + (pp[2] + pp[3]);
                tab[t_] = xscale[u.pm * BM + t_] * __builtin_amdgcn_rsqf(((s4[0] + s4[1]) + (s4[2] + s4[3])) * (1.0f / 1024.0f) + 1e-6f); }
            if (t_ == 0) ((PG8_LAS int*)tab)[256] = u.pm;
            asm volatile("s_waitcnt vmcnt(0) lgkmcnt(0)" ::: "memory"); __builtin_amdgcn_s_barrier(); asm volatile("" ::: "memory");
        }
        f32x4 wv[2][2];
#pragma unroll
        for (int bj = 0; bj < 2; ++bj)
#pragma unroll
            for (int n = 0; n < 2; ++n) wv[bj][n] = *(const f32x4*)(wscale + u.pn * BM + wc * 64 + 8 * fq + bj * 32 + 4 * n) * qs;
        const size_t rbase = (size_t)(u.pm * BM + wr * 64 + (lane >> 3)); bf16_t* const op = O + tl * BM + wc * 64 + 8 * (lane & 7);
#pragma unroll
        for (int ai = 0; ai < 2; ++ai)
#pragma unroll
            for (int m = 0; m < 4; ++m) { const float rf = tab[ai * HALF + wr * 64 + m * 16 + fr]; u32x4 w[2];
#pragma unroll
                for (int bj = 0; bj < 2; ++bj) { f32x4 v0, v1;
#pragma unroll
                    for (int e = 0; e < 4; ++e) { v0[e] = (float)acc[ai][bj][m][0][e] * (rf * wv[bj][0][e]); v1[e] = (float)acc[ai][bj][m][1][e] * (rf * wv[bj][1][e]); }
                    if (kind == 1) {
#pragma unroll
                        for (int e = 0; e < 4; ++e) { v0[e] = v0[e] * sigmoidf_(v0[e]); v1[e] = v1[e] * sigmoidf_(v1[e]); } }
                    w[bj].x = cvt_pk_bf16(v0[0], v0[1]); w[bj].y = cvt_pk_bf16(v0[2], v0[3]); w[bj].z = cvt_pk_bf16(v1[0], v1[1]); w[bj].w = cvt_pk_bf16(v1[2], v1[3]); }
                u32x4 o0, o1; piece_xpose(stg, w[0], w[1], o0, o1, fr, fq, lane);
                bf16_t* rp = op + (rbase + ai * HALF + m * 16) * ldc;
                __builtin_nontemporal_store(o0, (u32x4*)rp); __builtin_nontemporal_store(o1, (u32x4*)(rp + (size_t)8 * ldc));
                asm volatile("" ::: "memory"); }
        if (tl == 12 || tl == 13) {
#pragma unroll
            for (int bj = 0; bj < 2; ++bj)
#pragma unroll
                for (int n = 0; n < 2; ++n) { f32x4 cs = (f32x4){0.f, 0.f, 0.f, 0.f};
#pragma unroll
                    for (int ai = 0; ai < 2; ++ai)
#pragma unroll
                        for (int m = 0; m < 4; ++m) { float r2 = tab[ai * HALF + wr * 64 + m * 16 + fr]; asm volatile("" : "+v"(r2));
#pragma unroll
                            for (int e = 0; e < 4; ++e) cs[e] += (float)acc[ai][bj][m][n][e] * r2; }
#pragma unroll
                    for (int e = 0; e < 4; ++e) { float v = cs[e] * wv[bj][n][e]; v += __shfl_xor(v, 1); v += __shfl_xor(v, 2); v += __shfl_xor(v, 4); v += __shfl_xor(v, 8); cs[e] = v; }
                    if (fr == 0) { float* kp = kmean + (size_t)u.pm * 512 + (tl - 12) * 256 + wc * 64 + bj * 32 + 8 * fq + 4 * n;
#pragma unroll
                        for (int e = 0; e < 4; ++e) atomicAdd(kp + e, cs[e] * (1.0f / 256.0f)); } }
        }
    }
};
struct EpiGate {
    typedef i32x4 acc_t; static constexpr bool PERM = true, AFTER_DRAIN = false, HAS_MID = false; static constexpr int MID_T = 0;
    const float* bmerge; const float* wscale; const float* xscale; const float* rowss; unsigned char* gates;
    __device__ __forceinline__ void operator()(const i32x4 (&acc)[2][2][4][2], const Unit& u, int wr, int wc, int fr, int fq, PG8_LAS unsigned char* stg, int lane, int wid) const {
        asm volatile("" : "+v"(fr), "+v"(fq), "+v"(lane));
        const int col0 = u.pn * BM + wc * 64 + 8 * fq;
        PG8_LAS float* const tab = (PG8_LAS float*)(stg - wid * EPI_WAVE + 8 * EPI_WAVE + 256);
        if (__builtin_amdgcn_readfirstlane(((const PG8_LAS int*)tab)[256]) != u.pm) {
            asm volatile("s_waitcnt lgkmcnt(0)" ::: "memory"); __builtin_amdgcn_s_barrier(); asm volatile("" ::: "memory");
            const int t_ = wid * 64 + lane;
            if (t_ < 256) { const f32x4* pp = (const f32x4*)(rowss + (size_t)(u.pm * BM + t_) * 16); const f32x4 s4 = (pp[0] + pp[1]) + (pp[2] + pp[3]);
                tab[t_] = xscale[u.pm * BM + t_] * __builtin_amdgcn_rsqf(((s4[0] + s4[1]) + (s4[2] + s4[3])) * (1.0f / 1024.0f) + 1e-6f) * (-1.4426950408889634f); }
            if (t_ == 0) ((PG8_LAS int*)tab)[256] = u.pm;
            asm volatile("s_waitcnt vmcnt(0) lgkmcnt(0)" ::: "memory"); __builtin_amdgcn_s_barrier(); asm volatile("" ::: "memory");
        }
        f32x4 bv[2][2], wv[2][2];
#pragma unroll
        for (int bj = 0; bj < 2; ++bj)
#pragma unroll
            for (int n = 0; n < 2; ++n) { bv[bj][n] = *(const f32x4*)(bmerge + col0 + bj * 32 + 4 * n) * (-1.4426950408889634f); wv[bj][n] = *(const f32x4*)(wscale + col0 + bj * 32 + 4 * n); }
        unsigned char* gp = gates + ((size_t)((u.pm * 8 + u.pn) * 8 + wid) * 8) * 1024 + fr * 64 + fq * 16;
#pragma unroll
        for (int ai = 0; ai < 2; ++ai)
#pragma unroll
            for (int m = 0; m < 4; ++m) { const float rf = tab[ai * HALF + wr * 64 + m * 16 + fr]; u32x4 q;
#pragma unroll
                for (int bj = 0; bj < 2; ++bj)
#pragma unroll
                    for (int n = 0; n < 2; ++n) { unsigned w = 0u;
#pragma unroll
                        for (int e = 0; e < 4; ++e) { const float x2 = (float)acc[ai][bj][m][n][e] * (rf * wv[bj][n][e]) + bv[bj][n][e];
                            w = __builtin_amdgcn_cvt_pk_u8_f32(__builtin_fmaxf(255.0f * __builtin_amdgcn_rcpf(1.0f + __builtin_amdgcn_exp2f(x2)), 1.0f), e, w); }
                        q[2 * bj + n] = w; }
                __builtin_nontemporal_store(q, (u32x4*)(gp + (ai * 4 + m) * 1024)); }
    }
};
struct EpiMerge {
    typedef f32x4 acc_t; static constexpr bool PERM = true, AFTER_DRAIN = false, HAS_MID = true; static constexpr int MID_T = 2;
    bf16_t* O; const unsigned char* gates; int ldc;
    __device__ __forceinline__ static float ub(unsigned w, int i) { return (float)((w >> (8 * i)) & 0xffu); }
    __device__ __forceinline__ void mid(f32x4 (&acc)[2][2][4][2], const Unit& u, int wr, int wc, int fr, int fq, int wid) const {
        asm volatile("" : "+v"(fr), "+v"(fq));
        const unsigned char* ga = gates + ((size_t)((u.pm * 8 + u.pn) * 8 + wid) * 8) * 1024 + fr * 64 + fq * 16; const unsigned char* gb = ga + (size_t)4 * 8 * 8 * 1024;
        u32x4 av[2][4], bv[2][4];
#pragma unroll
        for (int ai = 0; ai < 2; ++ai)
#pragma unroll
            for (int m = 0; m < 4; ++m) { av[ai][m] = __builtin_nontemporal_load((const u32x4*)(ga + (ai * 4 + m) * 1024)); bv[ai][m] = *(const u32x4*)(gb + (ai * 4 + m) * 1024); }
#pragma unroll
        for (int ai = 0; ai < 2; ++ai)
#pragma unroll
            for (int m = 0; m < 4; ++m)
#pragma unroll
                for (int bj = 0; bj < 2; ++bj)
#pragma unroll
                    for (int n = 0; n < 2; ++n)
#pragma unroll
                        for (int e = 0; e < 4; ++e) acc[ai][bj][m][n][e] *= ub(av[ai][m][2 * bj + n], e) * __builtin_amdgcn_rcpf(ub(bv[ai][m][2 * bj + n], e));
    }
    __device__ __forceinline__ void operator()(const f32x4 (&acc)[2][2][4][2], const Unit& u, int wr, int wc, int fr, int fq, PG8_LAS unsigned char* stg, int lane, int wid) const {
        asm volatile("" : "+v"(fr), "+v"(fq), "+v"(lane));
        const unsigned char* gb = gates + ((size_t)((u.pm * 8 + 4 + u.pn) * 8 + wid) * 8) * 1024 + fr * 64 + fq * 16;
        const size_t rbase = (size_t)(u.pm * BM + wr * 64 + (lane >> 3)); bf16_t* const op = O + u.pn * BM + wc * 64 + 8 * (lane & 7);
        u32x4 gvv[2][4];
#pragma unroll
        for (int ai = 0; ai < 2; ++ai)
#pragma unroll
            for (int m = 0; m < 4; ++m) gvv[ai][m] = __builtin_nontemporal_load((const u32x4*)(gb + (ai * 4 + m) * 1024));
#pragma unroll
        for (int ai = 0; ai < 2; ++ai)
#pragma unroll
            for (int m = 0; m < 4; ++m) { const u32x4 gv = gvv[ai][m]; u32x4 w[2];
#pragma unroll
                for (int bj = 0; bj < 2; ++bj) { f32x4 v0 = acc[ai][bj][m][0], v1 = acc[ai][bj][m][1];
#pragma unroll
                    for (int e = 0; e < 4; ++e) { v0[e] *= ub(gv[2 * bj], e) * (1.0f / 255.0f); v1[e] *= ub(gv[2 * bj + 1], e) * (1.0f / 255.0f); }
                    w[bj].x = cvt_pk_bf16(v0[0], v0[1]); w[bj].y = cvt_pk_bf16(v0[2], v0[3]); w[bj].z = cvt_pk_bf16(v1[0], v1[1]); w[bj].w = cvt_pk_bf16(v1[2], v1[3]); }
                u32x4 o0, o1; piece_xpose(stg, w[0], w[1], o0, o1, fr, fq, lane);
                bf16_t* rp = op + (rbase + ai * HALF + m * 16) * ldc;
                __builtin_nontemporal_store(o0, (u32x4*)rp); __builtin_nontemporal_store(o1, (u32x4*)(rp + (size_t)8 * ldc));
                if (m & 1) asm volatile("" ::: "memory"); }
    }
};
template <int MODE> struct EpiResid {
    typedef f32x4 acc_t; static constexpr bool PERM = false, AFTER_DRAIN = false, HAS_MID = false; static constexpr int MID_T = 0;
    const float* R; bf16_t* XB; float* rowss; int ldc;
    __device__ __forceinline__ void operator()(const f32x4 (&acc)[2][2][4][2], const Unit& u, int wr, int wc, int fr, int fq, PG8_LAS unsigned char* stg, int lane, int wid) const {
        asm volatile("" : "+v"(fr), "+v"(fq), "+v"(lane));
        const size_t rbase = (size_t)(u.pm * BM + wr * 64 + (lane >> 3)); const int cb = u.pn * BM + wc * 64 + 4 * (lane & 7);
#pragma unroll
        for (int ai = 0; ai < 2; ++ai) {
            f32x4 rr[4][2][2];
#pragma unroll
            for (int m = 0; m < 4; ++m)
#pragma unroll
                for (int bj = 0; bj < 2; ++bj) { const size_t ro = (rbase + ai * HALF + m * 16) * ldc + cb + bj * 32;
                    if (MODE == 0) { rr[m][bj][0] = __builtin_nontemporal_load((const f32x4*)(R + ro)); rr[m][bj][1] = __builtin_nontemporal_load((const f32x4*)(R + ro + (size_t)8 * ldc)); }
                    else { const u32x2 b0 = __builtin_nontemporal_load((const u32x2*)(XB + ro)), b1 = __builtin_nontemporal_load((const u32x2*)(XB + ro + (size_t)8 * ldc));
                        rr[m][bj][0] = __builtin_bit_cast(f32x4, (u32x4){b0.x, b0.y, b1.x, b1.y}); } }
#pragma unroll
            for (int m = 0; m < 4; ++m) { float ss0 = 0.f, ss1 = 0.f;
#pragma unroll
                for (int bj = 0; bj < 2; ++bj) { const size_t ro = (rbase + ai * HALF + m * 16) * ldc + cb + bj * 32;
                    f32x4 r0, r1;
                    if (MODE == 0) { r0 = rr[m][bj][0]; r1 = rr[m][bj][1]; }
                    else { const u32x4 pk = __builtin_bit_cast(u32x4, rr[m][bj][0]);
                        r0 = (f32x4){bflo(pk.x), bfhi(pk.x), bflo(pk.y), bfhi(pk.y)}; r1 = (f32x4){bflo(pk.z), bfhi(pk.z), bflo(pk.w), bfhi(pk.w)}; }
                    u32x4 o0, o1; piece_xpose(stg, __builtin_bit_cast(u32x4, acc[ai][bj][m][0]), __builtin_bit_cast(u32x4, acc[ai][bj][m][1]), o0, o1, fr, fq, lane);
                    const f32x4 x0 = r0 + __builtin_bit_cast(f32x4, o0), x1 = r1 + __builtin_bit_cast(f32x4, o1);
                    *(u32x2*)(XB + ro) = (u32x2){cvt_pk_bf16(x0[0], x0[1]), cvt_pk_bf16(x0[2], x0[3])}; *(u32x2*)(XB + ro + (size_t)8 * ldc) = (u32x2){cvt_pk_bf16(x1[0], x1[1]), cvt_pk_bf16(x1[2], x1[3])};
                    ss0 += (x0[0] * x0[0] + x0[1] * x0[1]) + (x0[2] * x0[2] + x0[3] * x0[3]); ss1 += (x1[0] * x1[0] + x1[1] * x1[1]) + (x1[2] * x1[2] + x1[3] * x1[3]); }
                ss0 += __shfl_xor(ss0, 1); ss0 += __shfl_xor(ss0, 2); ss0 += __shfl_xor(ss0, 4); ss1 += __shfl_xor(ss1, 1); ss1 += __shfl_xor(ss1, 2); ss1 += __shfl_xor(ss1, 4);
                if ((lane & 7) == 0) { rowss[(rbase + ai * HALF + m * 16) * 16 + u.pn * 4 + wc] = ss0; rowss[(rbase + ai * HALF + m * 16 + 8) * 16 + u.pn * 4 + wc] = ss1; } }
            asm volatile("" ::: "memory");
        }
    }
};
}
#include <hip/hip_bf16.h>
#include <cmath>
namespace moba {
using bf16=__hip_bfloat16;
using bf16x8=__attribute__((ext_vector_type(8)))short;
using s16x4=__attribute__((ext_vector_type(4)))short;
using f32x16=__attribute__((ext_vector_type(16)))float;
using u32x4=__attribute__((ext_vector_type(4)))unsigned;
constexpr int SEQ=2048,D=64,PITCH=4608;
constexpr int NW=8,QBLK=32,QB=QBLK*NW,KVBLK=64;
__device__ __forceinline__ int crow(int r,int hi){return (r&3)+8*(r>>2)+4*hi;}
#define SBAR() __builtin_amdgcn_sched_barrier(0)
__device__ __forceinline__ void cmask(f32x16&p0,f32x16&p1,int jb,int qrel,int hi){
  const float NEG=-INFINITY; int kb=64*jb+4*hi;
  #pragma unroll
  for(int r=0;r<16;++r){int kv=kb+(r&3)+8*(r>>2); if(kv>qrel)p0[r]=NEG; if(kv+32>qrel)p1[r]=NEG;}
}

constexpr int NSLOT=3, SLOTB=8192;
constexpr int NVSLOT=4;
constexpr int LDS_K=0, LDS_V=NSLOT*SLOTB, LDS_WS=LDS_V+NVSLOT*SLOTB, LDS_OST=LDS_WS+NW*64*4, LDS_KM=LDS_OST+NW*4096, LDS_BYTES=LDS_KM+8*64*4;
__device__ __forceinline__ void glds16(const void*gsrc,unsigned lds_dst){unsigned keep;
  asm volatile("s_mov_b32 %0, m0\n\ts_mov_b32 m0, %2\n\ts_nop 0\n\tglobal_load_lds_dwordx4 %1, off\n\ts_mov_b32 m0, %0":"=&s"(keep):"v"(gsrc),"s"(lds_dst):"memory");}
__device__ __forceinline__ float max3f(float a,float b,float c){float r;asm("v_max3_f32 %0, %1, %2, %3":"=v"(r):"v"(a),"v"(b),"v"(c));return r;}
__device__ __forceinline__ float max2f(float a,float b){float r;asm("v_max_f32_e32 %0, %1, %2":"=v"(r):"v"(a),"v"(b));return r;}
typedef float f32x2_t __attribute__((ext_vector_type(2))); typedef __bf16 bf16x2_t __attribute__((ext_vector_type(2)));
__device__ __forceinline__ unsigned cvtpk_s(float lo,float hi){f32x2_t v={lo,hi};bf16x2_t b=__builtin_convertvector(v,bf16x2_t);return __builtin_bit_cast(unsigned,b);}
__device__ __forceinline__ float bl(unsigned u){return __uint_as_float(u<<16);}
__device__ __forceinline__ float bh(unsigned u){return __uint_as_float(u&0xffff0000u);}
#define WAIT_BAR(N) asm volatile("s_waitcnt vmcnt(" #N ") lgkmcnt(0)\n\ts_barrier":::"memory")

__device__ __forceinline__ void qkt(f32x16&p0,f32x16&p1,const char*Kslot,const bf16x8*qr,const f32x16&negm,int r32,int hi){
  const char*kb=Kslot+hi*1024+r32*16;
  #pragma unroll
  for(int d0=0;d0<4;++d0){
    const bf16x8 b0=*reinterpret_cast<const bf16x8*>(kb+d0*2048);
    const bf16x8 b1=*reinterpret_cast<const bf16x8*>(kb+d0*2048+512);
    if(d0==0){p0=__builtin_amdgcn_mfma_f32_32x32x16_bf16(b0,qr[0],negm,0,0,0);p1=__builtin_amdgcn_mfma_f32_32x32x16_bf16(b1,qr[0],negm,0,0,0);}
    else{p0=__builtin_amdgcn_mfma_f32_32x32x16_bf16(b0,qr[d0],p0,0,0,0);p1=__builtin_amdgcn_mfma_f32_32x32x16_bf16(b1,qr[d0],p1,0,0,0);}}
}
typedef __attribute__((address_space(3))) const char* lds_cptr;
typedef short v4i16_t __attribute__((ext_vector_type(4)));
__device__ __forceinline__ void kload8(bf16x8*kf,lds_cptr kp){
  kf[0]=*(const __attribute__((address_space(3))) bf16x8*)(kp);      kf[1]=*(const __attribute__((address_space(3))) bf16x8*)(kp+512);
  kf[2]=*(const __attribute__((address_space(3))) bf16x8*)(kp+2048); kf[3]=*(const __attribute__((address_space(3))) bf16x8*)(kp+2560);
  kf[4]=*(const __attribute__((address_space(3))) bf16x8*)(kp+4096); kf[5]=*(const __attribute__((address_space(3))) bf16x8*)(kp+4608);
  kf[6]=*(const __attribute__((address_space(3))) bf16x8*)(kp+6144); kf[7]=*(const __attribute__((address_space(3))) bf16x8*)(kp+6656);
}
__device__ __forceinline__ void kload2(bf16x8*kf,lds_cptr kp,int j){ kf[2*j]=*(const __attribute__((address_space(3))) bf16x8*)(kp+j*2048); kf[2*j+1]=*(const __attribute__((address_space(3))) bf16x8*)(kp+j*2048+512); }
__device__ __forceinline__ s16x4 vtr(lds_cptr p){ return __builtin_bit_cast(s16x4,__builtin_amdgcn_ds_read_tr16_b64_v4i16((__attribute__((address_space(3))) v4i16_t*)p)); }
__device__ __forceinline__ float rowmax(const f32x16&p0,const f32x16&p1){
  float a=max3f(p0[0],p0[1],p1[0]),b=max3f(p0[2],p0[3],p1[1]);a=max3f(a,p1[2],p1[3]);
  #pragma unroll
  for(int r=4;r<16;r+=4){a=max3f(a,p0[r],p0[r+1]);b=max3f(b,p0[r+2],p0[r+3]);a=max3f(a,p1[r],p1[r+1]);b=max3f(b,p1[r+2],p1[r+3]);}
  const float m=max2f(a,b);
  auto rr=__builtin_amdgcn_permlane32_swap(__float_as_uint(m),__float_as_uint(m),false,false);
  return max2f(__uint_as_float(rr[0]),__uint_as_float(rr[1]));
}
__device__ __forceinline__ float xhalf_sum(float v){ auto rr=__builtin_amdgcn_permlane32_swap(__float_as_uint(v),__float_as_uint(v),false,false); return __uint_as_float(rr[0])+__uint_as_float(rr[1]); }
__device__ __forceinline__ void pv(f32x16*o,int vb,bf16x8 pa0,bf16x8 pa1,bf16x8 pa2,bf16x8 pa3){
  #pragma unroll
  for(int d0=0;d0<2;++d0){s16x4 lo[4],hi[4];
    #pragma unroll
    for(int ks=0;ks<4;++ks){
      asm volatile("ds_read_b64_tr_b16 %0,%1 offset:%c2":"=&v"(lo[ks]):"v"(vb),"i"(d0*4096+ks*1024):"memory");
      asm volatile("ds_read_b64_tr_b16 %0,%1 offset:%c2":"=&v"(hi[ks]):"v"(vb),"i"(d0*4096+ks*1024+512):"memory");}
    asm volatile("s_waitcnt lgkmcnt(0)":::"memory");SBAR();
    #define PK(k) (bf16x8){lo[k][0],lo[k][1],lo[k][2],lo[k][3],hi[k][0],hi[k][1],hi[k][2],hi[k][3]}
    o[d0]=__builtin_amdgcn_mfma_f32_32x32x16_bf16(pa0,PK(0),o[d0],0,0,0);
    o[d0]=__builtin_amdgcn_mfma_f32_32x32x16_bf16(pa1,PK(1),o[d0],0,0,0);
    o[d0]=__builtin_amdgcn_mfma_f32_32x32x16_bf16(pa2,PK(2),o[d0],0,0,0);
    o[d0]=__builtin_amdgcn_mfma_f32_32x32x16_bf16(pa3,PK(3),o[d0],0,0,0);
    #undef PK
  }
}

template<int THRL> __device__ __forceinline__ void moba_unit(int b,int h,int c,const bf16*Pq,const bf16*__restrict__ Pk,const bf16*__restrict__ Pv,const bf16*Pz,bf16*Po,const float*__restrict__ kmean,char*shm){
  int tid_=threadIdx.x; asm volatile("":"+v"(tid_));
  const int tid=tid_,lane=tid&63,r32=lane&31,hi=lane>>5; const int wid=__builtin_amdgcn_readfirstlane(tid>>6);
  const long rowbase=(long)b*SEQ; const int q0=c*QB;
  const bf16*Qw=Pq+(rowbase+q0+wid*QBLK)*PITCH+h*D;
  const bf16*Kh=Pk+rowbase*PITCH+h*D,*Vh=Pv+rowbase*PITCH+h*D;
  const unsigned lds0=(unsigned)(uintptr_t)shm;
  float*wsf=(float*)(shm+LDS_WS)+wid*64;
  float*kml=(float*)(shm+LDS_KM);
  const int NT=(q0+QB)/KVBLK;
  const bf16*ksrc=Kh+(long)lane*PITCH+wid*8;
  const bf16*vsrc=Vh+(long)(16*(wid&3)+(lane>>2))*PITCH+(wid>>2)*32+(lane&3)*8;
  const unsigned kdst=lds0+LDS_K+wid*1024, vdst=lds0+LDS_V+wid*1024;
  #define DMA_K(t,slot) glds16(ksrc+(long)(NT-1-(t))*KVBLK*PITCH,(unsigned)__builtin_amdgcn_readfirstlane(kdst+(slot)))
  #define DMA_V(t,slot) glds16(vsrc+(long)(NT-1-(t))*KVBLK*PITCH,(unsigned)__builtin_amdgcn_readfirstlane(vdst+(slot)))
  const int vb0=(int)(lds0+LDS_V)+((lane>>4)&1)*32+(lane&3)*8+(4*hi+((lane&15)>>2))*64;
  const char*Kbase=shm+LDS_K; bf16x8 kf[8];
  const lds_cptr shm3=(lds_cptr)shm; const lds_cptr kp0=shm3+LDS_K+hi*1024+r32*16; const lds_cptr vp0=shm3+LDS_V+((lane>>4)&1)*32+(lane&3)*8+(4*hi+((lane&15)>>2))*64;
  #define VS(t) ((((t))&3)*SLOTB)
  DMA_K(0,0);DMA_V(0,VS(0));DMA_K(1,SLOTB);
  bf16x8 qr[4];
  #pragma unroll
  for(int d0=0;d0<4;++d0)qr[d0]=*reinterpret_cast<const bf16x8*>(&Qw[(long)r32*PITCH+d0*16+hi*8]);
  const int qrel=wid*QBLK+r32;
  u32x4 kdg[4];
  { const bf16*Kd=Kh+(long)(q0+qrel)*PITCH;
    #pragma unroll
    for(int d0=0;d0<4;++d0)kdg[d0]=*reinterpret_cast<const u32x4*>(&Kd[d0*16+hi*8]); }
  const float sl2=__uint_as_float(__builtin_amdgcn_readfirstlane(__float_as_uint(__builtin_amdgcn_exp2f(-(float)(h+1))*1.4426950408889634f)));
  unsigned sel=0u;
  if(c>0){
    if(tid<c*64) kml[tid]=kmean[((long)(b*8)+(tid>>6))*512+h*64+(tid&63)];
    asm volatile("s_waitcnt vmcnt(0) lgkmcnt(0)\n\ts_barrier":::"memory");
    if(c<=3) sel=(1u<<c)-1u;
    else{
      float g[8];
      #pragma unroll
      for(int j=0;j<8;++j){ g[j]=-INFINITY;
        if(j<c){ float a=0.f;
          #pragma unroll
          for(int d0=0;d0<4;++d0){ const u32x4 qv=__builtin_bit_cast(u32x4,qr[d0]); const float*km=kml+j*64+d0*16+hi*8;
            const float4 k0=*(const float4*)km, k1=*(const float4*)(km+4);
            a+=bl(qv.x)*k0.x+bh(qv.x)*k0.y+bl(qv.y)*k0.z+bh(qv.y)*k0.w+bl(qv.z)*k1.x+bh(qv.z)*k1.y+bl(qv.w)*k1.z+bh(qv.w)*k1.w; }
          g[j]=xhalf_sum(a); } }
      #pragma unroll
      for(int j=0;j<8;++j){ int rank=0;
        #pragma unroll
        for(int j2=0;j2<8;++j2){ if(j2!=j) rank+=((g[j2]>g[j])||(g[j2]==g[j]&&j2<j))?1:0; }
        if(j<c&&rank<3) sel|=(1u<<j); }
    }
  }
  float mhat;
  { float a=0.f;
    #pragma unroll
    for(int d0=0;d0<4;++d0){ const u32x4 kv=kdg[d0]; const u32x4 qv=__builtin_bit_cast(u32x4,qr[d0]);
      a+=bl(qv.x)*bl(kv.x)+bh(qv.x)*bh(kv.x)+bl(qv.y)*bl(kv.y)+bh(qv.y)*bh(kv.y)+bl(qv.z)*bl(kv.z)+bh(qv.z)*bh(kv.z)+bl(qv.w)*bl(kv.w)+bh(qv.w)*bh(kv.w); }
    mhat=xhalf_sum(a)+sl2*(float)qrel; }
  float l_reg=0.f;f32x16 o[2];o[0]=f32x16{};o[1]=f32x16{};
  f32x16 negm;
  #pragma unroll
  for(int r=0;r<16;++r)negm[r]=sl2*(float)((r&3)+8*(r>>2))-mhat;
  asm volatile("":"+v"(negm));
  #define MBIAS(P0,P1,t) do{ const int T_=NT-1-(t); const int jb_=T_-(NT-4); float a0_=sl2*(float)(64*jb_+4*hi); \
      if(jb_<0){ if(!((sel>>(T_>>2))&1u)) a0_=-INFINITY; } const float a1_=a0_+32.f*sl2; \
      _Pragma("unroll") for(int r=0;r<16;++r){P0[r]+=a0_;P1[r]+=a1_;} \
      if(jb_>=0)cmask(P0,P1,jb_,qrel,hi); }while(0)
  bool resc=false;
  #define RESC() do{ if(resc){ asm volatile("s_waitcnt lgkmcnt(0)":::"memory"); \
      _Pragma("unroll") for(int d_=0;d_<2;++d_) _Pragma("unroll") for(int r=0;r<16;++r)o[d_][r]*=wsf[crow(r,hi)]; } }while(0)
  f32x16 pA0,pA1,pB0,pB1;
  int sl_prev=0,sl_cur=0,sl_next=SLOTB;
  #define ROT() do{sl_prev=sl_cur;sl_cur=sl_next;sl_next=(sl_next==(NSLOT-1)*SLOTB)?0:sl_next+SLOTB;}while(0)
  DMA_K(2,2*SLOTB);DMA_V(1,VS(1));
  WAIT_BAR(2);
  qkt(pA0,pA1,Kbase,qr,negm,r32,hi);asm volatile("s_nop 15\n\ts_nop 7":"+v"(pA0),"+v"(pA1));MBIAS(pA0,pA1,0);
  { const float rm=rowmax(pA0,pA1);
    if(__any(rm>(float)THRL)){ const float dl=__builtin_fmaxf(rm,0.f);
      _Pragma("unroll") for(int r=0;r<16;++r){pA0[r]-=dl;pA1[r]-=dl;negm[r]-=dl;}
      asm volatile("":"+v"(negm)); } }
  _Pragma("unroll") for(int r=0;r<16;++r){pA0[r]=__builtin_amdgcn_exp2f(pA0[r]);pA1[r]=__builtin_amdgcn_exp2f(pA1[r]);}
  WAIT_BAR(2);
  DMA_K(3,0);DMA_V(2,VS(2));
  ROT();
  kload8(kf,kp0+sl_cur);
  WAIT_BAR(3);
  s16x4 vlo[8],vhi[8]; u32x4 pw0,pw1,pw2,pw3;
  #define PKW(P,B) cvtpk_s(P[B],P[B+1])
  #define PAF(k) __builtin_bit_cast(bf16x8,pw##k)
  #define VFR(i) (bf16x8){vlo[i][0],vlo[i][1],vlo[i][2],vlo[i][3],vhi[i][0],vhi[i][1],vhi[i][2],vhi[i][3]}
  #define PIN(x) asm volatile("":"+v"(x))
  #define MX3(a,b,c) __builtin_fmaxf(__builtin_fmaxf((a),(b)),(c))
  #define GAPA(MF,A0,A1,A2,A3,W0,W1,PW) do{ MF; sacc+=A0; sacc+=A1; sacc+=A2; sacc+=A3; PIN(sacc); W0; W1; PIN(PW); SBAR(); }while(0)
  #define EX(v) __builtin_amdgcn_exp2f(v)
  #define GAPB(MF,X,B) do{ MF; X[B]=EX(X[B]); X[B+1]=EX(X[B+1]); X[B+2]=EX(X[B+2]); X[B+3]=EX(X[B+3]); PIN(X); SBAR(); }while(0)
  #define VRD(i) do{ vlo[i]=vtr(vp_+(((i)>>2)*4096+((i)&3)*1024)); vhi[i]=vtr(vp_+(((i)>>2)*4096+((i)&3)*1024+512)); }while(0)
  #define KRD(G,j) do{ if(G){ kload2(kf,kp0+sl_next,j); SBAR(); } }while(0)
  #define STEP(C0,C1,P0,P1,t,GK,GV,GL) do{ SBAR(); \
    const lds_cptr vp_=vp0+VS((t)-1); \
    VRD(0); SBAR(); float sacc=(P0[0]+P0[1]); \
    GAPA(C0=__builtin_amdgcn_mfma_f32_32x32x16_bf16(kf[0],qr[0],negm,0,0,0), P0[2],P0[3],P0[4],P0[5],     pw0[0]=PKW(P0,0), pw0[1]=PKW(P0,2), pw0); \
    VRD(4); SBAR(); GAPA(C1=__builtin_amdgcn_mfma_f32_32x32x16_bf16(kf[1],qr[0],negm,0,0,0), P0[6],P0[7],P0[8],P0[9],     pw0[2]=PKW(P0,4), pw0[3]=PKW(P0,6), pw0); \
    VRD(1); SBAR(); GAPA(C0=__builtin_amdgcn_mfma_f32_32x32x16_bf16(kf[2],qr[1],C0,0,0,0),   P0[10],P0[11],P0[12],P0[13], pw1[0]=PKW(P0,8), pw1[1]=PKW(P0,10), pw1); \
    VRD(5); SBAR(); GAPA(C1=__builtin_amdgcn_mfma_f32_32x32x16_bf16(kf[3],qr[1],C1,0,0,0),   P0[14],P0[15],P1[0],P1[1],   pw1[2]=PKW(P0,12),pw1[3]=PKW(P0,14), pw1); \
    VRD(2); SBAR(); GAPA(C0=__builtin_amdgcn_mfma_f32_32x32x16_bf16(kf[4],qr[2],C0,0,0,0),   P1[2],P1[3],P1[4],P1[5],     pw2[0]=PKW(P1,0), pw2[1]=PKW(P1,2), pw2); \
    VRD(6); SBAR(); GAPA(C1=__builtin_amdgcn_mfma_f32_32x32x16_bf16(kf[5],qr[2],C1,0,0,0),   P1[6],P1[7],P1[8],P1[9],     pw2[2]=PKW(P1,4), pw2[3]=PKW(P1,6), pw2); \
    VRD(3); SBAR(); GAPA(C0=__builtin_amdgcn_mfma_f32_32x32x16_bf16(kf[6],qr[3],C0,0,0,0),   P1[10],P1[11],P1[12],P1[13], pw3[0]=PKW(P1,8), pw3[1]=PKW(P1,10), pw3); \
    VRD(7); SBAR(); GAPA(C1=__builtin_amdgcn_mfma_f32_32x32x16_bf16(kf[7],qr[3],C1,0,0,0),   P1[14],P1[15],0.f,0.f,       pw3[2]=PKW(P1,12),pw3[3]=PKW(P1,14), pw3); \
    l_reg+=sacc; \
    if(GK){DMA_K((t)+3,sl_cur);} if(GV){DMA_V((t)+2,VS((t)+2));} \
    MBIAS(C0,C1,t); \
    { float a=MX3(C0[0],C0[1],C1[0]),b=MX3(C0[2],C0[3],C1[1]); a=MX3(a,C1[2],C1[3]); \
      _Pragma("unroll") for(int r=4;r<16;r+=4){a=MX3(a,C0[r],C0[r+1]);b=MX3(b,C0[r+2],C0[r+3]);a=MX3(a,C1[r],C1[r+1]);b=MX3(b,C1[r+2],C1[r+3]);} \
      float rm=__builtin_fmaxf(a,b); { auto rr=__builtin_amdgcn_permlane32_swap(__float_as_uint(rm),__float_as_uint(rm),false,false); rm=__builtin_fmaxf(__uint_as_float(rr[0]),__uint_as_float(rr[1])); } \
      resc=false; \
      if(__builtin_expect(__any(rm>(float)THRL),0)){ const float dl=__builtin_fmaxf(rm,0.f); \
        _Pragma("unroll") for(int r=0;r<16;++r){C0[r]-=dl;C1[r]-=dl;} \
        _Pragma("unroll") for(int r=0;r<16;++r)negm[r]-=dl; asm volatile("":"+v"(negm)); \
        const float f=__builtin_amdgcn_exp2f(-dl); l_reg*=f; if(hi==0)wsf[r32]=f; resc=true; } } \
    SBAR(); \
    GAPB(o[0]=__builtin_amdgcn_mfma_f32_32x32x16_bf16(PAF(0),VFR(0),o[0],0,0,0), C0,0); \
    GAPB(o[1]=__builtin_amdgcn_mfma_f32_32x32x16_bf16(PAF(0),VFR(4),o[1],0,0,0), C0,4); \
    KRD(GL,0); GAPB(o[0]=__builtin_amdgcn_mfma_f32_32x32x16_bf16(PAF(1),VFR(1),o[0],0,0,0), C0,8); \
    KRD(GL,1); GAPB(o[1]=__builtin_amdgcn_mfma_f32_32x32x16_bf16(PAF(1),VFR(5),o[1],0,0,0), C0,12); \
    KRD(GL,2); GAPB(o[0]=__builtin_amdgcn_mfma_f32_32x32x16_bf16(PAF(2),VFR(2),o[0],0,0,0), C1,0); \
    KRD(GL,3); GAPB(o[1]=__builtin_amdgcn_mfma_f32_32x32x16_bf16(PAF(2),VFR(6),o[1],0,0,0), C1,4); \
    GAPB(o[0]=__builtin_amdgcn_mfma_f32_32x32x16_bf16(PAF(3),VFR(3),o[0],0,0,0), C1,8); \
    GAPB(o[1]=__builtin_amdgcn_mfma_f32_32x32x16_bf16(PAF(3),VFR(7),o[1],0,0,0), C1,12); \
    }while(0)
  int t=1;
  for(;t+5<NT;t+=2){
    STEP(pB0,pB1,pA0,pA1,t,true,true,true);     WAIT_BAR(3); RESC(); ROT();
    STEP(pA0,pA1,pB0,pB1,t+1,true,true,true);   WAIT_BAR(3); RESC(); ROT();
  }
  #define ENDW(tt) do{ if((tt)+3<NT){WAIT_BAR(3);} else if((tt)+2<NT){WAIT_BAR(2);} else {WAIT_BAR(0);} }while(0)
  for(;t+1<NT;t+=2){
    STEP(pB0,pB1,pA0,pA1,t,(t+3<NT),(t+2<NT),(t+1<NT));       ENDW(t);   RESC(); ROT();
    STEP(pA0,pA1,pB0,pB1,t+1,(t+4<NT),(t+3<NT),(t+2<NT));     ENDW(t+1); RESC(); ROT();
  }
  STEP(pB0,pB1,pA0,pA1,NT-1,false,false,false); RESC();
  { float sacc=pB0[0]+pB0[1]; _Pragma("unroll") for(int r=2;r<16;++r)sacc+=pB0[r]; _Pragma("unroll") for(int r=0;r<16;++r)sacc+=pB1[r]; l_reg+=sacc;
    pw0=(u32x4){PKW(pB0,0),PKW(pB0,2),PKW(pB0,4),PKW(pB0,6)};pw1=(u32x4){PKW(pB0,8),PKW(pB0,10),PKW(pB0,12),PKW(pB0,14)};pw2=(u32x4){PKW(pB1,0),PKW(pB1,2),PKW(pB1,4),PKW(pB1,6)};pw3=(u32x4){PKW(pB1,8),PKW(pB1,10),PKW(pB1,12),PKW(pB1,14)};
    SBAR(); pv(o,vb0+VS(NT-1),PAF(0),PAF(1),PAF(2),PAF(3)); }
  #undef PKW
  #undef PAF
  #undef VFR
  #undef PIN
  #undef MX3
  #undef GAPA
  #undef GAPB
  #undef EX
  #undef VRD
  #undef KRD
  #undef STEP
  #undef ENDW
  l_reg=xhalf_sum(l_reg);
  if(hi==0)wsf[32+r32]=l_reg;asm volatile("s_waitcnt lgkmcnt(0)":::"memory");
  float rli[16];
  #pragma unroll
  for(int r=0;r<16;++r)rli[r]=__builtin_amdgcn_rcpf(wsf[32+crow(r,hi)]);
  const bf16*Zw=Pz+(rowbase+q0+wid*QBLK)*PITCH+h*D; bf16*Ow=Po+(rowbase+q0+wid*QBLK)*PITCH+h*D;
  { bf16*stg=(bf16*)(shm+LDS_OST)+wid*2048;
    #pragma unroll
    for(int r=0;r<16;++r){const int orow=crow(r,hi);
      #pragma unroll
      for(int d0=0;d0<2;++d0)((unsigned short*)stg)[orow*64+d0*32+r32]=(unsigned short)cvtpk_s(o[d0][r]*rli[r],0.f);}
    asm volatile("s_waitcnt lgkmcnt(0)":::"memory");
    #pragma unroll
    for(int i=0;i<4;++i){const int row=i*8+(lane>>3),ch=lane&7; const u32x4 v=*(const u32x4*)(stg+row*64+ch*8);
      const u32x4 z=__builtin_nontemporal_load((const u32x4*)(Zw+(long)row*PITCH+ch*8)); u32x4*zp=(u32x4*)(Ow+(long)row*PITCH+ch*8); u32x4 w;
      w.x=cvtpk_s(bl(v.x)*bl(z.x),bh(v.x)*bh(z.x)); w.y=cvtpk_s(bl(v.y)*bl(z.y),bh(v.y)*bh(z.y)); w.z=cvtpk_s(bl(v.z)*bl(z.z),bh(v.z)*bh(z.z)); w.w=cvtpk_s(bl(v.w)*bl(z.w),bh(v.w)*bh(z.w));
      *zp=w; } }
  asm volatile("s_waitcnt lgkmcnt(0)\n\ts_barrier":::"memory");
  #undef DMA_K
  #undef DMA_V
  #undef VS
  #undef MBIAS
  #undef RESC
  #undef ROT
}
constexpr int ATTN_LDS_BYTES=LDS_BYTES;
#undef SBAR
#undef WAIT_BAR
}
namespace attna {
using moba::bf16; using moba::bf16x8; using moba::s16x4; using moba::f32x16; using moba::u32x4; using moba::lds_cptr;
using moba::crow; using moba::cvtpk_s; using moba::bl; using moba::bh; using moba::vtr; using moba::xhalf_sum;
constexpr int SEQ=2048,PITCH=4608;
constexpr int WK=0,WV=4608,WO=12800,WSC=16896,WBYTES=17152,LSE_OFF=8*WBYTES,LDS_BYTES=LSE_OFF+3*512*4;
#define AMFMA(a,b,c) __builtin_amdgcn_mfma_f32_32x32x16_bf16(a,b,c,0,0,0)

__device__ __forceinline__ void sub_item(bf16*P,int b,int hs,int g,int res,int l0,int chunk,char*wl,float*lse_l,int lane){
  asm volatile("":"+v"(lane));
  const int r32=lane&31,hi=lane>>5;
  const int dsh=2*g;
  const long rowb=(long)b*SEQ+res;
  const int qcol=g*768+hs*64;
  const float sl2=__builtin_amdgcn_exp2f(-(2.0f/3.0f)*(float)(4*g+hs+1))*(float)(1<<dsh)*1.4426950408889634f;
  #define AROW(l) ((rowb+((long)(l)<<dsh))*PITCH)
  #define KL(i,x) ((l0-128+32*(i)+(x))<0?0:(l0-128+32*(i)+(x)))
  const int i0=(l0>=128)?0:(4-(l0>>5));
  const int lrow=lane>>3, lch=lane&7;
  u32x4 qg[4],kg[5][4],vg[5][4];
  #pragma unroll
  for(int j=0;j<4;++j)qg[j]=*reinterpret_cast<const u32x4*>(P+AROW(l0+lrow+8*j)+qcol+lch*8);
  #pragma unroll
  for(int i=4;i>=0;--i)
    #pragma unroll
    for(int j=0;j<4;++j)kg[i][j]=*reinterpret_cast<const u32x4*>(P+AROW(KL(i,lrow+8*j))+qcol+256+lch*8);
  #pragma unroll
  for(int i=4;i>=0;--i)
    #pragma unroll
    for(int j=0;j<4;++j)vg[i][j]=*reinterpret_cast<const u32x4*>(P+AROW(KL(i,lrow+8*j))+qcol+512+lch*8);
  __builtin_amdgcn_sched_barrier(0);
  char*kb=wl+WK; const int kwoff=lrow*144+lch*16, kroff=r32*144+hi*16;
  bf16x8 qf[4];
  #pragma unroll
  for(int j=0;j<4;++j)*reinterpret_cast<u32x4*>(kb+kwoff+j*8*144)=qg[j];
  #pragma unroll
  for(int d0=0;d0<4;++d0)qf[d0]=*reinterpret_cast<const bf16x8*>(kb+kroff+d0*32);
  f32x16 S[5];
  #pragma unroll
  for(int i=4;i>=0;--i){
    #pragma unroll
    for(int j=0;j<4;++j)*reinterpret_cast<u32x4*>(kb+kwoff+j*8*144)=kg[i][j];
    bf16x8 kf[4];
    #pragma unroll
    for(int d0=0;d0<4;++d0)kf[d0]=*reinterpret_cast<const bf16x8*>(kb+kroff+d0*32);
    f32x16 acc=f32x16{};
    #pragma unroll
    for(int d0=0;d0<4;++d0)acc=AMFMA(kf[d0],qf[d0],acc);
    const float sbi=((i<i0)?-INFINITY:0.f)-sl2*(float)(32*(4-i)+r32-4*hi);
    #pragma unroll
    for(int r=0;r<16;++r){ const int kc=(r&3)+8*(r>>2); float v=__builtin_fmaf(sl2,(float)kc,acc[r]+sbi);
      if(i==4&&kc+4*hi>r32)v=-INFINITY; if(i==0&&kc+4*hi<r32)v=-INFINITY; acc[r]=v; }
    S[i]=acc;
  }
  float mx=-INFINITY;
  #pragma unroll
  for(int i=0;i<5;++i)
    #pragma unroll
    for(int r=0;r<16;++r)mx=fmaxf(mx,S[i][r]);
  { auto rr=__builtin_amdgcn_permlane32_swap(__float_as_uint(mx),__float_as_uint(mx),false,false); mx=fmaxf(__uint_as_float(rr[0]),__uint_as_float(rr[1])); }
  float ls=0.f;
  #pragma unroll
  for(int i=0;i<5;++i)
    #pragma unroll
    for(int r=0;r<16;++r){ const float p=__builtin_amdgcn_exp2f(S[i][r]-mx); S[i][r]=p; ls+=p; }
  ls=xhalf_sum(ls);
  f32x16 o[2]; o[0]=f32x16{}; o[1]=f32x16{};
  const lds_cptr wl3=(lds_cptr)wl;
  const int vtoff=((lane>>4)&1)*32+(lane&3)*8+(4*hi+((lane&15)>>2))*64;
  const int vwoff=(lch>>2)*2048+lrow*64+(lch&3)*16;
  #define PVSTEP(i) do{ char*vb_=wl+WV+((i)&1)*4096; \
      _Pragma("unroll") for(int j=0;j<4;++j)*reinterpret_cast<u32x4*>(vb_+vwoff+j*8*64)=vg[i][j]; \
      const u32x4 pw0=(u32x4){cvtpk_s(S[i][0],S[i][1]),cvtpk_s(S[i][2],S[i][3]),cvtpk_s(S[i][4],S[i][5]),cvtpk_s(S[i][6],S[i][7])}; \
      const u32x4 pw1=(u32x4){cvtpk_s(S[i][8],S[i][9]),cvtpk_s(S[i][10],S[i][11]),cvtpk_s(S[i][12],S[i][13]),cvtpk_s(S[i][14],S[i][15])}; \
      const lds_cptr vp=wl3+WV+((i)&1)*4096+vtoff; \
      _Pragma("unroll") for(int d0=0;d0<2;++d0){ \
        const s16x4 a0=vtr(vp+d0*2048),a1=vtr(vp+d0*2048+512),b0=vtr(vp+d0*2048+1024),b1=vtr(vp+d0*2048+1536); \
        const bf16x8 f0=(bf16x8){a0[0],a0[1],a0[2],a0[3],a1[0],a1[1],a1[2],a1[3]}, f1=(bf16x8){b0[0],b0[1],b0[2],b0[3],b1[0],b1[1],b1[2],b1[3]}; \
        o[d0]=AMFMA(__builtin_bit_cast(bf16x8,pw0),f0,o[d0]); \
        o[d0]=AMFMA(__builtin_bit_cast(bf16x8,pw1),f1,o[d0]); } }while(0)
  PVSTEP(4); PVSTEP(3); PVSTEP(2); PVSTEP(1); PVSTEP(0);
  float*ws=(float*)(wl+WSC);
  const int tokc=((l0+r32)<<dsh)+res-chunk*512;
  if(hi==0){ ws[r32]=__builtin_amdgcn_rcpf(ls); lse_l[g*512+tokc]=mx+__builtin_amdgcn_logf(ls); }
  bf16*stg=(bf16*)(wl+WO);
  #pragma unroll
  for(int r=0;r<16;++r){ const int orow=crow(r,hi); const float il=ws[orow];
    #pragma unroll
    for(int d0=0;d0<2;++d0)((unsigned short*)stg)[orow*64+d0*32+r32]=(unsigned short)cvtpk_s(o[d0][r]*il,0.f); }
  #pragma unroll
  for(int i=0;i<4;++i){ const int row=i*8+(lane>>3),ch=lane&7; const u32x4 v=*reinterpret_cast<const u32x4*>(stg+row*64+ch*8);
    *reinterpret_cast<u32x4*>(P+AROW(l0+row)+qcol+ch*8)=v; }
  #undef AROW
  #undef KL
  #undef PVSTEP
}

__device__ __forceinline__ void wg_item(bf16*P,int b,int hs,int chunk,char*shm){
  int tid_=threadIdx.x; asm volatile("":"+v"(tid_));
  const int tid=tid_,lane=tid&63; const int wid=__builtin_amdgcn_readfirstlane(tid>>6);
  char*wl=shm+wid*WBYTES; float*lse_l=(float*)(shm+LSE_OFF);
  #pragma unroll 1
  for(int i6=0;i6<6;++i6){
    const int si=wid+8*i6, g=si>>4, k=si&15;
    int res,l0;
    if(g==0){res=0;l0=32*(chunk*16+k);} else if(g==1){res=k>>2;l0=128*chunk+32*(k&3);} else {res=k;l0=32*chunk;}
    sub_item(P,b,hs,g,res,l0,chunk,wl,lse_l,lane);
  }
  __syncthreads();
  #pragma unroll
  for(int idx=tid;idx<512*8;idx+=512){
    const int tok=idx>>3,ch=idx&7; const long row=((long)b*SEQ+chunk*512+tok)*PITCH;
    const float e0=lse_l[tok],e1=lse_l[512+tok],e2=lse_l[1024+tok]; const float em=fmaxf(e0,fmaxf(e1,e2));
    float w0=__builtin_amdgcn_exp2f(e0-em),w1=__builtin_amdgcn_exp2f(e1-em),w2=__builtin_amdgcn_exp2f(e2-em); const float iw=__builtin_amdgcn_rcpf(w0+w1+w2); w0*=iw;w1*=iw;w2*=iw;
    const u32x4 a=*reinterpret_cast<const u32x4*>(P+row+hs*64+ch*8), bq=*reinterpret_cast<const u32x4*>(P+row+768+hs*64+ch*8), cq=*reinterpret_cast<const u32x4*>(P+row+1536+hs*64+ch*8);
    u32x4*zp=reinterpret_cast<u32x4*>(P+row+2304+hs*64+ch*8); const u32x4 z=__builtin_nontemporal_load(zp); u32x4 w;
    #define CMB(f) cvtpk_s((w0*bl(a.f)+w1*bl(bq.f)+w2*bl(cq.f))*bl(z.f),(w0*bh(a.f)+w1*bh(bq.f)+w2*bh(cq.f))*bh(z.f))
    w.x=CMB(x); w.y=CMB(y); w.z=CMB(z); w.w=CMB(w);
    #undef CMB
    *zp=w;
  }
  __syncthreads();
}
#undef AMFMA
}

constexpr int NWAVES = 8;
constexpr int BATCH = 16, SEQ = 2048, DM = 1024, M = BATCH * SEQ, DEPTH = 2;
constexpr int INC = 6656;
constexpr int LDP = 4608;
constexpr int C_AQKV = 0, C_ZA = 2304, C_BQKV = 2560, C_ZB = 4096, C_RA = 4608, C_RB = 5632;
constexpr int C_MERGED = 0;
constexpr float RMS_EPS = 1e-6f;
constexpr size_t MiB = 1u << 20;
constexpr size_t WS_CTL = 0;
constexpr size_t WS_BAR = 0, WS_BAR_BYTES = 64 * 1024;
constexpr size_t WS_KMEAN = 256 * 1024;
constexpr size_t WS_WIN = 1 * MiB;
constexpr size_t WS_WCAT = 14 * MiB;
constexpr size_t WS_WOUT = 17 * MiB;
constexpr size_t WS_XB = 21 * MiB;
constexpr size_t WS_PROJ = 85 * MiB;
constexpr size_t WS_GATES = 373 * MiB;
constexpr size_t WS_WIN1 = 437 * MiB;
constexpr size_t WS_ROWSS = 450 * MiB;
constexpr size_t WS_XB8 = 454 * MiB;
constexpr size_t WS_W8 = 486 * MiB;
constexpr size_t WS_COLMAX = 32 * 1024;
constexpr size_t WS_XSCALE = 128 * 1024;
constexpr int W8R = 256 * pg8::N8T + 2048;
constexpr size_t WS_END = WS_W8 + 2 * (size_t)W8R * 1024;
static_assert(WS_PROJ + (size_t)M * LDP * 2 == WS_GATES && WS_GATES + (size_t)M * 2048 == WS_WIN1, "ws map");
constexpr int LDS_MISC = pg8::EPI_OFF + 8 * pg8::EPI_WAVE;
constexpr int LDS_RSTAB = LDS_MISC + 256;
constexpr int LDS_BYTES = LDS_RSTAB + 1024 + 64;

#define LAS __attribute__((address_space(3)))
typedef unsigned short bf16;
typedef unsigned v4u __attribute__((ext_vector_type(4)));
typedef float f32x4 __attribute__((ext_vector_type(4)));
#define RLX_AGENT __ATOMIC_RELAXED, __HIP_MEMORY_SCOPE_AGENT
#define XB_TMO      128
#define XB_XCNT(j)  (256  + 64 * (j))
#define XB_XSUB(j)  (1280 + 64 * (j))
#define XB_XGEN(j)  (2304 + 64 * (j))
#define XB_TOP      3328
#define XB_TOPGEN   3392
#define XCD_BAR_WORDS 3456
#define XB_SPIN_CAP (1u << 18)

__device__ __forceinline__ unsigned xb_ld(unsigned* p)              { return __hip_atomic_load(p, __ATOMIC_RELAXED, __HIP_MEMORY_SCOPE_AGENT); }
__device__ __forceinline__ unsigned xb_add(unsigned* p, unsigned v) { return __hip_atomic_fetch_add(p, v, __ATOMIC_RELAXED, __HIP_MEMORY_SCOPE_AGENT); }
__device__ __forceinline__ unsigned xb_xcc_id() { return (unsigned)__builtin_amdgcn_s_getreg((3 << 11) | 20) & 0xFu; }
#define XB_SPIN(cond, bar) do { unsigned _sp = 0; while (cond) { __builtin_amdgcn_s_sleep(1); \
    if ((++_sp & 255u) == 0u) { if (xb_ld(&(bar)[XB_TMO])) break; if (_sp > XB_SPIN_CAP) { atomicAdd(&(bar)[XB_TMO], 1u); break; } } } } while (0)

struct XcdBarrier {
    unsigned* bar; unsigned x;
    volatile LAS unsigned* st;
};

__device__ __forceinline__ XcdBarrier xcd_barrier_post(unsigned* bar, volatile LAS unsigned* st) {
    XcdBarrier b; b.bar = bar; b.x = xb_xcc_id(); b.st = st;
    if (threadIdx.x == 0) (void)xb_add(&bar[XB_XCNT(b.x)], 1u);
    return b;
}
__device__ __forceinline__ void xcd_barrier_complete(unsigned* bar, unsigned x, unsigned& nloc, unsigned& nx) {
    const unsigned G = gridDim.x * gridDim.y * gridDim.z;
    unsigned sum, cnt, mine, sp = 0u;
    for (;;) {
        sum = 0u; cnt = 0u; mine = 0u;
#pragma unroll
        for (unsigned j = 0; j < 16; ++j) { const unsigned c = xb_ld(&bar[XB_XCNT(j)]); sum += c; cnt += (c > 0u) ? 1u : 0u; mine = (j == x) ? c : mine; }
        if (sum == G) break;
        __builtin_amdgcn_s_sleep(1);
        if ((++sp & 255u) == 0u) { if (xb_ld(&bar[XB_TMO])) break; if (sp > XB_SPIN_CAP) { atomicAdd(&bar[XB_TMO], 1u); break; } }
    }
    nloc = mine > 0u ? mine : 1u; nx = cnt > 0u ? cnt : 1u;
}

__device__ __forceinline__ void xcd_barrier(const XcdBarrier& b) {
    asm volatile("s_waitcnt vmcnt(0)" ::: "memory");
    __syncthreads();
    if (threadIdx.x == 0) {
        unsigned* bar = b.bar;
        __builtin_amdgcn_s_waitcnt(0);
        unsigned nloc = b.st[0], nx = b.st[1];
        if (nloc == 0u) { xcd_barrier_complete(bar, b.x, nloc, nx); b.st[0] = nloc; b.st[1] = nx; }
        const unsigned old = xb_add(&bar[XB_XSUB(b.x)], 1u);
        const unsigned gen = old / nloc;
        if (old + 1u == (gen + 1u) * nloc) {
            __builtin_amdgcn_fence(__ATOMIC_RELEASE, "agent");
            asm volatile("s_waitcnt vmcnt(0)" ::: "memory");
            const unsigned og = xb_add(&bar[XB_TOP], 1u);
            const unsigned tg = og / nx;
            if (og + 1u == (tg + 1u) * nx) xb_add(&bar[XB_TOPGEN], 1u);
            else XB_SPIN(xb_ld(&bar[XB_TOPGEN]) == tg, bar);
            __builtin_amdgcn_fence(__ATOMIC_ACQUIRE, "agent");
            xb_add(&bar[XB_XGEN(b.x)], 1u);
            asm volatile("s_waitcnt vmcnt(0)" ::: "memory");
        } else {
            XB_SPIN(xb_ld(&bar[XB_XGEN(b.x)]) == gen, bar);
            __builtin_amdgcn_fence(__ATOMIC_ACQUIRE, "agent");
            asm volatile("s_waitcnt vmcnt(0)" ::: "memory");
        }
    }
    __syncthreads();
}

__device__ __forceinline__ unsigned f2bf(float f) { unsigned u = __builtin_bit_cast(unsigned, f); return (u + 0x7fffu + ((u >> 16) & 1u)) >> 16; }
__device__ __forceinline__ unsigned pk2(float lo, float hi) { return f2bf(lo) | (f2bf(hi) << 16); }
__device__ __forceinline__ float bf2f(bf16 v) { return __uint_as_float(((unsigned)v) << 16); }
__device__ __forceinline__ float blo(unsigned u) { return __uint_as_float(u << 16); }
__device__ __forceinline__ float bhi(unsigned u) { return __uint_as_float(u & 0xffff0000u); }
__device__ __forceinline__ float wave_sum(float v) {
#pragma unroll
    for (int o = 1; o < 64; o <<= 1) v += __shfl_xor(v, o);
    return v;
}
__device__ __forceinline__ float wave_max(float v) {
#pragma unroll
    for (int o = 1; o < 64; o <<= 1) v = fmaxf(v, __shfl_xor(v, o));
    return v;
}
__device__ __forceinline__ void transpose_item(const float* W, int K, int N, bf16* WT, int ldw, LAS float* scr, int item, int lane, const float* gain = nullptr, int nsrc = -1) {
    const int nblk = N / 32, kb = item / nblk, nb = item % nblk, k0 = 64 * kb, n0 = 32 * nb; W += (nsrc >= 0 ? nsrc - n0 : 0);
    f32x4 v[8]; float gk[8];
#pragma unroll
    for (int i = 0; i < 8; ++i) { const int kk = 8 * i + (lane >> 3); v[i] = __builtin_nontemporal_load((const f32x4*)(W + (size_t)(k0 + kk) * N + n0 + 4 * (lane & 7))); gk[i] = gain ? gain[k0 + kk] : 1.0f; }
#pragma unroll
    for (int i = 0; i < 8; ++i) { const int kk = 8 * i + (lane >> 3); LAS float* d = scr + kk * 33 + 4 * (lane & 7); d[0] = v[i].x * gk[i]; d[1] = v[i].y * gk[i]; d[2] = v[i].z * gk[i]; d[3] = v[i].w * gk[i]; }
    asm volatile("s_waitcnt lgkmcnt(0)" ::: "memory");
    const int c = lane & 7;
#pragma unroll
    for (int j = 0; j < 4; ++j) { const int n = (lane >> 3) + 8 * j; const LAS float* s = scr + (8 * c) * 33 + n;
        v4u o; o.x = pk2(s[0 * 33], s[1 * 33]); o.y = pk2(s[2 * 33], s[3 * 33]); o.z = pk2(s[4 * 33], s[5 * 33]); o.w = pk2(s[6 * 33], s[7 * 33]);
        *(v4u*)(WT + (size_t)(n0 + n) * ldw + k0 + 8 * c) = o; }
    asm volatile("s_waitcnt lgkmcnt(0)" ::: "memory");
}
template <bool OUT_BF16> __device__ __forceinline__ void rms_row(const float* xrow, const float* g, void* orow, int lane) {
    const f32x4* xr = (const f32x4*)xrow + lane; const f32x4* gr = (const f32x4*)g + lane;
    f32x4 v[4]; float s = 0.f;
#pragma unroll
    for (int j = 0; j < 4; ++j) { v[j] = xr[64 * j]; s += (v[j].x * v[j].x + v[j].y * v[j].y) + (v[j].z * v[j].z + v[j].w * v[j].w); }
    const float rstd = 1.0f / sqrtf(wave_sum(s) * (1.f / DM) + RMS_EPS);
#pragma unroll
    for (int j = 0; j < 4; ++j) { const f32x4 gg = gr[64 * j]; v[j] = v[j] * rstd * gg; }
    if (OUT_BF16) { unsigned long long* o8 = (unsigned long long*)orow + lane;
#pragma unroll
        for (int j = 0; j < 4; ++j) o8[64 * j] = (unsigned long long)pk2(v[j].x, v[j].y) | ((unsigned long long)pk2(v[j].z, v[j].w) << 32);
    } else { f32x4* o = (f32x4*)orow + lane;
#pragma unroll
        for (int j = 0; j < 4; ++j) o[64 * j] = v[j]; }
}
__device__ __forceinline__ unsigned pack_i8x4(float a, float b, float c, float d) {
    const int ia = (int)__builtin_rintf(fminf(fmaxf(a, -127.f), 127.f)), ib = (int)__builtin_rintf(fminf(fmaxf(b, -127.f), 127.f)), ic = (int)__builtin_rintf(fminf(fmaxf(c, -127.f), 127.f)), id = (int)__builtin_rintf(fminf(fmaxf(d, -127.f), 127.f));
    return (unsigned)(ia & 255) | ((unsigned)(ib & 255) << 8) | ((unsigned)(ic & 255) << 16) | ((unsigned)(id & 255) << 24);
}
__device__ __forceinline__ void raw_row(const float* xrow, bf16* orow, float* ss, signed char* o8row, float* xs, int lane) {
    const f32x4* xr = (const f32x4*)xrow + lane; f32x4 v[4]; float s = 0.f, mx = 0.f;
#pragma unroll
    for (int j = 0; j < 4; ++j) { v[j] = __builtin_nontemporal_load(xr + 64 * j); s += (v[j].x * v[j].x + v[j].y * v[j].y) + (v[j].z * v[j].z + v[j].w * v[j].w);
        mx = fmaxf(mx, fmaxf(fmaxf(fabsf(v[j].x), fabsf(v[j].y)), fmaxf(fabsf(v[j].z), fabsf(v[j].w)))); }
    s = wave_sum(s); if (lane < 16) ss[lane] = (lane == 0) ? s : 0.f;
    mx = wave_max(mx); const float sc = mx > 0.f ? mx * (1.0f / 127.0f) : 1.0f, isc = 1.0f / sc; if (lane == 0) *xs = sc;
    unsigned long long* o8 = (unsigned long long*)orow + lane; unsigned* q8 = (unsigned*)o8row + lane;
#pragma unroll
    for (int j = 0; j < 4; ++j) { o8[64 * j] = (unsigned long long)pk2(v[j].x, v[j].y) | ((unsigned long long)pk2(v[j].z, v[j].w) << 32);
        q8[64 * j] = pack_i8x4(v[j].x * isc, v[j].y * isc, v[j].z * isc, v[j].w * isc); }
}
__device__ __forceinline__ void quant_row(const bf16* xrow, signed char* o8row, float* xs, int lane) {
    typedef unsigned u32x2_t __attribute__((ext_vector_type(2)));
    const u32x2_t* xr = (const u32x2_t*)xrow + lane; u32x2_t b[4]; float mx = 0.f;
#pragma unroll
    for (int j = 0; j < 4; ++j) { b[j] = xr[64 * j]; mx = fmaxf(mx, fmaxf(fmaxf(fabsf(blo(b[j].x)), fabsf(bhi(b[j].x))), fmaxf(fabsf(blo(b[j].y)), fabsf(bhi(b[j].y))))); }
    mx = wave_max(mx); const float sc = mx > 0.f ? mx * (1.0f / 127.0f) : 1.0f, isc = 1.0f / sc; if (lane == 0) *xs = sc;
    unsigned* q8 = (unsigned*)o8row + lane;
#pragma unroll
    for (int j = 0; j < 4; ++j) q8[64 * j] = pack_i8x4(blo(b[j].x) * isc, bhi(b[j].x) * isc, blo(b[j].y) * isc, bhi(b[j].y) * isc);
}
__device__ __forceinline__ void quant_strip_wg(const float* W, const float* gain, signed char* W8, float* wscale, LAS float* scr, LAS float* cmw, int strip, int lane, int wave) {
    const int n0 = 32 * strip; const int tj = n0 >> 8; const int src0 = tj < pg8::N8T ? 256 * pg8::tile_of(tj) + (n0 & 255) : 4608 + (n0 - 256 * pg8::N8T);
    const float* Wc = W + src0 + 4 * (lane & 7);
    f32x4 v[2][8]; float gk[2][8]; f32x4 m4 = (f32x4){0.f, 0.f, 0.f, 0.f};
#pragma unroll
    for (int q = 0; q < 2; ++q)
#pragma unroll
        for (int i = 0; i < 8; ++i) { const int kk = 64 * (2 * wave + q) + 8 * i + (lane >> 3); v[q][i] = *(const f32x4*)(Wc + (size_t)kk * INC); gk[q][i] = gain[kk]; }
#pragma unroll
    for (int q = 0; q < 2; ++q)
#pragma unroll
        for (int i = 0; i < 8; ++i) { v[q][i] = v[q][i] * gk[q][i]; m4.x = fmaxf(m4.x, fabsf(v[q][i].x)); m4.y = fmaxf(m4.y, fabsf(v[q][i].y)); m4.z = fmaxf(m4.z, fabsf(v[q][i].z)); m4.w = fmaxf(m4.w, fabsf(v[q][i].w)); }
#pragma unroll
    for (int o = 8; o < 64; o <<= 1) { m4.x = fmaxf(m4.x, __shfl_xor(m4.x, o)); m4.y = fmaxf(m4.y, __shfl_xor(m4.y, o)); m4.z = fmaxf(m4.z, __shfl_xor(m4.z, o)); m4.w = fmaxf(m4.w, __shfl_xor(m4.w, o)); }
    if (lane < 8) { LAS float* c = cmw + wave * 32 + 4 * lane; c[0] = m4.x; c[1] = m4.y; c[2] = m4.z; c[3] = m4.w; }
    __syncthreads();
    const int n = lane & 31, kh = lane >> 5; float cmx = 0.f;
#pragma unroll
    for (int w = 0; w < 8; ++w) cmx = fmaxf(cmx, cmw[w * 32 + n]);
    const float sc = cmx > 0.f ? cmx * (1.0f / 127.0f) : 1.0f, isc = 1.0f / sc;
    if (wave == 0 && kh == 0) wscale[n0 + n] = sc;
#pragma unroll
    for (int q = 0; q < 2; ++q) {
#pragma unroll
        for (int i = 0; i < 8; ++i) { const int kk = 8 * i + (lane >> 3); LAS float* d = scr + kk * 33 + 4 * (lane & 7); d[0] = v[q][i].x; d[1] = v[q][i].y; d[2] = v[q][i].z; d[3] = v[q][i].w; }
        asm volatile("s_waitcnt lgkmcnt(0)" ::: "memory");
        const LAS float* s = scr + (32 * kh) * 33 + n; v4u o0, o1;
        o0.x = pack_i8x4(s[0 * 33] * isc, s[1 * 33] * isc, s[2 * 33] * isc, s[3 * 33] * isc); o0.y = pack_i8x4(s[4 * 33] * isc, s[5 * 33] * isc, s[6 * 33] * isc, s[7 * 33] * isc);
        o0.z = pack_i8x4(s[8 * 33] * isc, s[9 * 33] * isc, s[10 * 33] * isc, s[11 * 33] * isc); o0.w = pack_i8x4(s[12 * 33] * isc, s[13 * 33] * isc, s[14 * 33] * isc, s[15 * 33] * isc);
        o1.x = pack_i8x4(s[16 * 33] * isc, s[17 * 33] * isc, s[18 * 33] * isc, s[19 * 33] * isc); o1.y = pack_i8x4(s[20 * 33] * isc, s[21 * 33] * isc, s[22 * 33] * isc, s[23 * 33] * isc);
        o1.z = pack_i8x4(s[24 * 33] * isc, s[25 * 33] * isc, s[26 * 33] * isc, s[27 * 33] * isc); o1.w = pack_i8x4(s[28 * 33] * isc, s[29 * 33] * isc, s[30 * 33] * isc, s[31 * 33] * isc);
        v4u* dst = (v4u*)(W8 + (size_t)(n0 + n) * 1024 + 64 * (2 * wave + q) + 32 * kh); dst[0] = o0; dst[1] = o1;
        asm volatile("s_waitcnt lgkmcnt(0)" ::: "memory");
    }
    __syncthreads();
}
__device__ __forceinline__ float dot64(const v4u (&q)[8], const bf16* krow) {
    const v4u* kp = (const v4u*)krow; float a0 = 0.f, a1 = 0.f;
#pragma unroll
    for (int i = 0; i < 8; ++i) { const v4u k = kp[i];
        a0 += blo(q[i].x) * blo(k.x) + blo(q[i].y) * blo(k.y) + blo(q[i].z) * blo(k.z) + blo(q[i].w) * blo(k.w);
        a1 += bhi(q[i].x) * bhi(k.x) + bhi(q[i].y) * bhi(k.y) + bhi(q[i].z) * bhi(k.z) + bhi(q[i].w) * bhi(k.w); }
    return a0 + a1;
}

struct Args { const float* x; const float* norm_g; const float* w_in; const float* b_merge; const float* w_pa; const float* w_pb; const float* w_out; const float* final_g;
              float* out; unsigned char* ws; };

#define PHASE_VARS() \
    int tid_ = threadIdx.x; asm volatile("" : "+v"(tid_)); \
    const int lane = tid_ & 63, wave = __builtin_amdgcn_readfirstlane(tid_ >> 6); \
    const int G = gridDim.x, gw = blockIdx.x * NWAVES + wave, NGW = G * NWAVES; \
    unsigned long long wsb_ = (unsigned long long)a.ws; asm volatile("" : "+s"(wsb_)); \
    unsigned char* const ws = (unsigned char*)(__attribute__((address_space(1))) unsigned char*)wsb_;     \
    bf16* const Win = (bf16*)(ws + (layer == 0 ? WS_WIN : WS_WIN1)); float* const rowss = (float*)(ws + WS_ROWSS); signed char* const XB8 = (signed char*)(ws + WS_XB8); signed char* const W8 = (signed char*)(ws + WS_W8); float* const wscale = (float*)(ws + WS_COLMAX); float* const xscale = (float*)(ws + WS_XSCALE); bf16* const Wcat = (bf16*)(ws + WS_WCAT); bf16* const Wout = (bf16*)(ws + WS_WOUT); \
    bf16* const XB = (bf16*)(ws + WS_XB); bf16* const P = (bf16*)(ws + WS_PROJ); float* const kmean = (float*)(ws + WS_KMEAN); unsigned char* const gatesb = ws + WS_GATES; \
    (void)lane; (void)wave; (void)G; (void)gw; (void)NGW; (void)Win; (void)Wcat; (void)Wout; (void)rowss; (void)XB8; (void)W8; (void)wscale; (void)xscale; (void)XB; (void)P; (void)kmean; (void)gatesb;

#define GRID_BAR() do { unsigned long long wb_ = (unsigned long long)a.ws; asm volatile("" : "+s"(wb_)); XcdBarrier bb_; bb_.bar = (unsigned*)(__attribute__((address_space(1))) unsigned*)wb_; \
    bb_.x = xb_xcc_id(); bb_.st = (volatile LAS unsigned*)(L + LDS_MISC); xcd_barrier(bb_); } while (0)
template <int layer> __device__ __forceinline__ void layer_fwd(const Args& a, unsigned char* lds, LAS unsigned char* L) {
    if (layer == 0) {
        PHASE_VARS();
        LAS float* scr = (LAS float*)(L + wave * 16384);
        constexpr int I_IN = (DM / 64) * (pg8::NBT * 8), I_PA = (256 / 64) * (DM / 32), I_PB = (512 / 64) * (DM / 32), I_OUT = (DM / 64) * (DM / 32);
        const int nitems = 2 * (I_IN + I_PA + I_PB + I_OUT);
        for (int it = gw; it < nitems; it += NGW) {
            const int l2 = it / (I_IN + I_PA + I_PB + I_OUT); int r = it - l2 * (I_IN + I_PA + I_PB + I_OUT);
            if (r < I_IN) { const int kb_ = r / (pg8::NBT * 8 + (pg8::NBT == 0)), nb_ = r % (pg8::NBT * 8 + (pg8::NBT == 0)), tj_ = nb_ >> 3, tl_ = pg8::tile_of(tj_ + pg8::N8T);
                transpose_item(a.w_in + (size_t)l2 * DM * INC, DM, INC, (bf16*)(ws + (l2 == 0 ? WS_WIN : WS_WIN1)), DM, scr, kb_ * (INC / 32) + nb_, lane, a.norm_g + l2 * DM, 256 * tl_ + 32 * (nb_ & 7)); continue; } r -= I_IN;
            if (r < I_PA) { transpose_item(a.w_pa + (size_t)l2 * 256 * DM, 256, DM, Wcat + (size_t)l2 * DM * 768, 768, scr, r, lane); continue; } r -= I_PA;
            if (r < I_PB) { transpose_item(a.w_pb + (size_t)l2 * 512 * DM, 512, DM, Wcat + (size_t)l2 * DM * 768 + 256, 768, scr, r, lane); continue; } r -= I_PB;
            transpose_item(a.w_out + (size_t)l2 * DM * DM, DM, DM, Wout + (size_t)l2 * DM * DM, DM, scr, r, lane);
        }
        for (int i = gw * 64 + lane; i < 2 * 128 * 512; i += NGW * 64) kmean[i] = 0.f;
        for (int it = (int)blockIdx.x; it < 2 * (W8R / 32); it += G) { const int l2 = it / (W8R / 32);
            quant_strip_wg(a.w_in + (size_t)l2 * DM * INC, a.norm_g + l2 * DM, W8 + (size_t)l2 * W8R * 1024, wscale + l2 * W8R, scr, (LAS float*)(L + 12288), it % (W8R / 32), lane, wave); }
        for (int m = gw; m < M; m += NGW) raw_row(a.x + (size_t)m * DM, XB + (size_t)m * DM, rowss + (size_t)m * 16, XB8 + (size_t)m * DM, xscale + m, lane);
    }
    if (layer == 0) GRID_BAR();
    if (layer == 1) {
        PHASE_VARS();
        for (int m = gw; m < M; m += NGW) quant_row(XB + (size_t)m * DM, XB8 + (size_t)m * DM, xscale + m, lane);
    }
    if (layer == 1) GRID_BAR();
    {
        PHASE_VARS();
        if (threadIdx.x == 0) ((LAS int*)(L + LDS_RSTAB))[256] = -1;
        __syncthreads();
        {
            pg8::Gemm g8{(const pg8::bf16_t*)XB8, (const pg8::bf16_t*)(W8 + (size_t)layer * W8R * 1024), M, 256 * pg8::N8T, 512, 512}; pg8::StaticOrder S8; S8.init(M, 256 * pg8::N8T, G, (int)blockIdx.x);
            pg8::EpiProjQ8 E8{P, LDP, wscale + layer * W8R, xscale, rowss + (size_t)layer * M * 16, kmean + layer * 128 * 512};
            pg8::gemm_phase<pg8::EpiProjQ8, pg8::StaticOrder, true, true>(L, g8, S8, E8);
        }
        if (pg8::NBT > 0) {
            if (threadIdx.x == 0) ((LAS int*)(L + LDS_RSTAB))[256] = -1;
            __syncthreads();
            pg8::Gemm g{XB, Win, M, 256 * pg8::NBT, DM, DM}; pg8::StaticOrder S; S.init(M, 256 * pg8::NBT, G, (int)blockIdx.x);
            pg8::EpiProj E{P, LDP, kmean + layer * 128 * 512, rowss + (size_t)layer * M * 16};
            pg8::gemm_phase<pg8::EpiProj, pg8::StaticOrder, true, true>(L, g, S, E);
        }
    }
    GRID_BAR();
    {
        PHASE_VARS();
        const int vcu = (G % 8 == 0) ? ((int)blockIdx.x % 8) * (G / 8) + (int)blockIdx.x / 8 : (int)blockIdx.x;
#pragma unroll 1
        for (int pass = 0; pass < 2; ++pass) {
            if ((pass ^ (vcu >> 2)) & 1) {
                for (int it = (int)blockIdx.x; it < BATCH * 4 * 4; it += G) attna::wg_item((attna::bf16*)P, it >> 4, (it >> 2) & 3, it & 3, (char*)lds);
            } else {
                for (int p = vcu; p < BATCH * 8 * 4; p += G) {
                    const int bh = p >> 2, s = p & 3;
#pragma unroll 1
                    for (int u = 0; u < 2; ++u)
                        moba::moba_unit<8>(bh >> 3, bh & 7, u ? 7 - s : s, (const moba::bf16*)(P + C_BQKV), (const moba::bf16*)(P + C_BQKV + 512), (const moba::bf16*)(P + C_BQKV + 1024), (const moba::bf16*)(P + C_ZB), (moba::bf16*)(P + C_BQKV), kmean + layer * 128 * 512, (char*)lds);
                }
            }
        }
    }
    GRID_BAR();
    {
        PHASE_VARS();
        pg8::StaticOrder S; S.init(M, DM, G, (int)blockIdx.x);
        {
            struct GateOrder { pg8::StaticOrder S;
                __device__ __forceinline__ bool next(int i, pg8::Unit& u) const { if (!S.next(i >> 1, u)) return false; u.pn += 4 * (i & 1); return true; }
                __device__ __forceinline__ void a_ready(const pg8::Unit&) const {} __device__ __forceinline__ void done(const pg8::Unit&) const {} } GS{S};
            if (threadIdx.x == 0) ((LAS int*)(L + LDS_RSTAB))[256] = -1;
            __syncthreads();
            pg8::Gemm gg{(const pg8::bf16_t*)XB8, (const pg8::bf16_t*)(W8 + ((size_t)layer * W8R + 256 * pg8::N8T) * 1024), M, 2048, 512, 512};
            pg8::EpiGate EG{a.b_merge + layer * 2 * DM, wscale + layer * W8R + 256 * pg8::N8T, xscale, rowss + (size_t)layer * M * 16, gatesb};
            pg8::gemm_phase<pg8::EpiGate, GateOrder, true, true>(L, gg, GS, EG);
        }
        pg8::Gemm g{P + C_ZA, Wcat + (size_t)layer * DM * 768, M, DM, 768, LDP}; pg8::EpiMerge E{P + C_MERGED, gatesb, LDP};
        pg8::gemm_phase<pg8::EpiMerge, pg8::StaticOrder, true, true>(L, g, S, E);
    }
    GRID_BAR();
    {
        PHASE_VARS();
        pg8::Gemm g{P + C_MERGED, Wout + (size_t)layer * DM * DM, M, DM, DM, LDP}; pg8::StaticOrder S; S.init(M, DM, G, (int)blockIdx.x);
        pg8::EpiResid<layer> E{a.x, XB, rowss + (layer == 0 ? (size_t)M * 16 : 0), DM};
        pg8::gemm_phase<pg8::EpiResid<layer>, pg8::StaticOrder, true, true>(L, g, S, E);
    }
    GRID_BAR();
}

__global__ void __launch_bounds__(NWAVES * 64, 2) hybrid_fwd(Args a) {
    extern __shared__ __attribute__((aligned(16))) unsigned char lds[];
    LAS unsigned char* L = (LAS unsigned char*)lds;
    if (threadIdx.x < 16) ((LAS unsigned*)(L + LDS_MISC))[threadIdx.x] = 0u;
    __syncthreads();
    (void)xcd_barrier_post((unsigned*)a.ws, (volatile LAS unsigned*)(L + LDS_MISC));
    layer_fwd<0>(a, lds, L);
    layer_fwd<1>(a, lds, L);
    {
        constexpr int layer = 1; (void)layer;
        PHASE_VARS();
        typedef unsigned u32x2_t __attribute__((ext_vector_type(2)));
        f32x4 gg[4];
#pragma unroll
        for (int j = 0; j < 4; ++j) gg[j] = *((const f32x4*)a.final_g + lane + 64 * j);
        for (int m = gw; m < M; m += NGW) {
            const f32x4* pp = (const f32x4*)(rowss + (size_t)m * 16); const f32x4 s4 = (pp[0] + pp[1]) + (pp[2] + pp[3]);
            const float rstd = __builtin_amdgcn_rsqf(((s4[0] + s4[1]) + (s4[2] + s4[3])) * (1.0f / 1024.0f) + RMS_EPS);
            const u32x2_t* xb = (const u32x2_t*)(XB + (size_t)m * DM) + lane; f32x4* o = (f32x4*)(a.out + (size_t)m * DM) + lane;
            u32x2_t bv[4];
#pragma unroll
            for (int j = 0; j < 4; ++j) bv[j] = __builtin_nontemporal_load(xb + 64 * j);
#pragma unroll
            for (int j = 0; j < 4; ++j) __builtin_nontemporal_store((f32x4){blo(bv[j].x), bhi(bv[j].x), blo(bv[j].y), bhi(bv[j].y)} * rstd * gg[j], o + 64 * j);
        }
    }
}

extern "C" void kernel_launch(void* const* d_in, const int* in_sizes, int n_in, void* d_out, int out_size, void* d_ws, size_t ws_size, hipStream_t stream) {
    static int grid = 0;
    if (grid == 0) {
        if (n_in != 8 || in_sizes[0] != M * DM || out_size != M * DM || ws_size < WS_END) { fprintf(stderr, "kernel_launch: unexpected shapes / workspace (n_in %d, ws %zu)\n", n_in, ws_size); grid = -1; return; }
        int dev = 0, cus = 0, per_cu = 0;
        hipGetDevice(&dev); hipDeviceGetAttribute(&cus, hipDeviceAttributeMultiprocessorCount, dev);
        if (hipFuncSetAttribute((const void*)hybrid_fwd, hipFuncAttributeMaxDynamicSharedMemorySize, LDS_BYTES) != hipSuccess) { fprintf(stderr, "kernel_launch: hipFuncSetAttribute failed\n"); grid = -1; return; }
        if (hipOccupancyMaxActiveBlocksPerMultiprocessor(&per_cu, (const void*)hybrid_fwd, NWAVES * 64, LDS_BYTES) != hipSuccess || per_cu < 1) { fprintf(stderr, "kernel_launch: the occupancy query admits %d workgroups per CU; nothing launched\n", per_cu); grid = -1; return; }
        (void)hipGetLastError();
        grid = cus;
    }
    if (grid < 0) return;
    if (hipMemsetAsync((char*)d_ws + WS_BAR, 0, WS_BAR_BYTES, stream) != hipSuccess) { fprintf(stderr, "kernel_launch: hipMemsetAsync failed\n"); return; }
    Args a{};
    a.x = (const float*)d_in[0]; a.norm_g = (const float*)d_in[1]; a.w_in = (const float*)d_in[2]; a.b_merge = (const float*)d_in[3];
    a.w_pa = (const float*)d_in[4]; a.w_pb = (const float*)d_in[5]; a.w_out = (const float*)d_in[6]; a.final_g = (const float*)d_in[7];
    a.out = (float*)d_out; a.ws = (unsigned char*)d_ws;
    hipLaunchKernelGGL(hybrid_fwd, dim3(grid), dim3(NWAVES * 64), LDS_BYTES, stream, a);
    const hipError_t e = hipPeekAtLastError();
    if (e != hipSuccess) fprintf(stderr, "kernel_launch: launch failed: %s (grid %d)\n", hipGetErrorString(e), grid);
}
```

```cpp
#include <hip/hip_runtime.h>
#include <cstdio>
#include <cstdint>
namespace pg8 {
#define PG8_LAS __attribute__((address_space(3)))
typedef unsigned short bf16_t;
typedef short bf16x8 __attribute__((ext_vector_type(8)));
typedef float f32x4 __attribute__((ext_vector_type(4)));
typedef unsigned u32x4 __attribute__((ext_vector_type(4)));
constexpr int BM = 256, BK = 64, HALF = 128, HTB = HALF * BK * 2  , STAGE_BYTES = 8 * HTB, NXCD = 8, WGM = 8;
constexpr int EPI_OFF = STAGE_BYTES, EPI_PITCH = 144, EPI_WAVE = 16 * EPI_PITCH;

__host__ __device__ __forceinline__ int lds_byte(int r, int c) { const int st = (r >> 4) * 2 + (c >> 5), rr = r & 15, cc = c & 31, ob = rr * 64 + cc * 2; return st * 1024 + (ob ^ (((ob >> 9) & 1) << 5)); }
__host__ __device__ __forceinline__ void stage_rc(int b, int& R, int& C) { const int st = b / 1024, sb = b % 1024, swz = sb ^ (((sb >> 9) & 1) << 5); R = (st >> 1) * 16 + swz / 64; C = (st & 1) * 32 + (swz % 64) / 2; }
__host__ __device__ __forceinline__ int perm32(int rho) { const int n = rho >> 4, i = rho & 15; return 8 * (i >> 2) + 4 * n + (i & 3); }

struct Unit { int pm, pn; };
struct Gemm { const bf16_t* A; const bf16_t* Bt; int M, N, K, lda; };

struct StaticOrder {
    int nM, nN, nwg, G, c;
    __host__ __device__ void init(int M, int N, int G_, int c_) { nM = M / BM; nN = N / BM; nwg = nM * nN; G = G_; c = c_; }
    __host__ __device__ bool next(int i, Unit& u) const {
        const long L = (long)i * G + c; if (L >= nwg) return false;
        int wgid = (int)L; { const int q = nwg / NXCD, r = nwg % NXCD, xcd = wgid % NXCD, off = wgid / NXCD; wgid = (xcd < r ? xcd * (q + 1) : r * (q + 1) + (xcd - r) * q) + off; }
        const int nig = WGM * nN, gid = wgid / nig, fm = gid * WGM, gsz = (nM - fm) < WGM ? (nM - fm) : WGM;
        u.pm = fm + ((wgid % nig) % gsz); u.pn = (wgid % nig) / gsz; return true;
    }
    __device__ __forceinline__ void a_ready(const Unit&) const {}
    __device__ __forceinline__ void done(const Unit&) const {}
};


typedef int i32x4 __attribute__((ext_vector_type(4)));
__device__ __forceinline__ f32x4 mma16(bf16x8 a, bf16x8 b, f32x4 c) { return __builtin_amdgcn_mfma_f32_16x16x32_bf16(a, b, c, 0, 0, 0); }
__device__ __forceinline__ i32x4 mma16(bf16x8 a, bf16x8 b, i32x4 c) { return __builtin_amdgcn_mfma_i32_16x16x64_i8(__builtin_bit_cast(i32x4, a), __builtin_bit_cast(i32x4, b), c, 0, 0, 0); }
template <class Epi, class Sched, bool ALIGN_EPI = false, bool SP2 = false>
__device__ __forceinline__ void gemm_phase(PG8_LAS unsigned char* lds, const Gemm g, const Sched& S, const Epi& E) {
    int tid_ = threadIdx.x; asm volatile("" : "+v"(tid_));
    const int tid = tid_, wid = __builtin_amdgcn_readfirstlane(tid >> 6), lane = tid & 63, wr = wid >> 2, wc = wid & 3, fr = lane & 15, fq = lane >> 4;
    const int K = g.K, nt = K / BK;
    unsigned voffA[2], voffB[2];
#pragma unroll
    for (int i = 0; i < 2; ++i) { int R, C; stage_rc(tid * 16 + i * 8192, R, C); const int Rb = 64 * (R >> 5) + (Epi::PERM ? perm32(R & 31) : (R & 31));
        voffA[i] = (unsigned)(R * g.lda + C) * 2u; voffB[i] = (unsigned)(Rb * K + C) * 2u; }
    const size_t kstep = (size_t)(BK * 2);
    const size_t hstepB = (size_t)32 * K * 2, hstepA = (size_t)HALF * g.lda * 2;
    const size_t tstepB = (size_t)BM * K * 2, tstepA = 2 * hstepA;
    const unsigned ldsw = (unsigned)wid * 1024u;
    const int aoff = lds_byte(wr * 64 + fr, fq * 8), boff = lds_byte(wc * 32 + fr, fq * 8);
#define PG8_SA(b, h) (((b) * 2 + (h)) * HTB)
#define PG8_SB(b, h) ((4 + (b) * 2 + (h)) * HTB)
#define PG8_STAGE(bufoff, gbase, voff) do { _Pragma("unroll") for (int _i = 0; _i < 2; ++_i) \
        __builtin_amdgcn_global_load_lds((const unsigned*)((const char*)(gbase) + (voff)[_i]), (PG8_LAS unsigned*)(lds + (bufoff) + ldsw + _i * 8192), 16, 0, 0); } while (0)
#define PG8_LDA(dst, b, h) do { _Pragma("unroll") for (int m = 0; m < 4; ++m) _Pragma("unroll") for (int k = 0; k < 2; ++k) dst[m][k] = *(const PG8_LAS bf16x8*)(lds + PG8_SA(b, h) + aoff + m * 2048 + k * 1024); } while (0)
#define PG8_LDB(dst, b, h) do { _Pragma("unroll") for (int n = 0; n < 2; ++n) _Pragma("unroll") for (int k = 0; k < 2; ++k) dst[n][k] = *(const PG8_LAS bf16x8*)(lds + PG8_SB(b, h) + boff + n * 2048 + k * 1024); } while (0)
#define PG8_MMA(ai, bj, At, Bt) do { __builtin_amdgcn_s_setprio(1); _Pragma("unroll") for (int m = 0; m < 4; ++m) _Pragma("unroll") for (int n = 0; n < 2; ++n) _Pragma("unroll") for (int k = 0; k < 2; ++k) \
        acc[ai][bj][m][n] = mma16(Bt[n][k], At[m][k], acc[ai][bj][m][n]); __builtin_amdgcn_s_setprio(0); } while (0)
#define PG8_WAIT_V(n) asm volatile("s_waitcnt vmcnt(" #n ")" ::: "memory")
#define PG8_WAIT_L(n) asm volatile("s_waitcnt lgkmcnt(" #n ")" ::: "memory")
#define PG8_BAR __builtin_amdgcn_s_barrier()
#define PG8_SCHED __builtin_amdgcn_sched_barrier(0)
    Unit cur, nxt; int ui = 0;
    if (!S.next(0, cur)) return;
    typename Epi::acc_t acc[2][2][4][2];
#pragma unroll
    for (int a = 0; a < 2; ++a)
#pragma unroll
        for (int b = 0; b < 2; ++b)
#pragma unroll
            for (int m = 0; m < 4; ++m)
#pragma unroll
                for (int n = 0; n < 2; ++n) acc[a][b][m][n] = (typename Epi::acc_t){0, 0, 0, 0};
    bf16x8 At[4][2], B0[2][2], B1[2][2];
    const char* cA = (const char*)g.A + (size_t)cur.pm * tstepA; const char* cB = (const char*)g.Bt + (size_t)cur.pn * tstepB;
    S.a_ready(cur);
    if constexpr (SP2) {
        PG8_STAGE(PG8_SB(0, 0), cB, voffB); PG8_STAGE(PG8_SB(0, 1), cB + hstepB, voffB); PG8_STAGE(PG8_SA(0, 0), cA, voffA); PG8_STAGE(PG8_SA(0, 1), cA + hstepA, voffA);
        if (wr == 1) PG8_BAR;
        PG8_WAIT_V(2); PG8_BAR;
        PG8_STAGE(PG8_SB(1, 0), cB + kstep, voffB); PG8_STAGE(PG8_SA(1, 0), cA + kstep, voffA); PG8_STAGE(PG8_SB(1, 1), cB + hstepB + kstep, voffB);
        PG8_WAIT_V(6); PG8_BAR;
    } else {
        PG8_STAGE(PG8_SB(0, 0), cB, voffB); PG8_STAGE(PG8_SA(0, 0), cA, voffA); PG8_STAGE(PG8_SB(0, 1), cB + hstepB, voffB); PG8_STAGE(PG8_SA(0, 1), cA + hstepA, voffA);
        if (wr == 1) PG8_BAR;
        PG8_WAIT_V(4); PG8_BAR;
        PG8_STAGE(PG8_SB(1, 0), cB + kstep, voffB); PG8_STAGE(PG8_SA(1, 0), cA + kstep, voffA); PG8_STAGE(PG8_SB(1, 1), cB + hstepB + kstep, voffB);
        PG8_WAIT_V(6); PG8_BAR;
    }
    for (;;) {
        const bool has_next = S.next(ui + 1, nxt);
        const char* nA = has_next ? (const char*)g.A + (size_t)nxt.pm * tstepA : cA; const char* nB = has_next ? (const char*)g.Bt + (size_t)nxt.pn * tstepB : cB;
        for (int t = 0; t < nt; t += 2) {
            const bool last = (t == nt - 2);
            const char* a1 = cA + (size_t)(t + 1) * kstep;
            const char* a2 = last ? nA : cA + (size_t)(t + 2) * kstep; const char* b2 = last ? nB : cB + (size_t)(t + 2) * kstep;
            const char* a3 = a2 + kstep; const char* b3 = b2 + kstep;
            if (last && has_next) S.a_ready(nxt);
            if constexpr (SP2) {
            PG8_LDB(B0, 0, 0); PG8_LDB(B1, 0, 1); PG8_SCHED; PG8_LDA(At, 0, 0); PG8_STAGE(PG8_SA(1, 1), a1 + hstepA, voffA);
            PG8_WAIT_V(8); PG8_WAIT_L(0); PG8_BAR; PG8_MMA(0, 0, At, B0); PG8_MMA(0, 1, At, B1); PG8_BAR; PG8_SCHED;
            PG8_LDA(At, 0, 1); PG8_STAGE(PG8_SB(0, 0), b2, voffB); PG8_STAGE(PG8_SB(0, 1), b2 + hstepB, voffB); PG8_STAGE(PG8_SA(0, 0), a2, voffA);
            PG8_WAIT_V(8); PG8_WAIT_L(0); PG8_BAR; PG8_MMA(1, 0, At, B0); PG8_MMA(1, 1, At, B1); PG8_BAR; PG8_SCHED;
            PG8_LDB(B0, 1, 0); PG8_LDB(B1, 1, 1); PG8_SCHED; PG8_LDA(At, 1, 0); PG8_STAGE(PG8_SA(0, 1), a2 + hstepA, voffA);
            PG8_WAIT_V(8); PG8_WAIT_L(0); PG8_BAR; PG8_MMA(0, 0, At, B0); PG8_MMA(0, 1, At, B1); PG8_BAR; PG8_SCHED;
            PG8_LDA(At, 1, 1); PG8_STAGE(PG8_SB(1, 0), b3, voffB); PG8_STAGE(PG8_SB(1, 1), b3 + hstepB, voffB); PG8_STAGE(PG8_SA(1, 0), a3, voffA);
            PG8_WAIT_V(8); PG8_WAIT_L(0); PG8_BAR; PG8_MMA(1, 0, At, B0); PG8_MMA(1, 1, At, B1); PG8_BAR; PG8_SCHED;
            if constexpr (Epi::HAS_MID) { if (t == Epi::MID_T) { E.mid(acc, cur, wr, wc, fr, fq, wid); PG8_SCHED; } }
            } else {
            PG8_LDB(B0, 0, 0); PG8_SCHED; PG8_LDA(At, 0, 0); PG8_STAGE(PG8_SA(1, 1), a1 + hstepA, voffA);
            PG8_WAIT_L(8); PG8_BAR; PG8_WAIT_L(0); PG8_MMA(0, 0, At, B0); PG8_BAR; PG8_SCHED;
            PG8_LDB(B1, 0, 1); PG8_STAGE(PG8_SB(0, 0), b2, voffB);
            PG8_BAR; PG8_WAIT_L(0); PG8_MMA(0, 1, At, B1); PG8_BAR;
            PG8_LDA(At, 0, 1); PG8_STAGE(PG8_SA(0, 0), a2, voffA);
            PG8_BAR; PG8_WAIT_L(0); PG8_MMA(1, 0, At, B0); PG8_BAR; PG8_SCHED;
            PG8_STAGE(PG8_SB(0, 1), b2 + hstepB, voffB);
            PG8_WAIT_V(6); PG8_BAR; PG8_MMA(1, 1, At, B1); PG8_BAR;
            PG8_LDB(B0, 1, 0); PG8_SCHED; PG8_LDA(At, 1, 0); PG8_STAGE(PG8_SA(0, 1), a2 + hstepA, voffA);
            PG8_WAIT_L(8); PG8_BAR; PG8_WAIT_L(0); PG8_MMA(0, 0, At, B0); PG8_BAR; PG8_SCHED;
            PG8_LDB(B1, 1, 1); PG8_STAGE(PG8_SB(1, 0), b3, voffB);
            PG8_BAR; PG8_WAIT_L(0); PG8_MMA(0, 1, At, B1); PG8_BAR;
            PG8_LDA(At, 1, 1); PG8_STAGE(PG8_SA(1, 0), a3, voffA);
            PG8_BAR; PG8_WAIT_L(0); PG8_MMA(1, 0, At, B0); PG8_BAR; PG8_SCHED;
            PG8_STAGE(PG8_SB(1, 1), b3 + hstepB, voffB);
            PG8_WAIT_V(6); PG8_BAR; PG8_MMA(1, 1, At, B1); PG8_BAR;
            }
        }
        if constexpr (ALIGN_EPI) { if (wr == 0) PG8_BAR; }
        if constexpr (!Epi::AFTER_DRAIN) { E(acc, cur, wr, wc, fr, fq, lds + EPI_OFF + wid * EPI_WAVE, lane, wid); S.done(cur); }
        if (!has_next) break;
#pragma unroll
        for (int a = 0; a < 2; ++a)
#pragma unroll
            for (int b = 0; b < 2; ++b)
#pragma unroll
                for (int m = 0; m < 4; ++m)
#pragma unroll
                    for (int n = 0; n < 2; ++n) acc[a][b][m][n] = (typename Epi::acc_t){0, 0, 0, 0};
        cur = nxt; cA = nA; cB = nB; ++ui;
        if constexpr (ALIGN_EPI) { if (wr == 1) PG8_BAR; }
    }
    PG8_WAIT_V(0);
    if constexpr (!ALIGN_EPI) { if (wr == 0) PG8_BAR; }
    PG8_BAR;
    if constexpr (Epi::AFTER_DRAIN) { E.fused(acc, cur, wr, wc, fr, fq, lds, wid, lane); S.done(cur); }
#undef PG8_SA
#undef PG8_SB
#undef PG8_STAGE
#undef PG8_LDA
#undef PG8_LDB
#undef PG8_MMA
#undef PG8_WAIT_V
#undef PG8_WAIT_L
#undef PG8_BAR
#undef PG8_SCHED
}
}


namespace pg8 {
__device__ __forceinline__ unsigned cvt_pk_bf16(float lo, float hi) { unsigned r; asm volatile("v_cvt_pk_bf16_f32 %0, %1, %2" : "=v"(r) : "v"(lo), "v"(hi)); return r; }
__device__ __forceinline__ float bflo(unsigned u) { return __uint_as_float(u << 16); }
__device__ __forceinline__ float bfhi(unsigned u) { return __uint_as_float(u & 0xffff0000u); }
__device__ __forceinline__ float sigmoidf_(float v) { return __builtin_amdgcn_rcpf(1.0f + __expf(-v)); }
typedef unsigned u32x2 __attribute__((ext_vector_type(2)));
__device__ __forceinline__ void piece_xpose(PG8_LAS unsigned char* stg, u32x4 in0, u32x4 in1, u32x4& out0, u32x4& out1, int fr, int fq, int lane) {
    *(PG8_LAS u32x4*)(stg + fr * EPI_PITCH + fq * 16) = in0; *(PG8_LAS u32x4*)(stg + fr * EPI_PITCH + 64 + fq * 16) = in1;
    out0 = *(const PG8_LAS u32x4*)(stg + (lane >> 3) * EPI_PITCH + (lane & 7) * 16); out1 = *(const PG8_LAS u32x4*)(stg + ((lane >> 3) + 8) * EPI_PITCH + (lane & 7) * 16);
}

constexpr int N8T = 18, NBT = 18 - N8T;
constexpr unsigned long long TORD_LO = 0x4bdc8288e620c20ull, TORD_HI = 0x1ac5aa30ull;
__device__ __forceinline__ int tile_of(int i) { return i < 12 ? (int)((TORD_LO >> (5 * i)) & 31) : (int)((TORD_HI >> (5 * (i - 12))) & 31); }
struct EpiProj {
    typedef f32x4 acc_t; static constexpr bool PERM = true, AFTER_DRAIN = false, HAS_MID = false; static constexpr int MID_T = 0;
    bf16_t* O; int ldc; float* kmean; const float* rowss;
    __device__ __forceinline__ void operator()(const f32x4 (&acc)[2][2][4][2], const Unit& u, int wr, int wc, int fr, int fq, PG8_LAS unsigned char* stg, int lane, int wid) const {
        asm volatile("" : "+v"(fr), "+v"(fq), "+v"(lane));
        const int tl = tile_of(u.pn + N8T);
        const int kind = (tl == 9 || tl == 16 || tl == 17) ? 1 : 0;
        PG8_LAS float* const tab = (PG8_LAS float*)(stg - wid * EPI_WAVE + 8 * EPI_WAVE + 256);
        if (__builtin_amdgcn_readfirstlane(((const PG8_LAS int*)tab)[256]) != u.pm) {
            asm volatile("s_waitcnt lgkmcnt(0)" ::: "memory"); __builtin_amdgcn_s_barrier(); asm volatile("" ::: "memory");
            const int t_ = wid * 64 + lane;
            if (t_ < 256) { const f32x4* pp = (const f32x4*)(rowss + (size_t)(u.pm * BM + t_) * 16); const f32x4 s4 = (pp[0] + pp[1]) + (pp[2] + pp[3]);
                tab[t_] = __builtin_amdgcn_rsqf(((s4[0] + s4[1]) + (s4[2] + s4[3])) * (1.0f / 1024.0f) + 1e-6f); }
            if (t_ == 0) ((PG8_LAS int*)tab)[256] = u.pm;
            asm volatile("s_waitcnt vmcnt(0) lgkmcnt(0)" ::: "memory"); __builtin_amdgcn_s_barrier(); asm volatile("" ::: "memory");
        }
        float rs[2][4];
#pragma unroll
        for (int ai = 0; ai < 2; ++ai)
#pragma unroll
            for (int m = 0; m < 4; ++m) rs[ai][m] = tab[ai * HALF + wr * 64 + m * 16 + fr];
        const float qs = (tl == 10 || tl == 11) ? 0.18033688011112042f : 1.0f;
        const size_t rbase = (size_t)(u.pm * BM + wr * 64 + (lane >> 3)); bf16_t* const op = O + tl * BM + wc * 64 + 8 * (lane & 7);
#pragma unroll
        for (int ai = 0; ai < 2; ++ai)
#pragma unroll
            for (int m = 0; m < 4; ++m) { u32x4 w[2];
#pragma unroll
                for (int bj = 0; bj < 2; ++bj) { f32x4 v0 = acc[ai][bj][m][0] * rs[ai][m], v1 = acc[ai][bj][m][1] * rs[ai][m];
                    if (kind == 1) {
#pragma unroll
                        for (int e = 0; e < 4; ++e) { v0[e] = v0[e] * sigmoidf_(v0[e]); v1[e] = v1[e] * sigmoidf_(v1[e]); } }
                    v0 = v0 * qs; v1 = v1 * qs;
                    w[bj].x = cvt_pk_bf16(v0[0], v0[1]); w[bj].y = cvt_pk_bf16(v0[2], v0[3]); w[bj].z = cvt_pk_bf16(v1[0], v1[1]); w[bj].w = cvt_pk_bf16(v1[2], v1[3]); }
                u32x4 o0, o1; piece_xpose(stg, w[0], w[1], o0, o1, fr, fq, lane);
                bf16_t* rp = op + (rbase + ai * HALF + m * 16) * ldc;
                __builtin_nontemporal_store(o0, (u32x4*)rp); __builtin_nontemporal_store(o1, (u32x4*)(rp + (size_t)8 * ldc));
                asm volatile("" ::: "memory"); }
        if (tl == 12 || tl == 13) {
#pragma unroll
            for (int bj = 0; bj < 2; ++bj)
#pragma unroll
                for (int n = 0; n < 2; ++n) { f32x4 cs = (f32x4){0.f, 0.f, 0.f, 0.f};
#pragma unroll
                    for (int ai = 0; ai < 2; ++ai)
#pragma unroll
                        for (int m = 0; m < 4; ++m) { float r2 = rs[ai][m]; asm volatile("" : "+v"(r2)); cs += acc[ai][bj][m][n] * r2; }
#pragma unroll
                    for (int e = 0; e < 4; ++e) { float v = cs[e]; v += __shfl_xor(v, 1); v += __shfl_xor(v, 2); v += __shfl_xor(v, 4); v += __shfl_xor(v, 8); cs[e] = v; }
                    if (fr == 0) { float* kp = kmean + (size_t)u.pm * 512 + (tl - 12) * 256 + wc * 64 + bj * 32 + 8 * fq + 4 * n;
#pragma unroll
                        for (int e = 0; e < 4; ++e) atomicAdd(kp + e, cs[e] * (1.0f / 256.0f)); } }
        }
    }
};
struct EpiProjQ8 {
    typedef i32x4 acc_t; static constexpr bool PERM = true, AFTER_DRAIN = false, HAS_MID = false; static constexpr int MID_T = 0;
    bf16_t* O; int ldc; const float* wscale; const float* xscale; const float* rowss; float* kmean;
    __device__ __forceinline__ void operator()(const i32x4 (&acc)[2][2][4][2], const Unit& u, int wr, int wc, int fr, int fq, PG8_LAS unsigned char* stg, int lane, int wid) const {
        asm volatile("" : "+v"(fr), "+v"(fq), "+v"(lane));
        const int tl = tile_of(u.pn);
        const int kind = (tl == 9 || tl == 16 || tl == 17) ? 1 : 0;
        const float qs = (tl == 0 || tl == 3 || tl == 6 || tl == 10 || tl == 11) ? 0.18033688011112042f : 1.0f;
        PG8_LAS float* const tab = (PG8_LAS float*)(stg - wid * EPI_WAVE + 8 * EPI_WAVE + 256);
        if (__builtin_amdgcn_readfirstlane(((const PG8_LAS int*)tab)[256]) != u.pm) {
            asm volatile("s_waitcnt lgkmcnt(0)" ::: "memory"); __builtin_amdgcn_s_barrier(); asm volatile("" ::: "memory");
            const int t_ = wid * 64 + lane;
            if (t_ < 256) { const f32x4* pp = (const f32x4*)(rowss + (size_t)(u.pm * BM + t_) * 16); const f32x4 s4 = (pp[0] + pp[1]) + (pp[2] + pp[3]);
                tab[t_] = xscale[u.pm * BM + t_] * __builtin_amdgcn_rsqf(((s4[0] + s4[1]) + (s4[2] + s4[3])) * (1.0f / 1024.0f) + 1e-6f); }
            if (t_ == 0) ((PG8_LAS int*)tab)[256] = u.pm;
            asm volatile("s_waitcnt vmcnt(0) lgkmcnt(0)" ::: "memory"); __builtin_amdgcn_s_barrier(); asm volatile("" ::: "memory");
        }
        f32x4 wv[2][2];
#pragma unroll
        for (int bj = 0; bj < 2; ++bj)
#pragma unroll
            for (int n = 0; n < 2; ++n) wv[bj][n] = *(const f32x4*)(wscale + u.pn * BM + wc * 64 + 8 * fq + bj * 32 + 4 * n) * qs;
        const size_t rbase = (size_t)(u.pm * BM + wr * 64 + (lane >> 3)); bf16_t* const op = O + tl * BM + wc * 64 + 8 * (lane & 7);
#pragma unroll
        for (int ai = 0; ai < 2; ++ai)
#pragma unroll
            for (int m = 0; m < 4; ++m) { const float rf = tab[ai * HALF + wr * 64 + m * 16 + fr]; u32x4 w[2];
#pragma unroll
                for (int bj = 0; bj < 2; ++bj) { f32x4 v0, v1;
#pragma unroll
                    for (int e = 0; e < 4; ++e) { v0[e] = (float)acc[ai][bj][m][0][e] * (rf * wv[bj][0][e]); v1[e] = (float)acc[ai][bj][m][1][e] * (rf * wv[bj][1][e]); }
                    if (kind == 1) {
#pragma unroll
                        for (int e = 0; e < 4; ++e) { v0[e] = v0[e] * sigmoidf_(v0[e]); v1[e] = v1[e] * sigmoidf_(v1[e]); } }
                    w[bj].x = cvt_pk_bf16(v0[0], v0[1]); w[bj].y = cvt_pk_bf16(v0[2], v0[3]); w[bj].z = cvt_pk_bf16(v1[0], v1[1]); w[bj].w = cvt_pk_bf16(v1[2], v1[3]); }
                u32x4 o0, o1; piece_xpose(stg, w[0], w[1], o0, o1, fr, fq, lane);
                bf16_t* rp = op + (rbase + ai * HALF + m * 16) * ldc;
                __builtin_nontemporal_store(o0, (u32x4*)rp); __builtin_nontemporal_store(o1, (u32x4*)(rp + (size_t)8 * ldc));
                asm volatile("" ::: "memory"); }
        if (tl == 12 || tl == 13) {
#pragma unroll
            for (int bj = 0; bj < 2; ++bj)
#pragma unroll
                for (int n = 0; n < 2; ++n) { f32x4 cs = (f32x4){0.f, 0.f, 0.f, 0.f};
#pragma unroll
                    for (int ai = 0; ai < 2; ++ai)
#pragma unroll
                        for (int m = 0; m < 4; ++m) { float r2 = tab[ai * HALF + wr * 64 + m * 16 + fr]; asm volatile("" : "+v"(r2));
#pragma unroll
                            for (int e = 0; e < 4; ++e) cs[e] += (float)acc[ai][bj][m][n][e] * r2; }
#pragma unroll
                    for (int e = 0; e < 4; ++e) { float v = cs[e] * wv[bj][n][e]; v += __shfl_xor(v, 1); v += __shfl_xor(v, 2); v += __shfl_xor(v, 4); v += __shfl_xor(v, 8); cs[e] = v; }
                    if (fr == 0) { float* kp = kmean + (size_t)u.pm * 512 + (tl - 12) * 256 + wc * 64 + bj * 32 + 8 * fq + 4 * n;
#pragma unroll
                        for (int e = 0; e < 4; ++e) atomicAdd(kp + e, cs[e] * (1.0f / 256.0f)); } }
        }
    }
};
struct EpiGate {
    typedef i32x4 acc_t; static constexpr bool PERM = true, AFTER_DRAIN = false, HAS_MID = false; static constexpr int MID_T = 0;
    const float* bmerge; const float* wscale; const float* xscale; const float* rowss; unsigned char* gates;
    __device__ __forceinline__ void operator()(const i32x4 (&acc)[2][2][4][2], const Unit& u, int wr, int wc, int fr, int fq, PG8_LAS unsigned char* stg, int lane, int wid) const {
        asm volatile("" : "+v"(fr), "+v"(fq), "+v"(lane));
        const int col0 = u.pn * BM + wc * 64 + 8 * fq;
        PG8_LAS float* const tab = (PG8_LAS float*)(stg - wid * EPI_WAVE + 8 * EPI_WAVE + 256);
        if (__builtin_amdgcn_readfirstlane(((const PG8_LAS int*)tab)[256]) != u.pm) {
            asm volatile("s_waitcnt lgkmcnt(0)" ::: "memory"); __builtin_amdgcn_s_barrier(); asm volatile("" ::: "memory");
            const int t_ = wid * 64 + lane;
            if (t_ < 256) { const f32x4* pp = (const f32x4*)(rowss + (size_t)(u.pm * BM + t_) * 16); const f32x4 s4 = (pp[0] + pp[1]) + (pp[2] + pp[3]);
                tab[t_] = xscale[u.pm * BM + t_] * __builtin_amdgcn_rsqf(((s4[0] + s4[1]) + (s4[2] + s4[3])) * (1.0f / 1024.0f) + 1e-6f) * (-1.4426950408889634f); }
            if (t_ == 0) ((PG8_LAS int*)tab)[256] = u.pm;
            asm volatile("s_waitcnt vmcnt(0) lgkmcnt(0)" ::: "memory"); __builtin_amdgcn_s_barrier(); asm volatile("" ::: "memory");
        }
        f32x4 bv[2][2], wv[2][2];
#pragma unroll
        for (int bj = 0; bj < 2; ++bj)
#pragma unroll
            for (int n = 0; n < 2; ++n) { bv[bj][n] = *(const f32x4*)(bmerge + col0 + bj * 32 + 4 * n) * (-1.4426950408889634f); wv[bj][n] = *(const f32x4*)(wscale + col0 + bj * 32 + 4 * n); }
        unsigned char* gp = gates + ((size_t)((u.pm * 8 + u.pn) * 8 + wid) * 8) * 1024 + fr * 64 + fq * 16;
#pragma unroll
        for (int ai = 0; ai < 2; ++ai)
#pragma unroll
            for (int m = 0; m < 4; ++m) { const float rf = tab[ai * HALF + wr * 64 + m * 16 + fr]; u32x4 q;
#pragma unroll
                for (int bj = 0; bj < 2; ++bj)
#pragma unroll
                    for (int n = 0; n < 2; ++n) { unsigned w = 0u;
#pragma unroll
                        for (int e = 0; e < 4; ++e) { const float x2 = (float)acc[ai][bj][m][n][e] * (rf * wv[bj][n][e]) + bv[bj][n][e];
                            w = __builtin_amdgcn_cvt_pk_u8_f32(__builtin_fmaxf(255.0f * __builtin_amdgcn_rcpf(1.0f + __builtin_amdgcn_exp2f(x2)), 1.0f), e, w); }
                        q[2 * bj + n] = w; }
                __builtin_nontemporal_store(q, (u32x4*)(gp + (ai * 4 + m) * 1024)); }
    }
};
struct EpiMerge {
    typedef f32x4 acc_t; static constexpr bool PERM = true, AFTER_DRAIN = false, HAS_MID = true; static constexpr int MID_T = 2;
    bf16_t* O; const unsigned char* gates; int ldc;
    __device__ __forceinline__ static float ub(unsigned w, int i) { return (float)((w >> (8 * i)) & 0xffu); }
    __device__ __forceinline__ void mid(f32x4 (&acc)[2][2][4][2], const Unit& u, int wr, int wc, int fr, int fq, int wid) const {
        asm volatile("" : "+v"(fr), "+v"(fq));
        const unsigned char* ga = gates + ((size_t)((u.pm * 8 + u.pn) * 8 + wid) * 8) * 1024 + fr * 64 + fq * 16; const unsigned char* gb = ga + (size_t)4 * 8 * 8 * 1024;
        u32x4 av[2][4], bv[2][4];
#pragma unroll
        for (int ai = 0; ai < 2; ++ai)
#pragma unroll
            for (int m = 0; m < 4; ++m) { av[ai][m] = __builtin_nontemporal_load((const u32x4*)(ga + (ai * 4 + m) * 1024)); bv[ai][m] = *(const u32x4*)(gb + (ai * 4 + m) * 1024); }
#pragma unroll
        for (int ai = 0; ai < 2; ++ai)
#pragma unroll
            for (int m = 0; m < 4; ++m)
#pragma unroll
                for (int bj = 0; bj < 2; ++bj)
#pragma unroll
                    for (int n = 0; n < 2; ++n)
#pragma unroll
                        for (int e = 0; e < 4; ++e) acc[ai][bj][m][n][e] *= ub(av[ai][m][2 * bj + n], e) * __builtin_amdgcn_rcpf(ub(bv[ai][m][2 * bj + n], e));
    }
    __device__ __forceinline__ void operator()(const f32x4 (&acc)[2][2][4][2], const Unit& u, int wr, int wc, int fr, int fq, PG8_LAS unsigned char* stg, int lane, int wid) const {
        asm volatile("" : "+v"(fr), "+v"(fq), "+v"(lane));
        const unsigned char* gb = gates + ((size_t)((u.pm * 8 + 4 + u.pn) * 8 + wid) * 8) * 1024 + fr * 64 + fq * 16;
        const size_t rbase = (size_t)(u.pm * BM + wr * 64 + (lane >> 3)); bf16_t* const op = O + u.pn * BM + wc * 64 + 8 * (lane & 7);
        u32x4 gvv[2][4];
#pragma unroll
        for (int ai = 0; ai < 2; ++ai)
#pragma unroll
            for (int m = 0; m < 4; ++m) gvv[ai][m] = __builtin_nontemporal_load((const u32x4*)(gb + (ai * 4 + m) * 1024));
#pragma unroll
        for (int ai = 0; ai < 2; ++ai)
#pragma unroll
            for (int m = 0; m < 4; ++m) { const u32x4 gv = gvv[ai][m]; u32x4 w[2];
#pragma unroll
                for (int bj = 0; bj < 2; ++bj) { f32x4 v0 = acc[ai][bj][m][0], v1 = acc[ai][bj][m][1];
#pragma unroll
                    for (int e = 0; e < 4; ++e) { v0[e] *= ub(gv[2 * bj], e) * (1.0f / 255.0f); v1[e] *= ub(gv[2 * bj + 1], e) * (1.0f / 255.0f); }
                    w[bj].x = cvt_pk_bf16(v0[0], v0[1]); w[bj].y = cvt_pk_bf16(v0[2], v0[3]); w[bj].z = cvt_pk_bf16(v1[0], v1[1]); w[bj].w = cvt_pk_bf16(v1[2], v1[3]); }
                u32x4 o0, o1; piece_xpose(stg, w[0], w[1], o0, o1, fr, fq, lane);
                bf16_t* rp = op + (rbase + ai * HALF + m * 16) * ldc;
                __builtin_nontemporal_store(o0, (u32x4*)rp); __builtin_nontemporal_store(o1, (u32x4*)(rp + (size_t)8 * ldc));
                if (m & 1) asm volatile("" ::: "memory"); }
    }
};
template <int MODE> struct EpiResid {
    typedef f32x4 acc_t; static constexpr bool PERM = false, AFTER_DRAIN = false, HAS_MID = false; static constexpr int MID_T = 0;
    const float* R; bf16_t* XB; float* rowss; int ldc;
    __device__ __forceinline__ void operator()(const f32x4 (&acc)[2][2][4][2], const Unit& u, int wr, int wc, int fr, int fq, PG8_LAS unsigned char* stg, int lane, int wid) const {
        asm volatile("" : "+v"(fr), "+v"(fq), "+v"(lane));
        const size_t rbase = (size_t)(u.pm * BM + wr * 64 + (lane >> 3)); const int cb = u.pn * BM + wc * 64 + 4 * (lane & 7);
#pragma unroll
        for (int ai = 0; ai < 2; ++ai) {
            f32x4 rr[4][2][2];
#pragma unroll
            for (int m = 0; m < 4; ++m)
#pragma unroll
                for (int bj = 0; bj < 2; ++bj) { const size_t ro = (rbase + ai * HALF + m * 16) * ldc + cb + bj * 32;
                    if (MODE == 0) { rr[m][bj][0] = __builtin_nontemporal_load((const f32x4*)(R + ro)); rr[m][bj][1] = __builtin_nontemporal_load((const f32x4*)(R + ro + (size_t)8 * ldc)); }
                    else { const u32x2 b0 = __builtin_nontemporal_load((const u32x2*)(XB + ro)), b1 = __builtin_nontemporal_load((const u32x2*)(XB + ro + (size_t)8 * ldc));
                        rr[m][bj][0] = __builtin_bit_cast(f32x4, (u32x4){b0.x, b0.y, b1.x, b1.y}); } }
#pragma unroll
            for (int m = 0; m < 4; ++m) { float ss0 = 0.f, ss1 = 0.f;
#pragma unroll
                for (int bj = 0; bj < 2; ++bj) { const size_t ro = (rbase + ai * HALF + m * 16) * ldc + cb + bj * 32;
                    f32x4 r0, r1;
                    if (MODE == 0) { r0 = rr[m][bj][0]; r1 = rr[m][bj][1]; }
                    else { const u32x4 pk = __builtin_bit_cast(u32x4, rr[m][bj][0]);
                        r0 = (f32x4){bflo(pk.x), bfhi(pk.x), bflo(pk.y), bfhi(pk.y)}; r1 = (f32x4){bflo(pk.z), bfhi(pk.z), bflo(pk.w), bfhi(pk.w)}; }
                    u32x4 o0, o1; piece_xpose(stg, __builtin_bit_cast(u32x4, acc[ai][bj][m][0]), __builtin_bit_cast(u32x4, acc[ai][bj][m][1]), o0, o1, fr, fq, lane);
                    const f32x4 x0 = r0 + __builtin_bit_cast(f32x4, o0), x1 = r1 + __builtin_bit_cast(f32x4, o1);
                    *(u32x2*)(XB + ro) = (u32x2){cvt_pk_bf16(x0[0], x0[1]), cvt_pk_bf16(x0[2], x0[3])}; *(u32x2*)(XB + ro + (size_t)8 * ldc) = (u32x2){cvt_pk_bf16(x1[0], x1[1]), cvt_pk_bf16(x1[2], x1[3])};
                    ss0 += (x0[0] * x0[0] + x0[1] * x0[1]) + (x0[2] * x0[2] + x0[3] * x0[3]); ss1 += (x1[0] * x1[0] + x1[1] * x1[1]) + (x1[2] * x1[2] + x1[3] * x1[3]); }
                ss0 += __shfl_xor(ss0, 1); ss0 += __shfl_xor(ss0, 2); ss0 += __shfl_xor(ss0, 4); ss1 += __shfl_xor(ss1, 1); ss1 += __shfl_xor(ss1, 2); ss1 += __shfl_xor(ss1, 4);
                if ((lane & 7) == 0) { rowss[(rbase + ai * HALF + m * 16) * 16 + u.pn * 4 + wc] = ss0; rowss[(rbase + ai * HALF + m * 16 + 8) * 16 + u.pn * 4 + wc] = ss1; } }
            asm volatile("" ::: "memory");
        }
    }
};
}
#include <hip/hip_bf16.h>
#include <cmath>
namespace moba {
using bf16=__hip_bfloat16;
using bf16x8=__attribute__((ext_vector_type(8)))short;
using s16x4=__attribute__((ext_vector_type(4)))short;
using f32x16=__attribute__((ext_vector_type(16)))float;
using u32x4=__attribute__((ext_vector_type(4)))unsigned;
constexpr int SEQ=2048,D=64,PITCH=4608;
constexpr int NW=8,QBLK=32,QB=QBLK*NW,KVBLK=64;
__device__ __forceinline__ int crow(int r,int hi){return (r&3)+8*(r>>2)+4*hi;}
#define SBAR() __builtin_amdgcn_sched_barrier(0)
__device__ __forceinline__ void cmask(f32x16&p0,f32x16&p1,int jb,int qrel,int hi){
  const float NEG=-INFINITY; int kb=64*jb+4*hi;
  #pragma unroll
  for(int r=0;r<16;++r){int kv=kb+(r&3)+8*(r>>2); if(kv>qrel)p0[r]=NEG; if(kv+32>qrel)p1[r]=NEG;}
}

constexpr int NSLOT=3, SLOTB=8192;
constexpr int NVSLOT=4;
constexpr int LDS_K=0, LDS_V=NSLOT*SLOTB, LDS_WS=LDS_V+NVSLOT*SLOTB, LDS_OST=LDS_WS+NW*64*4, LDS_KM=LDS_OST+NW*4096, LDS_BYTES=LDS_KM+8*64*4;
__device__ __forceinline__ void glds16(const void*gsrc,unsigned lds_dst){unsigned keep;
  asm volatile("s_mov_b32 %0, m0\n\ts_mov_b32 m0, %2\n\ts_nop 0\n\tglobal_load_lds_dwordx4 %1, off\n\ts_mov_b32 m0, %0":"=&s"(keep):"v"(gsrc),"s"(lds_dst):"memory");}
__device__ __forceinline__ float max3f(float a,float b,float c){float r;asm("v_max3_f32 %0, %1, %2, %3":"=v"(r):"v"(a),"v"(b),"v"(c));return r;}
__device__ __forceinline__ float max2f(float a,float b){float r;asm("v_max_f32_e32 %0, %1, %2":"=v"(r):"v"(a),"v"(b));return r;}
typedef float f32x2_t __attribute__((ext_vector_type(2))); typedef __bf16 bf16x2_t __attribute__((ext_vector_type(2)));
__device__ __forceinline__ unsigned cvtpk_s(float lo,float hi){f32x2_t v={lo,hi};bf16x2_t b=__builtin_convertvector(v,bf16x2_t);return __builtin_bit_cast(unsigned,b);}
__device__ __forceinline__ float bl(unsigned u){return __uint_as_float(u<<16);}
__device__ __forceinline__ float bh(unsigned u){return __uint_as_float(u&0xffff0000u);}
#define WAIT_BAR(N) asm volatile("s_waitcnt vmcnt(" #N ") lgkmcnt(0)\n\ts_barrier":::"memory")

__device__ __forceinline__ void qkt(f32x16&p0,f32x16&p1,const char*Kslot,const bf16x8*qr,const f32x16&negm,int r32,int hi){
  const char*kb=Kslot+hi*1024+r32*16;
  #pragma unroll
  for(int d0=0;d0<4;++d0){
    const bf16x8 b0=*reinterpret_cast<const bf16x8*>(kb+d0*2048);
    const bf16x8 b1=*reinterpret_cast<const bf16x8*>(kb+d0*2048+512);
    if(d0==0){p0=__builtin_amdgcn_mfma_f32_32x32x16_bf16(b0,qr[0],negm,0,0,0);p1=__builtin_amdgcn_mfma_f32_32x32x16_bf16(b1,qr[0],negm,0,0,0);}
    else{p0=__builtin_amdgcn_mfma_f32_32x32x16_bf16(b0,qr[d0],p0,0,0,0);p1=__builtin_amdgcn_mfma_f32_32x32x16_bf16(b1,qr[d0],p1,0,0,0);}}
}
typedef __attribute__((address_space(3))) const char* lds_cptr;
typedef short v4i16_t __attribute__((ext_vector_type(4)));
__device__ __forceinline__ void kload8(bf16x8*kf,lds_cptr kp){
  kf[0]=*(const __attribute__((address_space(3))) bf16x8*)(kp);      kf[1]=*(const __attribute__((address_space(3))) bf16x8*)(kp+512);
  kf[2]=*(const __attribute__((address_space(3))) bf16x8*)(kp+2048); kf[3]=*(const __attribute__((address_space(3))) bf16x8*)(kp+2560);
  kf[4]=*(const __attribute__((address_space(3))) bf16x8*)(kp+4096); kf[5]=*(const __attribute__((address_space(3))) bf16x8*)(kp+4608);
  kf[6]=*(const __attribute__((address_space(3))) bf16x8*)(kp+6144); kf[7]=*(const __attribute__((address_space(3))) bf16x8*)(kp+6656);
}
__device__ __forceinline__ void kload2(bf16x8*kf,lds_cptr kp,int j){ kf[2*j]=*(const __attribute__((address_space(3))) bf16x8*)(kp+j*2048); kf[2*j+1]=*(const __attribute__((address_space(3))) bf16x8*)(kp+j*2048+512); }
__device__ __forceinline__ s16x4 vtr(lds_cptr p){ return __builtin_bit_cast(s16x4,__builtin_amdgcn_ds_read_tr16_b64_v4i16((__attribute__((address_space(3))) v4i16_t*)p)); }
__device__ __forceinline__ float rowmax(const f32x16&p0,const f32x16&p1){
  float a=max3f(p0[0],p0[1],p1[0]),b=max3f(p0[2],p0[3],p1[1]);a=max3f(a,p1[2],p1[3]);
  #pragma unroll
  for(int r=4;r<16;r+=4){a=max3f(a,p0[r],p0[r+1]);b=max3f(b,p0[r+2],p0[r+3]);a=max3f(a,p1[r],p1[r+1]);b=max3f(b,p1[r+2],p1[r+3]);}
  const float m=max2f(a,b);
  auto rr=__builtin_amdgcn_permlane32_swap(__float_as_uint(m),__float_as_uint(m),false,false);
  return max2f(__uint_as_float(rr[0]),__uint_as_float(rr[1]));
}
__device__ __forceinline__ float xhalf_sum(float v){ auto rr=__builtin_amdgcn_permlane32_swap(__float_as_uint(v),__float_as_uint(v),false,false); return __uint_as_float(rr[0])+__uint_as_float(rr[1]); }
__device__ __forceinline__ void pv(f32x16*o,int vb,bf16x8 pa0,bf16x8 pa1,bf16x8 pa2,bf16x8 pa3){
  #pragma unroll
  for(int d0=0;d0<2;++d0){s16x4 lo[4],hi[4];
    #pragma unroll
    for(int ks=0;ks<4;++ks){
      asm volatile("ds_read_b64_tr_b16 %0,%1 offset:%c2":"=&v"(lo[ks]):"v"(vb),"i"(d0*4096+ks*1024):"memory");
      asm volatile("ds_read_b64_tr_b16 %0,%1 offset:%c2":"=&v"(hi[ks]):"v"(vb),"i"(d0*4096+ks*1024+512):"memory");}
    asm volatile("s_waitcnt lgkmcnt(0)":::"memory");SBAR();
    #define PK(k) (bf16x8){lo[k][0],lo[k][1],lo[k][2],lo[k][3],hi[k][0],hi[k][1],hi[k][2],hi[k][3]}
    o[d0]=__builtin_amdgcn_mfma_f32_32x32x16_bf16(pa0,PK(0),o[d0],0,0,0);
    o[d0]=__builtin_amdgcn_mfma_f32_32x32x16_bf16(pa1,PK(1),o[d0],0,0,0);
    o[d0]=__builtin_amdgcn_mfma_f32_32x32x16_bf16(pa2,PK(2),o[d0],0,0,0);
    o[d0]=__builtin_amdgcn_mfma_f32_32x32x16_bf16(pa3,PK(3),o[d0],0,0,0);
    #undef PK
  }
}

template<int THRL> __device__ __forceinline__ void moba_unit(int b,int h,int c,const bf16*Pq,const bf16*__restrict__ Pk,const bf16*__restrict__ Pv,const bf16*Pz,bf16*Po,const float*__restrict__ kmean,char*shm){
  int tid_=threadIdx.x; asm volatile("":"+v"(tid_));
  const int tid=tid_,lane=tid&63,r32=lane&31,hi=lane>>5; const int wid=__builtin_amdgcn_readfirstlane(tid>>6);
  const long rowbase=(long)b*SEQ; const int q0=c*QB;
  const bf16*Qw=Pq+(rowbase+q0+wid*QBLK)*PITCH+h*D;
  const bf16*Kh=Pk+rowbase*PITCH+h*D,*Vh=Pv+rowbase*PITCH+h*D;
  const unsigned lds0=(unsigned)(uintptr_t)shm;
  float*wsf=(float*)(shm+LDS_WS)+wid*64;
  float*kml=(float*)(shm+LDS_KM);
  const int NT=(q0+QB)/KVBLK;
  const bf16*ksrc=Kh+(long)lane*PITCH+wid*8;
  const bf16*vsrc=Vh+(long)(16*(wid&3)+(lane>>2))*PITCH+(wid>>2)*32+(lane&3)*8;
  const unsigned kdst=lds0+LDS_K+wid*1024, vdst=lds0+LDS_V+wid*1024;
  #define DMA_K(t,slot) glds16(ksrc+(long)(NT-1-(t))*KVBLK*PITCH,(unsigned)__builtin_amdgcn_readfirstlane(kdst+(slot)))
  #define DMA_V(t,slot) glds16(vsrc+(long)(NT-1-(t))*KVBLK*PITCH,(unsigned)__builtin_amdgcn_readfirstlane(vdst+(slot)))
  const int vb0=(int)(lds0+LDS_V)+((lane>>4)&1)*32+(lane&3)*8+(4*hi+((lane&15)>>2))*64;
  const char*Kbase=shm+LDS_K; bf16x8 kf[8];
  const lds_cptr shm3=(lds_cptr)shm; const lds_cptr kp0=shm3+LDS_K+hi*1024+r32*16; const lds_cptr vp0=shm3+LDS_V+((lane>>4)&1)*32+(lane&3)*8+(4*hi+((lane&15)>>2))*64;
  #define VS(t) ((((t))&3)*SLOTB)
  DMA_K(0,0);DMA_V(0,VS(0));DMA_K(1,SLOTB);
  bf16x8 qr[4];
  #pragma unroll
  for(int d0=0;d0<4;++d0)qr[d0]=*reinterpret_cast<const bf16x8*>(&Qw[(long)r32*PITCH+d0*16+hi*8]);
  const int qrel=wid*QBLK+r32;
  u32x4 kdg[4];
  { const bf16*Kd=Kh+(long)(q0+qrel)*PITCH;
    #pragma unroll
    for(int d0=0;d0<4;++d0)kdg[d0]=*reinterpret_cast<const u32x4*>(&Kd[d0*16+hi*8]); }
  const float sl2=__uint_as_float(__builtin_amdgcn_readfirstlane(__float_as_uint(__builtin_amdgcn_exp2f(-(float)(h+1))*1.4426950408889634f)));
  unsigned sel=0u;
  if(c>0){
    if(tid<c*64) kml[tid]=kmean[((long)(b*8)+(tid>>6))*512+h*64+(tid&63)];
    asm volatile("s_waitcnt vmcnt(0) lgkmcnt(0)\n\ts_barrier":::"memory");
    if(c<=3) sel=(1u<<c)-1u;
    else{
      float g[8];
      #pragma unroll
      for(int j=0;j<8;++j){ g[j]=-INFINITY;
        if(j<c){ float a=0.f;
          #pragma unroll
          for(int d0=0;d0<4;++d0){ const u32x4 qv=__builtin_bit_cast(u32x4,qr[d0]); const float*km=kml+j*64+d0*16+hi*8;
            const float4 k0=*(const float4*)km, k1=*(const float4*)(km+4);
            a+=bl(qv.x)*k0.x+bh(qv.x)*k0.y+bl(qv.y)*k0.z+bh(qv.y)*k0.w+bl(qv.z)*k1.x+bh(qv.z)*k1.y+bl(qv.w)*k1.z+bh(qv.w)*k1.w; }
          g[j]=xhalf_sum(a); } }
      #pragma unroll
      for(int j=0;j<8;++j){ int rank=0;
        #pragma unroll
        for(int j2=0;j2<8;++j2){ if(j2!=j) rank+=((g[j2]>g[j])||(g[j2]==g[j]&&j2<j))?1:0; }
        if(j<c&&rank<3) sel|=(1u<<j); }
    }
  }
  float mhat;
  { float a=0.f;
    #pragma unroll
    for(int d0=0;d0<4;++d0){ const u32x4 kv=kdg[d0]; const u32x4 qv=__builtin_bit_cast(u32x4,qr[d0]);
      a+=bl(qv.x)*bl(kv.x)+bh(qv.x)*bh(kv.x)+bl(qv.y)*bl(kv.y)+bh(qv.y)*bh(kv.y)+bl(qv.z)*bl(kv.z)+bh(qv.z)*bh(kv.z)+bl(qv.w)*bl(kv.w)+bh(qv.w)*bh(kv.w); }
    mhat=xhalf_sum(a)+sl2*(float)qrel; }
  float l_reg=0.f;f32x16 o[2];o[0]=f32x16{};o[1]=f32x16{};
  f32x16 negm;
  #pragma unroll
  for(int r=0;r<16;++r)negm[r]=sl2*(float)((r&3)+8*(r>>2))-mhat;
  asm volatile("":"+v"(negm));
  #define MBIAS(P0,P1,t) do{ const int T_=NT-1-(t); const int jb_=T_-(NT-4); float a0_=sl2*(float)(64*jb_+4*hi); \
      if(jb_<0){ if(!((sel>>(T_>>2))&1u)) a0_=-INFINITY; } const float a1_=a0_+32.f*sl2; \
      _Pragma("unroll") for(int r=0;r<16;++r){P0[r]+=a0_;P1[r]+=a1_;} \
      if(jb_>=0)cmask(P0,P1,jb_,qrel,hi); }while(0)
  bool resc=false;
  #define RESC() do{ if(resc){ asm volatile("s_waitcnt lgkmcnt(0)":::"memory"); \
      _Pragma("unroll") for(int d_=0;d_<2;++d_) _Pragma("unroll") for(int r=0;r<16;++r)o[d_][r]*=wsf[crow(r,hi)]; } }while(0)
  f32x16 pA0,pA1,pB0,pB1;
  int sl_prev=0,sl_cur=0,sl_next=SLOTB;
  #define ROT() do{sl_prev=sl_cur;sl_cur=sl_next;sl_next=(sl_next==(NSLOT-1)*SLOTB)?0:sl_next+SLOTB;}while(0)
  DMA_K(2,2*SLOTB);DMA_V(1,VS(1));
  WAIT_BAR(2);
  qkt(pA0,pA1,Kbase,qr,negm,r32,hi);asm volatile("s_nop 15\n\ts_nop 7":"+v"(pA0),"+v"(pA1));MBIAS(pA0,pA1,0);
  { const float rm=rowmax(pA0,pA1);
    if(__any(rm>(float)THRL)){ const float dl=__builtin_fmaxf(rm,0.f);
      _Pragma("unroll") for(int r=0;r<16;++r){pA0[r]-=dl;pA1[r]-=dl;negm[r]-=dl;}
      asm volatile("":"+v"(negm)); } }
  _Pragma("unroll") for(int r=0;r<16;++r){pA0[r]=__builtin_amdgcn_exp2f(pA0[r]);pA1[r]=__builtin_amdgcn_exp2f(pA1[r]);}
  WAIT_BAR(2);
  DMA_K(3,0);DMA_V(2,VS(2));
  ROT();
  kload8(kf,kp0+sl_cur);
  WAIT_BAR(3);
  s16x4 vlo[8],vhi[8]; u32x4 pw0,pw1,pw2,pw3;
  #define PKW(P,B) cvtpk_s(P[B],P[B+1])
  #define PAF(k) __builtin_bit_cast(bf16x8,pw##k)
  #define VFR(i) (bf16x8){vlo[i][0],vlo[i][1],vlo[i][2],vlo[i][3],vhi[i][0],vhi[i][1],vhi[i][2],vhi[i][3]}
  #define PIN(x) asm volatile("":"+v"(x))
  #define MX3(a,b,c) __builtin_fmaxf(__builtin_fmaxf((a),(b)),(c))
  #define GAPA(MF,A0,A1,A2,A3,W0,W1,PW) do{ MF; sacc+=A0; sacc+=A1; sacc+=A2; sacc+=A3; PIN(sacc); W0; W1; PIN(PW); SBAR(); }while(0)
  #define EX(v) __builtin_amdgcn_exp2f(v)
  #define GAPB(MF,X,B) do{ MF; X[B]=EX(X[B]); X[B+1]=EX(X[B+1]); X[B+2]=EX(X[B+2]); X[B+3]=EX(X[B+3]); PIN(X); SBAR(); }while(0)
  #define VRD(i) do{ vlo[i]=vtr(vp_+(((i)>>2)*4096+((i)&3)*1024)); vhi[i]=vtr(vp_+(((i)>>2)*4096+((i)&3)*1024+512)); }while(0)
  #define KRD(G,j) do{ if(G){ kload2(kf,kp0+sl_next,j); SBAR(); } }while(0)
  #define STEP(C0,C1,P0,P1,t,GK,GV,GL) do{ SBAR(); \
    const lds_cptr vp_=vp0+VS((t)-1); \
    VRD(0); SBAR(); float sacc=(P0[0]+P0[1]); \
    GAPA(C0=__builtin_amdgcn_mfma_f32_32x32x16_bf16(kf[0],qr[0],negm,0,0,0), P0[2],P0[3],P0[4],P0[5],     pw0[0]=PKW(P0,0), pw0[1]=PKW(P0,2), pw0); \
    VRD(4); SBAR(); GAPA(C1=__builtin_amdgcn_mfma_f32_32x32x16_bf16(kf[1],qr[0],negm,0,0,0), P0[6],P0[7],P0[8],P0[9],     pw0[2]=PKW(P0,4), pw0[3]=PKW(P0,6), pw0); \
    VRD(1); SBAR(); GAPA(C0=__builtin_amdgcn_mfma_f32_32x32x16_bf16(kf[2],qr[1],C0,0,0,0),   P0[10],P0[11],P0[12],P0[13], pw1[0]=PKW(P0,8), pw1[1]=PKW(P0,10), pw1); \
    VRD(5); SBAR(); GAPA(C1=__builtin_amdgcn_mfma_f32_32x32x16_bf16(kf[3],qr[1],C1,0,0,0),   P0[14],P0[15],P1[0],P1[1],   pw1[2]=PKW(P0,12),pw1[3]=PKW(P0,14), pw1); \
    VRD(2); SBAR(); GAPA(C0=__builtin_amdgcn_mfma_f32_32x32x16_bf16(kf[4],qr[2],C0,0,0,0),   P1[2],P1[3],P1[4],P1[5],     pw2[0]=PKW(P1,0), pw2[1]=PKW(P1,2), pw2); \
    VRD(6); SBAR(); GAPA(C1=__builtin_amdgcn_mfma_f32_32x32x16_bf16(kf[5],qr[2],C1,0,0,0),   P1[6],P1[7],P1[8],P1[9],     pw2[2]=PKW(P1,4), pw2[3]=PKW(P1,6), pw2); \
    VRD(3); SBAR(); GAPA(C0=__builtin_amdgcn_mfma_f32_32x32x16_bf16(kf[6],qr[3],C0,0,0,0),   P1[10],P1[11],P1[12],P1[13], pw3[0]=PKW(P1,8), pw3[1]=PKW(P1,10), pw3); \
    VRD(7); SBAR(); GAPA(C1=__builtin_amdgcn_mfma_f32_32x32x16_bf16(kf[7],qr[3],C1,0,0,0),   P1[14],P1[15],0.f,0.f,       pw3[2]=PKW(P1,12),pw3[3]=PKW(P1,14), pw3); \
    l_reg+=sacc; \
    if(GK){DMA_K((t)+3,sl_cur);} if(GV){DMA_V((t)+2,VS((t)+2));} \
    MBIAS(C0,C1,t); \
    { float a=MX3(C0[0],C0[1],C1[0]),b=MX3(C0[2],C0[3],C1[1]); a=MX3(a,C1[2],C1[3]); \
      _Pragma("unroll") for(int r=4;r<16;r+=4){a=MX3(a,C0[r],C0[r+1]);b=MX3(b,C0[r+2],C0[r+3]);a=MX3(a,C1[r],C1[r+1]);b=MX3(b,C1[r+2],C1[r+3]);} \
      float rm=__builtin_fmaxf(a,b); { auto rr=__builtin_amdgcn_permlane32_swap(__float_as_uint(rm),__float_as_uint(rm),false,false); rm=__builtin_fmaxf(__uint_as_float(rr[0]),__uint_as_float(rr[1])); } \
      resc=false; \
      if(__builtin_expect(__any(rm>(float)THRL),0)){ const float dl=__builtin_fmaxf(rm,0.f); \
        _Pragma("unroll") for(int r=0;r<16;++r){C0[r]-=dl;C1[r]-=dl;} \
        _Pragma("unroll") for(int r=0;r<16;++r)negm[r]-=dl; asm volatile("":"+v"(negm)); \
        const float f=__builtin_amdgcn_exp2f(-dl); l_reg*=f; if(hi==0)wsf[r32]=f; resc=true; } } \
    SBAR(); \
    GAPB(o[0]=__builtin_amdgcn_mfma_f32_32x32x16_bf16(PAF(0),VFR(0),o[0],0,0,0), C0,0); \
    GAPB(o[1]=__builtin_amdgcn_mfma_f32_32x32x16_bf16(PAF(0),VFR(4),o[1],0,0,0), C0,4); \
    KRD(GL,0); GAPB(o[0]=__builtin_amdgcn_mfma_f32_32x32x16_bf16(PAF(1),VFR(1),o[0],0,0,0), C0,8); \
    KRD(GL,1); GAPB(o[1]=__builtin_amdgcn_mfma_f32_32x32x16_bf16(PAF(1),VFR(5),o[1],0,0,0), C0,12); \
    KRD(GL,2); GAPB(o[0]=__builtin_amdgcn_mfma_f32_32x32x16_bf16(PAF(2),VFR(2),o[0],0,0,0), C1,0); \
    KRD(GL,3); GAPB(o[1]=__builtin_amdgcn_mfma_f32_32x32x16_bf16(PAF(2),VFR(6),o[1],0,0,0), C1,4); \
    GAPB(o[0]=__builtin_amdgcn_mfma_f32_32x32x16_bf16(PAF(3),VFR(3),o[0],0,0,0), C1,8); \
    GAPB(o[1]=__builtin_amdgcn_mfma_f32_32x32x16_bf16(PAF(3),VFR(7),o[1],0,0,0), C1,12); \
    }while(0)
  int t=1;
  for(;t+5<NT;t+=2){
    STEP(pB0,pB1,pA0,pA1,t,true,true,true);     WAIT_BAR(3); RESC(); ROT();
    STEP(pA0,pA1,pB0,pB1,t+1,true,true,true);   WAIT_BAR(3); RESC(); ROT();
  }
  #define ENDW(tt) do{ if((tt)+3<NT){WAIT_BAR(3);} else if((tt)+2<NT){WAIT_BAR(2);} else {WAIT_BAR(0);} }while(0)
  for(;t+1<NT;t+=2){
    STEP(pB0,pB1,pA0,pA1,t,(t+3<NT),(t+2<NT),(t+1<NT));       ENDW(t);   RESC(); ROT();
    STEP(pA0,pA1,pB0,pB1,t+1,(t+4<NT),(t+3<NT),(t+2<NT));     ENDW(t+1); RESC(); ROT();
  }
  STEP(pB0,pB1,pA0,pA1,NT-1,false,false,false); RESC();
  { float sacc=pB0[0]+pB0[1]; _Pragma("unroll") for(int r=2;r<16;++r)sacc+=pB0[r]; _Pragma("unroll") for(int r=0;r<16;++r)sacc+=pB1[r]; l_reg+=sacc;
    pw0=(u32x4){PKW(pB0,0),PKW(pB0,2),PKW(pB0,4),PKW(pB0,6)};pw1=(u32x4){PKW(pB0,8),PKW(pB0,10),PKW(pB0,12),PKW(pB0,14)};pw2=(u32x4){PKW(pB1,0),PKW(pB1,2),PKW(pB1,4),PKW(pB1,6)};pw3=(u32x4){PKW(pB1,8),PKW(pB1,10),PKW(pB1,12),PKW(pB1,14)};
    SBAR(); pv(o,vb0+VS(NT-1),PAF(0),PAF(1),PAF(2),PAF(3)); }
  #undef PKW
  #undef PAF
  #undef VFR
  #undef PIN
  #undef MX3
  #undef GAPA
  #undef GAPB
  #undef EX
  #undef VRD
  #undef KRD
  #undef STEP
  #undef ENDW
  l_reg=xhalf_sum(l_reg);
  if(hi==0)wsf[32+r32]=l_reg;asm volatile("s_waitcnt lgkmcnt(0)":::"memory");
  float rli[16];
  #pragma unroll
  for(int r=0;r<16;++r)rli[r]=__builtin_amdgcn_rcpf(wsf[32+crow(r,hi)]);
  const bf16*Zw=Pz+(rowbase+q0+wid*QBLK)*PITCH+h*D; bf16*Ow=Po+(rowbase+q0+wid*QBLK)*PITCH+h*D;
  { bf16*stg=(bf16*)(shm+LDS_OST)+wid*2048;
    #pragma unroll
    for(int r=0;r<16;++r){const int orow=crow(r,hi);
      #pragma unroll
      for(int d0=0;d0<2;++d0)((unsigned short*)stg)[orow*64+d0*32+r32]=(unsigned short)cvtpk_s(o[d0][r]*rli[r],0.f);}
    asm volatile("s_waitcnt lgkmcnt(0)":::"memory");
    #pragma unroll
    for(int i=0;i<4;++i){const int row=i*8+(lane>>3),ch=lane&7; const u32x4 v=*(const u32x4*)(stg+row*64+ch*8);
      const u32x4 z=__builtin_nontemporal_load((const u32x4*)(Zw+(long)row*PITCH+ch*8)); u32x4*zp=(u32x4*)(Ow+(long)row*PITCH+ch*8); u32x4 w;
      w.x=cvtpk_s(bl(v.x)*bl(z.x),bh(v.x)*bh(z.x)); w.y=cvtpk_s(bl(v.y)*bl(z.y),bh(v.y)*bh(z.y)); w.z=cvtpk_s(bl(v.z)*bl(z.z),bh(v.z)*bh(z.z)); w.w=cvtpk_s(bl(v.w)*bl(z.w),bh(v.w)*bh(z.w));
      *zp=w; } }
  asm volatile("s_waitcnt lgkmcnt(0)\n\ts_barrier":::"memory");
  #undef DMA_K
  #undef DMA_V
  #undef VS
  #undef MBIAS
  #undef RESC
  #undef ROT
}
constexpr int ATTN_LDS_BYTES=LDS_BYTES;
#undef SBAR
#undef WAIT_BAR
}
namespace attna {
using moba::bf16; using moba::bf16x8; using moba::s16x4; using moba::f32x16; using moba::u32x4; using moba::lds_cptr;
using moba::crow; using moba::cvtpk_s; using moba::bl; using moba::bh; using moba::vtr; using moba::xhalf_sum;
constexpr int SEQ=2048,PITCH=4608;
constexpr int WK=0,WV=4608,WO=12800,WSC=16896,WBYTES=17152,LSE_OFF=8*WBYTES,LDS_BYTES=LSE_OFF+3*512*4;
#define AMFMA(a,b,c) __builtin_amdgcn_mfma_f32_32x32x16_bf16(a,b,c,0,0,0)

__device__ __forceinline__ void sub_item(bf16*P,int b,int hs,int g,int res,int l0,int chunk,char*wl,float*lse_l,int lane){
  asm volatile("":"+v"(lane));
  const int r32=lane&31,hi=lane>>5;
  const int dsh=2*g;
  const long rowb=(long)b*SEQ+res;
  const int qcol=g*768+hs*64;
  const float sl2=__builtin_amdgcn_exp2f(-(2.0f/3.0f)*(float)(4*g+hs+1))*(float)(1<<dsh)*1.4426950408889634f;
  #define AROW(l) ((rowb+((long)(l)<<dsh))*PITCH)
  #define KL(i,x) ((l0-128+32*(i)+(x))<0?0:(l0-128+32*(i)+(x)))
  const int i0=(l0>=128)?0:(4-(l0>>5));
  const int lrow=lane>>3, lch=lane&7;
  u32x4 qg[4],kg[5][4],vg[5][4];
  #pragma unroll
  for(int j=0;j<4;++j)qg[j]=*reinterpret_cast<const u32x4*>(P+AROW(l0+lrow+8*j)+qcol+lch*8);
  #pragma unroll
  for(int i=4;i>=0;--i)
    #pragma unroll
    for(int j=0;j<4;++j)kg[i][j]=*reinterpret_cast<const u32x4*>(P+AROW(KL(i,lrow+8*j))+qcol+256+lch*8);
  #pragma unroll
  for(int i=4;i>=0;--i)
    #pragma unroll
    for(int j=0;j<4;++j)vg[i][j]=*reinterpret_cast<const u32x4*>(P+AROW(KL(i,lrow+8*j))+qcol+512+lch*8);
  __builtin_amdgcn_sched_barrier(0);
  char*kb=wl+WK; const int kwoff=lrow*144+lch*16, kroff=r32*144+hi*16;
  bf16x8 qf[4];
  #pragma unroll
  for(int j=0;j<4;++j)*reinterpret_cast<u32x4*>(kb+kwoff+j*8*144)=qg[j];
  #pragma unroll
  for(int d0=0;d0<4;++d0)qf[d0]=*reinterpret_cast<const bf16x8*>(kb+kroff+d0*32);
  f32x16 S[5];
  #pragma unroll
  for(int i=4;i>=0;--i){
    #pragma unroll
    for(int j=0;j<4;++j)*reinterpret_cast<u32x4*>(kb+kwoff+j*8*144)=kg[i][j];
    bf16x8 kf[4];
    #pragma unroll
    for(int d0=0;d0<4;++d0)kf[d0]=*reinterpret_cast<const bf16x8*>(kb+kroff+d0*32);
    f32x16 acc=f32x16{};
    #pragma unroll
    for(int d0=0;d0<4;++d0)acc=AMFMA(kf[d0],qf[d0],acc);
    const float sbi=((i<i0)?-INFINITY:0.f)-sl2*(float)(32*(4-i)+r32-4*hi);
    #pragma unroll
    for(int r=0;r<16;++r){ const int kc=(r&3)+8*(r>>2); float v=__builtin_fmaf(sl2,(float)kc,acc[r]+sbi);
      if(i==4&&kc+4*hi>r32)v=-INFINITY; if(i==0&&kc+4*hi<r32)v=-INFINITY; acc[r]=v; }
    S[i]=acc;
  }
  float mx=-INFINITY;
  #pragma unroll
  for(int i=0;i<5;++i)
    #pragma unroll
    for(int r=0;r<16;++r)mx=fmaxf(mx,S[i][r]);
  { auto rr=__builtin_amdgcn_permlane32_swap(__float_as_uint(mx),__float_as_uint(mx),false,false); mx=fmaxf(__uint_as_float(rr[0]),__uint_as_float(rr[1])); }
  float ls=0.f;
  #pragma unroll
  for(int i=0;i<5;++i)
    #pragma unroll
    for(int r=0;r<16;++r){ const float p=__builtin_amdgcn_exp2f(S[i][r]-mx); S[i][r]=p; ls+=p; }
  ls=xhalf_sum(ls);
  f32x16 o[2]; o[0]=f32x16{}; o[1]=f32x16{};
  const lds_cptr wl3=(lds_cptr)wl;
  const int vtoff=((lane>>4)&1)*32+(lane&3)*8+(4*hi+((lane&15)>>2))*64;
  const int vwoff=(lch>>2)*2048+lrow*64+(lch&3)*16;
  #define PVSTEP(i) do{ char*vb_=wl+WV+((i)&1)*4096; \
      _Pragma("unroll") for(int j=0;j<4;++j)*reinterpret_cast<u32x4*>(vb_+vwoff+j*8*64)=vg[i][j]; \
      const u32x4 pw0=(u32x4){cvtpk_s(S[i][0],S[i][1]),cvtpk_s(S[i][2],S[i][3]),cvtpk_s(S[i][4],S[i][5]),cvtpk_s(S[i][6],S[i][7])}; \
      const u32x4 pw1=(u32x4){cvtpk_s(S[i][8],S[i][9]),cvtpk_s(S[i][10],S[i][11]),cvtpk_s(S[i][12],S[i][13]),cvtpk_s(S[i][14],S[i][15])}; \
      const lds_cptr vp=wl3+WV+((i)&1)*4096+vtoff; \
      _Pragma("unroll") for(int d0=0;d0<2;++d0){ \
        const s16x4 a0=vtr(vp+d0*2048),a1=vtr(vp+d0*2048+512),b0=vtr(vp+d0*2048+1024),b1=vtr(vp+d0*2048+1536); \
        const bf16x8 f0=(bf16x8){a0[0],a0[1],a0[2],a0[3],a1[0],a1[1],a1[2],a1[3]}, f1=(bf16x8){b0[0],b0[1],b0[2],b0[3],b1[0],b1[1],b1[2],b1[3]}; \
        o[d0]=AMFMA(__builtin_bit_cast(bf16x8,pw0),f0,o[d0]); \
        o[d0]=AMFMA(__builtin_bit_cast(bf16x8,pw1),f1,o[d0]); } }while(0)
  PVSTEP(4); PVSTEP(3); PVSTEP(2); PVSTEP(1); PVSTEP(0);
  float*ws=(float*)(wl+WSC);
  const int tokc=((l0+r32)<<dsh)+res-chunk*512;
  if(hi==0){ ws[r32]=__builtin_amdgcn_rcpf(ls); lse_l[g*512+tokc]=mx+__builtin_amdgcn_logf(ls); }
  bf16*stg=(bf16*)(wl+WO);
  #pragma unroll
  for(int r=0;r<16;++r){ const int orow=crow(r,hi); const float il=ws[orow];
    #pragma unroll
    for(int d0=0;d0<2;++d0)((unsigned short*)stg)[orow*64+d0*32+r32]=(unsigned short)cvtpk_s(o[d0][r]*il,0.f); }
  #pragma unroll
  for(int i=0;i<4;++i){ const int row=i*8+(lane>>3),ch=lane&7; const u32x4 v=*reinterpret_cast<const u32x4*>(stg+row*64+ch*8);
    *reinterpret_cast<u32x4*>(P+AROW(l0+row)+qcol+ch*8)=v; }
  #undef AROW
  #undef KL
  #undef PVSTEP
}

__device__ __forceinline__ void wg_item(bf16*P,int b,int hs,int chunk,char*shm){
  int tid_=threadIdx.x; asm volatile("":"+v"(tid_));
  const int tid=tid_,lane=tid&63; const int wid=__builtin_amdgcn_readfirstlane(tid>>6);
  char*wl=shm+wid*WBYTES; float*lse_l=(float*)(shm+LSE_OFF);
  #pragma unroll 1
  for(int i6=0;i6<6;++i6){
    const int si=wid+8*i6, g=si>>4, k=si&15;
    int res,l0;
    if(g==0){res=0;l0=32*(chunk*16+k);} else if(g==1){res=k>>2;l0=128*chunk+32*(k&3);} else {res=k;l0=32*chunk;}
    sub_item(P,b,hs,g,res,l0,chunk,wl,lse_l,lane);
  }
  __syncthreads();
  #pragma unroll
  for(int idx=tid;idx<512*8;idx+=512){
    const int tok=idx>>3,ch=idx&7; const long row=((long)b*SEQ+chunk*512+tok)*PITCH;
    const float e0=lse_l[tok],e1=lse_l[512+tok],e2=lse_l[1024+tok]; const float em=fmaxf(e0,fmaxf(e1,e2));
    float w0=__builtin_amdgcn_exp2f(e0-em),w1=__builtin_amdgcn_exp2f(e1-em),w2=__builtin_amdgcn_exp2f(e2-em); const float iw=__builtin_amdgcn_rcpf(w0+w1+w2); w0*=iw;w1*=iw;w2*=iw;
    const u32x4 a=*reinterpret_cast<const u32x4*>(P+row+hs*64+ch*8), bq=*reinterpret_cast<const u32x4*>(P+row+768+hs*64+ch*8), cq=*reinterpret_cast<const u32x4*>(P+row+1536+hs*64+ch*8);
    u32x4*zp=reinterpret_cast<u32x4*>(P+row+2304+hs*64+ch*8); const u32x4 z=__builtin_nontemporal_load(zp); u32x4 w;
    #define CMB(f) cvtpk_s((w0*bl(a.f)+w1*bl(bq.f)+w2*bl(cq.f))*bl(z.f),(w0*bh(a.f)+w1*bh(bq.f)+w2*bh(cq.f))*bh(z.f))
    w.x=CMB(x); w.y=CMB(y); w.z=CMB(z); w.w=CMB(w);
    #undef CMB
    *zp=w;
  }
  __syncthreads();
}
#undef AMFMA
}

constexpr int NWAVES = 8;
constexpr int BATCH = 16, SEQ = 2048, DM = 1024, M = BATCH * SEQ, DEPTH = 2;
constexpr int INC = 6656;
constexpr int LDP = 4608;
constexpr int C_AQKV = 0, C_ZA = 2304, C_BQKV = 2560, C_ZB = 4096, C_RA = 4608, C_RB = 5632;
constexpr int C_MERGED = 0;
constexpr float RMS_EPS = 1e-6f;
constexpr size_t MiB = 1u << 20;
constexpr size_t WS_CTL = 0;
constexpr size_t WS_BAR = 0, WS_BAR_BYTES = 64 * 1024;
constexpr size_t WS_KMEAN = 256 * 1024;
constexpr size_t WS_WIN = 1 * MiB;
constexpr size_t WS_WCAT = 14 * MiB;
constexpr size_t WS_WOUT = 17 * MiB;
constexpr size_t WS_XB = 21 * MiB;
constexpr size_t WS_PROJ = 85 * MiB;
constexpr size_t WS_GATES = 373 * MiB;
constexpr size_t WS_WIN1 = 437 * MiB;
constexpr size_t WS_ROWSS = 450 * MiB;
constexpr size_t WS_XB8 = 454 * MiB;
constexpr size_t WS_W8 = 486 * MiB;
constexpr size_t WS_COLMAX = 32 * 1024;
constexpr size_t WS_XSCALE = 128 * 1024;
constexpr int W8R = 256 * pg8::N8T + 2048;
constexpr size_t WS_END = WS_W8 + 2 * (size_t)W8R * 1024;
static_assert(WS_PROJ + (size_t)M * LDP * 2 == WS_GATES && WS_GATES + (size_t)M * 2048 == WS_WIN1, "ws map");
constexpr int LDS_MISC = pg8::EPI_OFF + 8 * pg8::EPI_WAVE;
constexpr int LDS_RSTAB = LDS_MISC + 256;
constexpr int LDS_BYTES = LDS_RSTAB + 1024 + 64;

#define LAS __attribute__((address_space(3)))
typedef unsigned short bf16;
typedef unsigned v4u __attribute__((ext_vector_type(4)));
typedef float f32x4 __attribute__((ext_vector_type(4)));
#define RLX_AGENT __ATOMIC_RELAXED, __HIP_MEMORY_SCOPE_AGENT
#define XB_TMO      128
#define XB_XCNT(j)  (256  + 64 * (j))
#define XB_XSUB(j)  (1280 + 64 * (j))
#define XB_XGEN(j)  (2304 + 64 * (j))
#define XB_TOP      3328
#define XB_TOPGEN   3392
#define XCD_BAR_WORDS 3456
#define XB_SPIN_CAP (1u << 18)

__device__ __forceinline__ unsigned xb_ld(unsigned* p)              { return __hip_atomic_load(p, __ATOMIC_RELAXED, __HIP_MEMORY_SCOPE_AGENT); }
__device__ __forceinline__ unsigned xb_add(unsigned* p, unsigned v) { return __hip_atomic_fetch_add(p, v, __ATOMIC_RELAXED, __HIP_MEMORY_SCOPE_AGENT); }
__device__ __forceinline__ unsigned xb_xcc_id() { return (unsigned)__builtin_amdgcn_s_getreg((3 << 11) | 20) & 0xFu; }
#define XB_SPIN(cond, bar) do { unsigned _sp = 0; while (cond) { __builtin_amdgcn_s_sleep(1); \
    if ((++_sp & 255u) == 0u) { if (xb_ld(&(bar)[XB_TMO])) break; if (_sp > XB_SPIN_CAP) { atomicAdd(&(bar)[XB_TMO], 1u); break; } } } } while (0)

struct XcdBarrier {
    unsigned* bar; unsigned x;
    volatile LAS unsigned* st;
};

__device__ __forceinline__ XcdBarrier xcd_barrier_post(unsigned* bar, volatile LAS unsigned* st) {
    XcdBarrier b; b.bar = bar; b.x = xb_xcc_id(); b.st = st;
    if (threadIdx.x == 0) (void)xb_add(&bar[XB_XCNT(b.x)], 1u);
    return b;
}
__device__ __forceinline__ void xcd_barrier_complete(unsigned* bar, unsigned x, unsigned& nloc, unsigned& nx) {
    const unsigned G = gridDim.x * gridDim.y * gridDim.z;
    unsigned sum, cnt, mine, sp = 0u;
    for (;;) {
        sum = 0u; cnt = 0u; mine = 0u;
#pragma unroll
        for (unsigned j = 0; j < 16; ++j) { const unsigned c = xb_ld(&bar[XB_XCNT(j)]); sum += c; cnt += (c > 0u) ? 1u : 0u; mine = (j == x) ? c : mine; }
        if (sum == G) break;
        __builtin_amdgcn_s_sleep(1);
        if ((++sp & 255u) == 0u) { if (xb_ld(&bar[XB_TMO])) break; if (sp > XB_SPIN_CAP) { atomicAdd(&bar[XB_TMO], 1u); break; } }
    }
    nloc = mine > 0u ? mine : 1u; nx = cnt > 0u ? cnt : 1u;
}

__device__ __forceinline__ void xcd_barrier(const XcdBarrier& b) {
    asm volatile("s_waitcnt vmcnt(0)" ::: "memory");
    __syncthreads();
    if (threadIdx.x == 0) {
        unsigned* bar = b.bar;
        __builtin_amdgcn_s_waitcnt(0);
        unsigned nloc = b.st[0], nx = b.st[1];
        if (nloc == 0u) { xcd_barrier_complete(bar, b.x, nloc, nx); b.st[0] = nloc; b.st[1] = nx; }
        const unsigned old = xb_add(&bar[XB_XSUB(b.x)], 1u);
        const unsigned gen = old / nloc;
        if (old + 1u == (gen + 1u) * nloc) {
            __builtin_amdgcn_fence(__ATOMIC_RELEASE, "agent");
            asm volatile("s_waitcnt vmcnt(0)" ::: "memory");
            const unsigned og = xb_add(&bar[XB_TOP], 1u);
            const unsigned tg = og / nx;
            if (og + 1u == (tg + 1u) * nx) xb_add(&bar[XB_TOPGEN], 1u);
            else XB_SPIN(xb_ld(&bar[XB_TOPGEN]) == tg, bar);
            __builtin_amdgcn_fence(__ATOMIC_ACQUIRE, "agent");
            xb_add(&bar[XB_XGEN(b.x)], 1u);
            asm volatile("s_waitcnt vmcnt(0)" ::: "memory");
        } else {
            XB_SPIN(xb_ld(&bar[XB_XGEN(b.x)]) == gen, bar);
            __builtin_amdgcn_fence(__ATOMIC_ACQUIRE, "agent");
            asm volatile("s_waitcnt vmcnt(0)" ::: "memory");
        }
    }
    __syncthreads();
}

__device__ __forceinline__ unsigned f2bf(float f) { unsigned u = __builtin_bit_cast(unsigned, f); return (u + 0x7fffu + ((u >> 16) & 1u)) >> 16; }
__device__ __forceinline__ unsigned pk2(float lo, float hi) { return f2bf(lo) | (f2bf(hi) << 16); }
__device__ __forceinline__ float bf2f(bf16 v) { return __uint_as_float(((unsigned)v) << 16); }
__device__ __forceinline__ float blo(unsigned u) { return __uint_as_float(u << 16); }
__device__ __forceinline__ float bhi(unsigned u) { return __uint_as_float(u & 0xffff0000u); }
__device__ __forceinline__ float wave_sum(float v) {
#pragma unroll
    for (int o = 1; o < 64; o <<= 1) v += __shfl_xor(v, o);
    return v;
}
__device__ __forceinline__ float wave_max(float v) {
#pragma unroll
    for (int o = 1; o < 64; o <<= 1) v = fmaxf(v, __shfl_xor(v, o));
    return v;
}
__device__ __forceinline__ void transpose_item(const float* W, int K, int N, bf16* WT, int ldw, LAS float* scr, int item, int lane, const float* gain = nullptr, int nsrc = -1) {
    const int nblk = N / 32, kb = item / nblk, nb = item % nblk, k0 = 64 * kb, n0 = 32 * nb; W += (nsrc >= 0 ? nsrc - n0 : 0);
    f32x4 v[8]; float gk[8];
#pragma unroll
    for (int i = 0; i < 8; ++i) { const int kk = 8 * i + (lane >> 3); v[i] = __builtin_nontemporal_load((const f32x4*)(W + (size_t)(k0 + kk) * N + n0 + 4 * (lane & 7))); gk[i] = gain ? gain[k0 + kk] : 1.0f; }
#pragma unroll
    for (int i = 0; i < 8; ++i) { const int kk = 8 * i + (lane >> 3); LAS float* d = scr + kk * 33 + 4 * (lane & 7); d[0] = v[i].x * gk[i]; d[1] = v[i].y * gk[i]; d[2] = v[i].z * gk[i]; d[3] = v[i].w * gk[i]; }
    asm volatile("s_waitcnt lgkmcnt(0)" ::: "memory");
    const int c = lane & 7;
#pragma unroll
    for (int j = 0; j < 4; ++j) { const int n = (lane >> 3) + 8 * j; const LAS float* s = scr + (8 * c) * 33 + n;
        v4u o; o.x = pk2(s[0 * 33], s[1 * 33]); o.y = pk2(s[2 * 33], s[3 * 33]); o.z = pk2(s[4 * 33], s[5 * 33]); o.w = pk2(s[6 * 33], s[7 * 33]);
        *(v4u*)(WT + (size_t)(n0 + n) * ldw + k0 + 8 * c) = o; }
    asm volatile("s_waitcnt lgkmcnt(0)" ::: "memory");
}
template <bool OUT_BF16> __device__ __forceinline__ void rms_row(const float* xrow, const float* g, void* orow, int lane) {
    const f32x4* xr = (const f32x4*)xrow + lane; const f32x4* gr = (const f32x4*)g + lane;
    f32x4 v[4]; float s = 0.f;
#pragma unroll
    for (int j = 0; j < 4; ++j) { v[j] = xr[64 * j]; s += (v[j].x * v[j].x + v[j].y * v[j].y) + (v[j].z * v[j].z + v[j].w * v[j].w); }
    const float rstd = 1.0f / sqrtf(wave_sum(s) * (1.f / DM) + RMS_EPS);
#pragma unroll
    for (int j = 0; j < 4; ++j) { const f32x4 gg = gr[64 * j]; v[j] = v[j] * rstd * gg; }
    if (OUT_BF16) { unsigned long long* o8 = (unsigned long long*)orow + lane;
#pragma unroll
        for (int j = 0; j < 4; ++j) o8[64 * j] = (unsigned long long)pk2(v[j].x, v[j].y) | ((unsigned long long)pk2(v[j].z, v[j].w) << 32);
    } else { f32x4* o = (f32x4*)orow + lane;
#pragma unroll
        for (int j = 0; j < 4; ++j) o[64 * j] = v[j]; }
}
__device__ __forceinline__ unsigned pack_i8x4(float a, float b, float c, float d) {
    const int ia = (int)__builtin_rintf(fminf(fmaxf(a, -127.f), 127.f)), ib = (int)__builtin_rintf(fminf(fmaxf(b, -127.f), 127.f)), ic = (int)__builtin_rintf(fminf(fmaxf(c, -127.f), 127.f)), id = (int)__builtin_rintf(fminf(fmaxf(d, -127.f), 127.f));
    return (unsigned)(ia & 255) | ((unsigned)(ib & 255) << 8) | ((unsigned)(ic & 255) << 16) | ((unsigned)(id & 255) << 24);
}
__device__ __forceinline__ void raw_row(const float* xrow, bf16* orow, float* ss, signed char* o8row, float* xs, int lane) {
    const f32x4* xr = (const f32x4*)xrow + lane; f32x4 v[4]; float s = 0.f, mx = 0.f;
#pragma unroll
    for (int j = 0; j < 4; ++j) { v[j] = __builtin_nontemporal_load(xr + 64 * j); s += (v[j].x * v[j].x + v[j].y * v[j].y) + (v[j].z * v[j].z + v[j].w * v[j].w);
        mx = fmaxf(mx, fmaxf(fmaxf(fabsf(v[j].x), fabsf(v[j].y)), fmaxf(fabsf(v[j].z), fabsf(v[j].w)))); }
    s = wave_sum(s); if (lane < 16) ss[lane] = (lane == 0) ? s : 0.f;
    mx = wave_max(mx); const float sc = mx > 0.f ? mx * (1.0f / 127.0f) : 1.0f, isc = 1.0f / sc; if (lane == 0) *xs = sc;
    unsigned long long* o8 = (unsigned long long*)orow + lane; unsigned* q8 = (unsigned*)o8row + lane;
#pragma unroll
    for (int j = 0; j < 4; ++j) { o8[64 * j] = (unsigned long long)pk2(v[j].x, v[j].y) | ((unsigned long long)pk2(v[j].z, v[j].w) << 32);
        q8[64 * j] = pack_i8x4(v[j].x * isc, v[j].y * isc, v[j].z * isc, v[j].w * isc); }
}
__device__ __forceinline__ void quant_row(const bf16* xrow, signed char* o8row, float* xs, int lane) {
    typedef unsigned u32x2_t __attribute__((ext_vector_type(2)));
    const u32x2_t* xr = (const u32x2_t*)xrow + lane; u32x2_t b[4]; float mx = 0.f;
#pragma unroll
    for (int j = 0; j < 4; ++j) { b[j] = xr[64 * j]; mx = fmaxf(mx, fmaxf(fmaxf(fabsf(blo(b[j].x)), fabsf(bhi(b[j].x))), fmaxf(fabsf(blo(b[j].y)), fabsf(bhi(b[j].y))))); }
    mx = wave_max(mx); const float sc = mx > 0.f ? mx * (1.0f / 127.0f) : 1.0f, isc = 1.0f / sc; if (lane == 0) *xs = sc;
    unsigned* q8 = (unsigned*)o8row + lane;
#pragma unroll
    for (int j = 0; j < 4; ++j) q8[64 * j] = pack_i8x4(blo(b[j].x) * isc, bhi(b[j].x) * isc, blo(b[j].y) * isc, bhi(b[j].y) * isc);
}
__device__ __forceinline__ void quant_strip_wg(const float* W, const float* gain, signed char* W8, float* wscale, LAS float* scr, LAS float* cmw, int strip, int lane, int wave) {
    const int n0 = 32 * strip; const int tj = n0 >> 8; const int src0 = tj < pg8::N8T ? 256 * pg8::tile_of(tj) + (n0 & 255) : 4608 + (n0 - 256 * pg8::N8T);
    const float* Wc = W + src0 + 4 * (lane & 7);
    f32x4 v[2][8]; float gk[2][8]; f32x4 m4 = (f32x4){0.f, 0.f, 0.f, 0.f};
#pragma unroll
    for (int q = 0; q < 2; ++q)
#pragma unroll
        for (int i = 0; i < 8; ++i) { const int kk = 64 * (2 * wave + q) + 8 * i + (lane >> 3); v[q][i] = *(const f32x4*)(Wc + (size_t)kk * INC); gk[q][i] = gain[kk]; }
#pragma unroll
    for (int q = 0; q < 2; ++q)
#pragma unroll
        for (int i = 0; i < 8; ++i) { v[q][i] = v[q][i] * gk[q][i]; m4.x = fmaxf(m4.x, fabsf(v[q][i].x)); m4.y = fmaxf(m4.y, fabsf(v[q][i].y)); m4.z = fmaxf(m4.z, fabsf(v[q][i].z)); m4.w = fmaxf(m4.w, fabsf(v[q][i].w)); }
#pragma unroll
    for (int o = 8; o < 64; o <<= 1) { m4.x = fmaxf(m4.x, __shfl_xor(m4.x, o)); m4.y = fmaxf(m4.y, __shfl_xor(m4.y, o)); m4.z = fmaxf(m4.z, __shfl_xor(m4.z, o)); m4.w = fmaxf(m4.w, __shfl_xor(m4.w, o)); }
    if (lane < 8) { LAS float* c = cmw + wave * 32 + 4 * lane; c[0] = m4.x; c[1] = m4.y; c[2] = m4.z; c[3] = m4.w; }
    __syncthreads();
    const int n = lane & 31, kh = lane >> 5; float cmx = 0.f;
#pragma unroll
    for (int w = 0; w < 8; ++w) cmx = fmaxf(cmx, cmw[w * 32 + n]);
    const float sc = cmx > 0.f ? cmx * (1.0f / 127.0f) : 1.0f, isc = 1.0f / sc;
    if (wave == 0 && kh == 0) wscale[n0 + n] = sc;
#pragma unroll
    for (int q = 0; q < 2; ++q) {
#pragma unroll
        for (int i = 0; i < 8; ++i) { const int kk = 8 * i + (lane >> 3); LAS float* d = scr + kk * 33 + 4 * (lane & 7); d[0] = v[q][i].x; d[1] = v[q][i].y; d[2] = v[q][i].z; d[3] = v[q][i].w; }
        asm volatile("s_waitcnt lgkmcnt(0)" ::: "memory");
        const LAS float* s = scr + (32 * kh) * 33 + n; v4u o0, o1;
        o0.x = pack_i8x4(s[0 * 33] * isc, s[1 * 33] * isc, s[2 * 33] * isc, s[3 * 33] * isc); o0.y = pack_i8x4(s[4 * 33] * isc, s[5 * 33] * isc, s[6 * 33] * isc, s[7 * 33] * isc);
        o0.z = pack_i8x4(s[8 * 33] * isc, s[9 * 33] * isc, s[10 * 33] * isc, s[11 * 33] * isc); o0.w = pack_i8x4(s[12 * 33] * isc, s[13 * 33] * isc, s[14 * 33] * isc, s[15 * 33] * isc);
        o1.x = pack_i8x4(s[16 * 33] * isc, s[17 * 33] * isc, s[18 * 33] * isc, s[19 * 33] * isc); o1.y = pack_i8x4(s[20 * 33] * isc, s[21 * 33] * isc, s[22 * 33] * isc, s[23 * 33] * isc);
        o1.z = pack_i8x4(s[24 * 33] * isc, s[25 * 33] * isc, s[26 * 33] * isc, s[27 * 33] * isc); o1.w = pack_i8x4(s[28 * 33] * isc, s[29 * 33] * isc, s[30 * 33] * isc, s[31 * 33] * isc);
        v4u* dst = (v4u*)(W8 + (size_t)(n0 + n) * 1024 + 64 * (2 * wave + q) + 32 * kh); dst[0] = o0; dst[1] = o1;
        asm volatile("s_waitcnt lgkmcnt(0)" ::: "memory");
    }
    __syncthreads();
}
__device__ __forceinline__ float dot64(const v4u (&q)[8], const bf16* krow) {
    const v4u* kp = (const v4u*)krow; float a0 = 0.f, a1 = 0.f;
#pragma unroll
    for (int i = 0; i < 8; ++i) { const v4u k = kp[i];
        a0 += blo(q[i].x) * blo(k.x) + blo(q[i].y) * blo(k.y) + blo(q[i].z) * blo(k.z) + blo(q[i].w) * blo(k.w);
        a1 += bhi(q[i].x) * bhi(k.x) + bhi(q[i].y) * bhi(k.y) + bhi(q[i].z) * bhi(k.z) + bhi(q[i].w) * bhi(k.w); }
    return a0 + a1;
}

struct Args { const float* x; const float* norm_g; const float* w_in; const float* b_merge; const float* w_pa; const float* w_pb; const float* w_out; const float* final_g;
              float* out; unsigned char* ws; };

#define PHASE_VARS() \
    int tid_ = threadIdx.x; asm volatile("" : "+v"(tid_)); \
    const int lane = tid_ & 63, wave = __builtin_amdgcn_readfirstlane(tid_ >> 6); \
    const int G = gridDim.x, gw = blockIdx.x * NWAVES + wave, NGW = G * NWAVES; \
    unsigned long long wsb_ = (unsigned long long)a.ws; asm volatile("" : "+s"(wsb_)); \
    unsigned char* const ws = (unsigned char*)(__attribute__((address_space(1))) unsigned char*)wsb_;     \
    bf16* const Win = (bf16*)(ws + (layer == 0 ? WS_WIN : WS_WIN1)); float* const rowss = (float*)(ws + WS_ROWSS); signed char* const XB8 = (signed char*)(ws + WS_XB8); signed char* const W8 = (signed char*)(ws + WS_W8); float* const wscale = (float*)(ws + WS_COLMAX); float* const xscale = (float*)(ws + WS_XSCALE); bf16* const Wcat = (bf16*)(ws + WS_WCAT); bf16* const Wout = (bf16*)(ws + WS_WOUT); \
    bf16* const XB = (bf16*)(ws + WS_XB); bf16* const P = (bf16*)(ws + WS_PROJ); float* const kmean = (float*)(ws + WS_KMEAN); unsigned char* const gatesb = ws + WS_GATES; \
    (void)lane; (void)wave; (void)G; (void)gw; (void)NGW; (void)Win; (void)Wcat; (void)Wout; (void)rowss; (void)XB8; (void)W8; (void)wscale; (void)xscale; (void)XB; (void)P; (void)kmean; (void)gatesb;

#define GRID_BAR() do { unsigned long long wb_ = (unsigned long long)a.ws; asm volatile("" : "+s"(wb_)); XcdBarrier bb_; bb_.bar = (unsigned*)(__attribute__((address_space(1))) unsigned*)wb_; \
    bb_.x = xb_xcc_id(); bb_.st = (volatile LAS unsigned*)(L + LDS_MISC); xcd_barrier(bb_); } while (0)
template <int layer> __device__ __forceinline__ void layer_fwd(const Args& a, unsigned char* lds, LAS unsigned char* L) {
    if (layer == 0) {
        PHASE_VARS();
        LAS float* scr = (LAS float*)(L + wave * 16384);
        constexpr int I_IN = (DM / 64) * (pg8::NBT * 8), I_PA = (256 / 64) * (DM / 32), I_PB = (512 / 64) * (DM / 32), I_OUT = (DM / 64) * (DM / 32);
        const int nitems = 2 * (I_IN + I_PA + I_PB + I_OUT);
        for (int it = gw; it < nitems; it += NGW) {
            const int l2 = it / (I_IN + I_PA + I_PB + I_OUT); int r = it - l2 * (I_IN + I_PA + I_PB + I_OUT);
            if (r < I_IN) { const int kb_ = r / (pg8::NBT * 8 + (pg8::NBT == 0)), nb_ = r % (pg8::NBT * 8 + (pg8::NBT == 0)), tj_ = nb_ >> 3, tl_ = pg8::tile_of(tj_ + pg8::N8T);
                transpose_item(a.w_in + (size_t)l2 * DM * INC, DM, INC, (bf16*)(ws + (l2 == 0 ? WS_WIN : WS_WIN1)), DM, scr, kb_ * (INC / 32) + nb_, lane, a.norm_g + l2 * DM, 256 * tl_ + 32 * (nb_ & 7)); continue; } r -= I_IN;
            if (r < I_PA) { transpose_item(a.w_pa + (size_t)l2 * 256 * DM, 256, DM, Wcat + (size_t)l2 * DM * 768, 768, scr, r, lane); continue; } r -= I_PA;
            if (r < I_PB) { transpose_item(a.w_pb + (size_t)l2 * 512 * DM, 512, DM, Wcat + (size_t)l2 * DM * 768 + 256, 768, scr, r, lane); continue; } r -= I_PB;
            transpose_item(a.w_out + (size_t)l2 * DM * DM, DM, DM, Wout + (size_t)l2 * DM * DM, DM, scr, r, lane);
        }
        for (int i = gw * 64 + lane; i < 2 * 128 * 512; i += NGW * 64) kmean[i] = 0.f;
        for (int it = (int)blockIdx.x; it < 2 * (W8R / 32); it += G) { const int l2 = it / (W8R / 32);
            quant_strip_wg(a.w_in + (size_t)l2 * DM * INC, a.norm_g + l2 * DM, W8 + (size_t)l2 * W8R * 1024, wscale + l2 * W8R, scr, (LAS float*)(L + 12288), it % (W8R / 32), lane, wave); }
        for (int m = gw; m < M; m += NGW) raw_row(a.x + (size_t)m * DM, XB + (size_t)m * DM, rowss + (size_t)m * 16, XB8 + (size_t)m * DM, xscale + m, lane);
    }
    if (layer == 0) GRID_BAR();
    if (layer == 1) {
        PHASE_VARS();
        for (int m = gw; m < M; m += NGW) quant_row(XB + (size_t)m * DM, XB8 + (size_t)m * DM, xscale + m, lane);
    }
    if (layer == 1) GRID_BAR();
    {
        PHASE_VARS();
        if (threadIdx.x == 0) ((LAS int*)(L + LDS_RSTAB))[256] = -1;
        __syncthreads();
        {
            pg8::Gemm g8{(const pg8::bf16_t*)XB8, (const pg8::bf16_t*)(W8 + (size_t)layer * W8R * 1024), M, 256 * pg8::N8T, 512, 512}; pg8::StaticOrder S8; S8.init(M, 256 * pg8::N8T, G, (int)blockIdx.x);
            pg8::EpiProjQ8 E8{P, LDP, wscale + layer * W8R, xscale, rowss + (size_t)layer * M * 16, kmean + layer * 128 * 512};
            pg8::gemm_phase<pg8::EpiProjQ8, pg8::StaticOrder, true, true>(L, g8, S8, E8);
        }
        if (pg8::NBT > 0) {
            if (threadIdx.x == 0) ((LAS int*)(L + LDS_RSTAB))[256] = -1;
            __syncthreads();
            pg8::Gemm g{XB, Win, M, 256 * pg8::NBT, DM, DM}; pg8::StaticOrder S; S.init(M, 256 * pg8::NBT, G, (int)blockIdx.x);
            pg8::EpiProj E{P, LDP, kmean + layer * 128 * 512, rowss + (size_t)layer * M * 16};
            pg8::gemm_phase<pg8::EpiProj, pg8::StaticOrder, true, true>(L, g, S, E);
        }
    }
    GRID_BAR();
    {
        PHASE_VARS();
        const int vcu = (G % 8 == 0) ? ((int)blockIdx.x % 8) * (G / 8) + (int)blockIdx.x / 8 : (int)blockIdx.x;
#pragma unroll 1
        for (int pass = 0; pass < 2; ++pass) {
            if ((pass ^ (vcu >> 2)) & 1) {
                for (int it = (int)blockIdx.x; it < BATCH * 4 * 4; it += G) attna::wg_item((attna::bf16*)P, it >> 4, (it >> 2) & 3, it & 3, (char*)lds);
            } else {
                for (int p = vcu; p < BATCH * 8 * 4; p += G) {
                    const int bh = p >> 2, s = p & 3;
#pragma unroll 1
                    for (int u = 0; u < 2; ++u)
                        moba::moba_unit<8>(bh >> 3, bh & 7, u ? 7 - s : s, (const moba::bf16*)(P + C_BQKV), (const moba::bf16*)(P + C_BQKV + 512), (const moba::bf16*)(P + C_BQKV + 1024), (const moba::bf16*)(P + C_ZB), (moba::bf16*)(P + C_BQKV), kmean + layer * 128 * 512, (char*)lds);
                }
            }
        }
    }
    GRID_BAR();
    {
        PHASE_VARS();
        pg8::StaticOrder S; S.init(M, DM, G, (int)blockIdx.x);
        {
            struct GateOrder { pg8::StaticOrder S;
                __device__ __forceinline__ bool next(int i, pg8::Unit& u) const { if (!S.next(i >> 1, u)) return false; u.pn += 4 * (i & 1); return true; }
                __device__ __forceinline__ void a_ready(const pg8::Unit&) const {} __device__ __forceinline__ void done(const pg8::Unit&) const {} } GS{S};
            if (threadIdx.x == 0) ((LAS int*)(L + LDS_RSTAB))[256] = -1;
            __syncthreads();
            pg8::Gemm gg{(const pg8::bf16_t*)XB8, (const pg8::bf16_t*)(W8 + ((size_t)layer * W8R + 256 * pg8::N8T) * 1024), M, 2048, 512, 512};
            pg8::EpiGate EG{a.b_merge + layer * 2 * DM, wscale + layer * W8R + 256 * pg8::N8T, xscale, rowss + (size_t)layer * M * 16, gatesb};
            pg8::gemm_phase<pg8::EpiGate, GateOrder, true, true>(L, gg, GS, EG);
        }
        pg8::Gemm g{P + C_ZA, Wcat + (size_t)layer * DM * 768, M, DM, 768, LDP}; pg8::EpiMerge E{P + C_MERGED, gatesb, LDP};
        pg8::gemm_phase<pg8::EpiMerge, pg8::StaticOrder, true, true>(L, g, S, E);
    }
    GRID_BAR();
    {
        PHASE_VARS();
        pg8::Gemm g{P + C_MERGED, Wout + (size_t)layer * DM * DM, M, DM, DM, LDP}; pg8::StaticOrder S; S.init(M, DM, G, (int)blockIdx.x);
        pg8::EpiResid<layer> E{a.x, XB, rowss + (layer == 0 ? (size_t)M * 16 : 0), DM};
        pg8::gemm_phase<pg8::EpiResid<layer>, pg8::StaticOrder, true, true>(L, g, S, E);
    }
    GRID_BAR();
}

__global__ void __launch_bounds__(NWAVES * 64, 2) hybrid_fwd(Args a) {
    extern __shared__ __attribute__((aligned(16))) unsigned char lds[];
    LAS unsigned char* L = (LAS unsigned char*)lds;
    if (threadIdx.x < 16) ((LAS unsigned*)(L + LDS_MISC))[threadIdx.x] = 0u;
    __syncthreads();
    (void)xcd_barrier_post((unsigned*)a.ws, (volatile LAS unsigned*)(L + LDS_MISC));
    layer_fwd<0>(a, lds, L);
    layer_fwd<1>(a, lds, L);
    {
        constexpr int layer = 1; (void)layer;
        PHASE_VARS();
        typedef unsigned u32x2_t __attribute__((ext_vector_type(2)));
        f32x4 gg[4];
#pragma unroll
        for (int j = 0; j < 4; ++j) gg[j] = *((const f32x4*)a.final_g + lane + 64 * j);
        for (int m = gw; m < M; m += NGW) {
            const f32x4* pp = (const f32x4*)(rowss + (size_t)m * 16); const f32x4 s4 = (pp[0] + pp[1]) + (pp[2] + pp[3]);
            const float rstd = __builtin_amdgcn_rsqf(((s4[0] + s4[1]) + (s4[2] + s4[3])) * (1.0f / 1024.0f) + RMS_EPS);
            const u32x2_t* xb = (const u32x2_t*)(XB + (size_t)m * DM) + lane; f32x4* o = (f32x4*)(a.out + (size_t)m * DM) + lane;
            u32x2_t bv[4];
#pragma unroll
            for (int j = 0; j < 4; ++j) bv[j] = __builtin_nontemporal_load(xb + 64 * j);
#pragma unroll
            for (int j = 0; j < 4; ++j) __builtin_nontemporal_store((f32x4){blo(bv[j].x), bhi(bv[j].x), blo(bv[j].y), bhi(bv[j].y)} * rstd * gg[j], o + 64 * j);
        }
    }
}

extern "C" void kernel_launch(void* const* d_in, const int* in_sizes, int n_in, void* d_out, int out_size, void* d_ws, size_t ws_size, hipStream_t stream) {
    static int grid = 0;
    if (grid == 0) {
        if (n_in != 8 || in_sizes[0] != M * DM || out_size != M * DM || ws_size < WS_END) { fprintf(stderr, "kernel_launch: unexpected shapes / workspace (n_in %d, ws %zu)\n", n_in, ws_size); grid = -1; return; }
        int dev = 0, cus = 0, per_cu = 0;
        hipGetDevice(&dev); hipDeviceGetAttribute(&cus, hipDeviceAttributeMultiprocessorCount, dev);
        if (hipFuncSetAttribute((const void*)hybrid_fwd, hipFuncAttributeMaxDynamicSharedMemorySize, LDS_BYTES) != hipSuccess) { fprintf(stderr, "kernel_launch: hipFuncSetAttribute failed\n"); grid = -1; return; }
        if (hipOccupancyMaxActiveBlocksPerMultiprocessor(&per_cu, (const void*)hybrid_fwd, NWAVES * 64, LDS_BYTES) != hipSuccess || per_cu < 1) { fprintf(stderr, "kernel_launch: the occupancy query admits %d workgroups per CU; nothing launched\n", per_cu); grid = -1; return; }
        (void)hipGetLastError();
        grid = cus;
    }
    if (grid < 0) return;
    if (hipMemsetAsync((char*)d_ws + WS_BAR, 0, WS_BAR_BYTES, stream) != hipSuccess) { fprintf(stderr, "kernel_launch: hipMemsetAsync failed\n"); return; }
    Args a{};
    a.x = (const float*)d_in[0]; a.norm_g = (const float*)d_in[1]; a.w_in = (const float*)d_in[2]; a.b_merge = (const float*)d_in[3];
    a.w_pa = (const float*)d_in[4]; a.w_pb = (const float*)d_in[5]; a.w_out = (const float*)d_in[6]; a.final_g = (const float*)d_in[7];
    a.out = (float*)d_out; a.ws = (unsigned char*)d_ws;
    hipLaunchKernelGGL(hybrid_fwd, dim3(grid), dim3(NWAVES * 64), LDS_BYTES, stream, a);
    const hipError_t e = hipPeekAtLastError();
    if (e != hipSuccess) fprintf(stderr, "kernel_launch: launch failed: %s (grid %d)\n", hipGetErrorString(e), grid);
}
```

```cpp
#include <hip/hip_runtime.h>
#include <cstdio>
#include <cstdint>
namespace pg8 {
#define PG8_LAS __attribute__((address_space(3)))
typedef unsigned short bf16_t;
typedef short bf16x8 __attribute__((ext_vector_type(8)));
typedef float f32x4 __attribute__((ext_vector_type(4)));
typedef unsigned u32x4 __attribute__((ext_vector_type(4)));
constexpr int BM = 256, BK = 64, HALF = 128, HTB = HALF * BK * 2  , STAGE_BYTES = 8 * HTB, NXCD = 8, WGM = 8;
constexpr int EPI_OFF = STAGE_BYTES, EPI_PITCH = 144, EPI_WAVE = 16 * EPI_PITCH;

__host__ __device__ __forceinline__ int lds_byte(int r, int c) { const int st = (r >> 4) * 2 + (c >> 5), rr = r & 15, cc = c & 31, ob = rr * 64 + cc * 2; return st * 1024 + (ob ^ (((ob >> 9) & 1) << 5)); }
__host__ __device__ __forceinline__ void stage_rc(int b, int& R, int& C) { const int st = b / 1024, sb = b % 1024, swz = sb ^ (((sb >> 9) & 1) << 5); R = (st >> 1) * 16 + swz / 64; C = (st & 1) * 32 + (swz % 64) / 2; }
__host__ __device__ __forceinline__ int perm32(int rho) { const int n = rho >> 4, i = rho & 15; return 8 * (i >> 2) + 4 * n + (i & 3); }

struct Unit { int pm, pn; };
struct Gemm { const bf16_t* A; const bf16_t* Bt; int M, N, K, lda; };

struct StaticOrder {
    int nM, nN, nwg, G, c;
    __host__ __device__ void init(int M, int N, int G_, int c_) { nM = M / BM; nN = N / BM; nwg = nM * nN; G = G_; c = c_; }
    __host__ __device__ bool next(int i, Unit& u) const {
        const long L = (long)i * G + c; if (L >= nwg) return false;
        int wgid = (int)L; { const int q = nwg / NXCD, r = nwg % NXCD, xcd = wgid % NXCD, off = wgid / NXCD; wgid = (xcd < r ? xcd * (q + 1) : r * (q + 1) + (xcd - r) * q) + off; }
        const int nig = WGM * nN, gid = wgid / nig, fm = gid * WGM, gsz = (nM - fm) < WGM ? (nM - fm) : WGM;
        u.pm = fm + ((wgid % nig) % gsz); u.pn = (wgid % nig) / gsz; return true;
    }
    __device__ __forceinline__ void a_ready(const Unit&) const {}
    __device__ __forceinline__ void done(const Unit&) const {}
};


typedef int i32x4 __attribute__((ext_vector_type(4)));
__device__ __forceinline__ f32x4 mma16(bf16x8 a, bf16x8 b, f32x4 c) { return __builtin_amdgcn_mfma_f32_16x16x32_bf16(a, b, c, 0, 0, 0); }
__device__ __forceinline__ i32x4 mma16(bf16x8 a, bf16x8 b, i32x4 c) { return __builtin_amdgcn_mfma_i32_16x16x64_i8(__builtin_bit_cast(i32x4, a), __builtin_bit_cast(i32x4, b), c, 0, 0, 0); }
template <class Epi, class Sched, bool ALIGN_EPI = false, bool SP2 = false>
__device__ __forceinline__ void gemm_phase(PG8_LAS unsigned char* lds, const Gemm g, const Sched& S, const Epi& E) {
    int tid_ = threadIdx.x; asm volatile("" : "+v"(tid_));
    const int tid = tid_, wid = __builtin_amdgcn_readfirstlane(tid >> 6), lane = tid & 63, wr = wid >> 2, wc = wid & 3, fr = lane & 15, fq = lane >> 4;
    const int K = g.K, nt = K / BK;
    unsigned voffA[2], voffB[2];
#pragma unroll
    for (int i = 0; i < 2; ++i) { int R, C; stage_rc(tid * 16 + i * 8192, R, C); const int Rb = 64 * (R >> 5) + (Epi::PERM ? perm32(R & 31) : (R & 31));
        voffA[i] = (unsigned)(R * g.lda + C) * 2u; voffB[i] = (unsigned)(Rb * K + C) * 2u; }
    const size_t kstep = (size_t)(BK * 2);
    const size_t hstepB = (size_t)32 * K * 2, hstepA = (size_t)HALF * g.lda * 2;
    const size_t tstepB = (size_t)BM * K * 2, tstepA = 2 * hstepA;
    const unsigned ldsw = (unsigned)wid * 1024u;
    const int aoff = lds_byte(wr * 64 + fr, fq * 8), boff = lds_byte(wc * 32 + fr, fq * 8);
#define PG8_SA(b, h) (((b) * 2 + (h)) * HTB)
#define PG8_SB(b, h) ((4 + (b) * 2 + (h)) * HTB)
#define PG8_STAGE(bufoff, gbase, voff) do { _Pragma("unroll") for (int _i = 0; _i < 2; ++_i) \
        __builtin_amdgcn_global_load_lds((const unsigned*)((const char*)(gbase) + (voff)[_i]), (PG8_LAS unsigned*)(lds + (bufoff) + ldsw + _i * 8192), 16, 0, 0); } while (0)
#define PG8_LDA(dst, b, h) do { _Pragma("unroll") for (int m = 0; m < 4; ++m) _Pragma("unroll") for (int k = 0; k < 2; ++k) dst[m][k] = *(const PG8_LAS bf16x8*)(lds + PG8_SA(b, h) + aoff + m * 2048 + k * 1024); } while (0)
#define PG8_LDB(dst, b, h) do { _Pragma("unroll") for (int n = 0; n < 2; ++n) _Pragma("unroll") for (int k = 0; k < 2; ++k) dst[n][k] = *(const PG8_LAS bf16x8*)(lds + PG8_SB(b, h) + boff + n * 2048 + k * 1024); } while (0)
#define PG8_MMA(ai, bj, At, Bt) do { __builtin_amdgcn_s_setprio(1); _Pragma("unroll") for (int m = 0; m < 4; ++m) _Pragma("unroll") for (int n = 0; n < 2; ++n) _Pragma("unroll") for (int k = 0; k < 2; ++k) \
        acc[ai][bj][m][n] = mma16(Bt[n][k], At[m][k], acc[ai][bj][m][n]); __builtin_amdgcn_s_setprio(0); } while (0)
#define PG8_WAIT_V(n) asm volatile("s_waitcnt vmcnt(" #n ")" ::: "memory")
#define PG8_WAIT_L(n) asm volatile("s_waitcnt lgkmcnt(" #n ")" ::: "memory")
#define PG8_BAR __builtin_amdgcn_s_barrier()
#define PG8_SCHED __builtin_amdgcn_sched_barrier(0)
    Unit cur, nxt; int ui = 0;
    if (!S.next(0, cur)) return;
    typename Epi::acc_t acc[2][2][4][2];
#pragma unroll
    for (int a = 0; a < 2; ++a)
#pragma unroll
        for (int b = 0; b < 2; ++b)
#pragma unroll
            for (int m = 0; m < 4; ++m)
#pragma unroll
                for (int n = 0; n < 2; ++n) acc[a][b][m][n] = (typename Epi::acc_t){0, 0, 0, 0};
    bf16x8 At[4][2], B0[2][2], B1[2][2];
    const char* cA = (const char*)g.A + (size_t)cur.pm * tstepA; const char* cB = (const char*)g.Bt + (size_t)cur.pn * tstepB;
    S.a_ready(cur);
    if constexpr (SP2) {
        PG8_STAGE(PG8_SB(0, 0), cB, voffB); PG8_STAGE(PG8_SB(0, 1), cB + hstepB, voffB); PG8_STAGE(PG8_SA(0, 0), cA, voffA); PG8_STAGE(PG8_SA(0, 1), cA + hstepA, voffA);
        if (wr == 1) PG8_BAR;
        PG8_WAIT_V(2); PG8_BAR;
        PG8_STAGE(PG8_SB(1, 0), cB + kstep, voffB); PG8_STAGE(PG8_SA(1, 0), cA + kstep, voffA); PG8_STAGE(PG8_SB(1, 1), cB + hstepB + kstep, voffB);
        PG8_WAIT_V(6); PG8_BAR;
    } else {
        PG8_STAGE(PG8_SB(0, 0), cB, voffB); PG8_STAGE(PG8_SA(0, 0), cA, voffA); PG8_STAGE(PG8_SB(0, 1), cB + hstepB, voffB); PG8_STAGE(PG8_SA(0, 1), cA + hstepA, voffA);
        if (wr == 1) PG8_BAR;
        PG8_WAIT_V(4); PG8_BAR;
        PG8_STAGE(PG8_SB(1, 0), cB + kstep, voffB); PG8_STAGE(PG8_SA(1, 0), cA + kstep, voffA); PG8_STAGE(PG8_SB(1, 1), cB + hstepB + kstep, voffB);
        PG8_WAIT_V(6); PG8_BAR;
    }
    for (;;) {
        const bool has_next = S.next(ui + 1, nxt);
        const char* nA = has_next ? (const char*)g.A + (size_t)nxt.pm * tstepA : cA; const char* nB = has_next ? (const char*)g.Bt + (size_t)nxt.pn * tstepB : cB;
        for (int t = 0; t < nt; t += 2) {
            const bool last = (t == nt - 2);
            const char* a1 = cA + (size_t)(t + 1) * kstep;
            const char* a2 = last ? nA : cA + (size_t)(t + 2) * kstep; const char* b2 = last ? nB : cB + (size_t)(t + 2) * kstep;
            const char* a3 = a2 + kstep; const char* b3 = b2 + kstep;
            if (last && has_next) S.a_ready(nxt);
            if constexpr (SP2) {
            PG8_LDB(B0, 0, 0); PG8_LDB(B1, 0, 1); PG8_SCHED; PG8_LDA(At, 0, 0); PG8_STAGE(PG8_SA(1, 1), a1 + hstepA, voffA);
            PG8_WAIT_V(8); PG8_WAIT_L(0); PG8_BAR; PG8_MMA(0, 0, At, B0); PG8_MMA(0, 1, At, B1); PG8_BAR; PG8_SCHED;
            PG8_LDA(At, 0, 1); PG8_STAGE(PG8_SB(0, 0), b2, voffB); PG8_STAGE(PG8_SB(0, 1), b2 + hstepB, voffB); PG8_STAGE(PG8_SA(0, 0), a2, voffA);
            PG8_WAIT_V(8); PG8_WAIT_L(0); PG8_BAR; PG8_MMA(1, 0, At, B0); PG8_MMA(1, 1, At, B1); PG8_BAR; PG8_SCHED;
            PG8_LDB(B0, 1, 0); PG8_LDB(B1, 1, 1); PG8_SCHED; PG8_LDA(At, 1, 0); PG8_STAGE(PG8_SA(0, 1), a2 + hstepA, voffA);
            PG8_WAIT_V(8); PG8_WAIT_L(0); PG8_BAR; PG8_MMA(0, 0, At, B0); PG8_MMA(0, 1, At, B1); PG8_BAR; PG8_SCHED;
            PG8_LDA(At, 1, 1); PG8_STAGE(PG8_SB(1, 0), b3, voffB); PG8_STAGE(PG8_SB(1, 1), b3 + hstepB, voffB); PG8_STAGE(PG8_SA(1, 0), a3, voffA);
            PG8_WAIT_V(8); PG8_WAIT_L(0); PG8_BAR; PG8_MMA(1, 0, At, B0); PG8_MMA(1, 1, At, B1); PG8_BAR; PG8_SCHED;
            if constexpr (Epi::HAS_MID) { if (t == Epi::MID_T) { E.mid(acc, cur, wr, wc, fr, fq, wid); PG8_SCHED; } }
            } else {
            PG8_LDB(B0, 0, 0); PG8_SCHED; PG8_LDA(At, 0, 0); PG8_STAGE(PG8_SA(1, 1), a1 + hstepA, voffA);
            PG8_WAIT_L(8); PG8_BAR; PG8_WAIT_L(0); PG8_MMA(0, 0, At, B0); PG8_BAR; PG8_SCHED;
            PG8_LDB(B1, 0, 1); PG8_STAGE(PG8_SB(0, 0), b2, voffB);
            PG8_BAR; PG8_WAIT_L(0); PG8_MMA(0, 1, At, B1); PG8_BAR;
            PG8_LDA(At, 0, 1); PG8_STAGE(PG8_SA(0, 0), a2, voffA);
            PG8_BAR; PG8_WAIT_L(0); PG8_MMA(1, 0, At, B0); PG8_BAR; PG8_SCHED;
            PG8_STAGE(PG8_SB(0, 1), b2 + hstepB, voffB);
            PG8_WAIT_V(6); PG8_BAR; PG8_MMA(1, 1, At, B1); PG8_BAR;
            PG8_LDB(B0, 1, 0); PG8_SCHED; PG8_LDA(At, 1, 0); PG8_STAGE(PG8_SA(0, 1), a2 + hstepA, voffA);
            PG8_WAIT_L(8); PG8_BAR; PG8_WAIT_L(0); PG8_MMA(0, 0, At, B0); PG8_BAR; PG8_SCHED;
            PG8_LDB(B1, 1, 1); PG8_STAGE(PG8_SB(1, 0), b3, voffB);
            PG8_BAR; PG8_WAIT_L(0); PG8_MMA(0, 1, At, B1); PG8_BAR;
            PG8_LDA(At, 1, 1); PG8_STAGE(PG8_SA(1, 0), a3, voffA);
            PG8_BAR; PG8_WAIT_L(0); PG8_MMA(1, 0, At, B0); PG8_BAR; PG8_SCHED;
            PG8_STAGE(PG8_SB(1, 1), b3 + hstepB, voffB);
            PG8_WAIT_V(6); PG8_BAR; PG8_MMA(1, 1, At, B1); PG8_BAR;
            }
        }
        if constexpr (ALIGN_EPI) { if (wr == 0) PG8_BAR; }
        if constexpr (!Epi::AFTER_DRAIN) { E(acc, cur, wr, wc, fr, fq, lds + EPI_OFF + wid * EPI_WAVE, lane, wid); S.done(cur); }
        if (!has_next) break;
#pragma unroll
        for (int a = 0; a < 2; ++a)
#pragma unroll
            for (int b = 0; b < 2; ++b)
#pragma unroll
                for (int m = 0; m < 4; ++m)
#pragma unroll
                    for (int n = 0; n < 2; ++n) acc[a][b][m][n] = (typename Epi::acc_t){0, 0, 0, 0};
        cur = nxt; cA = nA; cB = nB; ++ui;
        if constexpr (ALIGN_EPI) { if (wr == 1) PG8_BAR; }
    }
    PG8_WAIT_V(0);
    if constexpr (!ALIGN_EPI) { if (wr == 0) PG8_BAR; }
    PG8_BAR;
    if constexpr (Epi::AFTER_DRAIN) { E.fused(acc, cur, wr, wc, fr, fq, lds, wid, lane); S.done(cur); }
#undef PG8_SA
#undef PG8_SB
#undef PG8_STAGE
#undef PG8_LDA
#undef PG8_LDB
#undef PG8_MMA
#undef PG8_WAIT_V
#undef PG8_WAIT_L
#undef PG8_BAR
#undef PG8_SCHED
}
}


namespace pg8 {
__device__ __forceinline__ unsigned cvt_pk_bf16(float lo, float hi) { unsigned r; asm volatile("v_cvt_pk_bf16_f32 %0, %1, %2" : "=v"(r) : "v"(lo), "v"(hi)); return r; }
__device__ __forceinline__ float bflo(unsigned u) { return __uint_as_float(u << 16); }
__device__ __forceinline__ float bfhi(unsigned u) { return __uint_as_float(u & 0xffff0000u); }
__device__ __forceinline__ float sigmoidf_(float v) { return __builtin_amdgcn_rcpf(1.0f + __expf(-v)); }
typedef float f32x2 __attribute__((ext_vector_type(2)));
__device__ __forceinline__ f32x2 silu2_(f32x2 v) { const f32x2 t = v * (-1.4426950408889634f); f32x2 d = (f32x2){__builtin_amdgcn_exp2f(t.x), __builtin_amdgcn_exp2f(t.y)} + 1.0f;
    return v * (f32x2){__builtin_amdgcn_rcpf(d.x), __builtin_amdgcn_rcpf(d.y)}; }
typedef unsigned u32x2 __attribute__((ext_vector_type(2)));
__device__ __forceinline__ void piece_xpose(PG8_LAS unsigned char* stg, u32x4 in0, u32x4 in1, u32x4& out0, u32x4& out1, int fr, int fq, int lane) {
    *(PG8_LAS u32x4*)(stg + fr * EPI_PITCH + fq * 16) = in0; *(PG8_LAS u32x4*)(stg + fr * EPI_PITCH + 64 + fq * 16) = in1;
    out0 = *(const PG8_LAS u32x4*)(stg + (lane >> 3) * EPI_PITCH + (lane & 7) * 16); out1 = *(const PG8_LAS u32x4*)(stg + ((lane >> 3) + 8) * EPI_PITCH + (lane & 7) * 16);
}

constexpr int N8T = 18, NBT = 18 - N8T;
constexpr unsigned long long TORD_LO = 0x4bdc8288e620c20ull, TORD_HI = 0x1ac5aa30ull;
__device__ __forceinline__ int tile_of(int i) { return i < 12 ? (int)((TORD_LO >> (5 * i)) & 31) : (int)((TORD_HI >> (5 * (i - 12))) & 31); }
struct EpiProj {
    typedef f32x4 acc_t; static constexpr bool PERM = true, AFTER_DRAIN = false, HAS_MID = false; static constexpr int MID_T = 0;
    bf16_t* O; int ldc; float* kmean; const float* rowss;
    __device__ __forceinline__ void operator()(const f32x4 (&acc)[2][2][4][2], const Unit& u, int wr, int wc, int fr, int fq, PG8_LAS unsigned char* stg, int lane, int wid) const {
        asm volatile("" : "+v"(fr), "+v"(fq), "+v"(lane));
        const int tl = tile_of(u.pn + N8T);
        const int kind = (tl == 9 || tl == 16 || tl == 17) ? 1 : 0;
        PG8_LAS float* const tab = (PG8_LAS float*)(stg - wid * EPI_WAVE + 8 * EPI_WAVE + 256);
        if (__builtin_amdgcn_readfirstlane(((const PG8_LAS int*)tab)[256]) != u.pm) {
            asm volatile("s_waitcnt lgkmcnt(0)" ::: "memory"); __builtin_amdgcn_s_barrier(); asm volatile("" ::: "memory");
            const int t_ = wid * 64 + lane;
            if (t_ < 256) { const f32x4* pp = (const f32x4*)(rowss + (size_t)(u.pm * BM + t_) * 16); const f32x4 s4 = (pp[0] + pp[1]) + (pp[2] + pp[3]);
                tab[t_] = __builtin_amdgcn_rsqf(((s4[0] + s4[1]) + (s4[2] + s4[3])) * (1.0f / 1024.0f) + 1e-6f); }
            if (t_ == 0) ((PG8_LAS int*)tab)[256] = u.pm;
            asm volatile("s_waitcnt vmcnt(0) lgkmcnt(0)" ::: "memory"); __builtin_amdgcn_s_barrier(); asm volatile("" ::: "memory");
        }
        float rs[2][4];
#pragma unroll
        for (int ai = 0; ai < 2; ++ai)
#pragma unroll
            for (int m = 0; m < 4; ++m) rs[ai][m] = tab[ai * HALF + wr * 64 + m * 16 + fr];
        const float qs = (tl == 10 || tl == 11) ? 0.18033688011112042f : 1.0f;
        const size_t rbase = (size_t)(u.pm * BM + wr * 64 + (lane >> 3)); bf16_t* const op = O + tl * BM + wc * 64 + 8 * (lane & 7);
#pragma unroll
        for (int ai = 0; ai < 2; ++ai)
#pragma unroll
            for (int m = 0; m < 4; ++m) { u32x4 w[2];
#pragma unroll
                for (int bj = 0; bj < 2; ++bj) { f32x4 v0 = acc[ai][bj][m][0] * rs[ai][m], v1 = acc[ai][bj][m][1] * rs[ai][m];
                    if (kind == 1) {
#pragma unroll
                        for (int e = 0; e < 4; ++e) { v0[e] = v0[e] * sigmoidf_(v0[e]); v1[e] = v1[e] * sigmoidf_(v1[e]); } }
                    v0 = v0 * qs; v1 = v1 * qs;
                    w[bj].x = cvt_pk_bf16(v0[0], v0[1]); w[bj].y = cvt_pk_bf16(v0[2], v0[3]); w[bj].z = cvt_pk_bf16(v1[0], v1[1]); w[bj].w = cvt_pk_bf16(v1[2], v1[3]); }
                u32x4 o0, o1; piece_xpose(stg, w[0], w[1], o0, o1, fr, fq, lane);
                bf16_t* rp = op + (rbase + ai * HALF + m * 16) * ldc;
                __builtin_nontemporal_store(o0, (u32x4*)rp); __builtin_nontemporal_store(o1, (u32x4*)(rp + (size_t)8 * ldc));
                asm volatile("" ::: "memory"); }
        if (tl == 12 || tl == 13) {
#pragma unroll
            for (int bj = 0; bj < 2; ++bj)
#pragma unroll
                for (int n = 0; n < 2; ++n) { f32x4 cs = (f32x4){0.f, 0.f, 0.f, 0.f};
#pragma unroll
                    for (int ai = 0; ai < 2; ++ai)
#pragma unroll
                        for (int m = 0; m < 4; ++m) { float r2 = rs[ai][m]; asm volatile("" : "+v"(r2)); cs += acc[ai][bj][m][n] * r2; }
#pragma unroll
                    for (int e = 0; e < 4; ++e) { float v = cs[e]; v += __shfl_xor(v, 1); v += __shfl_xor(v, 2); v += __shfl_xor(v, 4); v += __shfl_xor(v, 8); cs[e] = v; }
                    if (fr == 0) { float* kp = kmean + (size_t)u.pm * 512 + (tl - 12) * 256 + wc * 64 + bj * 32 + 8 * fq + 4 * n;
#pragma unroll
                        for (int e = 0; e < 4; ++e) atomicAdd(kp + e, cs[e] * (1.0f / 256.0f)); } }
        }
    }
};
struct EpiProjQ8 {
    typedef i32x4 acc_t; static constexpr bool PERM = true, AFTER_DRAIN = false, HAS_MID = false; static constexpr int MID_T = 0;
    bf16_t* O; int ldc; const float* wscale; const float* xscale; const float* rowss; float* kmean;
    __device__ __forceinline__ void operator()(const i32x4 (&acc)[2][2][4][2], const Unit& u, int wr, int wc, int fr, int fq, PG8_LAS unsigned char* stg, int lane, int wid) const {
        asm volatile("" : "+v"(fr), "+v"(fq), "+v"(lane));
        const int tl = tile_of(u.pn);
        const int kind = (tl == 9 || tl == 16 || tl == 17) ? 1 : 0;
        const float qs = (tl == 0 || tl == 3 || tl == 6 || tl == 10 || tl == 11) ? 0.18033688011112042f : 1.0f;
        PG8_LAS float* const tab = (PG8_LAS float*)(stg - wid * EPI_WAVE + 8 * EPI_WAVE + 256);
        if (__builtin_amdgcn_readfirstlane(((const PG8_LAS int*)tab)[256]) != u.pm) {
            asm volatile("s_waitcnt lgkmcnt(0)" ::: "memory"); __builtin_amdgcn_s_barrier(); asm volatile("" ::: "memory");
            const int t_ = wid * 64 + lane;
            if (t_ < 256) { const f32x4* pp = (const f32x4*)(rowss + (size_t)(u.pm * BM + t_) * 16); const f32x4 s4 = (pp[0] + pp[1]) + (pp[2] + pp[3]);
                tab[t_] = xscale[u.pm * BM + t_] * __builtin_amdgcn_rsqf(((s4[0] + s4[1]) + (s4[2] + s4[3])) * (1.0f / 1024.0f) + 1e-6f); }
            if (t_ == 0) ((PG8_LAS int*)tab)[256] = u.pm;
            asm volatile("s_waitcnt vmcnt(0) lgkmcnt(0)" ::: "memory"); __builtin_amdgcn_s_barrier(); asm volatile("" ::: "memory");
        }
        f32x4 wv[2][2];
#pragma unroll
        for (int bj = 0; bj < 2; ++bj)
#pragma unroll
            for (int n = 0; n < 2; ++n) wv[bj][n] = *(const f32x4*)(wscale + u.pn * BM + wc * 64 + 8 * fq + bj * 32 + 4 * n) * qs;
        const size_t rbase = (size_t)(u.pm * BM + wr * 64 + (lane >> 3)); bf16_t* const op = O + tl * BM + wc * 64 + 8 * (lane & 7);
#pragma unroll
        for (int ai = 0; ai < 2; ++ai)
#pragma unroll
            for (int m = 0; m < 4; ++m) { const float rf = tab[ai * HALF + wr * 64 + m * 16 + fr]; u32x4 w[2];
#pragma unroll
                for (int bj = 0; bj < 2; ++bj) { f32x2 p[4];
#pragma unroll
                    for (int n = 0; n < 2; ++n) { const i32x4 a4 = acc[ai][bj][m][n]; const f32x4 w4 = wv[bj][n];
                        p[2 * n] = ((f32x2){(float)a4[0], (float)a4[1]} * rf) * (f32x2){w4[0], w4[1]}; p[2 * n + 1] = ((f32x2){(float)a4[2], (float)a4[3]} * rf) * (f32x2){w4[2], w4[3]}; }
                    if (kind == 1) {
#pragma unroll
                        for (int h = 0; h < 4; ++h) p[h] = silu2_(p[h]); }
                    w[bj].x = cvt_pk_bf16(p[0].x, p[0].y); w[bj].y = cvt_pk_bf16(p[1].x, p[1].y); w[bj].z = cvt_pk_bf16(p[2].x, p[2].y); w[bj].w = cvt_pk_bf16(p[3].x, p[3].y); }
                u32x4 o0, o1; piece_xpose(stg, w[0], w[1], o0, o1, fr, fq, lane);
                bf16_t* rp = op + (rbase + ai * HALF + m * 16) * ldc;
                __builtin_nontemporal_store(o0, (u32x4*)rp); __builtin_nontemporal_store(o1, (u32x4*)(rp + (size_t)8 * ldc));
                asm volatile("" ::: "memory"); }
        if (tl == 12 || tl == 13) {
#pragma unroll
            for (int bj = 0; bj < 2; ++bj)
#pragma unroll
                for (int n = 0; n < 2; ++n) { f32x4 cs = (f32x4){0.f, 0.f, 0.f, 0.f};
#pragma unroll
                    for (int ai = 0; ai < 2; ++ai)
#pragma unroll
                        for (int m = 0; m < 4; ++m) { float r2 = tab[ai * HALF + wr * 64 + m * 16 + fr]; asm volatile("" : "+v"(r2));
#pragma unroll
                            for (int e = 0; e < 4; ++e) cs[e] += (float)acc[ai][bj][m][n][e] * r2; }
#pragma unroll
                    for (int e = 0; e < 4; ++e) { float v = cs[e] * wv[bj][n][e]; v += __shfl_xor(v, 1); v += __shfl_xor(v, 2); v += __shfl_xor(v, 4); v += __shfl_xor(v, 8); cs[e] = v; }
                    if (fr == 0) { float* kp = kmean + (size_t)u.pm * 512 + (tl - 12) * 256 + wc * 64 + bj * 32 + 8 * fq + 4 * n;
#pragma unroll
                        for (int e = 0; e < 4; ++e) atomicAdd(kp + e, cs[e] * (1.0f / 256.0f)); } }
        }
    }
};
struct EpiGate {
    typedef i32x4 acc_t; static constexpr bool PERM = true, AFTER_DRAIN = false, HAS_MID = false; static constexpr int MID_T = 0;
    const float* bmerge; const float* wscale; const float* xscale; const float* rowss; unsigned char* gates;
    __device__ __forceinline__ void operator()(const i32x4 (&acc)[2][2][4][2], const Unit& u, int wr, int wc, int fr, int fq, PG8_LAS unsigned char* stg, int lane, int wid) const {
        asm volatile("" : "+v"(fr), "+v"(fq), "+v"(lane));
        const int col0 = u.pn * BM + wc * 64 + 8 * fq;
        PG8_LAS float* const tab = (PG8_LAS float*)(stg - wid * EPI_WAVE + 8 * EPI_WAVE + 256);
        if (__builtin_amdgcn_readfirstlane(((const PG8_LAS int*)tab)[256]) != u.pm) {
            asm volatile("s_waitcnt lgkmcnt(0)" ::: "memory"); __builtin_amdgcn_s_barrier(); asm volatile("" ::: "memory");
            const int t_ = wid * 64 + lane;
            if (t_ < 256) { const f32x4* pp = (const f32x4*)(rowss + (size_t)(u.pm * BM + t_) * 16); const f32x4 s4 = (pp[0] + pp[1]) + (pp[2] + pp[3]);
                tab[t_] = xscale[u.pm * BM + t_] * __builtin_amdgcn_rsqf(((s4[0] + s4[1]) + (s4[2] + s4[3])) * (1.0f / 1024.0f) + 1e-6f) * (-1.4426950408889634f); }
            if (t_ == 0) ((PG8_LAS int*)tab)[256] = u.pm;
            asm volatile("s_waitcnt vmcnt(0) lgkmcnt(0)" ::: "memory"); __builtin_amdgcn_s_barrier(); asm volatile("" ::: "memory");
        }
        f32x4 bv[2][2], wv[2][2];
#pragma unroll
        for (int bj = 0; bj < 2; ++bj)
#pragma unroll
            for (int n = 0; n < 2; ++n) { bv[bj][n] = *(const f32x4*)(bmerge + col0 + bj * 32 + 4 * n) * (-1.4426950408889634f) - 7.99435343685885794f  ; wv[bj][n] = *(const f32x4*)(wscale + col0 + bj * 32 + 4 * n); }
        unsigned char* gp = gates + ((size_t)((u.pm * 8 + u.pn) * 8 + wid) * 8) * 1024 + fr * 64 + fq * 16;
#pragma unroll
        for (int ai = 0; ai < 2; ++ai)
#pragma unroll
            for (int m = 0; m < 4; ++m) { const float rf = tab[ai * HALF + wr * 64 + m * 16 + fr]; u32x4 q;
#pragma unroll
                for (int bj = 0; bj < 2; ++bj)
#pragma unroll
                    for (int n = 0; n < 2; ++n) { unsigned w = 0u; const i32x4 a4 = acc[ai][bj][m][n]; const f32x4 w4 = wv[bj][n], b4 = bv[bj][n];
#pragma unroll
                        for (int h = 0; h < 2; ++h) {
                            const f32x2 t = __builtin_elementwise_fma((f32x2){(float)a4[2 * h], (float)a4[2 * h + 1]} * rf, (f32x2){w4[2 * h], w4[2 * h + 1]}, (f32x2){b4[2 * h], b4[2 * h + 1]});
                            const f32x2 d = (f32x2){__builtin_amdgcn_exp2f(t.x), __builtin_amdgcn_exp2f(t.y)} + 0.00392156862745098f;
                            w = __builtin_amdgcn_cvt_pk_u8_f32(__builtin_fmaxf(__builtin_amdgcn_rcpf(d.x), 1.0f), 2 * h, w);
                            w = __builtin_amdgcn_cvt_pk_u8_f32(__builtin_fmaxf(__builtin_amdgcn_rcpf(d.y), 1.0f), 2 * h + 1, w); }
                        q[2 * bj + n] = w; }
                __builtin_nontemporal_store(q, (u32x4*)(gp + (ai * 4 + m) * 1024)); }
    }
};
struct EpiMerge {
    typedef f32x4 acc_t; static constexpr bool PERM = true, AFTER_DRAIN = false, HAS_MID = true; static constexpr int MID_T = 2;
    bf16_t* O; const unsigned char* gates; int ldc;
    __device__ __forceinline__ static float ub(unsigned w, int i) { return (float)((w >> (8 * i)) & 0xffu); }
    __device__ __forceinline__ void mid(f32x4 (&acc)[2][2][4][2], const Unit& u, int wr, int wc, int fr, int fq, int wid) const {
        asm volatile("" : "+v"(fr), "+v"(fq));
        const unsigned char* ga = gates + ((size_t)((u.pm * 8 + u.pn) * 8 + wid) * 8) * 1024 + fr * 64 + fq * 16; const unsigned char* gb = ga + (size_t)4 * 8 * 8 * 1024;
        u32x4 av[2][4], bv[2][4];
#pragma unroll
        for (int ai = 0; ai < 2; ++ai)
#pragma unroll
            for (int m = 0; m < 4; ++m) { av[ai][m] = __builtin_nontemporal_load((const u32x4*)(ga + (ai * 4 + m) * 1024)); bv[ai][m] = *(const u32x4*)(gb + (ai * 4 + m) * 1024); }
#pragma unroll
        for (int ai = 0; ai < 2; ++ai)
#pragma unroll
            for (int m = 0; m < 4; ++m)
#pragma unroll
                for (int bj = 0; bj < 2; ++bj)
#pragma unroll
                    for (int n = 0; n < 2; ++n)
#pragma unroll
                        for (int e = 0; e < 4; ++e) acc[ai][bj][m][n][e] *= ub(av[ai][m][2 * bj + n], e) * __builtin_amdgcn_rcpf(ub(bv[ai][m][2 * bj + n], e));
    }
    __device__ __forceinline__ void operator()(const f32x4 (&acc)[2][2][4][2], const Unit& u, int wr, int wc, int fr, int fq, PG8_LAS unsigned char* stg, int lane, int wid) const {
        asm volatile("" : "+v"(fr), "+v"(fq), "+v"(lane));
        const unsigned char* gb = gates + ((size_t)((u.pm * 8 + 4 + u.pn) * 8 + wid) * 8) * 1024 + fr * 64 + fq * 16;
        const size_t rbase = (size_t)(u.pm * BM + wr * 64 + (lane >> 3)); bf16_t* const op = O + u.pn * BM + wc * 64 + 8 * (lane & 7);
        u32x4 gvv[2][4];
#pragma unroll
        for (int ai = 0; ai < 2; ++ai)
#pragma unroll
            for (int m = 0; m < 4; ++m) gvv[ai][m] = __builtin_nontemporal_load((const u32x4*)(gb + (ai * 4 + m) * 1024));
#pragma unroll
        for (int ai = 0; ai < 2; ++ai)
#pragma unroll
            for (int m = 0; m < 4; ++m) { const u32x4 gv = gvv[ai][m]; u32x4 w[2];
#pragma unroll
                for (int bj = 0; bj < 2; ++bj) { f32x4 v0 = acc[ai][bj][m][0], v1 = acc[ai][bj][m][1];
#pragma unroll
                    for (int e = 0; e < 4; ++e) { v0[e] *= ub(gv[2 * bj], e) * (1.0f / 255.0f); v1[e] *= ub(gv[2 * bj + 1], e) * (1.0f / 255.0f); }
                    w[bj].x = cvt_pk_bf16(v0[0], v0[1]); w[bj].y = cvt_pk_bf16(v0[2], v0[3]); w[bj].z = cvt_pk_bf16(v1[0], v1[1]); w[bj].w = cvt_pk_bf16(v1[2], v1[3]); }
                u32x4 o0, o1; piece_xpose(stg, w[0], w[1], o0, o1, fr, fq, lane);
                bf16_t* rp = op + (rbase + ai * HALF + m * 16) * ldc;
                __builtin_nontemporal_store(o0, (u32x4*)rp); __builtin_nontemporal_store(o1, (u32x4*)(rp + (size_t)8 * ldc));
                if (m & 1) asm volatile("" ::: "memory"); }
    }
};
template <int MODE> struct EpiResid {
    typedef f32x4 acc_t; static constexpr bool PERM = false, AFTER_DRAIN = false, HAS_MID = false; static constexpr int MID_T = 0;
    const float* R; bf16_t* XB; float* rowss; int ldc;
    __device__ __forceinline__ void operator()(const f32x4 (&acc)[2][2][4][2], const Unit& u, int wr, int wc, int fr, int fq, PG8_LAS unsigned char* stg, int lane, int wid) const {
        asm volatile("" : "+v"(fr), "+v"(fq), "+v"(lane));
        const size_t rbase = (size_t)(u.pm * BM + wr * 64 + (lane >> 3)); const int cb = u.pn * BM + wc * 64 + 4 * (lane & 7);
#pragma unroll
        for (int ai = 0; ai < 2; ++ai) {
            f32x4 rr[4][2][2];
#pragma unroll
            for (int m = 0; m < 4; ++m)
#pragma unroll
                for (int bj = 0; bj < 2; ++bj) { const size_t ro = (rbase + ai * HALF + m * 16) * ldc + cb + bj * 32;
                    if (MODE == 0) { rr[m][bj][0] = __builtin_nontemporal_load((const f32x4*)(R + ro)); rr[m][bj][1] = __builtin_nontemporal_load((const f32x4*)(R + ro + (size_t)8 * ldc)); }
                    else { const u32x2 b0 = __builtin_nontemporal_load((const u32x2*)(XB + ro)), b1 = __builtin_nontemporal_load((const u32x2*)(XB + ro + (size_t)8 * ldc));
                        rr[m][bj][0] = __builtin_bit_cast(f32x4, (u32x4){b0.x, b0.y, b1.x, b1.y}); } }
#pragma unroll
            for (int m = 0; m < 4; ++m) { float ss0 = 0.f, ss1 = 0.f;
#pragma unroll
                for (int bj = 0; bj < 2; ++bj) { const size_t ro = (rbase + ai * HALF + m * 16) * ldc + cb + bj * 32;
                    f32x4 r0, r1;
                    if (MODE == 0) { r0 = rr[m][bj][0]; r1 = rr[m][bj][1]; }
                    else { const u32x4 pk = __builtin_bit_cast(u32x4, rr[m][bj][0]);
                        r0 = (f32x4){bflo(pk.x), bfhi(pk.x), bflo(pk.y), bfhi(pk.y)}; r1 = (f32x4){bflo(pk.z), bfhi(pk.z), bflo(pk.w), bfhi(pk.w)}; }
                    u32x4 o0, o1; piece_xpose(stg, __builtin_bit_cast(u32x4, acc[ai][bj][m][0]), __builtin_bit_cast(u32x4, acc[ai][bj][m][1]), o0, o1, fr, fq, lane);
                    const f32x4 x0 = r0 + __builtin_bit_cast(f32x4, o0), x1 = r1 + __builtin_bit_cast(f32x4, o1);
                    *(u32x2*)(XB + ro) = (u32x2){cvt_pk_bf16(x0[0], x0[1]), cvt_pk_bf16(x0[2], x0[3])}; *(u32x2*)(XB + ro + (size_t)8 * ldc) = (u32x2){cvt_pk_bf16(x1[0], x1[1]), cvt_pk_bf16(x1[2], x1[3])};
                    ss0 += (x0[0] * x0[0] + x0[1] * x0[1]) + (x0[2] * x0[2] + x0[3] * x0[3]); ss1 += (x1[0] * x1[0] + x1[1] * x1[1]) + (x1[2] * x1[2] + x1[3] * x1[3]); }
                ss0 += __shfl_xor(ss0, 1); ss0 += __shfl_xor(ss0, 2); ss0 += __shfl_xor(ss0, 4); ss1 += __shfl_xor(ss1, 1); ss1 += __shfl_xor(ss1, 2); ss1 += __shfl_xor(ss1, 4);
                if ((lane & 7) == 0) { rowss[(rbase + ai * HALF + m * 16) * 16 + u.pn * 4 + wc] = ss0; rowss[(rbase + ai * HALF + m * 16 + 8) * 16 + u.pn * 4 + wc] = ss1; } }
            asm volatile("" ::: "memory");
        }
    }
};
}
#include <hip/hip_bf16.h>
#include <cmath>
namespace moba {
using bf16=__hip_bfloat16;
using bf16x8=__attribute__((ext_vector_type(8)))short;
using s16x4=__attribute__((ext_vector_type(4)))short;
using f32x16=__attribute__((ext_vector_type(16)))float;
using u32x4=__attribute__((ext_vector_type(4)))unsigned;
constexpr int SEQ=2048,D=64,PITCH=4608;
constexpr int NW=8,QBLK=32,QB=QBLK*NW,KVBLK=64;
__device__ __forceinline__ int crow(int r,int hi){return (r&3)+8*(r>>2)+4*hi;}
#define SBAR() __builtin_amdgcn_sched_barrier(0)
__device__ __forceinline__ void cmask(f32x16&p0,f32x16&p1,int jb,int qrel,int hi){
  const float NEG=-INFINITY; int kb=64*jb+4*hi;
  #pragma unroll
  for(int r=0;r<16;++r){int kv=kb+(r&3)+8*(r>>2); if(kv>qrel)p0[r]=NEG; if(kv+32>qrel)p1[r]=NEG;}
}

constexpr int NSLOT=3, SLOTB=8192;
constexpr int NVSLOT=4;
constexpr int LDS_K=0, LDS_V=NSLOT*SLOTB, LDS_WS=LDS_V+NVSLOT*SLOTB, LDS_OST=LDS_WS+NW*64*4, LDS_KM=LDS_OST+NW*4096, LDS_BYTES=LDS_KM+8*64*4;
__device__ __forceinline__ void glds16(const void*gsrc,unsigned lds_dst){unsigned keep;
  asm volatile("s_mov_b32 %0, m0\n\ts_mov_b32 m0, %2\n\ts_nop 0\n\tglobal_load_lds_dwordx4 %1, off\n\ts_mov_b32 m0, %0":"=&s"(keep):"v"(gsrc),"s"(lds_dst):"memory");}
__device__ __forceinline__ float max3f(float a,float b,float c){float r;asm("v_max3_f32 %0, %1, %2, %3":"=v"(r):"v"(a),"v"(b),"v"(c));return r;}
__device__ __forceinline__ float max2f(float a,float b){float r;asm("v_max_f32_e32 %0, %1, %2":"=v"(r):"v"(a),"v"(b));return r;}
typedef float f32x2_t __attribute__((ext_vector_type(2))); typedef __bf16 bf16x2_t __attribute__((ext_vector_type(2)));
__device__ __forceinline__ unsigned cvtpk_s(float lo,float hi){f32x2_t v={lo,hi};bf16x2_t b=__builtin_convertvector(v,bf16x2_t);return __builtin_bit_cast(unsigned,b);}
__device__ __forceinline__ float bl(unsigned u){return __uint_as_float(u<<16);}
__device__ __forceinline__ float bh(unsigned u){return __uint_as_float(u&0xffff0000u);}
#define WAIT_BAR(N) asm volatile("s_waitcnt vmcnt(" #N ") lgkmcnt(0)\n\ts_barrier":::"memory")

__device__ __forceinline__ void qkt(f32x16&p0,f32x16&p1,const char*Kslot,const bf16x8*qr,const f32x16&negm,int r32,int hi){
  const char*kb=Kslot+hi*1024+r32*16;
  #pragma unroll
  for(int d0=0;d0<4;++d0){
    const bf16x8 b0=*reinterpret_cast<const bf16x8*>(kb+d0*2048);
    const bf16x8 b1=*reinterpret_cast<const bf16x8*>(kb+d0*2048+512);
    if(d0==0){p0=__builtin_amdgcn_mfma_f32_32x32x16_bf16(b0,qr[0],negm,0,0,0);p1=__builtin_amdgcn_mfma_f32_32x32x16_bf16(b1,qr[0],negm,0,0,0);}
    else{p0=__builtin_amdgcn_mfma_f32_32x32x16_bf16(b0,qr[d0],p0,0,0,0);p1=__builtin_amdgcn_mfma_f32_32x32x16_bf16(b1,qr[d0],p1,0,0,0);}}
}
typedef __attribute__((address_space(3))) const char* lds_cptr;
typedef short v4i16_t __attribute__((ext_vector_type(4)));
__device__ __forceinline__ void kload8(bf16x8*kf,lds_cptr kp){
  kf[0]=*(const __attribute__((address_space(3))) bf16x8*)(kp);      kf[1]=*(const __attribute__((address_space(3))) bf16x8*)(kp+512);
  kf[2]=*(const __attribute__((address_space(3))) bf16x8*)(kp+2048); kf[3]=*(const __attribute__((address_space(3))) bf16x8*)(kp+2560);
  kf[4]=*(const __attribute__((address_space(3))) bf16x8*)(kp+4096); kf[5]=*(const __attribute__((address_space(3))) bf16x8*)(kp+4608);
  kf[6]=*(const __attribute__((address_space(3))) bf16x8*)(kp+6144); kf[7]=*(const __attribute__((address_space(3))) bf16x8*)(kp+6656);
}
__device__ __forceinline__ void kload2(bf16x8*kf,lds_cptr kp,int j){ kf[2*j]=*(const __attribute__((address_space(3))) bf16x8*)(kp+j*2048); kf[2*j+1]=*(const __attribute__((address_space(3))) bf16x8*)(kp+j*2048+512); }
__device__ __forceinline__ s16x4 vtr(lds_cptr p){ return __builtin_bit_cast(s16x4,__builtin_amdgcn_ds_read_tr16_b64_v4i16((__attribute__((address_space(3))) v4i16_t*)p)); }
__device__ __forceinline__ float rowmax(const f32x16&p0,const f32x16&p1){
  float a=max3f(p0[0],p0[1],p1[0]),b=max3f(p0[2],p0[3],p1[1]);a=max3f(a,p1[2],p1[3]);
  #pragma unroll
  for(int r=4;r<16;r+=4){a=max3f(a,p0[r],p0[r+1]);b=max3f(b,p0[r+2],p0[r+3]);a=max3f(a,p1[r],p1[r+1]);b=max3f(b,p1[r+2],p1[r+3]);}
  const float m=max2f(a,b);
  auto rr=__builtin_amdgcn_permlane32_swap(__float_as_uint(m),__float_as_uint(m),false,false);
  return max2f(__uint_as_float(rr[0]),__uint_as_float(rr[1]));
}
__device__ __forceinline__ float xhalf_sum(float v){ auto rr=__builtin_amdgcn_permlane32_swap(__float_as_uint(v),__float_as_uint(v),false,false); return __uint_as_float(rr[0])+__uint_as_float(rr[1]); }
__device__ __forceinline__ void pv(f32x16*o,int vb,bf16x8 pa0,bf16x8 pa1,bf16x8 pa2,bf16x8 pa3){
  #pragma unroll
  for(int d0=0;d0<2;++d0){s16x4 lo[4],hi[4];
    #pragma unroll
    for(int ks=0;ks<4;++ks){
      asm volatile("ds_read_b64_tr_b16 %0,%1 offset:%c2":"=&v"(lo[ks]):"v"(vb),"i"(d0*4096+ks*1024):"memory");
      asm volatile("ds_read_b64_tr_b16 %0,%1 offset:%c2":"=&v"(hi[ks]):"v"(vb),"i"(d0*4096+ks*1024+512):"memory");}
    asm volatile("s_waitcnt lgkmcnt(0)":::"memory");SBAR();
    #define PK(k) (bf16x8){lo[k][0],lo[k][1],lo[k][2],lo[k][3],hi[k][0],hi[k][1],hi[k][2],hi[k][3]}
    o[d0]=__builtin_amdgcn_mfma_f32_32x32x16_bf16(pa0,PK(0),o[d0],0,0,0);
    o[d0]=__builtin_amdgcn_mfma_f32_32x32x16_bf16(pa1,PK(1),o[d0],0,0,0);
    o[d0]=__builtin_amdgcn_mfma_f32_32x32x16_bf16(pa2,PK(2),o[d0],0,0,0);
    o[d0]=__builtin_amdgcn_mfma_f32_32x32x16_bf16(pa3,PK(3),o[d0],0,0,0);
    #undef PK
  }
}

template<int THRL> __device__ __forceinline__ void moba_unit(int b,int h,int c,const bf16*Pq,const bf16*__restrict__ Pk,const bf16*__restrict__ Pv,const bf16*Pz,bf16*Po,const float*__restrict__ kmean,char*shm){
  int tid_=threadIdx.x; asm volatile("":"+v"(tid_));
  const int tid=tid_,lane=tid&63,r32=lane&31,hi=lane>>5; const int wid=__builtin_amdgcn_readfirstlane(tid>>6);
  const long rowbase=(long)b*SEQ; const int q0=c*QB;
  const bf16*Qw=Pq+(rowbase+q0+wid*QBLK)*PITCH+h*D;
  const bf16*Kh=Pk+rowbase*PITCH+h*D,*Vh=Pv+rowbase*PITCH+h*D;
  const unsigned lds0=(unsigned)(uintptr_t)shm;
  float*wsf=(float*)(shm+LDS_WS)+wid*64;
  float*kml=(float*)(shm+LDS_KM);
  const int NT=(q0+QB)/KVBLK;
  const bf16*ksrc=Kh+(long)lane*PITCH+wid*8;
  const bf16*vsrc=Vh+(long)(16*(wid&3)+(lane>>2))*PITCH+(wid>>2)*32+(lane&3)*8;
  const unsigned kdst=lds0+LDS_K+wid*1024, vdst=lds0+LDS_V+wid*1024;
  #define DMA_K(t,slot) glds16(ksrc+(long)(NT-1-(t))*KVBLK*PITCH,(unsigned)__builtin_amdgcn_readfirstlane(kdst+(slot)))
  #define DMA_V(t,slot) glds16(vsrc+(long)(NT-1-(t))*KVBLK*PITCH,(unsigned)__builtin_amdgcn_readfirstlane(vdst+(slot)))
  const int vb0=(int)(lds0+LDS_V)+((lane>>4)&1)*32+(lane&3)*8+(4*hi+((lane&15)>>2))*64;
  const char*Kbase=shm+LDS_K; bf16x8 kf[8];
  const lds_cptr shm3=(lds_cptr)shm; const lds_cptr kp0=shm3+LDS_K+hi*1024+r32*16; const lds_cptr vp0=shm3+LDS_V+((lane>>4)&1)*32+(lane&3)*8+(4*hi+((lane&15)>>2))*64;
  #define VS(t) ((((t))&3)*SLOTB)
  DMA_K(0,0);DMA_V(0,VS(0));DMA_K(1,SLOTB);
  bf16x8 qr[4];
  #pragma unroll
  for(int d0=0;d0<4;++d0)qr[d0]=*reinterpret_cast<const bf16x8*>(&Qw[(long)r32*PITCH+d0*16+hi*8]);
  const int qrel=wid*QBLK+r32;
  u32x4 kdg[4];
  { const bf16*Kd=Kh+(long)(q0+qrel)*PITCH;
    #pragma unroll
    for(int d0=0;d0<4;++d0)kdg[d0]=*reinterpret_cast<const u32x4*>(&Kd[d0*16+hi*8]); }
  const float sl2=__uint_as_float(__builtin_amdgcn_readfirstlane(__float_as_uint(__builtin_amdgcn_exp2f(-(float)(h+1))*1.4426950408889634f)));
  unsigned sel=0u;
  if(c>0){
    if(tid<c*64) kml[tid]=kmean[((long)(b*8)+(tid>>6))*512+h*64+(tid&63)];
    asm volatile("s_waitcnt vmcnt(0) lgkmcnt(0)\n\ts_barrier":::"memory");
    if(c<=3) sel=(1u<<c)-1u;
    else{
      float g[8];
      #pragma unroll
      for(int j=0;j<8;++j){ g[j]=-INFINITY;
        if(j<c){ float a=0.f;
          #pragma unroll
          for(int d0=0;d0<4;++d0){ const u32x4 qv=__builtin_bit_cast(u32x4,qr[d0]); const float*km=kml+j*64+d0*16+hi*8;
            const float4 k0=*(const float4*)km, k1=*(const float4*)(km+4);
            a+=bl(qv.x)*k0.x+bh(qv.x)*k0.y+bl(qv.y)*k0.z+bh(qv.y)*k0.w+bl(qv.z)*k1.x+bh(qv.z)*k1.y+bl(qv.w)*k1.z+bh(qv.w)*k1.w; }
          g[j]=xhalf_sum(a); } }
      #pragma unroll
      for(int j=0;j<8;++j){ int rank=0;
        #pragma unroll
        for(int j2=0;j2<8;++j2){ if(j2!=j) rank+=((g[j2]>g[j])||(g[j2]==g[j]&&j2<j))?1:0; }
        if(j<c&&rank<3) sel|=(1u<<j); }
    }
  }
  float mhat;
  { float a=0.f;
    #pragma unroll
    for(int d0=0;d0<4;++d0){ const u32x4 kv=kdg[d0]; const u32x4 qv=__builtin_bit_cast(u32x4,qr[d0]);
      a+=bl(qv.x)*bl(kv.x)+bh(qv.x)*bh(kv.x)+bl(qv.y)*bl(kv.y)+bh(qv.y)*bh(kv.y)+bl(qv.z)*bl(kv.z)+bh(qv.z)*bh(kv.z)+bl(qv.w)*bl(kv.w)+bh(qv.w)*bh(kv.w); }
    mhat=xhalf_sum(a)+sl2*(float)qrel; }
  float l_reg=0.f;f32x16 o[2];o[0]=f32x16{};o[1]=f32x16{};
  f32x16 negm;
  #pragma unroll
  for(int r=0;r<16;++r)negm[r]=sl2*(float)((r&3)+8*(r>>2))-mhat;
  asm volatile("":"+v"(negm));
  #define MBIAS(P0,P1,t) do{ const int T_=NT-1-(t); const int jb_=T_-(NT-4); float a0_=sl2*(float)(64*jb_+4*hi); \
      if(jb_<0){ if(!((sel>>(T_>>2))&1u)) a0_=-INFINITY; } const float a1_=a0_+32.f*sl2; \
      _Pragma("unroll") for(int r=0;r<16;++r){P0[r]+=a0_;P1[r]+=a1_;} \
      if(jb_>=0)cmask(P0,P1,jb_,qrel,hi); }while(0)
  bool resc=false;
  #define RESC() do{ if(resc){ asm volatile("s_waitcnt lgkmcnt(0)":::"memory"); \
      _Pragma("unroll") for(int d_=0;d_<2;++d_) _Pragma("unroll") for(int r=0;r<16;++r)o[d_][r]*=wsf[crow(r,hi)]; } }while(0)
  f32x16 pA0,pA1,pB0,pB1;
  int sl_prev=0,sl_cur=0,sl_next=SLOTB;
  #define ROT() do{sl_prev=sl_cur;sl_cur=sl_next;sl_next=(sl_next==(NSLOT-1)*SLOTB)?0:sl_next+SLOTB;}while(0)
  DMA_K(2,2*SLOTB);DMA_V(1,VS(1));
  WAIT_BAR(2);
  qkt(pA0,pA1,Kbase,qr,negm,r32,hi);asm volatile("s_nop 15\n\ts_nop 7":"+v"(pA0),"+v"(pA1));MBIAS(pA0,pA1,0);
  { const float rm=rowmax(pA0,pA1);
    if(__any(rm>(float)THRL)){ const float dl=__builtin_fmaxf(rm,0.f);
      _Pragma("unroll") for(int r=0;r<16;++r){pA0[r]-=dl;pA1[r]-=dl;negm[r]-=dl;}
      asm volatile("":"+v"(negm)); } }
  _Pragma("unroll") for(int r=0;r<16;++r){pA0[r]=__builtin_amdgcn_exp2f(pA0[r]);pA1[r]=__builtin_amdgcn_exp2f(pA1[r]);}
  WAIT_BAR(2);
  DMA_K(3,0);DMA_V(2,VS(2));
  ROT();
  kload8(kf,kp0+sl_cur);
  WAIT_BAR(3);
  s16x4 vlo[8],vhi[8]; u32x4 pw0,pw1,pw2,pw3;
  #define PKW(P,B) cvtpk_s(P[B],P[B+1])
  #define PAF(k) __builtin_bit_cast(bf16x8,pw##k)
  #define VFR(i) (bf16x8){vlo[i][0],vlo[i][1],vlo[i][2],vlo[i][3],vhi[i][0],vhi[i][1],vhi[i][2],vhi[i][3]}
  #define PIN(x) asm volatile("":"+v"(x))
  #define MX3(a,b,c) __builtin_fmaxf(__builtin_fmaxf((a),(b)),(c))
  #define GAPA(MF,A0,A1,A2,A3,W0,W1,PW) do{ MF; sacc+=A0; sacc+=A1; sacc+=A2; sacc+=A3; PIN(sacc); W0; W1; PIN(PW); SBAR(); }while(0)
  #define EX(v) __builtin_amdgcn_exp2f(v)
  #define GAPB(MF,X,B) do{ MF; X[B]=EX(X[B]); X[B+1]=EX(X[B+1]); X[B+2]=EX(X[B+2]); X[B+3]=EX(X[B+3]); PIN(X); SBAR(); }while(0)
  #define VRD(i) do{ vlo[i]=vtr(vp_+(((i)>>2)*4096+((i)&3)*1024)); vhi[i]=vtr(vp_+(((i)>>2)*4096+((i)&3)*1024+512)); }while(0)
  #define KRD(G,j) do{ if(G){ kload2(kf,kp0+sl_next,j); SBAR(); } }while(0)
  #define STEP(C0,C1,P0,P1,t,GK,GV,GL) do{ SBAR(); \
    const lds_cptr vp_=vp0+VS((t)-1); \
    VRD(0); SBAR(); float sacc=(P0[0]+P0[1]); \
    GAPA(C0=__builtin_amdgcn_mfma_f32_32x32x16_bf16(kf[0],qr[0],negm,0,0,0), P0[2],P0[3],P0[4],P0[5],     pw0[0]=PKW(P0,0), pw0[1]=PKW(P0,2), pw0); \
    VRD(4); SBAR(); GAPA(C1=__builtin_amdgcn_mfma_f32_32x32x16_bf16(kf[1],qr[0],negm,0,0,0), P0[6],P0[7],P0[8],P0[9],     pw0[2]=PKW(P0,4), pw0[3]=PKW(P0,6), pw0); \
    VRD(1); SBAR(); GAPA(C0=__builtin_amdgcn_mfma_f32_32x32x16_bf16(kf[2],qr[1],C0,0,0,0),   P0[10],P0[11],P0[12],P0[13], pw1[0]=PKW(P0,8), pw1[1]=PKW(P0,10), pw1); \
    VRD(5); SBAR(); GAPA(C1=__builtin_amdgcn_mfma_f32_32x32x16_bf16(kf[3],qr[1],C1,0,0,0),   P0[14],P0[15],P1[0],P1[1],   pw1[2]=PKW(P0,12),pw1[3]=PKW(P0,14), pw1); \
    VRD(2); SBAR(); GAPA(C0=__builtin_amdgcn_mfma_f32_32x32x16_bf16(kf[4],qr[2],C0,0,0,0),   P1[2],P1[3],P1[4],P1[5],     pw2[0]=PKW(P1,0), pw2[1]=PKW(P1,2), pw2); \
    VRD(6); SBAR(); GAPA(C1=__builtin_amdgcn_mfma_f32_32x32x16_bf16(kf[5],qr[2],C1,0,0,0),   P1[6],P1[7],P1[8],P1[9],     pw2[2]=PKW(P1,4), pw2[3]=PKW(P1,6), pw2); \
    VRD(3); SBAR(); GAPA(C0=__builtin_amdgcn_mfma_f32_32x32x16_bf16(kf[6],qr[3],C0,0,0,0),   P1[10],P1[11],P1[12],P1[13], pw3[0]=PKW(P1,8), pw3[1]=PKW(P1,10), pw3); \
    VRD(7); SBAR(); GAPA(C1=__builtin_amdgcn_mfma_f32_32x32x16_bf16(kf[7],qr[3],C1,0,0,0),   P1[14],P1[15],0.f,0.f,       pw3[2]=PKW(P1,12),pw3[3]=PKW(P1,14), pw3); \
    l_reg+=sacc; \
    if(GK){DMA_K((t)+3,sl_cur);} if(GV){DMA_V((t)+2,VS((t)+2));} \
    MBIAS(C0,C1,t); \
    { float a=MX3(C0[0],C0[1],C1[0]),b=MX3(C0[2],C0[3],C1[1]); a=MX3(a,C1[2],C1[3]); \
      _Pragma("unroll") for(int r=4;r<16;r+=4){a=MX3(a,C0[r],C0[r+1]);b=MX3(b,C0[r+2],C0[r+3]);a=MX3(a,C1[r],C1[r+1]);b=MX3(b,C1[r+2],C1[r+3]);} \
      float rm=__builtin_fmaxf(a,b); { auto rr=__builtin_amdgcn_permlane32_swap(__float_as_uint(rm),__float_as_uint(rm),false,false); rm=__builtin_fmaxf(__uint_as_float(rr[0]),__uint_as_float(rr[1])); } \
      resc=false; \
      if(__builtin_expect(__any(rm>(float)THRL),0)){ const float dl=__builtin_fmaxf(rm,0.f); \
        _Pragma("unroll") for(int r=0;r<16;++r){C0[r]-=dl;C1[r]-=dl;} \
        _Pragma("unroll") for(int r=0;r<16;++r)negm[r]-=dl; asm volatile("":"+v"(negm)); \
        const float f=__builtin_amdgcn_exp2f(-dl); l_reg*=f; if(hi==0)wsf[r32]=f; resc=true; } } \
    SBAR(); \
    GAPB(o[0]=__builtin_amdgcn_mfma_f32_32x32x16_bf16(PAF(0),VFR(0),o[0],0,0,0), C0,0); \
    GAPB(o[1]=__builtin_amdgcn_mfma_f32_32x32x16_bf16(PAF(0),VFR(4),o[1],0,0,0), C0,4); \
    KRD(GL,0); GAPB(o[0]=__builtin_amdgcn_mfma_f32_32x32x16_bf16(PAF(1),VFR(1),o[0],0,0,0), C0,8); \
    KRD(GL,1); GAPB(o[1]=__builtin_amdgcn_mfma_f32_32x32x16_bf16(PAF(1),VFR(5),o[1],0,0,0), C0,12); \
    KRD(GL,2); GAPB(o[0]=__builtin_amdgcn_mfma_f32_32x32x16_bf16(PAF(2),VFR(2),o[0],0,0,0), C1,0); \
    KRD(GL,3); GAPB(o[1]=__builtin_amdgcn_mfma_f32_32x32x16_bf16(PAF(2),VFR(6),o[1],0,0,0), C1,4); \
    GAPB(o[0]=__builtin_amdgcn_mfma_f32_32x32x16_bf16(PAF(3),VFR(3),o[0],0,0,0), C1,8); \
    GAPB(o[1]=__builtin_amdgcn_mfma_f32_32x32x16_bf16(PAF(3),VFR(7),o[1],0,0,0), C1,12); \
    }while(0)
  int t=1;
  for(;t+5<NT;t+=2){
    STEP(pB0,pB1,pA0,pA1,t,true,true,true);     WAIT_BAR(3); RESC(); ROT();
    STEP(pA0,pA1,pB0,pB1,t+1,true,true,true);   WAIT_BAR(3); RESC(); ROT();
  }
  #define ENDW(tt) do{ if((tt)+3<NT){WAIT_BAR(3);} else if((tt)+2<NT){WAIT_BAR(2);} else {WAIT_BAR(0);} }while(0)
  for(;t+1<NT;t+=2){
    STEP(pB0,pB1,pA0,pA1,t,(t+3<NT),(t+2<NT),(t+1<NT));       ENDW(t);   RESC(); ROT();
    STEP(pA0,pA1,pB0,pB1,t+1,(t+4<NT),(t+3<NT),(t+2<NT));     ENDW(t+1); RESC(); ROT();
  }
  STEP(pB0,pB1,pA0,pA1,NT-1,false,false,false); RESC();
  { float sacc=pB0[0]+pB0[1]; _Pragma("unroll") for(int r=2;r<16;++r)sacc+=pB0[r]; _Pragma("unroll") for(int r=0;r<16;++r)sacc+=pB1[r]; l_reg+=sacc;
    pw0=(u32x4){PKW(pB0,0),PKW(pB0,2),PKW(pB0,4),PKW(pB0,6)};pw1=(u32x4){PKW(pB0,8),PKW(pB0,10),PKW(pB0,12),PKW(pB0,14)};pw2=(u32x4){PKW(pB1,0),PKW(pB1,2),PKW(pB1,4),PKW(pB1,6)};pw3=(u32x4){PKW(pB1,8),PKW(pB1,10),PKW(pB1,12),PKW(pB1,14)};
    SBAR(); pv(o,vb0+VS(NT-1),PAF(0),PAF(1),PAF(2),PAF(3)); }
  #undef PKW
  #undef PAF
  #undef VFR
  #undef PIN
  #undef MX3
  #undef GAPA
  #undef GAPB
  #undef EX
  #undef VRD
  #undef KRD
  #undef STEP
  #undef ENDW
  l_reg=xhalf_sum(l_reg);
  if(hi==0)wsf[32+r32]=l_reg;asm volatile("s_waitcnt lgkmcnt(0)":::"memory");
  float rli[16];
  #pragma unroll
  for(int r=0;r<16;++r)rli[r]=__builtin_amdgcn_rcpf(wsf[32+crow(r,hi)]);
  const bf16*Zw=Pz+(rowbase+q0+wid*QBLK)*PITCH+h*D; bf16*Ow=Po+(rowbase+q0+wid*QBLK)*PITCH+h*D;
  { bf16*stg=(bf16*)(shm+LDS_OST)+wid*2048;
    #pragma unroll
    for(int r=0;r<16;++r){const int orow=crow(r,hi);
      #pragma unroll
      for(int d0=0;d0<2;++d0)((unsigned short*)stg)[orow*64+d0*32+r32]=(unsigned short)cvtpk_s(o[d0][r]*rli[r],0.f);}
    asm volatile("s_waitcnt lgkmcnt(0)":::"memory");
    #pragma unroll
    for(int i=0;i<4;++i){const int row=i*8+(lane>>3),ch=lane&7; const u32x4 v=*(const u32x4*)(stg+row*64+ch*8);
      const u32x4 z=__builtin_nontemporal_load((const u32x4*)(Zw+(long)row*PITCH+ch*8)); u32x4*zp=(u32x4*)(Ow+(long)row*PITCH+ch*8); u32x4 w;
      w.x=cvtpk_s(bl(v.x)*bl(z.x),bh(v.x)*bh(z.x)); w.y=cvtpk_s(bl(v.y)*bl(z.y),bh(v.y)*bh(z.y)); w.z=cvtpk_s(bl(v.z)*bl(z.z),bh(v.z)*bh(z.z)); w.w=cvtpk_s(bl(v.w)*bl(z.w),bh(v.w)*bh(z.w));
      *zp=w; } }
  asm volatile("s_waitcnt lgkmcnt(0)\n\ts_barrier":::"memory");
  #undef DMA_K
  #undef DMA_V
  #undef VS
  #undef MBIAS
  #undef RESC
  #undef ROT
}
constexpr int ATTN_LDS_BYTES=LDS_BYTES;
#undef SBAR
#undef WAIT_BAR
}
namespace attna {
using moba::bf16; using moba::bf16x8; using moba::s16x4; using moba::f32x16; using moba::u32x4; using moba::lds_cptr;
using moba::crow; using moba::cvtpk_s; using moba::bl; using moba::bh; using moba::vtr; using moba::xhalf_sum;
constexpr int SEQ=2048,PITCH=4608;
constexpr int WK=0,WV=4608,WO=12800,WSC=16896,WBYTES=17152,LSE_OFF=8*WBYTES,LDS_BYTES=LSE_OFF+3*512*4;
#define AMFMA(a,b,c) __builtin_amdgcn_mfma_f32_32x32x16_bf16(a,b,c,0,0,0)

__device__ __forceinline__ void sub_item(bf16*P,int b,int hs,int g,int res,int l0,int chunk,char*wl,float*lse_l,int lane){
  asm volatile("":"+v"(lane));
  const int r32=lane&31,hi=lane>>5;
  const int dsh=2*g;
  const long rowb=(long)b*SEQ+res;
  const int qcol=g*768+hs*64;
  const float sl2=__builtin_amdgcn_exp2f(-(2.0f/3.0f)*(float)(4*g+hs+1))*(float)(1<<dsh)*1.4426950408889634f;
  #define AROW(l) ((rowb+((long)(l)<<dsh))*PITCH)
  #define KL(i,x) ((l0-128+32*(i)+(x))<0?0:(l0-128+32*(i)+(x)))
  const int i0=(l0>=128)?0:(4-(l0>>5));
  const int lrow=lane>>3, lch=lane&7;
  u32x4 qg[4],kg[5][4],vg[5][4];
  #pragma unroll
  for(int j=0;j<4;++j)qg[j]=*reinterpret_cast<const u32x4*>(P+AROW(l0+lrow+8*j)+qcol+lch*8);
  #pragma unroll
  for(int i=4;i>=0;--i)
    #pragma unroll
    for(int j=0;j<4;++j)kg[i][j]=*reinterpret_cast<const u32x4*>(P+AROW(KL(i,lrow+8*j))+qcol+256+lch*8);
  #pragma unroll
  for(int i=4;i>=0;--i)
    #pragma unroll
    for(int j=0;j<4;++j)vg[i][j]=*reinterpret_cast<const u32x4*>(P+AROW(KL(i,lrow+8*j))+qcol+512+lch*8);
  __builtin_amdgcn_sched_barrier(0);
  char*kb=wl+WK; const int kwoff=lrow*144+lch*16, kroff=r32*144+hi*16;
  bf16x8 qf[4];
  #pragma unroll
  for(int j=0;j<4;++j)*reinterpret_cast<u32x4*>(kb+kwoff+j*8*144)=qg[j];
  #pragma unroll
  for(int d0=0;d0<4;++d0)qf[d0]=*reinterpret_cast<const bf16x8*>(kb+kroff+d0*32);
  f32x16 S[5];
  #pragma unroll
  for(int i=4;i>=0;--i){
    #pragma unroll
    for(int j=0;j<4;++j)*reinterpret_cast<u32x4*>(kb+kwoff+j*8*144)=kg[i][j];
    bf16x8 kf[4];
    #pragma unroll
    for(int d0=0;d0<4;++d0)kf[d0]=*reinterpret_cast<const bf16x8*>(kb+kroff+d0*32);
    f32x16 acc=f32x16{};
    #pragma unroll
    for(int d0=0;d0<4;++d0)acc=AMFMA(kf[d0],qf[d0],acc);
    const float sbi=((i<i0)?-INFINITY:0.f)-sl2*(float)(32*(4-i)+r32-4*hi);
    #pragma unroll
    for(int r=0;r<16;++r){ const int kc=(r&3)+8*(r>>2); float v=__builtin_fmaf(sl2,(float)kc,acc[r]+sbi);
      if(i==4&&kc+4*hi>r32)v=-INFINITY; if(i==0&&kc+4*hi<r32)v=-INFINITY; acc[r]=v; }
    S[i]=acc;
  }
  float mx=-INFINITY;
  #pragma unroll
  for(int i=0;i<5;++i)
    #pragma unroll
    for(int r=0;r<16;++r)mx=fmaxf(mx,S[i][r]);
  { auto rr=__builtin_amdgcn_permlane32_swap(__float_as_uint(mx),__float_as_uint(mx),false,false); mx=fmaxf(__uint_as_float(rr[0]),__uint_as_float(rr[1])); }
  float ls=0.f;
  #pragma unroll
  for(int i=0;i<5;++i)
    #pragma unroll
    for(int r=0;r<16;++r){ const float p=__builtin_amdgcn_exp2f(S[i][r]-mx); S[i][r]=p; ls+=p; }
  ls=xhalf_sum(ls);
  f32x16 o[2]; o[0]=f32x16{}; o[1]=f32x16{};
  const lds_cptr wl3=(lds_cptr)wl;
  const int vtoff=((lane>>4)&1)*32+(lane&3)*8+(4*hi+((lane&15)>>2))*64;
  const int vwoff=(lch>>2)*2048+lrow*64+(lch&3)*16;
  #define PVSTEP(i) do{ char*vb_=wl+WV+((i)&1)*4096; \
      _Pragma("unroll") for(int j=0;j<4;++j)*reinterpret_cast<u32x4*>(vb_+vwoff+j*8*64)=vg[i][j]; \
      const u32x4 pw0=(u32x4){cvtpk_s(S[i][0],S[i][1]),cvtpk_s(S[i][2],S[i][3]),cvtpk_s(S[i][4],S[i][5]),cvtpk_s(S[i][6],S[i][7])}; \
      const u32x4 pw1=(u32x4){cvtpk_s(S[i][8],S[i][9]),cvtpk_s(S[i][10],S[i][11]),cvtpk_s(S[i][12],S[i][13]),cvtpk_s(S[i][14],S[i][15])}; \
      const lds_cptr vp=wl3+WV+((i)&1)*4096+vtoff; \
      _Pragma("unroll") for(int d0=0;d0<2;++d0){ \
        const s16x4 a0=vtr(vp+d0*2048),a1=vtr(vp+d0*2048+512),b0=vtr(vp+d0*2048+1024),b1=vtr(vp+d0*2048+1536); \
        const bf16x8 f0=(bf16x8){a0[0],a0[1],a0[2],a0[3],a1[0],a1[1],a1[2],a1[3]}, f1=(bf16x8){b0[0],b0[1],b0[2],b0[3],b1[0],b1[1],b1[2],b1[3]}; \
        o[d0]=AMFMA(__builtin_bit_cast(bf16x8,pw0),f0,o[d0]); \
        o[d0]=AMFMA(__builtin_bit_cast(bf16x8,pw1),f1,o[d0]); } }while(0)
  PVSTEP(4); PVSTEP(3); PVSTEP(2); PVSTEP(1); PVSTEP(0);
  float*ws=(float*)(wl+WSC);
  const int tokc=((l0+r32)<<dsh)+res-chunk*512;
  if(hi==0){ ws[r32]=__builtin_amdgcn_rcpf(ls); lse_l[g*512+tokc]=mx+__builtin_amdgcn_logf(ls); }
  bf16*stg=(bf16*)(wl+WO);
  #pragma unroll
  for(int r=0;r<16;++r){ const int orow=crow(r,hi); const float il=ws[orow];
    #pragma unroll
    for(int d0=0;d0<2;++d0)((unsigned short*)stg)[orow*64+d0*32+r32]=(unsigned short)cvtpk_s(o[d0][r]*il,0.f); }
  #pragma unroll
  for(int i=0;i<4;++i){ const int row=i*8+(lane>>3),ch=lane&7; const u32x4 v=*reinterpret_cast<const u32x4*>(stg+row*64+ch*8);
    *reinterpret_cast<u32x4*>(P+AROW(l0+row)+qcol+ch*8)=v; }
  #undef AROW
  #undef KL
  #undef PVSTEP
}

__device__ __forceinline__ void wg_item(bf16*P,int b,int hs,int chunk,char*shm){
  int tid_=threadIdx.x; asm volatile("":"+v"(tid_));
  const int tid=tid_,lane=tid&63; const int wid=__builtin_amdgcn_readfirstlane(tid>>6);
  char*wl=shm+wid*WBYTES; float*lse_l=(float*)(shm+LSE_OFF);
  #pragma unroll 1
  for(int i6=0;i6<6;++i6){
    const int si=wid+8*i6, g=si>>4, k=si&15;
    int res,l0;
    if(g==0){res=0;l0=32*(chunk*16+k);} else if(g==1){res=k>>2;l0=128*chunk+32*(k&3);} else {res=k;l0=32*chunk;}
    sub_item(P,b,hs,g,res,l0,chunk,wl,lse_l,lane);
  }
  __syncthreads();
  #pragma unroll
  for(int idx=tid;idx<512*8;idx+=512){
    const int tok=idx>>3,ch=idx&7; const long row=((long)b*SEQ+chunk*512+tok)*PITCH;
    const float e0=lse_l[tok],e1=lse_l[512+tok],e2=lse_l[1024+tok]; const float em=fmaxf(e0,fmaxf(e1,e2));
    float w0=__builtin_amdgcn_exp2f(e0-em),w1=__builtin_amdgcn_exp2f(e1-em),w2=__builtin_amdgcn_exp2f(e2-em); const float iw=__builtin_amdgcn_rcpf(w0+w1+w2); w0*=iw;w1*=iw;w2*=iw;
    const u32x4 a=*reinterpret_cast<const u32x4*>(P+row+hs*64+ch*8), bq=*reinterpret_cast<const u32x4*>(P+row+768+hs*64+ch*8), cq=*reinterpret_cast<const u32x4*>(P+row+1536+hs*64+ch*8);
    u32x4*zp=reinterpret_cast<u32x4*>(P+row+2304+hs*64+ch*8); const u32x4 z=__builtin_nontemporal_load(zp); u32x4 w;
    #define CMB(f) cvtpk_s((w0*bl(a.f)+w1*bl(bq.f)+w2*bl(cq.f))*bl(z.f),(w0*bh(a.f)+w1*bh(bq.f)+w2*bh(cq.f))*bh(z.f))
    w.x=CMB(x); w.y=CMB(y); w.z=CMB(z); w.w=CMB(w);
    #undef CMB
    *zp=w;
  }
  __syncthreads();
}
#undef AMFMA
}

constexpr int NWAVES = 8;
constexpr int BATCH = 16, SEQ = 2048, DM = 1024, M = BATCH * SEQ, DEPTH = 2;
constexpr int INC = 6656;
constexpr int LDP = 4608;
constexpr int C_AQKV = 0, C_ZA = 2304, C_BQKV = 2560, C_ZB = 4096, C_RA = 4608, C_RB = 5632;
constexpr int C_MERGED = 0;
constexpr float RMS_EPS = 1e-6f;
constexpr size_t MiB = 1u << 20;
constexpr size_t WS_CTL = 0;
constexpr size_t WS_BAR = 0, WS_BAR_BYTES = 64 * 1024;
constexpr size_t WS_KMEAN = 256 * 1024;
constexpr size_t WS_WIN = 1 * MiB;
constexpr size_t WS_WCAT = 14 * MiB;
constexpr size_t WS_WOUT = 17 * MiB;
constexpr size_t WS_XB = 21 * MiB;
constexpr size_t WS_PROJ = 85 * MiB;
constexpr size_t WS_GATES = 373 * MiB;
constexpr size_t WS_WIN1 = 437 * MiB;
constexpr size_t WS_ROWSS = 450 * MiB;
constexpr size_t WS_XB8 = 454 * MiB;
constexpr size_t WS_W8 = 486 * MiB;
constexpr size_t WS_COLMAX = 32 * 1024;
constexpr size_t WS_XSCALE = 128 * 1024;
constexpr int W8R = 256 * pg8::N8T + 2048;
constexpr size_t WS_END = WS_W8 + 2 * (size_t)W8R * 1024;
static_assert(WS_PROJ + (size_t)M * LDP * 2 == WS_GATES && WS_GATES + (size_t)M * 2048 == WS_WIN1, "ws map");
constexpr int LDS_MISC = pg8::EPI_OFF + 8 * pg8::EPI_WAVE;
constexpr int LDS_RSTAB = LDS_MISC + 256;
constexpr int LDS_BYTES = LDS_RSTAB + 1024 + 64;

#define LAS __attribute__((address_space(3)))
typedef unsigned short bf16;
typedef unsigned v4u __attribute__((ext_vector_type(4)));
typedef float f32x4 __attribute__((ext_vector_type(4)));
#define RLX_AGENT __ATOMIC_RELAXED, __HIP_MEMORY_SCOPE_AGENT
#define XB_TMO      128
#define XB_XCNT(j)  (256  + 64 * (j))
#define XB_XSUB(j)  (1280 + 64 * (j))
#define XB_XGEN(j)  (2304 + 64 * (j))
#define XB_TOP      3328
#define XB_TOPGEN   3392
#define XCD_BAR_WORDS 3456
#define XB_SPIN_CAP (1u << 18)

__device__ __forceinline__ unsigned xb_ld(unsigned* p)              { return __hip_atomic_load(p, __ATOMIC_RELAXED, __HIP_MEMORY_SCOPE_AGENT); }
__device__ __forceinline__ unsigned xb_add(unsigned* p, unsigned v) { return __hip_atomic_fetch_add(p, v, __ATOMIC_RELAXED, __HIP_MEMORY_SCOPE_AGENT); }
__device__ __forceinline__ unsigned xb_xcc_id() { return (unsigned)__builtin_amdgcn_s_getreg((3 << 11) | 20) & 0xFu; }
#define XB_SPIN(cond, bar) do { unsigned _sp = 0; while (cond) { __builtin_amdgcn_s_sleep(1); \
    if ((++_sp & 255u) == 0u) { if (xb_ld(&(bar)[XB_TMO])) break; if (_sp > XB_SPIN_CAP) { atomicAdd(&(bar)[XB_TMO], 1u); break; } } } } while (0)

struct XcdBarrier {
    unsigned* bar; unsigned x;
    volatile LAS unsigned* st;
};

__device__ __forceinline__ XcdBarrier xcd_barrier_post(unsigned* bar, volatile LAS unsigned* st) {
    XcdBarrier b; b.bar = bar; b.x = xb_xcc_id(); b.st = st;
    if (threadIdx.x == 0) (void)xb_add(&bar[XB_XCNT(b.x)], 1u);
    return b;
}
__device__ __forceinline__ void xcd_barrier_complete(unsigned* bar, unsigned x, unsigned& nloc, unsigned& nx) {
    const unsigned G = gridDim.x * gridDim.y * gridDim.z;
    unsigned sum, cnt, mine, sp = 0u;
    for (;;) {
        sum = 0u; cnt = 0u; mine = 0u;
#pragma unroll
        for (unsigned j = 0; j < 16; ++j) { const unsigned c = xb_ld(&bar[XB_XCNT(j)]); sum += c; cnt += (c > 0u) ? 1u : 0u; mine = (j == x) ? c : mine; }
        if (sum == G) break;
        __builtin_amdgcn_s_sleep(1);
        if ((++sp & 255u) == 0u) { if (xb_ld(&bar[XB_TMO])) break; if (sp > XB_SPIN_CAP) { atomicAdd(&bar[XB_TMO], 1u); break; } }
    }
    nloc = mine > 0u ? mine : 1u; nx = cnt > 0u ? cnt : 1u;
}

__device__ __forceinline__ void xcd_barrier(const XcdBarrier& b) {
    asm volatile("s_waitcnt vmcnt(0)" ::: "memory");
    __syncthreads();
    if (threadIdx.x == 0) {
        unsigned* bar = b.bar;
        __builtin_amdgcn_s_waitcnt(0);
        unsigned nloc = b.st[0], nx = b.st[1];
        if (nloc == 0u) { xcd_barrier_complete(bar, b.x, nloc, nx); b.st[0] = nloc; b.st[1] = nx; }
        const unsigned old = xb_add(&bar[XB_XSUB(b.x)], 1u);
        const unsigned gen = old / nloc;
        if (old + 1u == (gen + 1u) * nloc) {
            __builtin_amdgcn_fence(__ATOMIC_RELEASE, "agent");
            asm volatile("s_waitcnt vmcnt(0)" ::: "memory");
            const unsigned og = xb_add(&bar[XB_TOP], 1u);
            const unsigned tg = og / nx;
            if (og + 1u == (tg + 1u) * nx) xb_add(&bar[XB_TOPGEN], 1u);
            else XB_SPIN(xb_ld(&bar[XB_TOPGEN]) == tg, bar);
            __builtin_amdgcn_fence(__ATOMIC_ACQUIRE, "agent");
            xb_add(&bar[XB_XGEN(b.x)], 1u);
            asm volatile("s_waitcnt vmcnt(0)" ::: "memory");
        } else {
            XB_SPIN(xb_ld(&bar[XB_XGEN(b.x)]) == gen, bar);
            __builtin_amdgcn_fence(__ATOMIC_ACQUIRE, "agent");
            asm volatile("s_waitcnt vmcnt(0)" ::: "memory");
        }
    }
    __syncthreads();
}

__device__ __forceinline__ unsigned f2bf(float f) { unsigned u = __builtin_bit_cast(unsigned, f); return (u + 0x7fffu + ((u >> 16) & 1u)) >> 16; }
__device__ __forceinline__ unsigned pk2(float lo, float hi) { return f2bf(lo) | (f2bf(hi) << 16); }
__device__ __forceinline__ float bf2f(bf16 v) { return __uint_as_float(((unsigned)v) << 16); }
__device__ __forceinline__ float blo(unsigned u) { return __uint_as_float(u << 16); }
__device__ __forceinline__ float bhi(unsigned u) { return __uint_as_float(u & 0xffff0000u); }
__device__ __forceinline__ float wave_sum(float v) {
#pragma unroll
    for (int o = 1; o < 64; o <<= 1) v += __shfl_xor(v, o);
    return v;
}
__device__ __forceinline__ float wave_max(float v) {
#pragma unroll
    for (int o = 1; o < 64; o <<= 1) v = fmaxf(v, __shfl_xor(v, o));
    return v;
}
__device__ __forceinline__ void transpose_item(const float* W, int K, int N, bf16* WT, int ldw, LAS float* scr, int item, int lane, const float* gain = nullptr, int nsrc = -1) {
    const int nblk = N / 32, kb = item / nblk, nb = item % nblk, k0 = 64 * kb, n0 = 32 * nb; W += (nsrc >= 0 ? nsrc - n0 : 0);
    f32x4 v[8]; float gk[8];
#pragma unroll
    for (int i = 0; i < 8; ++i) { const int kk = 8 * i + (lane >> 3); v[i] = __builtin_nontemporal_load((const f32x4*)(W + (size_t)(k0 + kk) * N + n0 + 4 * (lane & 7))); gk[i] = gain ? gain[k0 + kk] : 1.0f; }
#pragma unroll
    for (int i = 0; i < 8; ++i) { const int kk = 8 * i + (lane >> 3); LAS float* d = scr + kk * 33 + 4 * (lane & 7); d[0] = v[i].x * gk[i]; d[1] = v[i].y * gk[i]; d[2] = v[i].z * gk[i]; d[3] = v[i].w * gk[i]; }
    asm volatile("s_waitcnt lgkmcnt(0)" ::: "memory");
    const int c = lane & 7;
#pragma unroll
    for (int j = 0; j < 4; ++j) { const int n = (lane >> 3) + 8 * j; const LAS float* s = scr + (8 * c) * 33 + n;
        v4u o; o.x = pk2(s[0 * 33], s[1 * 33]); o.y = pk2(s[2 * 33], s[3 * 33]); o.z = pk2(s[4 * 33], s[5 * 33]); o.w = pk2(s[6 * 33], s[7 * 33]);
        *(v4u*)(WT + (size_t)(n0 + n) * ldw + k0 + 8 * c) = o; }
    asm volatile("s_waitcnt lgkmcnt(0)" ::: "memory");
}
template <bool OUT_BF16> __device__ __forceinline__ void rms_row(const float* xrow, const float* g, void* orow, int lane) {
    const f32x4* xr = (const f32x4*)xrow + lane; const f32x4* gr = (const f32x4*)g + lane;
    f32x4 v[4]; float s = 0.f;
#pragma unroll
    for (int j = 0; j < 4; ++j) { v[j] = xr[64 * j]; s += (v[j].x * v[j].x + v[j].y * v[j].y) + (v[j].z * v[j].z + v[j].w * v[j].w); }
    const float rstd = 1.0f / sqrtf(wave_sum(s) * (1.f / DM) + RMS_EPS);
#pragma unroll
    for (int j = 0; j < 4; ++j) { const f32x4 gg = gr[64 * j]; v[j] = v[j] * rstd * gg; }
    if (OUT_BF16) { unsigned long long* o8 = (unsigned long long*)orow + lane;
#pragma unroll
        for (int j = 0; j < 4; ++j) o8[64 * j] = (unsigned long long)pk2(v[j].x, v[j].y) | ((unsigned long long)pk2(v[j].z, v[j].w) << 32);
    } else { f32x4* o = (f32x4*)orow + lane;
#pragma unroll
        for (int j = 0; j < 4; ++j) o[64 * j] = v[j]; }
}
__device__ __forceinline__ unsigned pack_i8x4(float a, float b, float c, float d) {
    const int ia = (int)__builtin_rintf(fminf(fmaxf(a, -127.f), 127.f)), ib = (int)__builtin_rintf(fminf(fmaxf(b, -127.f), 127.f)), ic = (int)__builtin_rintf(fminf(fmaxf(c, -127.f), 127.f)), id = (int)__builtin_rintf(fminf(fmaxf(d, -127.f), 127.f));
    return (unsigned)(ia & 255) | ((unsigned)(ib & 255) << 8) | ((unsigned)(ic & 255) << 16) | ((unsigned)(id & 255) << 24);
}
__device__ __forceinline__ void raw_row(const float* xrow, bf16* orow, float* ss, signed char* o8row, float* xs, int lane) {
    const f32x4* xr = (const f32x4*)xrow + lane; f32x4 v[4]; float s = 0.f, mx = 0.f;
#pragma unroll
    for (int j = 0; j < 4; ++j) { v[j] = __builtin_nontemporal_load(xr + 64 * j); s += (v[j].x * v[j].x + v[j].y * v[j].y) + (v[j].z * v[j].z + v[j].w * v[j].w);
        mx = fmaxf(mx, fmaxf(fmaxf(fabsf(v[j].x), fabsf(v[j].y)), fmaxf(fabsf(v[j].z), fabsf(v[j].w)))); }
    s = wave_sum(s); if (lane < 16) ss[lane] = (lane == 0) ? s : 0.f;
    mx = wave_max(mx); const float sc = mx > 0.f ? mx * (1.0f / 127.0f) : 1.0f, isc = 1.0f / sc; if (lane == 0) *xs = sc;
    unsigned* q8 = (unsigned*)o8row + lane; (void)orow;
#pragma unroll
    for (int j = 0; j < 4; ++j) q8[64 * j] = pack_i8x4(v[j].x * isc, v[j].y * isc, v[j].z * isc, v[j].w * isc);
}
__device__ __forceinline__ void quant_row(const bf16* xrow, signed char* o8row, float* xs, int lane) {
    typedef unsigned u32x2_t __attribute__((ext_vector_type(2)));
    const u32x2_t* xr = (const u32x2_t*)xrow + lane; u32x2_t b[4]; float mx = 0.f;
#pragma unroll
    for (int j = 0; j < 4; ++j) { b[j] = xr[64 * j]; mx = fmaxf(mx, fmaxf(fmaxf(fabsf(blo(b[j].x)), fabsf(bhi(b[j].x))), fmaxf(fabsf(blo(b[j].y)), fabsf(bhi(b[j].y))))); }
    mx = wave_max(mx); const float sc = mx > 0.f ? mx * (1.0f / 127.0f) : 1.0f, isc = 1.0f / sc; if (lane == 0) *xs = sc;
    unsigned* q8 = (unsigned*)o8row + lane;
#pragma unroll
    for (int j = 0; j < 4; ++j) q8[64 * j] = pack_i8x4(blo(b[j].x) * isc, bhi(b[j].x) * isc, blo(b[j].y) * isc, bhi(b[j].y) * isc);
}
__device__ __forceinline__ void quant_strip_wg(const float* W, const float* gain, signed char* W8, float* wscale, LAS float* scr, LAS float* cmw, int strip, int lane, int wave) {
    const int n0 = 32 * strip; const int tj = n0 >> 8; const int src0 = tj < pg8::N8T ? 256 * pg8::tile_of(tj) + (n0 & 255) : 4608 + (n0 - 256 * pg8::N8T);
    const float* Wc = W + src0 + 4 * (lane & 7);
    f32x4 v[2][8]; float gk[2][8]; f32x4 m4 = (f32x4){0.f, 0.f, 0.f, 0.f};
#pragma unroll
    for (int q = 0; q < 2; ++q)
#pragma unroll
        for (int i = 0; i < 8; ++i) { const int kk = 64 * (2 * wave + q) + 8 * i + (lane >> 3); v[q][i] = *(const f32x4*)(Wc + (size_t)kk * INC); gk[q][i] = gain[kk]; }
#pragma unroll
    for (int q = 0; q < 2; ++q)
#pragma unroll
        for (int i = 0; i < 8; ++i) { v[q][i] = v[q][i] * gk[q][i]; m4.x = fmaxf(m4.x, fabsf(v[q][i].x)); m4.y = fmaxf(m4.y, fabsf(v[q][i].y)); m4.z = fmaxf(m4.z, fabsf(v[q][i].z)); m4.w = fmaxf(m4.w, fabsf(v[q][i].w)); }
#pragma unroll
    for (int o = 8; o < 64; o <<= 1) { m4.x = fmaxf(m4.x, __shfl_xor(m4.x, o)); m4.y = fmaxf(m4.y, __shfl_xor(m4.y, o)); m4.z = fmaxf(m4.z, __shfl_xor(m4.z, o)); m4.w = fmaxf(m4.w, __shfl_xor(m4.w, o)); }
    if (lane < 8) { LAS float* c = cmw + wave * 32 + 4 * lane; c[0] = m4.x; c[1] = m4.y; c[2] = m4.z; c[3] = m4.w; }
    __syncthreads();
    const int n = lane & 31, kh = lane >> 5; float cmx = 0.f;
#pragma unroll
    for (int w = 0; w < 8; ++w) cmx = fmaxf(cmx, cmw[w * 32 + n]);
    const float sc = cmx > 0.f ? cmx * (1.0f / 127.0f) : 1.0f, isc = 1.0f / sc;
    if (wave == 0 && kh == 0) wscale[n0 + n] = sc;
#pragma unroll
    for (int q = 0; q < 2; ++q) {
#pragma unroll
        for (int i = 0; i < 8; ++i) { const int kk = 8 * i + (lane >> 3); LAS float* d = scr + kk * 33 + 4 * (lane & 7); d[0] = v[q][i].x; d[1] = v[q][i].y; d[2] = v[q][i].z; d[3] = v[q][i].w; }
        asm volatile("s_waitcnt lgkmcnt(0)" ::: "memory");
        const LAS float* s = scr + (32 * kh) * 33 + n; v4u o0, o1;
        o0.x = pack_i8x4(s[0 * 33] * isc, s[1 * 33] * isc, s[2 * 33] * isc, s[3 * 33] * isc); o0.y = pack_i8x4(s[4 * 33] * isc, s[5 * 33] * isc, s[6 * 33] * isc, s[7 * 33] * isc);
        o0.z = pack_i8x4(s[8 * 33] * isc, s[9 * 33] * isc, s[10 * 33] * isc, s[11 * 33] * isc); o0.w = pack_i8x4(s[12 * 33] * isc, s[13 * 33] * isc, s[14 * 33] * isc, s[15 * 33] * isc);
        o1.x = pack_i8x4(s[16 * 33] * isc, s[17 * 33] * isc, s[18 * 33] * isc, s[19 * 33] * isc); o1.y = pack_i8x4(s[20 * 33] * isc, s[21 * 33] * isc, s[22 * 33] * isc, s[23 * 33] * isc);
        o1.z = pack_i8x4(s[24 * 33] * isc, s[25 * 33] * isc, s[26 * 33] * isc, s[27 * 33] * isc); o1.w = pack_i8x4(s[28 * 33] * isc, s[29 * 33] * isc, s[30 * 33] * isc, s[31 * 33] * isc);
        v4u* dst = (v4u*)(W8 + (size_t)(n0 + n) * 1024 + 64 * (2 * wave + q) + 32 * kh); dst[0] = o0; dst[1] = o1;
        asm volatile("s_waitcnt lgkmcnt(0)" ::: "memory");
    }
    __syncthreads();
}
__device__ __forceinline__ float dot64(const v4u (&q)[8], const bf16* krow) {
    const v4u* kp = (const v4u*)krow; float a0 = 0.f, a1 = 0.f;
#pragma unroll
    for (int i = 0; i < 8; ++i) { const v4u k = kp[i];
        a0 += blo(q[i].x) * blo(k.x) + blo(q[i].y) * blo(k.y) + blo(q[i].z) * blo(k.z) + blo(q[i].w) * blo(k.w);
        a1 += bhi(q[i].x) * bhi(k.x) + bhi(q[i].y) * bhi(k.y) + bhi(q[i].z) * bhi(k.z) + bhi(q[i].w) * bhi(k.w); }
    return a0 + a1;
}

struct Args { const float* x; const float* norm_g; const float* w_in; const float* b_merge; const float* w_pa; const float* w_pb; const float* w_out; const float* final_g;
              float* out; unsigned char* ws; };

#define PHASE_VARS() \
    int tid_ = threadIdx.x; asm volatile("" : "+v"(tid_)); \
    const int lane = tid_ & 63, wave = __builtin_amdgcn_readfirstlane(tid_ >> 6); \
    const int G = gridDim.x, gw = blockIdx.x * NWAVES + wave, NGW = G * NWAVES; \
    unsigned long long wsb_ = (unsigned long long)a.ws; asm volatile("" : "+s"(wsb_)); \
    unsigned char* const ws = (unsigned char*)(__attribute__((address_space(1))) unsigned char*)wsb_;     \
    bf16* const Win = (bf16*)(ws + (layer == 0 ? WS_WIN : WS_WIN1)); float* const rowss = (float*)(ws + WS_ROWSS); signed char* const XB8 = (signed char*)(ws + WS_XB8); signed char* const W8 = (signed char*)(ws + WS_W8); float* const wscale = (float*)(ws + WS_COLMAX); float* const xscale = (float*)(ws + WS_XSCALE); bf16* const Wcat = (bf16*)(ws + WS_WCAT); bf16* const Wout = (bf16*)(ws + WS_WOUT); \
    bf16* const XB = (bf16*)(ws + WS_XB); bf16* const P = (bf16*)(ws + WS_PROJ); float* const kmean = (float*)(ws + WS_KMEAN); unsigned char* const gatesb = ws + WS_GATES; \
    (void)lane; (void)wave; (void)G; (void)gw; (void)NGW; (void)Win; (void)Wcat; (void)Wout; (void)rowss; (void)XB8; (void)W8; (void)wscale; (void)xscale; (void)XB; (void)P; (void)kmean; (void)gatesb;

#define GRID_BAR() do { unsigned long long wb_ = (unsigned long long)a.ws; asm volatile("" : "+s"(wb_)); XcdBarrier bb_; bb_.bar = (unsigned*)(__attribute__((address_space(1))) unsigned*)wb_; \
    bb_.x = xb_xcc_id(); bb_.st = (volatile LAS unsigned*)(L + LDS_MISC); xcd_barrier(bb_); } while (0)
template <int layer> __device__ __forceinline__ void layer_fwd(const Args& a, unsigned char* lds, LAS unsigned char* L) {
    if (layer == 0) {
        PHASE_VARS();
        LAS float* scr = (LAS float*)(L + wave * 16384);
        constexpr int I_IN = (DM / 64) * (pg8::NBT * 8), I_PA = (256 / 64) * (DM / 32), I_PB = (512 / 64) * (DM / 32), I_OUT = (DM / 64) * (DM / 32);
        const int nitems = 2 * (I_IN + I_PA + I_PB + I_OUT);
        for (int it = gw; it < nitems; it += NGW) {
            const int l2 = it / (I_IN + I_PA + I_PB + I_OUT); int r = it - l2 * (I_IN + I_PA + I_PB + I_OUT);
            if (r < I_IN) { const int kb_ = r / (pg8::NBT * 8 + (pg8::NBT == 0)), nb_ = r % (pg8::NBT * 8 + (pg8::NBT == 0)), tj_ = nb_ >> 3, tl_ = pg8::tile_of(tj_ + pg8::N8T);
                transpose_item(a.w_in + (size_t)l2 * DM * INC, DM, INC, (bf16*)(ws + (l2 == 0 ? WS_WIN : WS_WIN1)), DM, scr, kb_ * (INC / 32) + nb_, lane, a.norm_g + l2 * DM, 256 * tl_ + 32 * (nb_ & 7)); continue; } r -= I_IN;
            if (r < I_PA) { transpose_item(a.w_pa + (size_t)l2 * 256 * DM, 256, DM, Wcat + (size_t)l2 * DM * 768, 768, scr, r, lane); continue; } r -= I_PA;
            if (r < I_PB) { transpose_item(a.w_pb + (size_t)l2 * 512 * DM, 512, DM, Wcat + (size_t)l2 * DM * 768 + 256, 768, scr, r, lane); continue; } r -= I_PB;
            transpose_item(a.w_out + (size_t)l2 * DM * DM, DM, DM, Wout + (size_t)l2 * DM * DM, DM, scr, r, lane);
        }
        for (int i = gw * 64 + lane; i < 2 * 128 * 512; i += NGW * 64) kmean[i] = 0.f;
        for (int it = (int)blockIdx.x; it < 2 * (W8R / 32); it += G) { const int l2 = it / (W8R / 32);
            quant_strip_wg(a.w_in + (size_t)l2 * DM * INC, a.norm_g + l2 * DM, W8 + (size_t)l2 * W8R * 1024, wscale + l2 * W8R, scr, (LAS float*)(L + 12288), it % (W8R / 32), lane, wave); }
        for (int m = gw; m < M; m += NGW) raw_row(a.x + (size_t)m * DM, XB + (size_t)m * DM, rowss + (size_t)m * 16, XB8 + (size_t)m * DM, xscale + m, lane);
    }
    if (layer == 0) GRID_BAR();
    if (layer == 1) {
        PHASE_VARS();
        for (int m = gw; m < M; m += NGW) quant_row(XB + (size_t)m * DM, XB8 + (size_t)m * DM, xscale + m, lane);
    }
    if (layer == 1) GRID_BAR();
    {
        PHASE_VARS();
        if (threadIdx.x == 0) ((LAS int*)(L + LDS_RSTAB))[256] = -1;
        __syncthreads();
        {
            pg8::Gemm g8{(const pg8::bf16_t*)XB8, (const pg8::bf16_t*)(W8 + (size_t)layer * W8R * 1024), M, 256 * pg8::N8T, 512, 512}; pg8::StaticOrder S8; S8.init(M, 256 * pg8::N8T, G, (int)blockIdx.x);
            pg8::EpiProjQ8 E8{P, LDP, wscale + layer * W8R, xscale, rowss + (size_t)layer * M * 16, kmean + layer * 128 * 512};
            pg8::gemm_phase<pg8::EpiProjQ8, pg8::StaticOrder, true, true>(L, g8, S8, E8);
        }
        if (pg8::NBT > 0) {
            if (threadIdx.x == 0) ((LAS int*)(L + LDS_RSTAB))[256] = -1;
            __syncthreads();
            pg8::Gemm g{XB, Win, M, 256 * pg8::NBT, DM, DM}; pg8::StaticOrder S; S.init(M, 256 * pg8::NBT, G, (int)blockIdx.x);
            pg8::EpiProj E{P, LDP, kmean + layer * 128 * 512, rowss + (size_t)layer * M * 16};
            pg8::gemm_phase<pg8::EpiProj, pg8::StaticOrder, true, true>(L, g, S, E);
        }
    }
    GRID_BAR();
    {
        PHASE_VARS();
        const int vcu = (G % 8 == 0) ? ((int)blockIdx.x % 8) * (G / 8) + (int)blockIdx.x / 8 : (int)blockIdx.x;
#pragma unroll 1
        for (int pass = 0; pass < 2; ++pass) {
            if ((pass ^ (vcu >> 2)) & 1) {
                for (int it = (int)blockIdx.x; it < BATCH * 4 * 4; it += G) attna::wg_item((attna::bf16*)P, it >> 4, (it >> 2) & 3, it & 3, (char*)lds);
            } else {
                for (int p = vcu; p < BATCH * 8 * 4; p += G) {
                    const int bh = p >> 2, s = p & 3;
#pragma unroll 1
                    for (int u = 0; u < 2; ++u)
                        moba::moba_unit<8>(bh >> 3, bh & 7, u ? 7 - s : s, (const moba::bf16*)(P + C_BQKV), (const moba::bf16*)(P + C_BQKV + 512), (const moba::bf16*)(P + C_BQKV + 1024), (const moba::bf16*)(P + C_ZB), (moba::bf16*)(P + C_BQKV), kmean + layer * 128 * 512, (char*)lds);
                }
            }
        }
    }
    GRID_BAR();
    {
        PHASE_VARS();
        pg8::StaticOrder S; S.init(M, DM, G, (int)blockIdx.x);
        {
            struct GateOrder { pg8::StaticOrder S;
                __device__ __forceinline__ bool next(int i, pg8::Unit& u) const { if (!S.next(i >> 1, u)) return false; u.pn += 4 * (i & 1); return true; }
                __device__ __forceinline__ void a_ready(const pg8::Unit&) const {} __device__ __forceinline__ void done(const pg8::Unit&) const {} } GS{S};
            if (threadIdx.x == 0) ((LAS int*)(L + LDS_RSTAB))[256] = -1;
            __syncthreads();
            pg8::Gemm gg{(const pg8::bf16_t*)XB8, (const pg8::bf16_t*)(W8 + ((size_t)layer * W8R + 256 * pg8::N8T) * 1024), M, 2048, 512, 512};
            pg8::EpiGate EG{a.b_merge + layer * 2 * DM, wscale + layer * W8R + 256 * pg8::N8T, xscale, rowss + (size_t)layer * M * 16, gatesb};
            pg8::gemm_phase<pg8::EpiGate, GateOrder, true, true>(L, gg, GS, EG);
        }
        pg8::Gemm g{P + C_ZA, Wcat + (size_t)layer * DM * 768, M, DM, 768, LDP}; pg8::EpiMerge E{P + C_MERGED, gatesb, LDP};
        pg8::gemm_phase<pg8::EpiMerge, pg8::StaticOrder, true, true>(L, g, S, E);
    }
    GRID_BAR();
    {
        PHASE_VARS();
        pg8::Gemm g{P + C_MERGED, Wout + (size_t)layer * DM * DM, M, DM, DM, LDP}; pg8::StaticOrder S; S.init(M, DM, G, (int)blockIdx.x);
        pg8::EpiResid<layer> E{a.x, XB, rowss + (layer == 0 ? (size_t)M * 16 : 0), DM};
        pg8::gemm_phase<pg8::EpiResid<layer>, pg8::StaticOrder, true, true>(L, g, S, E);
    }
    GRID_BAR();
}

__global__ void __launch_bounds__(NWAVES * 64, 2) hybrid_fwd(Args a) {
    extern __shared__ __attribute__((aligned(16))) unsigned char lds[];
    LAS unsigned char* L = (LAS unsigned char*)lds;
    if (threadIdx.x < 16) ((LAS unsigned*)(L + LDS_MISC))[threadIdx.x] = 0u;
    __syncthreads();
    (void)xcd_barrier_post((unsigned*)a.ws, (volatile LAS unsigned*)(L + LDS_MISC));
    layer_fwd<0>(a, lds, L);
    layer_fwd<1>(a, lds, L);
    {
        constexpr int layer = 1; (void)layer;
        PHASE_VARS();
        typedef unsigned u32x2_t __attribute__((ext_vector_type(2)));
        f32x4 gg[4];
#pragma unroll
        for (int j = 0; j < 4; ++j) gg[j] = *((const f32x4*)a.final_g + lane + 64 * j);
        for (int m = gw; m < M; m += NGW) {
            const f32x4* pp = (const f32x4*)(rowss + (size_t)m * 16); const f32x4 s4 = (pp[0] + pp[1]) + (pp[2] + pp[3]);
            const float rstd = __builtin_amdgcn_rsqf(((s4[0] + s4[1]) + (s4[2] + s4[3])) * (1.0f / 1024.0f) + RMS_EPS);
            const u32x2_t* xb = (const u32x2_t*)(XB + (size_t)m * DM) + lane; f32x4* o = (f32x4*)(a.out + (size_t)m * DM) + lane;
            u32x2_t bv[4];
#pragma unroll
            for (int j = 0; j < 4; ++j) bv[j] = __builtin_nontemporal_load(xb + 64 * j);
#pragma unroll
            for (int j = 0; j < 4; ++j) __builtin_nontemporal_store((f32x4){blo(bv[j].x), bhi(bv[j].x), blo(bv[j].y), bhi(bv[j].y)} * rstd * gg[j], o + 64 * j);
        }
    }
}

extern "C" void kernel_launch(void* const* d_in, const int* in_sizes, int n_in, void* d_out, int out_size, void* d_ws, size_t ws_size, hipStream_t stream) {
    static int grid = 0;
    if (grid == 0) {
        if (n_in != 8 || in_sizes[0] != M * DM || out_size != M * DM || ws_size < WS_END) { fprintf(stderr, "kernel_launch: unexpected shapes / workspace (n_in %d, ws %zu)\n", n_in, ws_size); grid = -1; return; }
        int dev = 0, cus = 0, per_cu = 0;
        hipGetDevice(&dev); hipDeviceGetAttribute(&cus, hipDeviceAttributeMultiprocessorCount, dev);
        if (hipFuncSetAttribute((const void*)hybrid_fwd, hipFuncAttributeMaxDynamicSharedMemorySize, LDS_BYTES) != hipSuccess) { fprintf(stderr, "kernel_launch: hipFuncSetAttribute failed\n"); grid = -1; return; }
        if (hipOccupancyMaxActiveBlocksPerMultiprocessor(&per_cu, (const void*)hybrid_fwd, NWAVES * 64, LDS_BYTES) != hipSuccess || per_cu < 1) { fprintf(stderr, "kernel_launch: the occupancy query admits %d workgroups per CU; nothing launched\n", per_cu); grid = -1; return; }
        (void)hipGetLastError();
        grid = cus;
    }
    if (grid < 0) return;
    if (hipMemsetAsync((char*)d_ws + WS_BAR, 0, WS_BAR_BYTES, stream) != hipSuccess) { fprintf(stderr, "kernel_launch: hipMemsetAsync failed\n"); return; }
    Args a{};
    a.x = (const float*)d_in[0]; a.norm_g = (const float*)d_in[1]; a.w_in = (const float*)d_in[2]; a.b_merge = (const float*)d_in[3];
    a.w_pa = (const float*)d_in[4]; a.w_pb = (const float*)d_in[5]; a.w_out = (const float*)d_in[6]; a.final_g = (const float*)d_in[7];
    a.out = (float*)d_out; a.ws = (unsigned char*)d_ws;
    hipLaunchKernelGGL(hybrid_fwd, dim3(grid), dim3(NWAVES * 64), LDS_BYTES, stream, a);
    const hipError_t e = hipPeekAtLastError();
    if (e != hipSuccess) fprintf(stderr, "kernel_launch: launch failed: %s (grid %d)\n", hipGetErrorString(e), grid);
}
```
